# Optimizing an MI355X kernel written in HIP

```python
import math
import jax
import jax.numpy as jnp
from jax import lax
import numpy as np

D_MODEL = 1024
BATCH = 8
SEQ = 2048
DEPTH = 1

ATTN_HEADS = 8
HEAD_DIM = 64
ATTN_WIDTH = ATTN_HEADS * HEAD_DIM
IDX_HEADS = 8
IDX_DIM = 32
MAX_TOPK_KEYS = 256
Q_BLOCK = 64
SSD_HEADS = 8
SSD_HEAD_DIM = 64
SSD_WIDTH = SSD_HEADS * SSD_HEAD_DIM
SSD_GROUPS = 2
D_STATE = 128
CONV_WIDTH = 4
CHUNK = 128
MIX_WIDTH = ATTN_WIDTH + SSD_WIDTH
PEER_HEADS = 8
N_KEYS = 128
N_EXPERTS = N_KEYS * N_KEYS
PEER_QUERY_DIM = 256
PEER_HALF = PEER_QUERY_DIM // 2
PEER_SUB_TOPK = 16
PEER_TOPK = 16
TOK_BLOCK = 128
ROPE_THETA = 10000.0
LN_EPS = 1e-5
DEEPNORM_ALPHA = (2 * DEPTH) ** 0.25
DEEPNORM_BETA = (8 * DEPTH) ** -0.25

IN_SIZES = (ATTN_WIDTH, ATTN_WIDTH, ATTN_WIDTH, IDX_HEADS * IDX_DIM, IDX_DIM, IDX_HEADS,
            SSD_WIDTH, SSD_WIDTH + 2 * SSD_GROUPS * D_STATE, SSD_HEADS)
IN_WIDTH = sum(IN_SIZES)
SPLIT_POINTS = tuple(sum(IN_SIZES[:i + 1]) for i in range(len(IN_SIZES) - 1))
XBC_WIDTH = SSD_WIDTH + 2 * SSD_GROUPS * D_STATE

kernel_name = "hymba_dsa_ssd_peer_deepnorm"


def layer_norm(x, g, b):
    xf = x.astype(jnp.float32)
    mu = jnp.mean(xf, -1, keepdims=True)
    var = jnp.mean(jnp.square(xf - mu), -1, keepdims=True)
    y = (xf - mu) * lax.rsqrt(var + LN_EPS)
    return (y * g.astype(jnp.float32) + b.astype(jnp.float32)).astype(x.dtype)


def rope(x, positions):
    d = x.shape[-1]
    inv = ROPE_THETA ** (-jnp.arange(0, d, 2, dtype=jnp.float32) / d)
    ang = positions.astype(jnp.float32)[..., None] * inv
    ang = ang.reshape(ang.shape[:2] + (1,) * (x.ndim - 3) + ang.shape[-1:])
    cos = jnp.cos(ang).astype(x.dtype)
    sin = jnp.sin(ang).astype(x.dtype)
    x1, x2 = x[..., : d // 2], x[..., d // 2:]
    return jnp.concatenate([x1 * cos - x2 * sin, x2 * cos + x1 * sin], axis=-1)


def dsa_attention(q, k, v, iq, ik, iw, positions):
    bsz, seq, _ = q.shape
    q = rope(q.reshape(bsz, seq, ATTN_HEADS, HEAD_DIM), positions)
    k = rope(k.reshape(bsz, seq, ATTN_HEADS, HEAD_DIM), positions)
    v = v.reshape(bsz, seq, ATTN_HEADS, HEAD_DIM)
    iq = rope(iq.reshape(bsz, seq, IDX_HEADS, IDX_DIM), positions)
    ik = rope(ik, positions)
    iw = iw * (IDX_HEADS ** -0.5)
    topk = min(MAX_TOPK_KEYS, seq // 4)
    nb = seq // Q_BLOCK
    key_pos = jnp.arange(seq)

    def blockify(a):
        return a.reshape((bsz, nb, Q_BLOCK) + a.shape[2:]).swapaxes(0, 1)

    def one_block(args):
        qb, iqb, iwb, start = args
        t = start + jnp.arange(Q_BLOCK)
        rel = jax.nn.relu(jnp.einsum('bqhd,bsd->bqhs', iqb, ik) * (IDX_DIM ** -0.5))
        score = jnp.einsum('bqh,bqhs->bqs', iwb, rel).astype(jnp.float32)
        causal = key_pos[None, :] <= t[:, None]
        score = jnp.where(causal[None], score, -jnp.inf)
        _, idx = lax.top_k(score, topk)
        kg = jax.vmap(lambda kb, ib: kb[ib])(k, idx)
        vg = jax.vmap(lambda vb, ib: vb[ib])(v, idx)
        logits = jnp.einsum('bqhd,bqkhd->bqhk', qb, kg).astype(jnp.float32) * (HEAD_DIM ** -0.5)
        valid = idx <= t[None, :, None]
        logits = jnp.where(valid[:, :, None, :], logits, -jnp.inf)
        p = jax.nn.softmax(logits, axis=-1).astype(vg.dtype)
        return jnp.einsum('bqhk,bqkhd->bqhd', p, vg)

    starts = jnp.arange(nb, dtype=jnp.int32) * Q_BLOCK
    out = lax.map(one_block, (blockify(q), blockify(iq), blockify(iw), starts))
    return out.swapaxes(0, 1).reshape(bsz, seq, ATTN_WIDTH)


def segsum(a):
    t = a.shape[-1]
    ac = jnp.cumsum(a, axis=-1)
    seg = ac[..., :, None] - ac[..., None, :]
    mask = jnp.tril(jnp.ones((t, t), dtype=bool))
    return jnp.where(mask, seg, -jnp.inf)


def ssd_scan(xs, dt, a, bm, cm):
    bsz, seq, nh, hp = xs.shape
    nc = seq // CHUNK
    rep = nh // bm.shape[2]
    bm = jnp.repeat(bm, rep, axis=2)
    cm = jnp.repeat(cm, rep, axis=2)
    n = bm.shape[-1]
    xc = (xs * dt[..., None]).reshape(bsz, nc, CHUNK, nh, hp)
    bc = bm.reshape(bsz, nc, CHUNK, nh, n)
    cc = cm.reshape(bsz, nc, CHUNK, nh, n)
    ac = (dt * a).reshape(bsz, nc, CHUNK, nh).transpose(0, 3, 1, 2)
    a_cum = jnp.cumsum(ac, axis=-1)
    decay_in = jnp.exp(segsum(ac))
    cb = jnp.einsum('bclhn,bcshn->bhcls', cc, bc)
    y_diag = jnp.einsum('bhcls,bcshp->bclhp', cb * decay_in, xc)
    decay_to_end = jnp.exp(a_cum[..., -1:] - a_cum).transpose(0, 2, 3, 1)
    states = jnp.einsum('bclhn,bclhp->bchpn', bc, xc * decay_to_end[..., None])
    states = jnp.concatenate([jnp.zeros_like(states[:, :1]), states], axis=1)
    chunk_decay = jnp.exp(segsum(jnp.pad(a_cum[..., -1], ((0, 0), (0, 0), (1, 0)))))
    carried = jnp.einsum('bhzc,bchpn->bzhpn', chunk_decay, states)[:, :-1]
    y_off = jnp.einsum('bclhn,bchpn->bclhp', cc, carried) * jnp.exp(a_cum).transpose(0, 2, 3, 1)[..., None]
    return (y_diag + y_off).reshape(bsz, seq, nh, hp)


def ssd_mixer(z, xbc, dt, conv_w, conv_b, dt_bias, a_log, d_skip, norm_w):
    bsz, seq, _ = z.shape
    xbc = lax.conv_general_dilated(
        xbc, conv_w[:, None, :].astype(xbc.dtype), window_strides=(1,),
        padding=[(CONV_WIDTH - 1, 0)], dimension_numbers=('NWC', 'WIO', 'NWC'),
        feature_group_count=XBC_WIDTH) + conv_b.astype(xbc.dtype)
    xbc = jax.nn.silu(xbc).astype(jnp.float32)
    xs = xbc[..., :SSD_WIDTH].reshape(bsz, seq, SSD_HEADS, SSD_HEAD_DIM)
    bm = xbc[..., SSD_WIDTH:SSD_WIDTH + SSD_GROUPS * D_STATE].reshape(bsz, seq, SSD_GROUPS, D_STATE)
    cm = xbc[..., SSD_WIDTH + SSD_GROUPS * D_STATE:].reshape(bsz, seq, SSD_GROUPS, D_STATE)
    dt = jax.nn.softplus(dt.astype(jnp.float32) + dt_bias.astype(jnp.float32))
    a = -jnp.exp(a_log.astype(jnp.float32))
    y = ssd_scan(xs, dt, a, bm, cm) + xs * d_skip.astype(jnp.float32)[:, None]
    y = y.reshape(bsz, seq, SSD_WIDTH) * jax.nn.silu(z.astype(jnp.float32))
    yg = y.reshape(bsz, seq, SSD_GROUPS, SSD_WIDTH // SSD_GROUPS)
    yg = yg * lax.rsqrt(jnp.mean(jnp.square(yg), -1, keepdims=True) + LN_EPS)
    y = yg.reshape(bsz, seq, SSD_WIDTH) * norm_w.astype(jnp.float32)
    return y.astype(z.dtype)


def token_mix(x, positions, w_in, conv_w, conv_b, dt_bias, a_log, d_skip, norm_w, w_out):
    proj = x @ w_in
    q, k, v, iq, ik, iw, z, xbc, dt = jnp.split(proj, SPLIT_POINTS, axis=-1)
    attn = dsa_attention(q, k, v, iq, ik, iw, positions)
    ssd = ssd_mixer(z, xbc, dt, conv_w, conv_b, dt_bias, a_log, d_skip, norm_w)
    return jnp.concatenate([attn, ssd], axis=-1) @ w_out


def peer(h, wq, k1, k2, u, v):
    bsz, seq, dm = h.shape
    xt = h.reshape(-1, dm)
    ntok = xt.shape[0]
    q = (xt @ wq).reshape(ntok, PEER_HEADS, 2, PEER_HALF)
    s1 = jnp.einsum('nhd,kd->nhk', q[:, :, 0], k1).astype(jnp.float32)
    s2 = jnp.einsum('nhd,kd->nhk', q[:, :, 1], k2).astype(jnp.float32)
    v1, i1 = lax.top_k(s1, PEER_SUB_TOPK)
    v2, i2 = lax.top_k(s2, PEER_SUB_TOPK)
    cand = (v1[..., :, None] + v2[..., None, :]).reshape(ntok, PEER_HEADS, -1)
    cidx = (i1[..., :, None] * N_KEYS + i2[..., None, :]).reshape(ntok, PEER_HEADS, -1)
    best, pos = lax.top_k(cand, PEER_TOPK)
    eidx = jnp.take_along_axis(cidx, pos, axis=-1).reshape(ntok, PEER_HEADS * PEER_TOPK)
    gate = jax.nn.softmax(best, axis=-1).reshape(ntok, PEER_HEADS * PEER_TOPK).astype(h.dtype)
    nb = ntok // TOK_BLOCK

    def one_block(args):
        xb, ib, gb = args
        act = jax.nn.gelu(jnp.einsum('td,tkd->tk', xb, u[ib]), approximate=False) * gb
        return jnp.einsum('tk,tkd->td', act, v[ib])

    out = lax.map(one_block, (xt.reshape(nb, TOK_BLOCK, dm),
                              eidx.reshape(nb, TOK_BLOCK, -1),
                              gate.reshape(nb, TOK_BLOCK, -1)))
    return out.reshape(bsz, seq, dm)


def setup_inputs(seed: int = 0) -> dict:
    key = jax.random.key(seed)
    ks = jax.random.split(key, 20)
    f32 = jnp.float32
    x = jax.random.normal(ks[0], (BATCH, SEQ, D_MODEL), f32)
    positions = jnp.broadcast_to(jnp.arange(SEQ, dtype=jnp.int32), (BATCH, SEQ))
    col_scale = jnp.ones((IN_WIDTH,), f32).at[2 * ATTN_WIDTH:3 * ATTN_WIDTH].set(DEEPNORM_BETA)
    w_in = jax.random.normal(ks[1], (DEPTH, D_MODEL, IN_WIDTH), f32) * (D_MODEL ** -0.5) * col_scale
    conv_w = jax.random.normal(ks[2], (DEPTH, CONV_WIDTH, XBC_WIDTH), f32) * (CONV_WIDTH ** -0.5)
    conv_b = 0.02 * jax.random.normal(ks[3], (DEPTH, XBC_WIDTH), f32)
    dt0 = jnp.exp(jax.random.uniform(ks[4], (DEPTH, SSD_HEADS), f32, math.log(1e-3), math.log(1e-1)))
    dt_bias = dt0 + jnp.log(-jnp.expm1(-dt0))
    a_log = jnp.log(jax.random.uniform(ks[5], (DEPTH, SSD_HEADS), f32, 1.0, 16.0))
    d_skip = 1.0 + 0.1 * jax.random.normal(ks[6], (DEPTH, SSD_HEADS), f32)
    ssm_norm_w = 1.0 + 0.02 * jax.random.normal(ks[7], (DEPTH, SSD_WIDTH), f32)
    w_out = jax.random.normal(ks[8], (DEPTH, MIX_WIDTH, D_MODEL), f32) * (MIX_WIDTH ** -0.5) * DEEPNORM_BETA
    ln1_g = 1.0 + 0.02 * jax.random.normal(ks[9], (DEPTH, D_MODEL), f32)
    ln1_b = 0.02 * jax.random.normal(ks[10], (DEPTH, D_MODEL), f32)
    peer_wq = jax.random.normal(ks[11], (DEPTH, D_MODEL, PEER_HEADS * PEER_QUERY_DIM), f32) * (D_MODEL ** -0.5)
    peer_k1 = jax.random.normal(ks[12], (DEPTH, N_KEYS, PEER_HALF), f32) * (PEER_HALF ** -0.5)
    peer_k2 = jax.random.normal(ks[13], (DEPTH, N_KEYS, PEER_HALF), f32) * (PEER_HALF ** -0.5)
    peer_u = jax.random.normal(ks[14], (DEPTH, N_EXPERTS, D_MODEL), f32) * (D_MODEL ** -0.5)
    peer_v = jax.random.normal(ks[15], (DEPTH, N_EXPERTS, D_MODEL), f32) * DEEPNORM_BETA
    ln2_g = 1.0 + 0.02 * jax.random.normal(ks[16], (DEPTH, D_MODEL), f32)
    ln2_b = 0.02 * jax.random.normal(ks[17], (DEPTH, D_MODEL), f32)
    return {"x": x, "positions": positions, "w_in": w_in, "conv_w": conv_w, "conv_b": conv_b,
            "dt_bias": dt_bias, "a_log": a_log, "d_skip": d_skip, "ssm_norm_w": ssm_norm_w,
            "w_out": w_out, "ln1_g": ln1_g, "ln1_b": ln1_b, "peer_wq": peer_wq,
            "peer_k1": peer_k1, "peer_k2": peer_k2, "peer_u": peer_u, "peer_v": peer_v,
            "ln2_g": ln2_g, "ln2_b": ln2_b}


def reference(x, positions, w_in, conv_w, conv_b, dt_bias, a_log, d_skip, ssm_norm_w,
              w_out, ln1_g, ln1_b, peer_wq, peer_k1, peer_k2, peer_u, peer_v, ln2_g, ln2_b):
    for i in range(DEPTH):
        mix = token_mix(x, positions, w_in[i], conv_w[i], conv_b[i], dt_bias[i], a_log[i],
                        d_skip[i], ssm_norm_w[i], w_out[i])
        x = layer_norm(DEEPNORM_ALPHA * x + mix, ln1_g[i], ln1_b[i])
        ffn = peer(x, peer_wq[i], peer_k1[i], peer_k2[i], peer_u[i], peer_v[i])
        x = layer_norm(DEEPNORM_ALPHA * x + ffn, ln2_g[i], ln2_b[i])
    return x
```

```cpp
#include <hip/hip_runtime.h>
#include <hip/hip_cooperative_groups.h>
#include <stdint.h>
#include <stdio.h>
namespace cg = cooperative_groups;

typedef unsigned short bf16_t;
typedef short bf16x8 __attribute__((ext_vector_type(8)));
typedef short bf16x4 __attribute__((ext_vector_type(4)));
typedef float f32x4 __attribute__((ext_vector_type(4)));

#ifndef ONE_LAUNCH
#define ONE_LAUNCH 0
#endif

constexpr int NB = 8, SEQ = 2048, DM = 1024, NTOK = NB * SEQ;
constexpr int NP = 3456;
constexpr int QOFF = 0, KOFF = 512, VOFF = 1024, IQOFF = 1536, MISCOFF = 1792, ZOFF = 1856, XBCOFF = 2368, NUSED = 3392;
constexpr float ALPHA = 1.189207115002721f;
constexpr float LN_EPS = 1e-5f;

constexpr size_t MB = 1024 * 1024;
constexpr size_t O_WIN_T = 0;
constexpr size_t O_WOUT_T = O_WIN_T + (size_t)NP * 1024 * 2;
constexpr size_t O_WQ_T = O_WOUT_T + 2 * MB;
constexpr size_t O_K1B = O_WQ_T + 4 * MB;
constexpr size_t O_K2B = O_K1B + 32768;
constexpr size_t O_CS64 = O_K2B + 32768;
constexpr size_t O_CS32 = O_CS64 + 4 * MB;
constexpr size_t O_MIX = O_CS32 + 2 * MB;
constexpr size_t O_R1 = O_MIX + 32 * MB;
constexpr size_t O_XB = O_R1;
constexpr size_t O_XT = O_R1;
constexpr size_t O_BRM = O_XT + 16 * MB;
constexpr size_t O_CRM = O_BRM + 8 * MB;
constexpr size_t O_QB = O_XB + 32 * MB;
constexpr size_t O_KB = O_QB + 16 * MB;
constexpr size_t O_VT = O_KB + 16 * MB;
constexpr size_t O_IQB = O_VT + 16 * MB;
constexpr size_t O_IKB = O_IQB + 8 * MB;
constexpr size_t O_IWF = O_IKB + 1 * MB;
constexpr size_t O_DTF = O_IWF + MB / 2;
constexpr size_t O_ZB = O_DTF + MB / 2;
constexpr size_t O_XBCT = O_ZB + 16 * MB;
constexpr size_t O_ACUM = O_XBCT + 32 * MB;
constexpr size_t O_ATOT = O_ACUM + MB / 2;
constexpr size_t O_ST = O_ATOT + MB / 2;
constexpr size_t O_MASK = O_ST + 32 * MB;
constexpr size_t O_R1_END = O_MASK + 4 * MB;
constexpr size_t O_HB = O_R1;
constexpr size_t O_QP = O_HB + 32 * MB;
constexpr size_t O_EIDX = O_QP + 64 * MB;
constexpr size_t O_GATE = O_EIDX + 8 * MB;
constexpr size_t O_UB = O_GATE + 8 * MB;
constexpr size_t O_VB = O_UB + 32 * MB;
constexpr size_t O_R2_END = O_VB + 32 * MB;
constexpr size_t WS_NEEDED = (O_R1_END > O_R2_END ? O_R1_END : O_R2_END);
static_assert(WS_NEEDED <= 256 * MB, "workspace too large");

struct Params {
    const float* x; const int* pos; const float* w_in; const float* conv_w; const float* conv_b; const float* dt_bias;
    const float* a_log; const float* d_skip; const float* norm_w; const float* w_out; const float* ln1_g; const float* ln1_b;
    const float* wq; const float* k1; const float* k2; const float* u; const float* v; const float* ln2_g; const float* ln2_b;
    float* out; char* ws;
};

#define SMEM_BYTES 71680

__device__ __forceinline__ bf16_t f2bf(float f) {
    unsigned u = __float_as_uint(f);
    u += 0x7FFFu + ((u >> 16) & 1u);
    return (bf16_t)(u >> 16);
}
__device__ __forceinline__ float bf2f(bf16_t b) { return __uint_as_float(((unsigned)b) << 16); }
__device__ __forceinline__ unsigned pack2(float a, float b) { return (unsigned)f2bf(a) | ((unsigned)f2bf(b) << 16); }
__device__ __forceinline__ unsigned f2sort(float f) { unsigned u = __float_as_uint(f); return (u & 0x80000000u) ? ~u : (u | 0x80000000u); }
__device__ __forceinline__ float sort2f(unsigned s) { unsigned u = (s & 0x80000000u) ? (s & 0x7FFFFFFFu) : ~s; return __uint_as_float(u); }
__device__ __forceinline__ f32x4 mfma16(bf16x8 a, bf16x8 b, f32x4 c) { return __builtin_amdgcn_mfma_f32_16x16x32_bf16(a, b, c, 0, 0, 0); }
__device__ __forceinline__ float silu_f(float v) { return v / (1.f + __expf(-v)); }
__device__ __forceinline__ bf16x8 ld8(const bf16_t* p) { return *(const bf16x8*)p; }
__device__ __forceinline__ bf16x8 cat4(bf16x4 lo, bf16x4 hi) { return __builtin_shufflevector(lo, hi, 0, 1, 2, 3, 4, 5, 6, 7); }

__device__ __forceinline__ int win_src_col(int n) {
    if (n < 1832) return n;
    if (n < 1840) return 3368 + (n - 1832);
    if (n < 1856) return -1;
    if (n < 2368) return 1832 + (n - 1856);
    if (n < 3392) return 2344 + (n - 2368);
    return -1;
}
__device__ void p0_transpose(const float* __restrict__ W, int N, int Nout, bool remap, bf16_t* __restrict__ Wt, int gtid, int gsz) {
    const int items = Nout * 128;
    for (int it = gtid; it < items; it += gsz) {
        const int n = it % Nout, kc = it / Nout;
        const int src = remap ? win_src_col(n) : n;
        unsigned w[4] = {0, 0, 0, 0};
        if (src >= 0) {
            float f[8];
#pragma unroll
            for (int j = 0; j < 8; ++j) f[j] = W[(size_t)(kc * 8 + j) * N + src];
#pragma unroll
            for (int j = 0; j < 4; ++j) w[j] = pack2(f[2 * j], f[2 * j + 1]);
        }
        *(uint4*)(Wt + (size_t)n * 1024 + kc * 8) = make_uint4(w[0], w[1], w[2], w[3]);
    }
}
__device__ void p0_convert(const float* __restrict__ src, bf16_t* __restrict__ dst, size_t n4, size_t gtid, size_t gsz) {
    for (size_t i = gtid; i < n4; i += gsz) {
        const float4 f = ((const float4*)src)[i];
        ((uint2*)dst)[i] = make_uint2(pack2(f.x, f.y), pack2(f.z, f.w));
    }
}
__device__ void phase0(const Params& p) {
    const int gtid = blockIdx.x * blockDim.x + threadIdx.x, gsz = gridDim.x * blockDim.x;
    p0_transpose(p.w_in, 3376, NP, true, (bf16_t*)(p.ws + O_WIN_T), gtid, gsz);
    p0_transpose(p.w_out, 1024, 1024, false, (bf16_t*)(p.ws + O_WOUT_T), gtid, gsz);
    p0_transpose(p.wq, 2048, 2048, false, (bf16_t*)(p.ws + O_WQ_T), gtid, gsz);
    p0_convert(p.k1, (bf16_t*)(p.ws + O_K1B), 128 * 128 / 4, gtid, gsz);
    p0_convert(p.k2, (bf16_t*)(p.ws + O_K2B), 128 * 128 / 4, gtid, gsz);
    p0_convert(p.x, (bf16_t*)(p.ws + O_XB), (size_t)NTOK * DM / 4, gtid, gsz);
    float2* cs64 = (float2*)(p.ws + O_CS64); float2* cs32 = (float2*)(p.ws + O_CS32);
    for (int it = gtid; it < NTOK * 48; it += gsz) {
        const int m = it / 48, i = it % 48;
        const float ps = (float)p.pos[m];
        if (i < 32) { const float inv = powf(10000.f, -(float)(2 * i) / 64.f); const float a = ps * inv; cs64[m * 32 + i] = make_float2(cosf(a), sinf(a)); }
        else { const int k = i - 32; const float inv = powf(10000.f, -(float)(2 * k) / 32.f); const float a = ps * inv; cs32[m * 16 + k] = make_float2(cosf(a), sinf(a)); }
    }
}

#define GEMM_LDS_A (256 * 72 * 2)
template <class Epi>
__device__ __forceinline__ void gemm_tile(const bf16_t* __restrict__ A, const bf16_t* __restrict__ Bt, int K, int m0, int n0, const Epi& epi, char* smem) {
    const int tid = threadIdx.x, lane = tid & 63, w = tid >> 6, wm = w >> 1, wn = w & 1;
    bf16_t* sA = (bf16_t*)smem; bf16_t* sB = (bf16_t*)(smem + GEMM_LDS_A);
    f32x4 acc[4][4];
#pragma unroll
    for (int i = 0; i < 4; ++i)
#pragma unroll
        for (int j = 0; j < 4; ++j) acc[i][j] = (f32x4){0.f, 0.f, 0.f, 0.f};
    const int lrow = tid >> 3, lkc = (tid & 7) * 8;
    const bf16_t* ga = A + (size_t)(m0 + lrow) * K + lkc;
    const bf16_t* gb = Bt + (size_t)(n0 + lrow) * K + lkc;
    const size_t astep = (size_t)64 * K;
    uint4 ra0, ra1, ra2, ra3, rb0, rb1;
    ra0 = *(const uint4*)(ga); ra1 = *(const uint4*)(ga + astep); ra2 = *(const uint4*)(ga + 2 * astep); ra3 = *(const uint4*)(ga + 3 * astep);
    rb0 = *(const uint4*)(gb); rb1 = *(const uint4*)(gb + astep);
    bf16_t* wa = sA + lrow * 72 + lkc; bf16_t* wb = sB + lrow * 72 + lkc;
    for (int k0 = 0; k0 < K; k0 += 64) {
        __syncthreads();
        *(uint4*)(wa) = ra0; *(uint4*)(wa + 64 * 72) = ra1; *(uint4*)(wa + 128 * 72) = ra2; *(uint4*)(wa + 192 * 72) = ra3;
        *(uint4*)(wb) = rb0; *(uint4*)(wb + 64 * 72) = rb1;
        __syncthreads();
        if (k0 + 64 < K) {
            ga += 64; gb += 64;
            ra0 = *(const uint4*)(ga); ra1 = *(const uint4*)(ga + astep); ra2 = *(const uint4*)(ga + 2 * astep); ra3 = *(const uint4*)(ga + 3 * astep);
            rb0 = *(const uint4*)(gb); rb1 = *(const uint4*)(gb + astep);
        }
#pragma unroll
        for (int ks = 0; ks < 2; ++ks) {
            bf16x8 a[4], b[4];
#pragma unroll
            for (int i = 0; i < 4; ++i) a[i] = ld8(sA + (wm * 64 + i * 16 + (lane & 15)) * 72 + ks * 32 + (lane >> 4) * 8);
#pragma unroll
            for (int i = 0; i < 4; ++i) b[i] = ld8(sB + (wn * 64 + i * 16 + (lane & 15)) * 72 + ks * 32 + (lane >> 4) * 8);
#pragma unroll
            for (int i = 0; i < 4; ++i)
#pragma unroll
                for (int j = 0; j < 4; ++j) acc[i][j] = mfma16(a[i], b[j], acc[i][j]);
        }
    }
    epi(acc, m0 + wm * 64, n0 + wn * 64, lane);
}

struct ProjEpi {
    bf16_t *Qb, *Kb, *Vt, *IQb, *IKb, *Zb, *XBCt; float *IWf, *DTf; const float2 *cs64, *cs32; const float* dt_bias;
    __device__ __forceinline__ void operator()(const f32x4 (&acc)[4][4], int mb, int nb, int lane) const {
        const int c = lane & 15, g = lane >> 4;
        if (nb < 1024) {
            const bool isq = nb < 512; const int head = (nb & 511) >> 6; bf16_t* dst = isq ? Qb : Kb; const float sc = isq ? 0.125f : 1.f;
#pragma unroll
            for (int mi = 0; mi < 4; ++mi)
#pragma unroll
                for (int r = 0; r < 4; ++r) {
                    const int m = mb + 16 * mi + 4 * g + r, b = m >> 11, t = m & 2047;
                    bf16_t* row = dst + ((size_t)(b * 8 + head) * 2048 + t) * 64;
#pragma unroll
                    for (int ni = 0; ni < 2; ++ni) {
                        const int i = 16 * ni + c; const float2 cs = cs64[(size_t)m * 32 + i];
                        const float x1 = acc[mi][ni][r], x2 = acc[mi][ni + 2][r];
                        row[i] = f2bf((x1 * cs.x - x2 * cs.y) * sc); row[i + 32] = f2bf((x2 * cs.x + x1 * cs.y) * sc);
                    }
                }
        } else if (nb < 1536) {
            const int head = (nb - 1024) >> 6;
#pragma unroll
            for (int mi = 0; mi < 4; ++mi) {
                const int m = mb + 16 * mi + 4 * g, b = m >> 11, t0 = m & 2047;
#pragma unroll
                for (int ni = 0; ni < 4; ++ni) {
                    const int d = 16 * ni + c;
                    *(uint2*)(Vt + ((size_t)(b * 8 + head) * 64 + d) * 2048 + t0) = make_uint2(pack2(acc[mi][ni][0], acc[mi][ni][1]), pack2(acc[mi][ni][2], acc[mi][ni][3]));
                }
            }
        } else if (nb < 1792) {
            const float isc = 0.17677669529663687f;
#pragma unroll
            for (int pr = 0; pr < 2; ++pr) {
                const int headi = ((nb - 1536) >> 5) + pr;
#pragma unroll
                for (int mi = 0; mi < 4; ++mi)
#pragma unroll
                    for (int r = 0; r < 4; ++r) {
                        const int m = mb + 16 * mi + 4 * g + r; const float2 cs = cs32[(size_t)m * 16 + c];
                        const float x1 = acc[mi][2 * pr][r], x2 = acc[mi][2 * pr + 1][r];
                        bf16_t* dst = IQb + ((size_t)m * 8 + headi) * 32;
                        dst[c] = f2bf((x1 * cs.x - x2 * cs.y) * isc); dst[c + 16] = f2bf((x2 * cs.x + x1 * cs.y) * isc);
                    }
            }
        } else if (nb == 1792) {
#pragma unroll
            for (int mi = 0; mi < 4; ++mi)
#pragma unroll
                for (int r = 0; r < 4; ++r) {
                    const int m = mb + 16 * mi + 4 * g + r; const float2 cs = cs32[(size_t)m * 16 + c];
                    const float x1 = acc[mi][0][r], x2 = acc[mi][1][r];
                    bf16_t* dst = IKb + (size_t)m * 32;
                    dst[c] = f2bf(x1 * cs.x - x2 * cs.y); dst[c + 16] = f2bf(x2 * cs.x + x1 * cs.y);
                    const float v = acc[mi][2][r];
                    if (c < 8) IWf[(size_t)m * 8 + c] = v * 0.35355339059327373f;
                    else { const float xx = v + dt_bias[c - 8]; DTf[(size_t)m * 8 + (c - 8)] = (xx > 20.f) ? xx : log1pf(expf(xx)); }
                }
        } else if (nb < 2368) {
#pragma unroll
            for (int mi = 0; mi < 4; ++mi)
#pragma unroll
                for (int r = 0; r < 4; ++r) {
                    const int m = mb + 16 * mi + 4 * g + r;
#pragma unroll
                    for (int ni = 0; ni < 4; ++ni) Zb[(size_t)m * 512 + (nb - ZOFF) + 16 * ni + c] = f2bf(acc[mi][ni][r]);
                }
        } else if (nb < 3392) {
#pragma unroll
            for (int mi = 0; mi < 4; ++mi) {
                const int m = mb + 16 * mi + 4 * g, b = m >> 11, t0 = m & 2047;
#pragma unroll
                for (int ni = 0; ni < 4; ++ni) {
                    const int ch = nb - XBCOFF + 16 * ni + c;
                    *(uint2*)(XBCt + ((size_t)b * 1024 + ch) * 2048 + t0) = make_uint2(pack2(acc[mi][ni][0], acc[mi][ni][1]), pack2(acc[mi][ni][2], acc[mi][ni][3]));
                }
            }
        }
    }
};
__device__ void phase1(const Params& p, char* smem) {
    ProjEpi e; char* ws = p.ws;
    e.Qb = (bf16_t*)(ws + O_QB); e.Kb = (bf16_t*)(ws + O_KB); e.Vt = (bf16_t*)(ws + O_VT); e.IQb = (bf16_t*)(ws + O_IQB); e.IKb = (bf16_t*)(ws + O_IKB);
    e.Zb = (bf16_t*)(ws + O_ZB); e.XBCt = (bf16_t*)(ws + O_XBCT); e.IWf = (float*)(ws + O_IWF); e.DTf = (float*)(ws + O_DTF);
    e.cs64 = (const float2*)(ws + O_CS64); e.cs32 = (const float2*)(ws + O_CS32); e.dt_bias = p.dt_bias;
    const int ntn = NP / 128, ntm = NTOK / 256;
    for (int t = blockIdx.x; t < ntn * ntm; t += gridDim.x) {
        const int tn = t % ntn, tm = t / ntn;
        gemm_tile((const bf16_t*)(ws + O_XB), (const bf16_t*)(ws + O_WIN_T), 1024, tm * 256, tn * 128, e, smem);
    }
}

#define IDX_NT 16
__device__ __forceinline__ void idx_total(unsigned (&cn)[4], unsigned* lc, int par, int w, int c, int g, unsigned (&tot)[4]) {
#pragma unroll
    for (int r = 0; r < 4; ++r) { cn[r] += __shfl_xor(cn[r], 1); cn[r] += __shfl_xor(cn[r], 2); cn[r] += __shfl_xor(cn[r], 4); cn[r] += __shfl_xor(cn[r], 8); }
    if (c == 0) {
#pragma unroll
        for (int r = 0; r < 4; ++r) lc[(par * 8 + w) * 16 + 4 * g + r] = cn[r];
    }
    __syncthreads();
#pragma unroll
    for (int r = 0; r < 4; ++r) {
        unsigned t = 0;
#pragma unroll
        for (int ww = 0; ww < 8; ++ww) t += lc[(par * 8 + ww) * 16 + 4 * g + r];
        tot[r] = t;
    }
}
__device__ void indexer_unit(const Params& p, int unit, char* smem) {
    const int tid = threadIdx.x, lane = tid & 63, w = tid >> 6, c = lane & 15, g = lane >> 4;
    const int b = unit & 7, grp = 127 - (unit >> 3), t0 = grp * 16;
    char* ws = p.ws;
    unsigned short* mask = (unsigned short*)(ws + O_MASK) + (size_t)(b * 2048 + t0) * 128;
    const int nblk64 = (t0 + 16 + 63) >> 6;
    const int ntile = (nblk64 + 1) >> 1;
    if (t0 < 256) {
        if (lane < 16) {
            const int t = t0 + lane;
            for (int i = 0; i < ntile; ++i) {
                const int tg = w * ntile + i, s0 = tg * 16;
                const unsigned bits = (t >= s0 + 15) ? 0xFFFFu : (t < s0 ? 0u : ((1u << (t - s0 + 1)) - 1u));
                mask[lane * 128 + tg] = (unsigned short)bits;
            }
        }
        return;
    }
    const bf16_t* IQb = (const bf16_t*)(ws + O_IQB); const bf16_t* IKb = (const bf16_t*)(ws + O_IKB); const float* IWf = (const float*)(ws + O_IWF);
    unsigned* lc = (unsigned*)smem;
    float* siw = (float*)(smem + 1024);
    __syncthreads();
    if (tid < 128) siw[tid] = IWf[(size_t)(b * 2048 + t0) * 8 + tid];
    __syncthreads();
    bf16x8 aq[8];
#pragma unroll
    for (int h = 0; h < 8; ++h) aq[h] = ld8(IQb + ((size_t)(b * 2048 + t0 + c) * 8 + h) * 32 + g * 8);
    unsigned sk[IDX_NT][4];
#pragma unroll
    for (int i = 0; i < IDX_NT; ++i) {
        if (i < ntile) {
            const int s0 = (w * ntile + i) * 16;
            const bf16x8 bk = ld8(IKb + (size_t)(b * 2048 + s0 + c) * 32 + g * 8);
            float sc[4] = {0.f, 0.f, 0.f, 0.f};
#pragma unroll
            for (int h = 0; h < 8; ++h) {
                const f32x4 o = mfma16(aq[h], bk, (f32x4){0.f, 0.f, 0.f, 0.f});
#pragma unroll
                for (int r = 0; r < 4; ++r) sc[r] += siw[(4 * g + r) * 8 + h] * fmaxf(o[r], 0.f);
            }
#pragma unroll
            for (int r = 0; r < 4; ++r) sk[i][r] = (s0 + c <= t0 + 4 * g + r) ? f2sort(sc[r]) : 0u;
        } else {
#pragma unroll
            for (int r = 0; r < 4; ++r) sk[i][r] = 0u;
        }
    }
    int par = 0;
    unsigned K[4] = {0u, 0u, 0u, 0u}; bool done[4] = {false, false, false, false};
    for (int bit = 31; bit >= 0; --bit) {
        unsigned cand[4], cn[4], tot[4];
#pragma unroll
        for (int r = 0; r < 4; ++r) { cand[r] = K[r] | (1u << bit); cn[r] = 0u; }
#pragma unroll
        for (int i = 0; i < IDX_NT; ++i)
            if (i < ntile) {
#pragma unroll
                for (int r = 0; r < 4; ++r) cn[r] += (sk[i][r] >= cand[r]) ? 1u : 0u;
            }
        idx_total(cn, lc, par, w, c, g, tot); par ^= 1;
        bool alld = true;
#pragma unroll
        for (int r = 0; r < 4; ++r) {
            if (!done[r] && tot[r] >= 256u) { K[r] = cand[r]; if (tot[r] == 256u) done[r] = true; }
            alld = alld && done[r];
        }
        if (__all(alld)) break;
    }
    unsigned X[4] = {2047u, 2047u, 2047u, 2047u};
    if (!__all(done[0] && done[1] && done[2] && done[3])) {
        unsigned need[4], cn[4], tot[4];
#pragma unroll
        for (int r = 0; r < 4; ++r) cn[r] = 0u;
#pragma unroll
        for (int i = 0; i < IDX_NT; ++i)
            if (i < ntile) {
#pragma unroll
                for (int r = 0; r < 4; ++r) cn[r] += (sk[i][r] > K[r]) ? 1u : 0u;
            }
        idx_total(cn, lc, par, w, c, g, tot); par ^= 1;
#pragma unroll
        for (int r = 0; r < 4; ++r) { need[r] = done[r] ? 0x7FFFFFFFu : (256u - tot[r]); X[r] = 0u; }
        for (int bit = 10; bit >= 0; --bit) {
            unsigned cx[4];
#pragma unroll
            for (int r = 0; r < 4; ++r) { cx[r] = X[r] | (1u << bit); cn[r] = 0u; }
#pragma unroll
            for (int i = 0; i < IDX_NT; ++i)
                if (i < ntile) {
                    const unsigned s = (unsigned)((w * ntile + i) * 16 + c);
#pragma unroll
                    for (int r = 0; r < 4; ++r) cn[r] += (sk[i][r] == K[r] && s < cx[r]) ? 1u : 0u;
                }
            idx_total(cn, lc, par, w, c, g, tot); par ^= 1;
#pragma unroll
            for (int r = 0; r < 4; ++r) if (tot[r] < need[r]) X[r] = cx[r];
        }
    }
#pragma unroll
    for (int i = 0; i < IDX_NT; ++i)
        if (i < ntile) {
            const int tg = w * ntile + i; const unsigned s = (unsigned)(tg * 16 + c);
#pragma unroll
            for (int r = 0; r < 4; ++r) {
                const bool sel = (sk[i][r] > K[r]) || (sk[i][r] == K[r] && s <= X[r]);
                const unsigned long long bal = __ballot(sel);
                if (c == 0) mask[(4 * g + r) * 128 + tg] = (unsigned short)((bal >> (16 * g)) & 0xFFFFull);
            }
        }
}

__device__ void ssd_prep_unit(const Params& p, int unit, char* smem) {
    const int tid = threadIdx.x, lane = tid & 63, w = tid >> 6, cL = lane & 15, gq = lane >> 4;
    const int h = unit & 7, c = (unit >> 3) & 15, b = unit >> 7, g = h >> 2;
    char* ws = p.ws;
    float* s_acum = (float*)smem; float* s_dt = s_acum + 128; float* s_w = s_dt + 128;
    bf16_t* sXw = (bf16_t*)(smem + 2048); bf16_t* sBt = sXw + 64 * 136;
    const int tok0 = b * 2048 + c * 128;
    const float a_h = -expf(p.a_log[h]);
    const float* DTf = (const float*)(ws + O_DTF);
    __syncthreads();
    if (tid < 128) s_dt[tid] = DTf[(size_t)(tok0 + tid) * 8 + h];
    __syncthreads();
    if (tid < 128) {
        float s = 0.f;
        for (int k = 0; k <= tid; ++k) s += s_dt[k] * a_h;
        s_acum[tid] = s;
        ((float*)(ws + O_ACUM))[(size_t)(b * 8 + h) * 2048 + c * 128 + tid] = s;
    }
    __syncthreads();
    if (tid < 128) {
        const float tot = s_acum[127];
        s_w[tid] = s_dt[tid] * __expf(tot - s_acum[tid]);
        if (tid == 0) ((float*)(ws + O_ATOT))[(b * 8 + h) * 16 + c] = tot;
    }
    __syncthreads();
    const bf16_t* XBCt = (const bf16_t*)(ws + O_XBCT);
    bf16_t* Xt = (bf16_t*)(ws + O_XT); bf16_t* Brm = (bf16_t*)(ws + O_BRM); bf16_t* Crm = (bf16_t*)(ws + O_CRM);
    for (int item = tid; item < 3584; item += 512) {
        int kind, idx, tc, ch;
        if (item < 1024) { kind = 0; idx = item >> 4; tc = item & 15; ch = h * 64 + idx; }
        else if (item < 3072) { kind = 1; idx = (item - 1024) >> 4; tc = item & 15; ch = 512 + g * 128 + idx; }
        else { kind = 2; idx = (h & 3) * 32 + ((item - 3072) >> 4); tc = item & 15; ch = 768 + g * 128 + idx; }
        const bf16_t* src = XBCt + ((size_t)b * 1024 + ch) * 2048 + c * 128 + tc * 8;
        const uint4 cur = *(const uint4*)src;
        uint4 prv = make_uint4(0, 0, 0, 0);
        if (c * 128 + tc * 8 >= 8) prv = *(const uint4*)(src - 8);
        float xv[11];
        xv[0] = bf2f((bf16_t)(prv.z >> 16)); xv[1] = bf2f((bf16_t)(prv.w & 0xFFFF)); xv[2] = bf2f((bf16_t)(prv.w >> 16));
        xv[3] = bf2f((bf16_t)(cur.x & 0xFFFF)); xv[4] = bf2f((bf16_t)(cur.x >> 16)); xv[5] = bf2f((bf16_t)(cur.y & 0xFFFF)); xv[6] = bf2f((bf16_t)(cur.y >> 16));
        xv[7] = bf2f((bf16_t)(cur.z & 0xFFFF)); xv[8] = bf2f((bf16_t)(cur.z >> 16)); xv[9] = bf2f((bf16_t)(cur.w & 0xFFFF)); xv[10] = bf2f((bf16_t)(cur.w >> 16));
        const float w0 = p.conv_w[ch], w1 = p.conv_w[1024 + ch], w2 = p.conv_w[2048 + ch], w3 = p.conv_w[3072 + ch], bias = p.conv_b[ch];
        float o[8];
#pragma unroll
        for (int j = 0; j < 8; ++j) { const float v = bias + w0 * xv[j] + w1 * xv[j + 1] + w2 * xv[j + 2] + w3 * xv[j + 3]; o[j] = bf2f(f2bf(silu_f(v))); }
        if (kind == 0) {
            *(uint4*)(Xt + ((size_t)b * 512 + ch) * 2048 + c * 128 + tc * 8) = make_uint4(pack2(o[0], o[1]), pack2(o[2], o[3]), pack2(o[4], o[5]), pack2(o[6], o[7]));
            float q[8];
#pragma unroll
            for (int j = 0; j < 8; ++j) q[j] = o[j] * s_w[tc * 8 + j];
            *(uint4*)(sXw + idx * 136 + tc * 8) = make_uint4(pack2(q[0], q[1]), pack2(q[2], q[3]), pack2(q[4], q[5]), pack2(q[6], q[7]));
        } else if (kind == 1) {
            *(uint4*)(sBt + idx * 136 + tc * 8) = make_uint4(pack2(o[0], o[1]), pack2(o[2], o[3]), pack2(o[4], o[5]), pack2(o[6], o[7]));
            if ((h & 3) == 0) {
#pragma unroll
                for (int j = 0; j < 8; ++j) Brm[(size_t)(tok0 + tc * 8 + j) * 256 + g * 128 + idx] = f2bf(o[j]);
            }
        } else {
#pragma unroll
            for (int j = 0; j < 8; ++j) Crm[(size_t)(tok0 + tc * 8 + j) * 256 + g * 128 + idx] = f2bf(o[j]);
        }
    }
    __syncthreads();
    f32x4 acc[4];
#pragma unroll
    for (int i = 0; i < 4; ++i) acc[i] = (f32x4){0.f, 0.f, 0.f, 0.f};
#pragma unroll
    for (int ks = 0; ks < 4; ++ks) {
        const bf16x8 bb = ld8(sBt + (16 * w + cL) * 136 + ks * 32 + gq * 8);
#pragma unroll
        for (int pt = 0; pt < 4; ++pt) acc[pt] = mfma16(ld8(sXw + (16 * pt + cL) * 136 + ks * 32 + gq * 8), bb, acc[pt]);
    }
    float* ST = (float*)(ws + O_ST) + ((size_t)((b * 16 + c) * 8 + h)) * 8192;
#pragma unroll
    for (int pt = 0; pt < 4; ++pt)
#pragma unroll
        for (int r = 0; r < 4; ++r) ST[(16 * pt + 4 * gq + r) * 128 + 16 * w + cL] = acc[pt][r];
}

__device__ void attn_unit(const Params& p, int unit) {
    const int tid = threadIdx.x, lane = tid & 63, w = tid >> 6, cL = lane & 15, gq = lane >> 4;
    const int qb = 15 - (unit >> 6), bh = unit & 63, b = bh >> 3, h = bh & 7;
    char* ws = p.ws;
    const int q0 = qb * 128 + 16 * w;
    const int ktmax = (q0 + 15) >> 6;
    const bf16_t* Q = (const bf16_t*)(ws + O_QB) + (size_t)bh * 2048 * 64;
    const bf16_t* Kp = (const bf16_t*)(ws + O_KB) + (size_t)bh * 2048 * 64;
    const bf16_t* V = (const bf16_t*)(ws + O_VT) + (size_t)bh * 64 * 2048;
    const unsigned short* mrow = (const unsigned short*)(ws + O_MASK) + (size_t)(b * 2048 + q0 + cL) * 128;
    bf16x8 qf[2];
    qf[0] = ld8(Q + (size_t)(q0 + cL) * 64 + gq * 8); qf[1] = ld8(Q + (size_t)(q0 + cL) * 64 + 32 + gq * 8);
    float m_run = -1e30f, l_run = 0.f;
    f32x4 o[4];
#pragma unroll
    for (int i = 0; i < 4; ++i) o[i] = (f32x4){0.f, 0.f, 0.f, 0.f};
    for (int kt = 0; kt <= ktmax; ++kt) {
        const int s0 = kt * 64;
        const unsigned long long mb = *(const unsigned long long*)(mrow + kt * 4);
        f32x4 st[4];
#pragma unroll
        for (int j = 0; j < 4; ++j) {
            f32x4 a = (f32x4){0.f, 0.f, 0.f, 0.f};
            const bf16_t* kr = Kp + (size_t)(s0 + 16 * j + cL) * 64 + gq * 8;
            a = mfma16(ld8(kr), qf[0], a); a = mfma16(ld8(kr + 32), qf[1], a);
            st[j] = a;
        }
        float mx = m_run;
#pragma unroll
        for (int j = 0; j < 4; ++j)
#pragma unroll
            for (int r = 0; r < 4; ++r) {
                const bool bit = (mb >> (16 * j + 4 * gq + r)) & 1ull;
                const float v = bit ? st[j][r] : -INFINITY;
                st[j][r] = v; mx = fmaxf(mx, v);
            }
        mx = fmaxf(mx, __shfl_xor(mx, 16)); mx = fmaxf(mx, __shfl_xor(mx, 32));
        const float alpha = __expf(m_run - mx); m_run = mx;
        float ls = 0.f;
#pragma unroll
        for (int j = 0; j < 4; ++j)
#pragma unroll
            for (int r = 0; r < 4; ++r) { const float pv = __expf(st[j][r] - mx); st[j][r] = pv; ls += pv; }
        ls += __shfl_xor(ls, 16); ls += __shfl_xor(ls, 32);
        l_run = l_run * alpha + ls;
#pragma unroll
        for (int i = 0; i < 4; ++i) o[i] = o[i] * alpha;
#pragma unroll
        for (int kk = 0; kk < 2; ++kk) {
            bf16x8 pf;
#pragma unroll
            for (int r = 0; r < 4; ++r) { pf[r] = (short)f2bf(st[2 * kk][r]); pf[4 + r] = (short)f2bf(st[2 * kk + 1][r]); }
#pragma unroll
            for (int dt = 0; dt < 4; ++dt) {
                const bf16_t* vr = V + (size_t)(16 * dt + cL) * 2048 + s0 + 32 * kk + 4 * gq;
                o[dt] = mfma16(cat4(*(const bf16x4*)vr, *(const bf16x4*)(vr + 16)), pf, o[dt]);
            }
        }
    }
    const float inv = 1.f / l_run;
    bf16_t* mix = (bf16_t*)(ws + O_MIX) + (size_t)(b * 2048 + q0 + cL) * 1024 + h * 64;
#pragma unroll
    for (int dt = 0; dt < 4; ++dt)
        *(uint2*)(mix + 16 * dt + 4 * gq) = make_uint2(pack2(o[dt][0] * inv, o[dt][1] * inv), pack2(o[dt][2] * inv, o[dt][3] * inv));
}

__device__ void ssd_main_unit(const Params& p, int unit, char* smem) {
    const int tid = threadIdx.x, lane = tid & 63, w = tid >> 6, cL = lane & 15, gq = lane >> 4;
    const int g = unit & 1, c = (unit >> 1) & 15, b = unit >> 5;
    char* ws = p.ws;
    bf16_t* sCar = (bf16_t*)smem;
    const int tok0 = b * 2048 + c * 128;
    const float* ATOT = (const float*)(ws + O_ATOT); const float* ACUM = (const float*)(ws + O_ACUM); const float* DTf = (const float*)(ws + O_DTF);
    const bf16_t* Xt = (const bf16_t*)(ws + O_XT); const bf16_t* Brm = (const bf16_t*)(ws + O_BRM); const bf16_t* Crm = (const bf16_t*)(ws + O_CRM);
    const bf16_t* Zb = (const bf16_t*)(ws + O_ZB);
    __syncthreads();
    for (int hh = 0; hh < 4; ++hh) {
        const int h = 4 * g + hh;
        const float* at = ATOT + (b * 8 + h) * 16;
        for (int k = 0; k < 4; ++k) {
            const int e4 = tid + 512 * k;
            float4 a = make_float4(0.f, 0.f, 0.f, 0.f);
            float wl = 0.f;
            for (int i = c - 1; i >= 0; --i) {
                const float wgt = __expf(wl);
                const float4 s = *(const float4*)((const float*)(ws + O_ST) + ((size_t)((b * 16 + i) * 8 + h)) * 8192 + e4 * 4);
                a.x += wgt * s.x; a.y += wgt * s.y; a.z += wgt * s.z; a.w += wgt * s.w;
                wl += at[i];
            }
            const int e = e4 * 4, pp = e >> 7, n = e & 127;
            *(uint2*)(sCar + (hh * 64 + pp) * 136 + n) = make_uint2(pack2(a.x, a.y), pack2(a.z, a.w));
        }
    }
    __syncthreads();
    bf16_t* mix = (bf16_t*)(ws + O_MIX);
    {
        const int lt = w;
        const int ltok = tok0 + 16 * lt + cL;
        bf16x8 Cq[4];
#pragma unroll
        for (int ks = 0; ks < 4; ++ks) Cq[ks] = ld8(Crm + (size_t)ltok * 256 + g * 128 + ks * 32 + gq * 8);
        f32x4 cbT[8];
#pragma unroll
        for (int st = 0; st < 8; ++st) {
            cbT[st] = (f32x4){0.f, 0.f, 0.f, 0.f};
            if (st <= lt) {
                const bf16_t* br = Brm + (size_t)(tok0 + 16 * st + cL) * 256 + g * 128 + gq * 8;
#pragma unroll
                for (int ks = 0; ks < 4; ++ks) cbT[st] = mfma16(ld8(br + ks * 32), Cq[ks], cbT[st]);
            }
        }
        float ssq = 0.f;
#pragma unroll 1
        for (int hh = 0; hh < 4; ++hh) {
            const int h = 4 * g + hh;
            const float* ac = ACUM + (size_t)(b * 8 + h) * 2048 + c * 128;
            const float al = ac[16 * lt + cL];
            f32x4 acc1[4], acc2[4];
#pragma unroll
            for (int i = 0; i < 4; ++i) { acc1[i] = (f32x4){0.f, 0.f, 0.f, 0.f}; acc2[i] = (f32x4){0.f, 0.f, 0.f, 0.f}; }
#pragma unroll
            for (int kk = 0; kk < 4; ++kk) {
                if (2 * kk <= lt) {
                    bf16x8 mf;
#pragma unroll
                    for (int half = 0; half < 2; ++half) {
                        const int st = 2 * kk + half;
#pragma unroll
                        for (int r = 0; r < 4; ++r) {
                            const int sl = 16 * st + 4 * gq + r;
                            float v = 0.f;
                            if (st <= lt && sl <= 16 * lt + cL) v = cbT[st][r] * __expf(al - ac[sl]) * DTf[(size_t)(tok0 + sl) * 8 + h];
                            mf[half * 4 + r] = (short)f2bf(v);
                        }
                    }
#pragma unroll
                    for (int pt = 0; pt < 4; ++pt) {
                        const bf16_t* xr = Xt + ((size_t)b * 512 + h * 64 + 16 * pt + cL) * 2048 + c * 128 + 32 * kk + 4 * gq;
                        acc1[pt] = mfma16(cat4(*(const bf16x4*)xr, *(const bf16x4*)(xr + 16)), mf, acc1[pt]);
                    }
                }
            }
#pragma unroll
            for (int ks = 0; ks < 4; ++ks)
#pragma unroll
                for (int pt = 0; pt < 4; ++pt) acc2[pt] = mfma16(ld8(sCar + (hh * 64 + 16 * pt + cL) * 136 + ks * 32 + gq * 8), Cq[ks], acc2[pt]);
            const float el = __expf(al), dsk = p.d_skip[h];
#pragma unroll
            for (int pt = 0; pt < 4; ++pt) {
                const uint2 zz = *(const uint2*)(Zb + (size_t)ltok * 512 + h * 64 + 16 * pt + 4 * gq);
                const float zf[4] = {bf2f((bf16_t)(zz.x & 0xFFFF)), bf2f((bf16_t)(zz.x >> 16)), bf2f((bf16_t)(zz.y & 0xFFFF)), bf2f((bf16_t)(zz.y >> 16))};
                float yv[4];
#pragma unroll
                for (int r = 0; r < 4; ++r) {
                    const int pp = 16 * pt + 4 * gq + r;
                    const float xs = bf2f(Xt[((size_t)b * 512 + h * 64 + pp) * 2048 + c * 128 + 16 * lt + cL]);
                    float t = acc1[pt][r] + el * acc2[pt][r] + xs * dsk;
                    t *= silu_f(zf[r]);
                    yv[r] = t; ssq += t * t;
                }
                *(uint2*)(mix + (size_t)ltok * 1024 + 512 + h * 64 + 16 * pt + 4 * gq) = make_uint2(pack2(yv[0], yv[1]), pack2(yv[2], yv[3]));
            }
        }
        ssq += __shfl_xor(ssq, 16); ssq += __shfl_xor(ssq, 32);
        const float rstd = rsqrtf(ssq * (1.f / 256.f) + LN_EPS);
#pragma unroll 1
        for (int hh = 0; hh < 4; ++hh)
#pragma unroll
            for (int pt = 0; pt < 4; ++pt) {
                const int ch = (4 * g + hh) * 64 + 16 * pt + 4 * gq;
                const float4 nw = *(const float4*)(p.norm_w + ch);
                const uint2 yy = *(const uint2*)(mix + (size_t)ltok * 1024 + 512 + ch);
                const unsigned y01 = yy.x, y23 = yy.y;
                const float y0 = bf2f((bf16_t)(y01 & 0xFFFF)), y1 = bf2f((bf16_t)(y01 >> 16)), y2 = bf2f((bf16_t)(y23 & 0xFFFF)), y3 = bf2f((bf16_t)(y23 >> 16));
                *(uint2*)(mix + (size_t)ltok * 1024 + 512 + ch) = make_uint2(pack2(y0 * rstd * nw.x, y1 * rstd * nw.y), pack2(y2 * rstd * nw.z, y3 * rstd * nw.w));
            }
    }
}

__device__ void phase2(const Params& p, char* smem) {
    for (int u = blockIdx.x; u < 2048; u += gridDim.x) {
        if (u < 1024) indexer_unit(p, u, smem); else ssd_prep_unit(p, u - 1024, smem);
    }
}
__device__ void phase3(const Params& p, char* smem) {
    for (int u = blockIdx.x; u < 1024 + 256; u += gridDim.x) {
        if (u < 256) ssd_main_unit(p, u, smem); else attn_unit(p, u - 256);
    }
}

struct OutEpi {
    const float* x; float* y;
    __device__ __forceinline__ void operator()(const f32x4 (&acc)[4][4], int mb, int nb, int lane) const {
        const int c = lane & 15, g = lane >> 4;
#pragma unroll
        for (int mi = 0; mi < 4; ++mi)
#pragma unroll
            for (int r = 0; r < 4; ++r) {
                const size_t m = mb + 16 * mi + 4 * g + r;
#pragma unroll
                for (int ni = 0; ni < 4; ++ni) { const int n = nb + 16 * ni + c; y[m * 1024 + n] = ALPHA * x[m * 1024 + n] + acc[mi][ni][r]; }
            }
    }
};
__device__ void phase4(const Params& p, char* smem) {
    OutEpi e; e.x = p.x; e.y = p.out;
    for (int t = blockIdx.x; t < 8 * 64; t += gridDim.x) {
        const int tn = t % 8, tm = t / 8;
        gemm_tile((const bf16_t*)(p.ws + O_MIX), (const bf16_t*)(p.ws + O_WOUT_T), 1024, tm * 256, tn * 128, e, smem);
    }
}

__device__ __forceinline__ float wave_sum(float v) {
    v += __shfl_xor(v, 32); v += __shfl_xor(v, 16); v += __shfl_xor(v, 8); v += __shfl_xor(v, 4); v += __shfl_xor(v, 2); v += __shfl_xor(v, 1); return v;
}
__device__ void phase5(const Params& p) {
    const int lane = threadIdx.x & 63, w = threadIdx.x >> 6;
    bf16_t* hb = (bf16_t*)(p.ws + O_HB);
    for (int row = blockIdx.x * 8 + w; row < NTOK; row += gridDim.x * 8) {
        float* yr = p.out + (size_t)row * 1024;
        float4 v[4]; float s = 0.f;
#pragma unroll
        for (int j = 0; j < 4; ++j) { v[j] = *(const float4*)(yr + 4 * lane + 256 * j); s += v[j].x + v[j].y + v[j].z + v[j].w; }
        const float mean = wave_sum(s) * (1.f / 1024.f);
        float q = 0.f;
#pragma unroll
        for (int j = 0; j < 4; ++j) { const float a = v[j].x - mean, b2 = v[j].y - mean, c2 = v[j].z - mean, d = v[j].w - mean; q += a * a + b2 * b2 + c2 * c2 + d * d; }
        const float rstd = rsqrtf(wave_sum(q) * (1.f / 1024.f) + LN_EPS);
#pragma unroll
        for (int j = 0; j < 4; ++j) {
            const int col = 4 * lane + 256 * j;
            const float4 gg = *(const float4*)(p.ln1_g + col), bb = *(const float4*)(p.ln1_b + col);
            float4 o;
            o.x = (v[j].x - mean) * rstd * gg.x + bb.x; o.y = (v[j].y - mean) * rstd * gg.y + bb.y; o.z = (v[j].z - mean) * rstd * gg.z + bb.z; o.w = (v[j].w - mean) * rstd * gg.w + bb.w;
            *(float4*)(yr + col) = o;
            *(uint2*)(hb + (size_t)row * 1024 + col) = make_uint2(pack2(o.x, o.y), pack2(o.z, o.w));
        }
    }
    const size_t gtid = (size_t)blockIdx.x * blockDim.x + threadIdx.x, gsz = (size_t)gridDim.x * blockDim.x;
    p0_convert(p.u, (bf16_t*)(p.ws + O_UB), (size_t)16384 * 1024 / 4, gtid, gsz);
    p0_convert(p.v, (bf16_t*)(p.ws + O_VB), (size_t)16384 * 1024 / 4, gtid, gsz);
}

struct QpEpi {
    bf16_t* qp;
    __device__ __forceinline__ void operator()(const f32x4 (&acc)[4][4], int mb, int nb, int lane) const {
        const int c = lane & 15, g = lane >> 4;
#pragma unroll
        for (int mi = 0; mi < 4; ++mi)
#pragma unroll
            for (int r = 0; r < 4; ++r) {
                const size_t m = mb + 16 * mi + 4 * g + r;
#pragma unroll
                for (int ni = 0; ni < 4; ++ni) qp[m * 2048 + nb + 16 * ni + c] = f2bf(acc[mi][ni][r]);
            }
    }
};
__device__ void phase6(const Params& p, char* smem) {
    QpEpi e; e.qp = (bf16_t*)(p.ws + O_QP);
    for (int t = blockIdx.x; t < 16 * 64; t += gridDim.x) {
        const int tn = t % 16, tm = t / 16;
        gemm_tile((const bf16_t*)(p.ws + O_HB), (const bf16_t*)(p.ws + O_WQ_T), 1024, tm * 256, tn * 128, e, smem);
    }
}

__constant__ unsigned char CAND_I[64] = {0,0,0,0,0,0,0,0,0,0,0,0,0,0,0,0, 1,1,1,1,1,1,1,1, 2,2,2,2,2, 3,3,3,3, 4,4,4, 5,5, 6,6, 7,7, 8,9,10,11,12,13,14,15, 0,0,0,0,0,0,0,0,0,0,0,0,0,0};
__constant__ unsigned char CAND_J[64] = {0,1,2,3,4,5,6,7,8,9,10,11,12,13,14,15, 0,1,2,3,4,5,6,7, 0,1,2,3,4, 0,1,2,3, 0,1,2, 0,1, 0,1, 0,1, 0,0,0,0,0,0,0,0, 0,0,0,0,0,0,0,0,0,0,0,0,0,0};
__device__ __forceinline__ unsigned rowmax_u(unsigned v) {
    v = max(v, (unsigned)__shfl_xor((int)v, 1)); v = max(v, (unsigned)__shfl_xor((int)v, 2)); v = max(v, (unsigned)__shfl_xor((int)v, 4)); v = max(v, (unsigned)__shfl_xor((int)v, 8)); return v;
}
__device__ void peer_select_wave(const Params& p, int wunit) {
    const int lane = threadIdx.x & 63, cL = lane & 15, gq = lane >> 4, rowbase = lane & 48;
    const int tg = wunit >> 3, h = wunit & 7, tok0 = tg * 16;
    char* ws = p.ws;
    const bf16_t* QP = (const bf16_t*)(ws + O_QP);
    unsigned top[2][4];
#pragma unroll
    for (int half = 0; half < 2; ++half) {
        const bf16_t* KB = (const bf16_t*)(ws + (half ? O_K2B : O_K1B));
        bf16x8 a[4];
#pragma unroll
        for (int ks = 0; ks < 4; ++ks) a[ks] = ld8(QP + (size_t)(tok0 + cL) * 2048 + h * 256 + half * 128 + ks * 32 + gq * 8);
        unsigned pk[8][4];
#pragma unroll
        for (int nt = 0; nt < 8; ++nt) {
            f32x4 acc = (f32x4){0.f, 0.f, 0.f, 0.f};
#pragma unroll
            for (int ks = 0; ks < 4; ++ks) acc = mfma16(a[ks], ld8(KB + (size_t)(16 * nt + cL) * 128 + ks * 32 + gq * 8), acc);
#pragma unroll
            for (int r = 0; r < 4; ++r) pk[nt][r] = (f2sort(acc[r]) & ~0x7Fu) | (unsigned)(127 - (16 * nt + cL));
        }
#pragma unroll
        for (int r = 0; r < 4; ++r) top[half][r] = 0u;
        for (int it = 0; it < 16; ++it) {
#pragma unroll
            for (int r = 0; r < 4; ++r) {
                unsigned lm = pk[0][r];
#pragma unroll
                for (int nt = 1; nt < 8; ++nt) lm = max(lm, pk[nt][r]);
                const unsigned gm = rowmax_u(lm);
                if (cL == it) top[half][r] = gm;
#pragma unroll
                for (int nt = 0; nt < 8; ++nt) pk[nt][r] = (pk[nt][r] == gm) ? 0u : pk[nt][r];
            }
        }
    }
    unsigned ck[4][4];
#pragma unroll
    for (int s = 0; s < 4; ++s) {
        const int q = s * 16 + cL; const int ci = CAND_I[q], cj = CAND_J[q];
#pragma unroll
        for (int r = 0; r < 4; ++r) {
            const unsigned t1 = (unsigned)__shfl((int)top[0][r], rowbase + ci), t2 = (unsigned)__shfl((int)top[1][r], rowbase + cj);
            const float f = sort2f(t1 & ~0x7Fu) + sort2f(t2 & ~0x7Fu);
            ck[s][r] = (q < 50) ? ((f2sort(f) & ~0x3Fu) | (unsigned)(63 - q)) : 0u;
        }
    }
    unsigned best[4] = {0u, 0u, 0u, 0u};
    for (int it = 0; it < 16; ++it) {
#pragma unroll
        for (int r = 0; r < 4; ++r) {
            const unsigned lm = max(max(ck[0][r], ck[1][r]), max(ck[2][r], ck[3][r]));
            const unsigned gm = rowmax_u(lm);
            if (cL == it) best[r] = gm;
#pragma unroll
            for (int s = 0; s < 4; ++s) ck[s][r] = (ck[s][r] == gm) ? 0u : ck[s][r];
        }
    }
    int* EIDX = (int*)(ws + O_EIDX); float* GATE = (float*)(ws + O_GATE);
#pragma unroll
    for (int r = 0; r < 4; ++r) {
        const float fv = sort2f(best[r] & ~0x3Fu);
        const int q = 63 - (int)(best[r] & 63u);
        const int ci = CAND_I[q], cj = CAND_J[q];
        const unsigned t1 = (unsigned)__shfl((int)top[0][r], rowbase + ci), t2 = (unsigned)__shfl((int)top[1][r], rowbase + cj);
        const int e = (127 - (int)(t1 & 127u)) * 128 + (127 - (int)(t2 & 127u));
        const float mx = __shfl(fv, rowbase);
        const float ex = __expf(fv - mx);
        float sm = ex; sm += __shfl_xor(sm, 1); sm += __shfl_xor(sm, 2); sm += __shfl_xor(sm, 4); sm += __shfl_xor(sm, 8);
        const size_t o = (size_t)(tok0 + 4 * gq + r) * 128 + h * 16 + cL;
        EIDX[o] = e; GATE[o] = ex / sm;
    }
}
__device__ void phase7(const Params& p) {
    const int w = threadIdx.x >> 6;
    for (int u = blockIdx.x * 8 + w; u < 8192; u += gridDim.x * 8) peer_select_wave(p, u);
}

__device__ void phase8(const Params& p) {
    const int lane = threadIdx.x & 63, w = threadIdx.x >> 6;
    char* ws = p.ws;
    const bf16_t* UB = (const bf16_t*)(ws + O_UB); const bf16_t* VB = (const bf16_t*)(ws + O_VB);
    const int* EIDX = (const int*)(ws + O_EIDX); const float* GATE = (const float*)(ws + O_GATE);
    for (int row = blockIdx.x * 8 + w; row < NTOK; row += gridDim.x * 8) {
        float* hr = p.out + (size_t)row * 1024;
        float4 hv[4];
#pragma unroll
        for (int j = 0; j < 4; ++j) hv[j] = *(const float4*)(hr + 4 * lane + 256 * j);
        const int id0 = EIDX[(size_t)row * 128 + lane], id1 = EIDX[(size_t)row * 128 + 64 + lane];
        const float g0 = GATE[(size_t)row * 128 + lane], g1 = GATE[(size_t)row * 128 + 64 + lane];
        float a0 = 0.f, a1 = 0.f;
#pragma unroll 4
        for (int e = 0; e < 128; ++e) {
            const int eid = __shfl((e < 64) ? id0 : id1, e & 63);
            const bf16_t* ur = UB + (size_t)eid * 1024 + 4 * lane;
            float d = 0.f;
#pragma unroll
            for (int j = 0; j < 4; ++j) {
                const uint2 uu = *(const uint2*)(ur + 256 * j);
                d += hv[j].x * bf2f((bf16_t)(uu.x & 0xFFFF)) + hv[j].y * bf2f((bf16_t)(uu.x >> 16)) + hv[j].z * bf2f((bf16_t)(uu.y & 0xFFFF)) + hv[j].w * bf2f((bf16_t)(uu.y >> 16));
            }
            d = wave_sum(d);
            const float act = 0.5f * d * (1.f + erff(d * 0.70710678118654752f));
            if (e < 64) { if (lane == e) a0 = act * g0; } else { if (lane == e - 64) a1 = act * g1; }
        }
        float4 acc[4];
#pragma unroll
        for (int j = 0; j < 4; ++j) acc[j] = make_float4(0.f, 0.f, 0.f, 0.f);
#pragma unroll 4
        for (int e = 0; e < 128; ++e) {
            const int eid = __shfl((e < 64) ? id0 : id1, e & 63);
            const float av = __shfl((e < 64) ? a0 : a1, e & 63);
            const bf16_t* vr = VB + (size_t)eid * 1024 + 4 * lane;
#pragma unroll
            for (int j = 0; j < 4; ++j) {
                const uint2 vv = *(const uint2*)(vr + 256 * j);
                acc[j].x += av * bf2f((bf16_t)(vv.x & 0xFFFF)); acc[j].y += av * bf2f((bf16_t)(vv.x >> 16)); acc[j].z += av * bf2f((bf16_t)(vv.y & 0xFFFF)); acc[j].w += av * bf2f((bf16_t)(vv.y >> 16));
            }
        }
        float s = 0.f;
#pragma unroll
        for (int j = 0; j < 4; ++j) { acc[j].x += ALPHA * hv[j].x; acc[j].y += ALPHA * hv[j].y; acc[j].z += ALPHA * hv[j].z; acc[j].w += ALPHA * hv[j].w; s += acc[j].x + acc[j].y + acc[j].z + acc[j].w; }
        const float mean = wave_sum(s) * (1.f / 1024.f);
        float q = 0.f;
#pragma unroll
        for (int j = 0; j < 4; ++j) { const float a = acc[j].x - mean, b2 = acc[j].y - mean, c2 = acc[j].z - mean, d = acc[j].w - mean; q += a * a + b2 * b2 + c2 * c2 + d * d; }
        const float rstd = rsqrtf(wave_sum(q) * (1.f / 1024.f) + LN_EPS);
#pragma unroll
        for (int j = 0; j < 4; ++j) {
            const int col = 4 * lane + 256 * j;
            const float4 gg = *(const float4*)(p.ln2_g + col), bb = *(const float4*)(p.ln2_b + col);
            float4 o;
            o.x = (acc[j].x - mean) * rstd * gg.x + bb.x; o.y = (acc[j].y - mean) * rstd * gg.y + bb.y; o.z = (acc[j].z - mean) * rstd * gg.z + bb.z; o.w = (acc[j].w - mean) * rstd * gg.w + bb.w;
            *(float4*)(hr + col) = o;
        }
    }
}

#if ONE_LAUNCH
__global__ void __launch_bounds__(512, 2) fwd_megakernel(Params p) {
    __shared__ __attribute__((aligned(16))) char smem[SMEM_BYTES];
    cg::grid_group grid = cg::this_grid();
    phase0(p); grid.sync();
    phase1(p, smem); grid.sync();
    phase2(p, smem); grid.sync();
    phase3(p, smem); grid.sync();
    phase4(p, smem); grid.sync();
    phase5(p); grid.sync();
    phase6(p, smem); grid.sync();
    phase7(p); grid.sync();
    phase8(p);
}
#else
__global__ void __launch_bounds__(512, 2) k_phase0(Params p) { phase0(p); }
__global__ void __launch_bounds__(512, 2) k_phase1(Params p) { __shared__ __attribute__((aligned(16))) char smem[SMEM_BYTES]; phase1(p, smem); }
__global__ void __launch_bounds__(512, 2) k_phase2(Params p) { __shared__ __attribute__((aligned(16))) char smem[SMEM_BYTES]; phase2(p, smem); }
__global__ void __launch_bounds__(512, 2) k_phase3(Params p) { __shared__ __attribute__((aligned(16))) char smem[SMEM_BYTES]; phase3(p, smem); }
__global__ void __launch_bounds__(512, 2) k_phase4(Params p) { __shared__ __attribute__((aligned(16))) char smem[SMEM_BYTES]; phase4(p, smem); }
__global__ void __launch_bounds__(512, 2) k_phase5(Params p) { phase5(p); }
__global__ void __launch_bounds__(512, 2) k_phase6(Params p) { __shared__ __attribute__((aligned(16))) char smem[SMEM_BYTES]; phase6(p, smem); }
__global__ void __launch_bounds__(512, 2) k_phase7(Params p) { phase7(p); }
__global__ void __launch_bounds__(512, 2) k_phase8(Params p) { phase8(p); }
#endif

extern "C" void kernel_launch(void* const* d_in, const int* in_sizes, int n_in, void* d_out, int out_size, void* d_ws, size_t ws_size, hipStream_t stream) {
    Params p{};
    p.x = (const float*)d_in[0]; p.pos = (const int*)d_in[1]; p.w_in = (const float*)d_in[2]; p.conv_w = (const float*)d_in[3]; p.conv_b = (const float*)d_in[4];
    p.dt_bias = (const float*)d_in[5]; p.a_log = (const float*)d_in[6]; p.d_skip = (const float*)d_in[7]; p.norm_w = (const float*)d_in[8]; p.w_out = (const float*)d_in[9];
    p.ln1_g = (const float*)d_in[10]; p.ln1_b = (const float*)d_in[11]; p.wq = (const float*)d_in[12]; p.k1 = (const float*)d_in[13]; p.k2 = (const float*)d_in[14];
    p.u = (const float*)d_in[15]; p.v = (const float*)d_in[16]; p.ln2_g = (const float*)d_in[17]; p.ln2_b = (const float*)d_in[18];
    p.out = (float*)d_out; p.ws = (char*)d_ws;
    if (ws_size < WS_NEEDED) { fprintf(stderr, "kernel_launch: workspace too small (%zu < %zu)\n", ws_size, (size_t)WS_NEEDED); return; }
#if ONE_LAUNCH
    static int grid_blocks = 0;
    if (!grid_blocks) {
        int dev = 0, cus = 0, per_cu = 0;
        hipGetDevice(&dev);
        hipDeviceGetAttribute(&cus, hipDeviceAttributeMultiprocessorCount, dev);
        hipOccupancyMaxActiveBlocksPerMultiprocessor(&per_cu, fwd_megakernel, 512, 0);
        if (per_cu > 1) per_cu = 1;
        if (per_cu < 1) per_cu = 1;
        grid_blocks = cus * per_cu;
    }
    void* args[] = {&p};
    hipError_t e = hipLaunchCooperativeKernel((void*)fwd_megakernel, dim3(grid_blocks), dim3(512), args, 0, stream);
    if (e != hipSuccess) fprintf(stderr, "cooperative launch failed: %s (grid %d)\n", hipGetErrorString(e), grid_blocks);
#else
    const int G = 512;
    k_phase0<<<G, 512, 0, stream>>>(p);
    k_phase1<<<G, 512, 0, stream>>>(p);
    k_phase2<<<G, 512, 0, stream>>>(p);
    k_phase3<<<G, 512, 0, stream>>>(p);
    k_phase4<<<G, 512, 0, stream>>>(p);
    k_phase5<<<G, 512, 0, stream>>>(p);
    k_phase6<<<G, 512, 0, stream>>>(p);
    k_phase7<<<G, 512, 0, stream>>>(p);
    k_phase8<<<G, 512, 0, stream>>>(p);
#endif
}
```

```cpp
#include <hip/hip_runtime.h>
#include <hip/hip_cooperative_groups.h>
#include <stdint.h>
#include <stdio.h>
namespace cg = cooperative_groups;

typedef unsigned short bf16_t;
typedef short bf16x8 __attribute__((ext_vector_type(8)));
typedef short bf16x4 __attribute__((ext_vector_type(4)));
typedef float f32x4 __attribute__((ext_vector_type(4)));
typedef float f32x2 __attribute__((ext_vector_type(2)));

#ifndef ONE_LAUNCH
#define ONE_LAUNCH 1
#endif

constexpr int NB = 8, SEQ = 2048, DM = 1024, NTOK = NB * SEQ;
constexpr int NP = 3456;
constexpr int QOFF = 0, KOFF = 512, VOFF = 1024, IQOFF = 1536, MISCOFF = 1792, ZOFF = 1856, XBCOFF = 2368, NUSED = 3392;
constexpr float ALPHA = 1.189207115002721f;
constexpr float LN_EPS = 1e-5f;

constexpr size_t MB = 1024 * 1024;
constexpr size_t O_WIN_T = 0;
constexpr size_t O_WOUT_T = O_WIN_T + (size_t)NP * 1024 * 2;
constexpr size_t O_WQ_T = O_WOUT_T + 2 * MB;
constexpr size_t O_K1B = O_WQ_T + 4 * MB;
constexpr size_t O_K2B = O_K1B + 32768;
constexpr size_t O_CS64 = O_K2B + 32768;
constexpr size_t O_CS32 = O_CS64 + 4 * MB;
constexpr size_t O_BAR = O_CS32 + 2 * MB;
constexpr size_t O_MIX = O_BAR + 65536;
constexpr size_t O_R1 = O_MIX + 32 * MB;
constexpr size_t O_XB = O_R1;
constexpr size_t O_XT = O_R1;
constexpr size_t O_BRM = O_XT + 16 * MB;
constexpr size_t O_CRM = O_BRM + 8 * MB;
constexpr size_t O_QB = O_XB + 32 * MB;
constexpr size_t O_KB = O_QB + 16 * MB;
constexpr size_t O_VT = O_KB + 16 * MB;
constexpr size_t O_IQB = O_VT + 16 * MB;
constexpr size_t O_IKB = O_IQB + 8 * MB;
constexpr size_t O_IWF = O_IKB + 1 * MB;
constexpr size_t O_DTF = O_IWF + MB / 2;
constexpr size_t O_ZB = O_DTF + MB / 2;
constexpr size_t O_XBCT = O_ZB + 16 * MB;
constexpr size_t O_CAR = O_XBCT;
constexpr size_t O_ACUM = O_XBCT + 32 * MB;
constexpr size_t O_ATOT = O_ACUM + MB / 2;
constexpr size_t O_ST = O_ATOT + MB / 2;
constexpr size_t O_MASK = O_ST + 32 * MB;
constexpr size_t O_R1_END = O_MASK + 4 * MB;
constexpr size_t O_HB = O_R1;
constexpr size_t O_QP = O_HB + 32 * MB;
constexpr size_t O_EIDX = O_QP + 64 * MB;
constexpr size_t O_GATE = O_EIDX + 8 * MB;
constexpr size_t O_U8 = O_GATE + 8 * MB;
constexpr size_t O_V8 = O_U8 + 16 * MB;
constexpr size_t O_ACT = O_V8 + 16 * MB;
constexpr size_t O_H8HI = O_ACT + 8 * MB;
constexpr size_t O_H8LO = O_H8HI + 16 * MB;
constexpr size_t O_R2_END = O_H8LO + 16 * MB;
constexpr size_t WS_NEEDED = (O_R1_END > O_R2_END ? O_R1_END : O_R2_END);
static_assert(WS_NEEDED <= 256 * MB, "workspace too large");
static_assert(O_R2_END <= O_R1_END + 64 * MB, "region 2 too large");

struct Params {
    const float* x; const int* pos; const float* w_in; const float* conv_w; const float* conv_b; const float* dt_bias;
    const float* a_log; const float* d_skip; const float* norm_w; const float* w_out; const float* ln1_g; const float* ln1_b;
    const float* wq; const float* k1; const float* k2; const float* u; const float* v; const float* ln2_g; const float* ln2_b;
    float* out; char* ws; int use_cg; int pad_;
};

#define SMEM_BYTES 133120

__device__ __forceinline__ int tid_op() { int t = threadIdx.x; asm volatile("" : "+v"(t)); return t; }
__device__ __forceinline__ bf16_t f2bf(float f) {
    unsigned u = __float_as_uint(f);
    u += 0x7FFFu + ((u >> 16) & 1u);
    return (bf16_t)(u >> 16);
}
__device__ __forceinline__ float bf2f(bf16_t b) { return __uint_as_float(((unsigned)b) << 16); }
__device__ __forceinline__ unsigned pack2(float a, float b) { return (unsigned)f2bf(a) | ((unsigned)f2bf(b) << 16); }
__device__ __forceinline__ unsigned f2sort(float f) { unsigned u = __float_as_uint(f); return (u & 0x80000000u) ? ~u : (u | 0x80000000u); }
__device__ __forceinline__ float sort2f(unsigned s) { unsigned u = (s & 0x80000000u) ? (s & 0x7FFFFFFFu) : ~s; return __uint_as_float(u); }
__device__ __forceinline__ f32x4 mfma16(bf16x8 a, bf16x8 b, f32x4 c) { return __builtin_amdgcn_mfma_f32_16x16x32_bf16(a, b, c, 0, 0, 0); }
__device__ __forceinline__ float silu_f(float v) { return v / (1.f + __expf(-v)); }
__device__ __forceinline__ bf16x8 ld8(const bf16_t* p) { return *(const bf16x8*)p; }
__device__ __forceinline__ bf16x8 cat4(bf16x4 lo, bf16x4 hi) { return __builtin_shufflevector(lo, hi, 0, 1, 2, 3, 4, 5, 6, 7); }


template <int CTRL, int ROWMASK, bool BC> __device__ __forceinline__ int dpp_i(int v) { return __builtin_amdgcn_update_dpp(0, v, CTRL, ROWMASK, 0xF, BC); }
template <int CTRL, int ROWMASK, bool BC> __device__ __forceinline__ float dpp_f(float v) { return __builtin_bit_cast(float, __builtin_amdgcn_update_dpp(0, __builtin_bit_cast(int, v), CTRL, ROWMASK, 0xF, BC)); }
__device__ __forceinline__ float row_sum(float v) { v += dpp_f<0xB1, 0xF, true>(v); v += dpp_f<0x4E, 0xF, true>(v); v += dpp_f<0x141, 0xF, true>(v); v += dpp_f<0x140, 0xF, true>(v); return v; }
__device__ __forceinline__ unsigned row_sum_u(unsigned v) { v += (unsigned)dpp_i<0xB1, 0xF, true>((int)v); v += (unsigned)dpp_i<0x4E, 0xF, true>((int)v); v += (unsigned)dpp_i<0x141, 0xF, true>((int)v); v += (unsigned)dpp_i<0x140, 0xF, true>((int)v); return v; }
__device__ __forceinline__ unsigned row_max_u(unsigned v) {
    v = max(v, (unsigned)dpp_i<0xB1, 0xF, true>((int)v)); v = max(v, (unsigned)dpp_i<0x4E, 0xF, true>((int)v));
    v = max(v, (unsigned)dpp_i<0x141, 0xF, true>((int)v)); v = max(v, (unsigned)dpp_i<0x140, 0xF, true>((int)v)); return v;
}
__device__ __forceinline__ float wave_sum_u(float v) {
    v = row_sum(v);
    v += dpp_f<0x142, 0xA, false>(v);
    v += dpp_f<0x143, 0xC, false>(v);
    return __builtin_bit_cast(float, __builtin_amdgcn_readlane(__builtin_bit_cast(int, v), 63));
}
typedef unsigned u32x2_t __attribute__((ext_vector_type(2)));
__device__ __forceinline__ float sum_x16(float v) { const u32x2_t r = __builtin_amdgcn_permlane16_swap(__float_as_uint(v), __float_as_uint(v), false, false); return __uint_as_float(r.x) + __uint_as_float(r.y); }
__device__ __forceinline__ float sum_x32(float v) { const u32x2_t r = __builtin_amdgcn_permlane32_swap(__float_as_uint(v), __float_as_uint(v), false, false); return __uint_as_float(r.x) + __uint_as_float(r.y); }
__device__ __forceinline__ float max_x16(float v) { const u32x2_t r = __builtin_amdgcn_permlane16_swap(__float_as_uint(v), __float_as_uint(v), false, false); return fmaxf(__uint_as_float(r.x), __uint_as_float(r.y)); }
__device__ __forceinline__ float max_x32(float v) { const u32x2_t r = __builtin_amdgcn_permlane32_swap(__float_as_uint(v), __float_as_uint(v), false, false); return fmaxf(__uint_as_float(r.x), __uint_as_float(r.y)); }
__device__ __forceinline__ float wave_sum(float v) { return sum_x32(sum_x16(row_sum(v))); }

#define XB_TMO      128
#define XB_XCNT(j)  (256  + 64 * (j))
#define XB_XSUB(j)  (1280 + 64 * (j))
#define XB_XGEN(j)  (2304 + 64 * (j))
#define XB_TOP      3328
#define XB_TOPGEN   3392
#define XCD_BAR_WORDS 3456
#define XB_SPIN_CAP (1u << 22)
#define LAS __attribute__((address_space(3)))
__device__ __forceinline__ unsigned xb_ld(unsigned* p)              { return __hip_atomic_load(p, __ATOMIC_RELAXED, __HIP_MEMORY_SCOPE_AGENT); }
__device__ __forceinline__ unsigned xb_add(unsigned* p, unsigned v) { return __hip_atomic_fetch_add(p, v, __ATOMIC_RELAXED, __HIP_MEMORY_SCOPE_AGENT); }
__device__ __forceinline__ unsigned xb_xcc_id() { return (unsigned)__builtin_amdgcn_s_getreg((3 << 11) | 20) & 0xFu; }
#define XB_SPIN(cond, bar) do { unsigned _sp = 0; while (cond) { __builtin_amdgcn_s_sleep(1); \
    if ((++_sp & 255u) == 0u) { if (xb_ld(&(bar)[XB_TMO])) break; if (_sp > XB_SPIN_CAP) { atomicAdd(&(bar)[XB_TMO], 1u); break; } } } } while (0)
struct XcdBarrier { unsigned* bar; unsigned x; volatile LAS unsigned* st; };
__device__ __forceinline__ XcdBarrier xcd_barrier_post(unsigned* bar, volatile LAS unsigned* st) {
    XcdBarrier b; b.bar = bar; b.x = xb_xcc_id(); b.st = st;
    if (threadIdx.x == 0) st[3] = xb_add(&bar[XB_XCNT(b.x)], 1u);
    return b;
}
__device__ __forceinline__ void xcd_barrier_complete(unsigned* bar, unsigned x, unsigned& nloc, unsigned& nx, unsigned& low8) {
    const unsigned G = gridDim.x * gridDim.y * gridDim.z;
    unsigned sum, cnt, mine, lo, sp = 0u;
    for (;;) {
        sum = 0u; cnt = 0u; mine = 0u; lo = 0u;
#pragma unroll
        for (unsigned j = 0; j < 16; ++j) { const unsigned c = xb_ld(&bar[XB_XCNT(j)]); sum += c; cnt += (c > 0u) ? 1u : 0u; lo += (j < 8u && c > 0u) ? 1u : 0u; mine = (j == x) ? c : mine; }
        if (sum == G) break;
        __builtin_amdgcn_s_sleep(1);
        if ((++sp & 255u) == 0u) { if (xb_ld(&bar[XB_TMO])) break; if (sp > XB_SPIN_CAP) { atomicAdd(&bar[XB_TMO], 1u); break; } }
    }
    nloc = mine > 0u ? mine : 1u; nx = cnt > 0u ? cnt : 1u; low8 = (lo == 8u && cnt == 8u) ? 1u : 0u;
}
__device__ __forceinline__ void xcd_barrier(const XcdBarrier& b) {
    asm volatile("s_waitcnt vmcnt(0)" ::: "memory");
    __syncthreads();
    if (threadIdx.x == 0) {
        unsigned* bar = b.bar;
        __builtin_amdgcn_s_waitcnt(0);
        unsigned nloc = b.st[0], nx = b.st[1];
        if (nloc == 0u) { unsigned low8; xcd_barrier_complete(bar, b.x, nloc, nx, low8); b.st[0] = nloc; b.st[1] = nx; b.st[2] = low8; }
        const unsigned old = xb_add(&bar[XB_XSUB(b.x)], 1u);
        const unsigned gen = old / nloc;
        if (old + 1u == (gen + 1u) * nloc) {
            __builtin_amdgcn_fence(__ATOMIC_RELEASE, "agent");
            asm volatile("s_waitcnt vmcnt(0)" ::: "memory");
            const unsigned og = xb_add(&bar[XB_TOP], 1u);
            const unsigned tg = og / nx;
            if (og + 1u == (tg + 1u) * nx) xb_add(&bar[XB_TOPGEN], 1u);
            else XB_SPIN(xb_ld(&bar[XB_TOPGEN]) == tg, bar);
            __builtin_amdgcn_fence(__ATOMIC_ACQUIRE, "agent");
            xb_add(&bar[XB_XGEN(b.x)], 1u);
            asm volatile("s_waitcnt vmcnt(0)" ::: "memory");
        } else {
            XB_SPIN(xb_ld(&bar[XB_XGEN(b.x)]) == gen, bar);
            __builtin_amdgcn_fence(__ATOMIC_ACQUIRE, "agent");
            asm volatile("s_waitcnt vmcnt(0)" ::: "memory");
        }
    }
    __syncthreads();
}

__device__ __forceinline__ int win_src_col(int n) {
    if (n < 1832) return n;
    if (n < 1840) return 3368 + (n - 1832);
    if (n < 1856) return -1;
    if (n < 2368) return 1832 + (n - 1856);
    if (n < 3392) return 2344 + (n - 2368);
    return -1;
}
__device__ __forceinline__ void p0_transpose(const float* __restrict__ W, int N, int Nout, bool remap, bf16_t* __restrict__ Wt, int gtid, int gsz) {
    const int items = Nout * 128;
    for (int it = gtid; it < items; it += gsz) {
        const int n = it % Nout, kc = it / Nout;
        const int src = remap ? win_src_col(n) : n;
        unsigned w[4] = {0, 0, 0, 0};
        if (src >= 0) {
            float f[8];
#pragma unroll
            for (int j = 0; j < 8; ++j) f[j] = W[(size_t)(kc * 8 + j) * N + src];
#pragma unroll
            for (int j = 0; j < 4; ++j) w[j] = pack2(f[2 * j], f[2 * j + 1]);
        }
        *(uint4*)(Wt + (size_t)n * 1024 + kc * 8) = make_uint4(w[0], w[1], w[2], w[3]);
    }
}
__device__ __forceinline__ void p0_convert(const float* __restrict__ src, bf16_t* __restrict__ dst, size_t n4, size_t gtid, size_t gsz) {
    for (size_t i = gtid; i < n4; i += gsz) {
        const float4 f = ((const float4*)src)[i];
        ((uint2*)dst)[i] = make_uint2(pack2(f.x, f.y), pack2(f.z, f.w));
    }
}
__device__ __forceinline__ void phase0(const Params& p) {
    const int gtid = blockIdx.x * blockDim.x + tid_op(), gsz = gridDim.x * blockDim.x;
    p0_transpose(p.w_in, 3376, NP, true, (bf16_t*)(p.ws + O_WIN_T), gtid, gsz);
    p0_transpose(p.w_out, 1024, 1024, false, (bf16_t*)(p.ws + O_WOUT_T), gtid, gsz);
    p0_transpose(p.wq, 2048, 2048, false, (bf16_t*)(p.ws + O_WQ_T), gtid, gsz);
    p0_convert(p.k1, (bf16_t*)(p.ws + O_K1B), 128 * 128 / 4, gtid, gsz);
    p0_convert(p.k2, (bf16_t*)(p.ws + O_K2B), 128 * 128 / 4, gtid, gsz);
    p0_convert(p.x, (bf16_t*)(p.ws + O_XB), (size_t)NTOK * DM / 4, gtid, gsz);
    float2* cs64 = (float2*)(p.ws + O_CS64); float2* cs32 = (float2*)(p.ws + O_CS32);
    for (int it = gtid; it < NTOK * 48; it += gsz) {
        const int m = it / 48, i = it % 48;
        const float ps = (float)p.pos[m];
        if (i < 32) { const float inv = powf(10000.f, -(float)(2 * i) / 64.f); const float a = ps * inv; cs64[m * 32 + i] = make_float2(cosf(a), sinf(a)); }
        else { const int k = i - 32; const float inv = powf(10000.f, -(float)(2 * k) / 32.f); const float a = ps * inv; cs32[m * 16 + k] = make_float2(cosf(a), sinf(a)); }
    }
}

struct XcdMap { int slice, rank, nloc; };
__device__ __forceinline__ bool gemm_next_tile(const XcdMap& xm, int it, int ntn, int& tm, int& tn) {
    const int j = xm.rank + xm.nloc * it;
    if (j >= 8 * ntn) return false;
    tm = 8 * xm.slice + j / ntn; tn = j % ntn; return true;
}
#define GEMM_LDK 80
#define GEMM_LDS_A (256 * GEMM_LDK * 2)
#define GEMM_LDS_STAGE (GEMM_LDS_A + 128 * GEMM_LDK * 2)
typedef unsigned u32x4g __attribute__((ext_vector_type(4)));
struct GemmRegs { u32x4g a0, a1, a2, a3, b0, b1; };
__device__ __forceinline__ void gemm_gload(GemmRegs& r, const bf16_t* ga, const bf16_t* gb, size_t astep) {
    r.a0 = *(const u32x4g*)(ga); r.a1 = *(const u32x4g*)(ga + astep); r.a2 = *(const u32x4g*)(ga + 2 * astep); r.a3 = *(const u32x4g*)(ga + 3 * astep);
    r.b0 = *(const u32x4g*)(gb); r.b1 = *(const u32x4g*)(gb + astep);
}
__device__ __forceinline__ void gemm_lstore(const GemmRegs& r, bf16_t* wa, bf16_t* wb) {
    *(u32x4g*)(wa) = r.a0; *(u32x4g*)(wa + 64 * GEMM_LDK) = r.a1; *(u32x4g*)(wa + 128 * GEMM_LDK) = r.a2; *(u32x4g*)(wa + 192 * GEMM_LDK) = r.a3;
    *(u32x4g*)(wb) = r.b0; *(u32x4g*)(wb + 64 * GEMM_LDK) = r.b1;
}
__device__ __forceinline__ void gemm_compute(f32x4 (&acc)[4][4], const bf16_t* sA, const bf16_t* sB, int wm, int wn, int lane) {
#pragma unroll
    for (int ks = 0; ks < 2; ++ks) {
        bf16x8 a[4], b[4];
#pragma unroll
        for (int i = 0; i < 4; ++i) a[i] = ld8(sA + (wm * 64 + i * 16 + (lane & 15)) * GEMM_LDK + ks * 32 + (lane >> 4) * 8);
#pragma unroll
        for (int i = 0; i < 4; ++i) b[i] = ld8(sB + (wn * 64 + i * 16 + (lane & 15)) * GEMM_LDK + ks * 32 + (lane >> 4) * 8);
#pragma unroll
        for (int i = 0; i < 4; ++i)
#pragma unroll
            for (int j = 0; j < 4; ++j) acc[i][j] = mfma16(a[i], b[j], acc[i][j]);
    }
}
template <class Epi>
__device__ __forceinline__ void gemm_tile(const bf16_t* __restrict__ A, const bf16_t* __restrict__ Bt, int K, int m0, int n0, const Epi& epi, char* smem) {
    const int tid = tid_op(), lane = tid & 63, w = tid >> 6, wm = w >> 1, wn = w & 1;
    f32x4 acc[4][4];
#pragma unroll
    for (int i = 0; i < 4; ++i)
#pragma unroll
        for (int j = 0; j < 4; ++j) acc[i][j] = (f32x4){0.f, 0.f, 0.f, 0.f};
    const int lrow = tid >> 3, lkc = (tid & 7) * 8;
    const bf16_t* ga = A + (size_t)(m0 + lrow) * K + lkc;
    const bf16_t* gb = Bt + (size_t)(n0 + lrow) * K + lkc;
    const size_t astep = (size_t)64 * K;
    bf16_t* sA0 = (bf16_t*)smem; bf16_t* sB0 = (bf16_t*)(smem + GEMM_LDS_A);
    bf16_t* sA1 = (bf16_t*)(smem + GEMM_LDS_STAGE); bf16_t* sB1 = (bf16_t*)(smem + GEMM_LDS_STAGE + GEMM_LDS_A);
    const int woff = lrow * GEMM_LDK + lkc;
    GemmRegs r0, r1;
    gemm_gload(r0, ga, gb, astep);
    gemm_gload(r1, ga + 64, gb + 64, astep);
    __syncthreads();
    gemm_lstore(r0, sA0 + woff, sB0 + woff);
    __syncthreads();
    const int nk = K / 64;
    for (int k = 0; k < nk; k += 2) {
        { const int kk = (k + 2 < nk) ? k + 2 : nk - 1; gemm_gload(r0, ga + kk * 64, gb + kk * 64, astep); }
        gemm_compute(acc, sA0, sB0, wm, wn, lane);
        gemm_lstore(r1, sA1 + woff, sB1 + woff);
        __syncthreads();
        { const int kk = (k + 3 < nk) ? k + 3 : nk - 1; gemm_gload(r1, ga + kk * 64, gb + kk * 64, astep); }
        gemm_compute(acc, sA1, sB1, wm, wn, lane);
        gemm_lstore(r0, sA0 + woff, sB0 + woff);
        __syncthreads();
    }
    epi(acc, m0 + wm * 64, n0 + wn * 64, lane, smem + w * 9216);
}

struct ProjEpi {
    bf16_t *Qb, *Kb, *Vt, *IQb, *IKb, *Zb, *XBCt; float *IWf, *DTf; const float2 *cs64, *cs32; const float* dt_bias;
    __device__ __forceinline__ void operator()(const f32x4 (&acc)[4][4], int mb, int nb, int lane, char* lds) const {
        const int c = lane & 15, g = lane >> 4;
        if (nb < 1024) {
            const bool isq = nb < 512; const int head = (nb & 511) >> 6; bf16_t* dst = isq ? Qb : Kb; const float sc = isq ? 0.125f * 1.4426950408889634f : 1.f;
#pragma unroll
            for (int mi = 0; mi < 4; ++mi)
#pragma unroll
                for (int r = 0; r < 4; ++r) {
                    const int m = mb + 16 * mi + 4 * g + r, b = m >> 11, t = m & 2047;
                    bf16_t* row = dst + ((size_t)(b * 8 + head) * 2048 + t) * 64;
#pragma unroll
                    for (int ni = 0; ni < 2; ++ni) {
                        const int i = 16 * ni + c; const float2 cs = cs64[(size_t)m * 32 + i];
                        const float x1 = acc[mi][ni][r], x2 = acc[mi][ni + 2][r];
                        row[i] = f2bf((x1 * cs.x - x2 * cs.y) * sc); row[i + 32] = f2bf((x2 * cs.x + x1 * cs.y) * sc);
                    }
                }
        } else if (nb < 1536) {
            const int head = (nb - 1024) >> 6;
#pragma unroll
            for (int mi = 0; mi < 4; ++mi) {
                const int m = mb + 16 * mi + 4 * g, b = m >> 11, t0 = m & 2047;
#pragma unroll
                for (int ni = 0; ni < 4; ++ni) {
                    const int d = 16 * ni + c;
                    *(uint2*)(Vt + ((size_t)(b * 8 + head) * 64 + d) * 2048 + t0) = make_uint2(pack2(acc[mi][ni][0], acc[mi][ni][1]), pack2(acc[mi][ni][2], acc[mi][ni][3]));
                }
            }
        } else if (nb < 1792) {
            const float isc = 0.17677669529663687f;
#pragma unroll
            for (int pr = 0; pr < 2; ++pr) {
                const int headi = ((nb - 1536) >> 5) + pr;
#pragma unroll
                for (int mi = 0; mi < 4; ++mi)
#pragma unroll
                    for (int r = 0; r < 4; ++r) {
                        const int m = mb + 16 * mi + 4 * g + r; const float2 cs = cs32[(size_t)m * 16 + c];
                        const float x1 = acc[mi][2 * pr][r], x2 = acc[mi][2 * pr + 1][r];
                        bf16_t* dst = IQb + ((size_t)m * 8 + headi) * 32;
                        dst[c] = f2bf((x1 * cs.x - x2 * cs.y) * isc); dst[c + 16] = f2bf((x2 * cs.x + x1 * cs.y) * isc);
                    }
            }
        } else if (nb == 1792) {
#pragma unroll
            for (int mi = 0; mi < 4; ++mi)
#pragma unroll
                for (int r = 0; r < 4; ++r) {
                    const int m = mb + 16 * mi + 4 * g + r; const float2 cs = cs32[(size_t)m * 16 + c];
                    const float x1 = acc[mi][0][r], x2 = acc[mi][1][r];
                    bf16_t* dst = IKb + (size_t)m * 32;
                    dst[c] = f2bf(x1 * cs.x - x2 * cs.y); dst[c + 16] = f2bf(x2 * cs.x + x1 * cs.y);
                    const float v = acc[mi][2][r];
                    if (c < 8) IWf[(size_t)m * 8 + c] = v * 0.35355339059327373f;
                    else { const float xx = v + dt_bias[c - 8]; DTf[(size_t)m * 8 + (c - 8)] = (xx > 20.f) ? xx : log1pf(expf(xx)); }
                }
        } else if (nb < 2368) {
#pragma unroll
            for (int mi = 0; mi < 4; ++mi)
#pragma unroll
                for (int r = 0; r < 4; ++r) {
                    const int m = mb + 16 * mi + 4 * g + r;
#pragma unroll
                    for (int ni = 0; ni < 4; ++ni) Zb[(size_t)m * 512 + (nb - ZOFF) + 16 * ni + c] = f2bf(acc[mi][ni][r]);
                }
        } else if (nb < 3392) {
#pragma unroll
            for (int mi = 0; mi < 4; ++mi) {
                const int m = mb + 16 * mi + 4 * g, b = m >> 11, t0 = m & 2047;
#pragma unroll
                for (int ni = 0; ni < 4; ++ni) {
                    const int ch = nb - XBCOFF + 16 * ni + c;
                    *(uint2*)(XBCt + ((size_t)b * 1024 + ch) * 2048 + t0) = make_uint2(pack2(acc[mi][ni][0], acc[mi][ni][1]), pack2(acc[mi][ni][2], acc[mi][ni][3]));
                }
            }
        }
    }
};
__device__ __forceinline__ void phase1(const Params& p, char* smem, const XcdMap xm) {
    ProjEpi e; char* ws = p.ws;
    e.Qb = (bf16_t*)(ws + O_QB); e.Kb = (bf16_t*)(ws + O_KB); e.Vt = (bf16_t*)(ws + O_VT); e.IQb = (bf16_t*)(ws + O_IQB); e.IKb = (bf16_t*)(ws + O_IKB);
    e.Zb = (bf16_t*)(ws + O_ZB); e.XBCt = (bf16_t*)(ws + O_XBCT); e.IWf = (float*)(ws + O_IWF); e.DTf = (float*)(ws + O_DTF);
    e.cs64 = (const float2*)(ws + O_CS64); e.cs32 = (const float2*)(ws + O_CS32); e.dt_bias = p.dt_bias;
    int tm, tn;
    for (int it = 0; gemm_next_tile(xm, it, NP / 128, tm, tn); ++it)
        gemm_tile((const bf16_t*)(ws + O_XB), (const bf16_t*)(ws + O_WIN_T), 1024, tm * 256, tn * 128, e, smem);
}

#define IDX_NT 16
#define IDX_LDS_SCORES (16 * 2048 * 4)
__device__ __forceinline__ unsigned wave_sum_cnt(unsigned v) {
    v = row_sum_u(v);
    v += (unsigned)dpp_i<0x142, 0xA, false>((int)v);
    v += (unsigned)dpp_i<0x143, 0xC, false>((int)v);
    return (unsigned)__builtin_amdgcn_readlane((int)v, 63);
}
template <int NR> __device__ __forceinline__ unsigned idx_count_ge(const unsigned (&k)[NR], unsigned cand) {
    unsigned n = 0u;
#pragma unroll
    for (int i = 0; i < NR; ++i) n += (k[i] >= cand) ? 1u : 0u;
    return wave_sum_cnt(n);
}
template <int NR> __device__ __forceinline__ unsigned long long idx_words(const unsigned (&k)[NR], unsigned K, bool exact, int lane) {
    unsigned long long wd = 0ull;
    if (exact) {
#pragma unroll
        for (int i = 0; i < NR; ++i) { const unsigned long long bal = __ballot(k[i] >= K); if (lane == i) wd = bal; }
    } else {
        unsigned n = 0u;
#pragma unroll
        for (int i = 0; i < NR; ++i) n += (k[i] > K) ? 1u : 0u;
        unsigned rem = 256u - wave_sum_cnt(n);
#pragma unroll 1
        for (int i = 0; i < NR; ++i) {
            unsigned ki = k[0];
#pragma unroll
            for (int j = 1; j < NR; ++j) ki = (j == i) ? k[j] : ki;
            const unsigned long long gt = __ballot(ki > K), eq = __ballot(ki == K);
            unsigned long long take = 0ull, e = eq;
            while (rem > 0u && e) { take |= e & (~e + 1ull); e &= e - 1ull; --rem; }
            if (lane == i) wd = gt | take;
        }
    }
    return wd;
}
template <int NR> __device__ __forceinline__ void idx_select(const unsigned* Sa, unsigned long long* mrow, int lane) {
    unsigned ka[NR], kb[NR];
#pragma unroll
    for (int i = 0; i < NR; ++i) { ka[i] = Sa[64 * i]; kb[i] = Sa[2048 + 64 * i]; }
    unsigned Ka = 0u, Kb = 0u; bool da = false, db = false;
    for (int bit = 31; bit >= 0; --bit) {
        const unsigned ca = Ka | (1u << bit), cb = Kb | (1u << bit);
        const unsigned ta = idx_count_ge<NR>(ka, ca), tb = idx_count_ge<NR>(kb, cb);
        if (!da && ta >= 256u) { Ka = ca; da = (ta == 256u); }
        if (!db && tb >= 256u) { Kb = cb; db = (tb == 256u); }
        if (da && db) break;
    }
    const unsigned long long wa = idx_words<NR>(ka, Ka, da, lane), wb = idx_words<NR>(kb, Kb, db, lane);
    if (lane < NR) { mrow[lane] = wa; mrow[32 + lane] = wb; }
}
__device__ __forceinline__ void indexer_unit(const Params& p, int unit, char* smem) {
    const int tid = tid_op(), lane = tid & 63, w = tid >> 6, c = lane & 15, g = lane >> 4;
    const int b = unit & 7, grp = 127 - (unit >> 3), t0 = grp * 16;
    char* ws = p.ws;
    unsigned long long* mask64 = (unsigned long long*)(ws + O_MASK) + (size_t)(b * 2048 + t0) * 32;
    const int nblk64 = (t0 + 16 + 63) >> 6;
    if (t0 < 256) {
        for (int i = tid; i < 16 * nblk64; i += 512) {
            const int q = i / nblk64, wd = i % nblk64, t = t0 + q, s0 = wd * 64;
            const unsigned long long bits = (t >= s0 + 63) ? ~0ull : (t < s0 ? 0ull : ((1ull << (t - s0 + 1)) - 1ull));
            mask64[q * 32 + wd] = bits;
        }
        return;
    }
    const int ntile = (nblk64 + 1) >> 1;
    const bf16_t* IQb = (const bf16_t*)(ws + O_IQB); const bf16_t* IKb = (const bf16_t*)(ws + O_IKB); const float* IWf = (const float*)(ws + O_IWF);
    unsigned* S = (unsigned*)smem;
    float* siw = (float*)(smem + IDX_LDS_SCORES);
    __syncthreads();
    if (tid < 128) siw[tid] = IWf[(size_t)(b * 2048 + t0) * 8 + tid];
    {
        const int nr = (nblk64 <= 8) ? 8 : (nblk64 <= 16) ? 16 : (nblk64 <= 24) ? 24 : 32, kfrom = 8 * ntile * 16, kto = nr * 64;
        for (int i = tid; i < 16 * (kto - kfrom); i += 512) { const int q = i / (kto - kfrom), k = kfrom + i % (kto - kfrom); S[q * 2048 + k] = 0u; }
    }
    __syncthreads();
    {
        bf16x8 aq[8];
#pragma unroll
        for (int h = 0; h < 8; ++h) aq[h] = ld8(IQb + ((size_t)(b * 2048 + t0 + c) * 8 + h) * 32 + g * 8);
        float wq[4][8];
#pragma unroll
        for (int r = 0; r < 4; ++r)
#pragma unroll
            for (int h = 0; h < 8; ++h) wq[r][h] = siw[(4 * g + r) * 8 + h];
        bf16x8 bk[IDX_NT];
#pragma unroll
        for (int i = 0; i < IDX_NT; ++i) {
            const int ti = (i < ntile) ? (w * ntile + i) : (w * ntile);
            bk[i] = ld8(IKb + (size_t)(b * 2048 + ti * 16 + c) * 32 + g * 8);
        }
#pragma unroll
        for (int i = 0; i < IDX_NT; ++i) {
            if (i < ntile) {
                const int s0 = (w * ntile + i) * 16;
                float sc[4] = {0.f, 0.f, 0.f, 0.f};
#pragma unroll
                for (int h = 0; h < 8; ++h) {
                    const f32x4 o = mfma16(aq[h], bk[i], (f32x4){0.f, 0.f, 0.f, 0.f});
#pragma unroll
                    for (int r = 0; r < 4; ++r) sc[r] += wq[r][h] * fmaxf(o[r], 0.f);
                }
#pragma unroll
                for (int r = 0; r < 4; ++r) S[(4 * g + r) * 2048 + s0 + c] = (s0 + c <= t0 + 4 * g + r) ? f2sort(sc[r]) : 0u;
            }
        }
    }
    __syncthreads();
    if (nblk64 <= 8) idx_select<8>(S + (2 * w) * 2048 + lane, mask64 + (2 * w) * 32, lane);
    else if (nblk64 <= 16) idx_select<16>(S + (2 * w) * 2048 + lane, mask64 + (2 * w) * 32, lane);
    else if (nblk64 <= 24) idx_select<24>(S + (2 * w) * 2048 + lane, mask64 + (2 * w) * 32, lane);
    else idx_select<32>(S + (2 * w) * 2048 + lane, mask64 + (2 * w) * 32, lane);
}

__device__ __forceinline__ void ssd_prep_unit(const Params& p, int unit, char* smem) {
    const int tid = tid_op(), lane = tid & 63, w = tid >> 6, cL = lane & 15, gq = lane >> 4;
    const int h = unit & 7, c = (unit >> 3) & 15, b = unit >> 7, g = h >> 2;
    char* ws = p.ws;
    float* s_acum = (float*)smem; float* s_dt = s_acum + 128; float* s_w = s_dt + 128;
    bf16_t* sXw = (bf16_t*)(smem + 2048); bf16_t* sBt = sXw + 64 * 136;
    const int tok0 = b * 2048 + c * 128;
    const float a_h = -expf(p.a_log[h]);
    const float* DTf = (const float*)(ws + O_DTF);
    __syncthreads();
    if (tid < 128) s_dt[tid] = DTf[(size_t)(tok0 + tid) * 8 + h];
    __syncthreads();
    if (tid < 128) {
        float s = 0.f;
        for (int k = 0; k <= tid; ++k) s += s_dt[k] * a_h;
        s_acum[tid] = s;
        ((float*)(ws + O_ACUM))[(size_t)(b * 8 + h) * 2048 + c * 128 + tid] = s;
    }
    __syncthreads();
    if (tid < 128) {
        const float tot = s_acum[127];
        s_w[tid] = s_dt[tid] * __expf(tot - s_acum[tid]);
        if (tid == 0) ((float*)(ws + O_ATOT))[(b * 8 + h) * 16 + c] = tot;
    }
    __syncthreads();
    const bf16_t* XBCt = (const bf16_t*)(ws + O_XBCT);
    bf16_t* Xt = (bf16_t*)(ws + O_XT); bf16_t* Brm = (bf16_t*)(ws + O_BRM); bf16_t* Crm = (bf16_t*)(ws + O_CRM);
#pragma unroll
    for (int bt = 0; bt < 2; ++bt) {
    const int it0 = bt * 4, itn = bt ? 3 : 4;
    u32x4g cur7[4], prv7[4]; float cw7[4][5];
#pragma unroll
    for (int it = 0; it < 4; ++it) if (it < itn) {
        const int item = tid + 512 * (it0 + it);
        int ch; const int tc = item & 15;
        if (item < 1024) ch = h * 64 + (item >> 4);
        else if (item < 3072) ch = 512 + g * 128 + ((item - 1024) >> 4);
        else ch = 768 + g * 128 + (h & 3) * 32 + ((item - 3072) >> 4);
        const bf16_t* src = XBCt + ((size_t)b * 1024 + ch) * 2048 + c * 128 + tc * 8;
        cur7[it] = *(const u32x4g*)src;
        const bool hasprev = (c * 128 + tc * 8 >= 8);
        prv7[it] = *(const u32x4g*)(hasprev ? src - 8 : src);
        if (!hasprev) prv7[it] = (u32x4g){0u, 0u, 0u, 0u};
        cw7[it][0] = p.conv_w[ch]; cw7[it][1] = p.conv_w[1024 + ch]; cw7[it][2] = p.conv_w[2048 + ch]; cw7[it][3] = p.conv_w[3072 + ch]; cw7[it][4] = p.conv_b[ch];
    }
#pragma unroll
    for (int it = 0; it < 4; ++it) if (it < itn) {
        const int item = tid + 512 * (it0 + it);
        int kind, idx, ch; const int tc = item & 15;
        if (item < 1024) { kind = 0; idx = item >> 4; ch = h * 64 + idx; }
        else if (item < 3072) { kind = 1; idx = (item - 1024) >> 4; ch = 512 + g * 128 + idx; }
        else { kind = 2; idx = (h & 3) * 32 + ((item - 3072) >> 4); ch = 768 + g * 128 + idx; }
        const u32x4g cur = cur7[it], prv = prv7[it];
        float xv[11];
        xv[0] = bf2f((bf16_t)(prv.z >> 16)); xv[1] = bf2f((bf16_t)(prv.w & 0xFFFF)); xv[2] = bf2f((bf16_t)(prv.w >> 16));
        xv[3] = bf2f((bf16_t)(cur.x & 0xFFFF)); xv[4] = bf2f((bf16_t)(cur.x >> 16)); xv[5] = bf2f((bf16_t)(cur.y & 0xFFFF)); xv[6] = bf2f((bf16_t)(cur.y >> 16));
        xv[7] = bf2f((bf16_t)(cur.z & 0xFFFF)); xv[8] = bf2f((bf16_t)(cur.z >> 16)); xv[9] = bf2f((bf16_t)(cur.w & 0xFFFF)); xv[10] = bf2f((bf16_t)(cur.w >> 16));
        const float w0 = cw7[it][0], w1 = cw7[it][1], w2 = cw7[it][2], w3 = cw7[it][3], bias = cw7[it][4];
        float o[8];
#pragma unroll
        for (int j = 0; j < 8; ++j) { const float v = bias + w0 * xv[j] + w1 * xv[j + 1] + w2 * xv[j + 2] + w3 * xv[j + 3]; o[j] = bf2f(f2bf(silu_f(v))); }
        if (kind == 0) {
            *(uint4*)(Xt + ((size_t)b * 512 + ch) * 2048 + c * 128 + tc * 8) = make_uint4(pack2(o[0], o[1]), pack2(o[2], o[3]), pack2(o[4], o[5]), pack2(o[6], o[7]));
            float q[8];
#pragma unroll
            for (int j = 0; j < 8; ++j) q[j] = o[j] * s_w[tc * 8 + j];
            *(uint4*)(sXw + idx * 136 + tc * 8) = make_uint4(pack2(q[0], q[1]), pack2(q[2], q[3]), pack2(q[4], q[5]), pack2(q[6], q[7]));
        } else if (kind == 1) {
            *(uint4*)(sBt + idx * 136 + tc * 8) = make_uint4(pack2(o[0], o[1]), pack2(o[2], o[3]), pack2(o[4], o[5]), pack2(o[6], o[7]));
            if ((h & 3) == 0) {
#pragma unroll
                for (int j = 0; j < 8; ++j) Brm[(size_t)(tok0 + tc * 8 + j) * 256 + g * 128 + idx] = f2bf(o[j]);
            }
        } else {
#pragma unroll
            for (int j = 0; j < 8; ++j) Crm[(size_t)(tok0 + tc * 8 + j) * 256 + g * 128 + idx] = f2bf(o[j]);
        }
    }
    }
    __syncthreads();
    f32x4 acc[4];
#pragma unroll
    for (int i = 0; i < 4; ++i) acc[i] = (f32x4){0.f, 0.f, 0.f, 0.f};
#pragma unroll
    for (int ks = 0; ks < 4; ++ks) {
        const bf16x8 bb = ld8(sBt + (16 * w + cL) * 136 + ks * 32 + gq * 8);
#pragma unroll
        for (int pt = 0; pt < 4; ++pt) acc[pt] = mfma16(ld8(sXw + (16 * pt + cL) * 136 + ks * 32 + gq * 8), bb, acc[pt]);
    }
    float* ST = (float*)(ws + O_ST) + ((size_t)((b * 16 + c) * 8 + h)) * 8192;
#pragma unroll
    for (int pt = 0; pt < 4; ++pt)
#pragma unroll
        for (int r = 0; r < 4; ++r) ST[(16 * pt + 4 * gq + r) * 128 + 16 * w + cL] = acc[pt][r];
}

__device__ __forceinline__ void phase2c(const Params& p) {
    char* ws = p.ws;
    const int idx = blockIdx.x * 512 + tid_op();
    if (idx >= 64 * 2048) return;
    const int bh = idx >> 11, e4 = idx & 2047, b = bh >> 3, h = bh & 7;
    const float* ST = (const float*)(ws + O_ST); const float* ATOT = (const float*)(ws + O_ATOT);
    float4 sv[16]; float4 at4[4];
#pragma unroll
    for (int c = 0; c < 16; ++c) sv[c] = *(const float4*)(ST + ((size_t)((b * 16 + c) * 8 + h)) * 8192 + (size_t)e4 * 4);
#pragma unroll
    for (int k = 0; k < 4; ++k) at4[k] = *(const float4*)(ATOT + bh * 16 + 4 * k);
    const float at[16] = {at4[0].x, at4[0].y, at4[0].z, at4[0].w, at4[1].x, at4[1].y, at4[1].z, at4[1].w, at4[2].x, at4[2].y, at4[2].z, at4[2].w, at4[3].x, at4[3].y, at4[3].z, at4[3].w};
    float4 car = make_float4(0.f, 0.f, 0.f, 0.f);
    bf16_t* CAR = (bf16_t*)(ws + O_CAR);
#pragma unroll
    for (int c = 0; c < 16; ++c) {
        *(uint2*)(CAR + ((size_t)((b * 16 + c) * 8 + h)) * 8192 + (size_t)e4 * 4) = make_uint2(pack2(car.x, car.y), pack2(car.z, car.w));
        const float dec = __expf(at[c]);
        car.x = dec * car.x + sv[c].x; car.y = dec * car.y + sv[c].y; car.z = dec * car.z + sv[c].z; car.w = dec * car.w + sv[c].w;
    }
}

#define ATT_LDK 80
#define ATT_LDV 72
__device__ __forceinline__ void attn_unit(const Params& p, int unit, char* smem) {
    const int tid = tid_op(), lane = tid & 63, w = tid >> 6, cL = lane & 15, gq = lane >> 4;
    const int qb = 15 - (unit >> 6), bh = unit & 63, b = bh >> 3, h = bh & 7;
    char* ws = p.ws;
    const int q0 = qb * 128 + 16 * w;
    const int ktmax = (q0 + 15) >> 6;
    const int ntile = 2 * qb + 2;
    const bf16_t* Q = (const bf16_t*)(ws + O_QB) + (size_t)bh * 2048 * 64;
    const bf16_t* Kp = (const bf16_t*)(ws + O_KB) + (size_t)bh * 2048 * 64;
    const bf16_t* V = (const bf16_t*)(ws + O_VT) + (size_t)bh * 64 * 2048;
    const unsigned short* mrow = (const unsigned short*)(ws + O_MASK) + (size_t)(b * 2048 + q0 + cL) * 128;
    bf16_t* sK = (bf16_t*)smem;
    bf16_t* sV = (bf16_t*)(smem + 2 * 64 * ATT_LDK * 2);
    const int lr = tid >> 3, lc = (tid & 7) * 8;
    bf16x8 qf[2];
    qf[0] = ld8(Q + (size_t)(q0 + cL) * 64 + gq * 8); qf[1] = ld8(Q + (size_t)(q0 + cL) * 64 + 32 + gq * 8);
    float m_run = -1e30f, l_run = 0.f;
    f32x4 o[4];
#pragma unroll
    for (int i = 0; i < 4; ++i) o[i] = (f32x4){0.f, 0.f, 0.f, 0.f};
    u32x4g rk = *(const u32x4g*)(Kp + (size_t)lr * 64 + lc);
    u32x4g rv = *(const u32x4g*)(V + (size_t)lr * 2048 + lc);
    u32x4g rk1 = *(const u32x4g*)(Kp + (size_t)(64 + lr) * 64 + lc);
    u32x4g rv1 = *(const u32x4g*)(V + (size_t)lr * 2048 + 64 + lc);
    __syncthreads();
    *(u32x4g*)(sK + lr * ATT_LDK + lc) = rk; *(u32x4g*)(sV + lr * ATT_LDV + lc) = rv;
    __syncthreads();
    for (int kt = 0; kt < ntile; ++kt) {
        const int s0 = kt * 64, cur = kt & 1;
        rk = rk1; rv = rv1;
        { const int t2 = (kt + 2 < ntile) ? kt + 2 : ntile - 1; rk1 = *(const u32x4g*)(Kp + (size_t)(t2 * 64 + lr) * 64 + lc); rv1 = *(const u32x4g*)(V + (size_t)lr * 2048 + t2 * 64 + lc); }
        if (kt <= ktmax) {
            const bf16_t* tK = sK + cur * 64 * ATT_LDK; const bf16_t* tV = sV + cur * 64 * ATT_LDV;
            const unsigned long long mb = *(const unsigned long long*)(mrow + kt * 4);
            f32x4 st[4];
#pragma unroll
            for (int j = 0; j < 4; ++j) {
                f32x4 a = (f32x4){0.f, 0.f, 0.f, 0.f};
                const bf16_t* kr = tK + (16 * j + cL) * ATT_LDK + gq * 8;
                a = mfma16(ld8(kr), qf[0], a); a = mfma16(ld8(kr + 32), qf[1], a);
                st[j] = a;
            }
            float mx = m_run;
            const unsigned mlo = (unsigned)mb >> (4 * gq), mhi = (unsigned)(mb >> 32) >> (4 * gq);
#pragma unroll
            for (int j = 0; j < 4; ++j)
#pragma unroll
                for (int r = 0; r < 4; ++r) {
                    const bool bit = ((j < 2 ? mlo : mhi) & (1u << (16 * (j & 1) + r))) != 0u;
                    const float v = bit ? st[j][r] : -INFINITY;
                    st[j][r] = v; mx = fmaxf(mx, v);
                }
            mx = max_x32(max_x16(mx));
            const float alpha = __builtin_amdgcn_exp2f(m_run - mx); m_run = mx;
            float ls = 0.f;
#pragma unroll
            for (int j = 0; j < 4; ++j)
#pragma unroll
                for (int r = 0; r < 4; ++r) { const float pv = __builtin_amdgcn_exp2f(st[j][r] - mx); st[j][r] = pv; ls += pv; }
            ls = sum_x32(sum_x16(ls));
            l_run = l_run * alpha + ls;
#pragma unroll
            for (int i = 0; i < 4; ++i) o[i] = o[i] * alpha;
#pragma unroll
            for (int kk = 0; kk < 2; ++kk) {
                bf16x8 pf;
#pragma unroll
                for (int r = 0; r < 4; ++r) { pf[r] = (short)f2bf(st[2 * kk][r]); pf[4 + r] = (short)f2bf(st[2 * kk + 1][r]); }
#pragma unroll
                for (int dt = 0; dt < 4; ++dt) {
                    const bf16_t* vr = tV + (16 * dt + cL) * ATT_LDV + 32 * kk + 4 * gq;
                    o[dt] = mfma16(cat4(*(const bf16x4*)vr, *(const bf16x4*)(vr + 16)), pf, o[dt]);
                }
            }
        }
        if (kt + 1 < ntile) {
            const int nxt = cur ^ 1;
            *(u32x4g*)(sK + nxt * 64 * ATT_LDK + lr * ATT_LDK + lc) = rk; *(u32x4g*)(sV + nxt * 64 * ATT_LDV + lr * ATT_LDV + lc) = rv;
        }
        __syncthreads();
    }
    const float inv = 1.f / l_run;
    bf16_t* mix = (bf16_t*)(ws + O_MIX) + (size_t)(b * 2048 + q0 + cL) * 1024 + h * 64;
#pragma unroll
    for (int dt = 0; dt < 4; ++dt)
        *(uint2*)(mix + 16 * dt + 4 * gq) = make_uint2(pack2(o[dt][0] * inv, o[dt][1] * inv), pack2(o[dt][2] * inv, o[dt][3] * inv));
}

#define SSD_CAR_BYTES (4 * 64 * 136 * 2)
__device__ __forceinline__ void ssd_main_unit(const Params& p, int unit, char* smem) {
    const int tid = tid_op(), lane = tid & 63, w = tid >> 6, cL = lane & 15, gq = lane >> 4;
    const int g = unit & 1, c = (unit >> 1) & 15, b = unit >> 5;
    char* ws = p.ws;
    float* sAc = (float*)smem;
    float* sDt = sAc + 512;
    const int tok0 = b * 2048 + c * 128;
    const float* ATOT = (const float*)(ws + O_ATOT); const float* ACUM = (const float*)(ws + O_ACUM); const float* DTf = (const float*)(ws + O_DTF);
    const bf16_t* Xt = (const bf16_t*)(ws + O_XT); const bf16_t* Brm = (const bf16_t*)(ws + O_BRM); const bf16_t* Crm = (const bf16_t*)(ws + O_CRM);
    const bf16_t* Zb = (const bf16_t*)(ws + O_ZB);
    __syncthreads();
    {
        const int hh = tid >> 7, l = tid & 127;
        sAc[tid] = ACUM[(size_t)(b * 8 + 4 * g + hh) * 2048 + c * 128 + l];
        sDt[tid] = DTf[(size_t)(tok0 + l) * 8 + 4 * g + hh];
    }
    __syncthreads();
    bf16_t* mix = (bf16_t*)(ws + O_MIX);
    const int lt = w;
    const int ltok = tok0 + 16 * lt + cL;
    bf16x8 Cq[4];
#pragma unroll
    for (int ks = 0; ks < 4; ++ks) Cq[ks] = ld8(Crm + (size_t)ltok * 256 + g * 128 + ks * 32 + gq * 8);
    f32x4 cbT[8];
#pragma unroll
    for (int st = 0; st < 8; ++st) {
        cbT[st] = (f32x4){0.f, 0.f, 0.f, 0.f};
        if (st <= lt) {
            const bf16_t* br = Brm + (size_t)(tok0 + 16 * st + cL) * 256 + g * 128 + gq * 8;
#pragma unroll
            for (int ks = 0; ks < 4; ++ks) cbT[st] = mfma16(ld8(br + ks * 32), Cq[ks], cbT[st]);
        }
    }
    float ssq = 0.f;
#pragma unroll 1
    for (int hh = 0; hh < 4; ++hh) {
        const int h = 4 * g + hh;
        const float* ac = sAc + hh * 128; const float* dtl = sDt + hh * 128;
        const float al = ac[16 * lt + cL];
        const bf16_t* xh = Xt + ((size_t)b * 512 + h * 64) * 2048 + c * 128;
        const bf16_t* zh = Zb + (size_t)tok0 * 512 + h * 64;
        const bf16_t* carh = (const bf16_t*)(ws + O_CAR) + ((size_t)((b * 16 + c) * 8 + h)) * 8192;
        bf16x8 xf[4][4];
#pragma unroll
        for (int kk = 0; kk < 4; ++kk)
#pragma unroll
            for (int pt = 0; pt < 4; ++pt) {
                const int kc = (2 * kk <= lt) ? kk : 0;
                const unsigned xo = (unsigned)((16 * pt + cL) * 2048 + 32 * kc + 4 * gq);
                xf[kk][pt] = cat4(*(const bf16x4*)(xh + xo), *(const bf16x4*)(xh + xo + 16));
            }
        f32x4 acc1[4], acc2[4];
#pragma unroll
        for (int i = 0; i < 4; ++i) { acc1[i] = (f32x4){0.f, 0.f, 0.f, 0.f}; acc2[i] = (f32x4){0.f, 0.f, 0.f, 0.f}; }
#pragma unroll
        for (int kk = 0; kk < 4; ++kk) {
            if (2 * kk <= lt) {
                bf16x8 mf;
#pragma unroll
                for (int half = 0; half < 2; ++half) {
                    const int st = 2 * kk + half;
#pragma unroll
                    for (int r = 0; r < 4; ++r) {
                        const int sl = 16 * st + 4 * gq + r;
                        float v = 0.f;
                        if (st <= lt && sl <= 16 * lt + cL) v = cbT[st][r] * __expf(al - ac[sl]) * dtl[sl];
                        mf[half * 4 + r] = (short)f2bf(v);
                    }
                }
#pragma unroll
                for (int pt = 0; pt < 4; ++pt) acc1[pt] = mfma16(xf[kk][pt], mf, acc1[pt]);
            }
        }
        uint2 zz[4]; bf16_t xsv[4][4];
#pragma unroll
        for (int pt = 0; pt < 4; ++pt) {
            zz[pt] = *(const uint2*)(zh + (unsigned)((16 * lt + cL) * 512 + 16 * pt + 4 * gq));
#pragma unroll
            for (int r = 0; r < 4; ++r) xsv[pt][r] = xh[(unsigned)((16 * pt + 4 * gq + r) * 2048 + 16 * lt + cL)];
        }
#pragma unroll
        for (int ks = 0; ks < 4; ++ks)
#pragma unroll
            for (int pt = 0; pt < 4; ++pt) acc2[pt] = mfma16(ld8(carh + (unsigned)((16 * pt + cL) * 128 + ks * 32 + gq * 8)), Cq[ks], acc2[pt]);
        const float el = __expf(al), dsk = p.d_skip[h];
#pragma unroll
        for (int pt = 0; pt < 4; ++pt) {
            const float zf[4] = {bf2f((bf16_t)(zz[pt].x & 0xFFFF)), bf2f((bf16_t)(zz[pt].x >> 16)), bf2f((bf16_t)(zz[pt].y & 0xFFFF)), bf2f((bf16_t)(zz[pt].y >> 16))};
            float yv[4];
#pragma unroll
            for (int r = 0; r < 4; ++r) {
                float t = acc1[pt][r] + el * acc2[pt][r] + bf2f(xsv[pt][r]) * dsk;
                t *= silu_f(zf[r]);
                yv[r] = t; ssq += t * t;
            }
            *(uint2*)(mix + (size_t)ltok * 1024 + 512 + h * 64 + 16 * pt + 4 * gq) = make_uint2(pack2(yv[0], yv[1]), pack2(yv[2], yv[3]));
        }
    }
    ssq = sum_x32(sum_x16(ssq));
    const float rstd = rsqrtf(ssq * (1.f / 256.f) + LN_EPS);
#pragma unroll
    for (int hh = 0; hh < 4; ++hh)
#pragma unroll
        for (int pt = 0; pt < 4; ++pt) {
            const int ch = (4 * g + hh) * 64 + 16 * pt + 4 * gq;
            const float4 nw = *(const float4*)(p.norm_w + ch);
            const uint2 yy = *(const uint2*)(mix + (size_t)ltok * 1024 + 512 + ch);
            const float y0 = bf2f((bf16_t)(yy.x & 0xFFFF)), y1 = bf2f((bf16_t)(yy.x >> 16)), y2 = bf2f((bf16_t)(yy.y & 0xFFFF)), y3 = bf2f((bf16_t)(yy.y >> 16));
            *(uint2*)(mix + (size_t)ltok * 1024 + 512 + ch) = make_uint2(pack2(y0 * rstd * nw.x, y1 * rstd * nw.y), pack2(y2 * rstd * nw.z, y3 * rstd * nw.w));
        }
}

__device__ __forceinline__ void phase2(const Params& p, char* smem, int which = 3) {
    const int G = gridDim.x;
    for (int k = 0; k * G < 2048; ++k) {
        const int u = k * G + ((k & 1) ? (G - 1 - (int)blockIdx.x) : (int)blockIdx.x);
        if (u >= 2048) continue;
        if (u < 1024) { if (which & 1) indexer_unit(p, u, smem); } else { if (which & 2) ssd_prep_unit(p, u - 1024, smem); }
    }
}
__device__ __forceinline__ void phase3(const Params& p, char* smem, int which = 3) {
    const int G = gridDim.x;
    for (int k = 0; k * G < 1024 + 256; ++k) {
        const int u = k * G + ((k & 1) ? (G - 1 - (int)blockIdx.x) : (int)blockIdx.x);
        if (u >= 1024 + 256) continue;
        if (u < 256) { if (which & 1) ssd_main_unit(p, u, smem); } else { if (which & 2) attn_unit(p, u - 256, smem); }
    }
}

struct OutEpi {
    const float* x; float* y;
    __device__ __forceinline__ void operator()(const f32x4 (&acc)[4][4], int mb, int nb, int lane, char* lds) const {
        const int c = lane & 15, g = lane >> 4;
        float* L = (float*)lds;
#pragma unroll
        for (int half = 0; half < 2; ++half) {
#pragma unroll
            for (int mi2 = 0; mi2 < 2; ++mi2)
#pragma unroll
                for (int r = 0; r < 4; ++r)
#pragma unroll
                    for (int ni = 0; ni < 4; ++ni) L[(16 * mi2 + 4 * g + r) * 68 + 16 * ni + c] = acc[2 * half + mi2][ni][r];
#pragma unroll
            for (int i = 0; i < 8; ++i) {
                const int row = 4 * i + g;
                const float4 a = *(const float4*)(L + row * 68 + 4 * c);
                const size_t o = (size_t)(mb + 32 * half + row) * 1024 + nb + 4 * c;
                const float4 xv = *(const float4*)(x + o);
                *(float4*)(y + o) = make_float4(ALPHA * xv.x + a.x, ALPHA * xv.y + a.y, ALPHA * xv.z + a.z, ALPHA * xv.w + a.w);
            }
        }
    }
};
__device__ __forceinline__ void phase4(const Params& p, char* smem, const XcdMap xm) {
    OutEpi e; e.x = p.x; e.y = p.out;
    int tm, tn;
    for (int it = 0; gemm_next_tile(xm, it, 8, tm, tn); ++it)
        gemm_tile((const bf16_t*)(p.ws + O_MIX), (const bf16_t*)(p.ws + O_WOUT_T), 1024, tm * 256, tn * 128, e, smem);
}

__device__ __forceinline__ void phase5(const Params& p) {
    const int lane = tid_op() & 63, w = tid_op() >> 6;
    bf16_t* hb = (bf16_t*)(p.ws + O_HB);
    for (int row = blockIdx.x * 8 + w; row < NTOK; row += gridDim.x * 8) {
        float* yr = p.out + (size_t)row * 1024;
        float4 v[4]; float s = 0.f;
#pragma unroll
        for (int j = 0; j < 4; ++j) { v[j] = *(const float4*)(yr + 4 * lane + 256 * j); s += v[j].x + v[j].y + v[j].z + v[j].w; }
        const float mean = wave_sum(s) * (1.f / 1024.f);
        float q = 0.f;
#pragma unroll
        for (int j = 0; j < 4; ++j) { const float a = v[j].x - mean, b2 = v[j].y - mean, c2 = v[j].z - mean, d = v[j].w - mean; q += a * a + b2 * b2 + c2 * c2 + d * d; }
        const float rstd = rsqrtf(wave_sum(q) * (1.f / 1024.f) + LN_EPS);
#pragma unroll
        for (int j = 0; j < 4; ++j) {
            const int col = 4 * lane + 256 * j;
            const float4 gg = *(const float4*)(p.ln1_g + col), bb = *(const float4*)(p.ln1_b + col);
            float4 o;
            o.x = (v[j].x - mean) * rstd * gg.x + bb.x; o.y = (v[j].y - mean) * rstd * gg.y + bb.y; o.z = (v[j].z - mean) * rstd * gg.z + bb.z; o.w = (v[j].w - mean) * rstd * gg.w + bb.w;
            *(float4*)(yr + col) = o;
            *(uint2*)(hb + (size_t)row * 1024 + col) = make_uint2(pack2(o.x, o.y), pack2(o.z, o.w));
            int ph = __builtin_amdgcn_cvt_pk_fp8_f32(o.x, o.y, 0, false); ph = __builtin_amdgcn_cvt_pk_fp8_f32(o.z, o.w, ph, true);
            const f32x2 b01 = __builtin_amdgcn_cvt_pk_f32_fp8(ph, false), b23 = __builtin_amdgcn_cvt_pk_f32_fp8(ph, true);
            int pl = __builtin_amdgcn_cvt_pk_fp8_f32((o.x - b01.x) * 16.f, (o.y - b01.y) * 16.f, 0, false); pl = __builtin_amdgcn_cvt_pk_fp8_f32((o.z - b23.x) * 16.f, (o.w - b23.y) * 16.f, pl, true);
            *(int*)(p.ws + O_H8HI + (size_t)row * 1024 + col) = ph; *(int*)(p.ws + O_H8LO + (size_t)row * 1024 + col) = pl;
        }
    }
    const size_t gtid = (size_t)blockIdx.x * blockDim.x + tid_op(), gsz = (size_t)gridDim.x * blockDim.x;
    {
        unsigned* u8 = (unsigned*)(p.ws + O_U8); unsigned* v8 = (unsigned*)(p.ws + O_V8);
        for (size_t i = gtid; i < (size_t)16384 * 256; i += gsz) {
            const float4 fu = ((const float4*)p.u)[i];
            int pk = __builtin_amdgcn_cvt_pk_fp8_f32(fu.x * 32.f, fu.y * 32.f, 0, false); pk = __builtin_amdgcn_cvt_pk_fp8_f32(fu.z * 32.f, fu.w * 32.f, pk, true);
            u8[i] = (unsigned)pk;
            const float4 fv = ((const float4*)p.v)[i];
            int pv = __builtin_amdgcn_cvt_pk_fp8_f32(fv.x, fv.y, 0, false); pv = __builtin_amdgcn_cvt_pk_fp8_f32(fv.z, fv.w, pv, true);
            const size_t e = i >> 8, c4 = i & 255;
            v8[((c4 >> 5) * 16384 + e) * 32 + (c4 & 31)] = (unsigned)pv;
        }
    }
}

struct QpEpi {
    bf16_t* qp;
    __device__ __forceinline__ void operator()(const f32x4 (&acc)[4][4], int mb, int nb, int lane, char* lds) const {
        const int c = lane & 15, g = lane >> 4;
        bf16_t* L = (bf16_t*)lds;
#pragma unroll
        for (int mi = 0; mi < 4; ++mi)
#pragma unroll
            for (int r = 0; r < 4; ++r)
#pragma unroll
                for (int ni = 0; ni < 4; ++ni) L[(16 * mi + 4 * g + r) * 72 + 16 * ni + c] = f2bf(acc[mi][ni][r]);
#pragma unroll
        for (int i = 0; i < 8; ++i) {
            const int row = 8 * i + (lane >> 3), cc = (lane & 7) * 8;
            *(uint4*)(qp + (size_t)(mb + row) * 2048 + nb + cc) = *(const uint4*)(L + row * 72 + cc);
        }
    }
};
__device__ __forceinline__ void phase6(const Params& p, char* smem, const XcdMap xm) {
    QpEpi e; e.qp = (bf16_t*)(p.ws + O_QP);
    int tm, tn;
    for (int it = 0; gemm_next_tile(xm, it, 16, tm, tn); ++it)
        gemm_tile((const bf16_t*)(p.ws + O_HB), (const bf16_t*)(p.ws + O_WQ_T), 1024, tm * 256, tn * 128, e, smem);
}

__constant__ unsigned char CAND_I[64] = {0,0,0,0,0,0,0,0,0,0,0,0,0,0,0,0, 1,1,1,1,1,1,1,1, 2,2,2,2,2, 3,3,3,3, 4,4,4, 5,5, 6,6, 7,7, 8,9,10,11,12,13,14,15, 0,0,0,0,0,0,0,0,0,0,0,0,0,0};
__constant__ unsigned char CAND_J[64] = {0,1,2,3,4,5,6,7,8,9,10,11,12,13,14,15, 0,1,2,3,4,5,6,7, 0,1,2,3,4, 0,1,2,3, 0,1,2, 0,1, 0,1, 0,1, 0,0,0,0,0,0,0,0, 0,0,0,0,0,0,0,0,0,0,0,0,0,0};
__device__ __forceinline__ unsigned rowmax_u(unsigned v) { return row_max_u(v); }
__device__ __forceinline__ void peer_select_wave(const Params& p, int wunit) {
    const int lane = tid_op() & 63, cL = lane & 15, gq = lane >> 4, rowbase = lane & 48;
    const int tg = wunit >> 3, h = wunit & 7, tok0 = tg * 16;
    char* ws = p.ws;
    const bf16_t* QP = (const bf16_t*)(ws + O_QP);
    unsigned top[2][4];
#pragma unroll
    for (int half = 0; half < 2; ++half) {
        const bf16_t* KB = (const bf16_t*)(ws + (half ? O_K2B : O_K1B));
        bf16x8 a[4];
#pragma unroll
        for (int ks = 0; ks < 4; ++ks) a[ks] = ld8(QP + (size_t)(tok0 + cL) * 2048 + h * 256 + half * 128 + ks * 32 + gq * 8);
        unsigned pk[8][4];
#pragma unroll
        for (int nt = 0; nt < 8; ++nt) {
            f32x4 acc = (f32x4){0.f, 0.f, 0.f, 0.f};
#pragma unroll
            for (int ks = 0; ks < 4; ++ks) acc = mfma16(a[ks], ld8(KB + (size_t)(16 * nt + cL) * 128 + ks * 32 + gq * 8), acc);
#pragma unroll
            for (int r = 0; r < 4; ++r) pk[nt][r] = (f2sort(acc[r]) & ~0x7Fu) | (unsigned)(127 - (16 * nt + cL));
        }
#pragma unroll
        for (int r = 0; r < 4; ++r) top[half][r] = 0u;
        for (int it = 0; it < 16; ++it) {
#pragma unroll
            for (int r = 0; r < 4; ++r) {
                unsigned lm = pk[0][r];
#pragma unroll
                for (int nt = 1; nt < 8; ++nt) lm = max(lm, pk[nt][r]);
                const unsigned gm = rowmax_u(lm);
                if (cL == it) top[half][r] = gm;
#pragma unroll
                for (int nt = 0; nt < 8; ++nt) pk[nt][r] = (pk[nt][r] == gm) ? 0u : pk[nt][r];
            }
        }
    }
    unsigned ck[4][4];
#pragma unroll
    for (int s = 0; s < 4; ++s) {
        const int q = s * 16 + cL; const int ci = CAND_I[q], cj = CAND_J[q];
#pragma unroll
        for (int r = 0; r < 4; ++r) {
            const unsigned t1 = (unsigned)__shfl((int)top[0][r], rowbase + ci), t2 = (unsigned)__shfl((int)top[1][r], rowbase + cj);
            const float f = sort2f(t1 & ~0x7Fu) + sort2f(t2 & ~0x7Fu);
            ck[s][r] = (q < 50) ? ((f2sort(f) & ~0x3Fu) | (unsigned)(63 - q)) : 0u;
        }
    }
    unsigned best[4] = {0u, 0u, 0u, 0u};
    for (int it = 0; it < 16; ++it) {
#pragma unroll
        for (int r = 0; r < 4; ++r) {
            const unsigned lm = max(max(ck[0][r], ck[1][r]), max(ck[2][r], ck[3][r]));
            const unsigned gm = rowmax_u(lm);
            if (cL == it) best[r] = gm;
#pragma unroll
            for (int s = 0; s < 4; ++s) ck[s][r] = (ck[s][r] == gm) ? 0u : ck[s][r];
        }
    }
    int* EIDX = (int*)(ws + O_EIDX); float* GATE = (float*)(ws + O_GATE);
#pragma unroll
    for (int r = 0; r < 4; ++r) {
        const float fv = sort2f(best[r] & ~0x3Fu);
        const int q = 63 - (int)(best[r] & 63u);
        const int ci = CAND_I[q], cj = CAND_J[q];
        const unsigned t1 = (unsigned)__shfl((int)top[0][r], rowbase + ci), t2 = (unsigned)__shfl((int)top[1][r], rowbase + cj);
        const int e = (127 - (int)(t1 & 127u)) * 128 + (127 - (int)(t2 & 127u));
        const float mx = __shfl(fv, rowbase);
        const float ex = __expf(fv - mx);
        const float sm = row_sum(ex);
        const size_t o = (size_t)(tok0 + 4 * gq + r) * 128 + h * 16 + cL;
        EIDX[o] = e; GATE[o] = ex / sm;
    }
}
__device__ __forceinline__ void phase7(const Params& p) {
    const int w = tid_op() >> 6;
    for (int u = blockIdx.x * 8 + w; u < 8192; u += gridDim.x * 8) peer_select_wave(p, u);
}

#define P8A_T 24
__device__ __forceinline__ float gelu_erf(float d) { return 0.5f * d * (1.f + erff(d * 0.70710678118654752f)); }
__device__ __forceinline__ float dot16_fp8(const uint4& r, const float (&hv)[16]) {
    const f32x2 a0 = __builtin_amdgcn_cvt_pk_f32_fp8((int)r.x, false), a1 = __builtin_amdgcn_cvt_pk_f32_fp8((int)r.x, true);
    const f32x2 b0 = __builtin_amdgcn_cvt_pk_f32_fp8((int)r.y, false), b1 = __builtin_amdgcn_cvt_pk_f32_fp8((int)r.y, true);
    const f32x2 c0 = __builtin_amdgcn_cvt_pk_f32_fp8((int)r.z, false), c1 = __builtin_amdgcn_cvt_pk_f32_fp8((int)r.z, true);
    const f32x2 d0 = __builtin_amdgcn_cvt_pk_f32_fp8((int)r.w, false), d1 = __builtin_amdgcn_cvt_pk_f32_fp8((int)r.w, true);
    return (hv[0] * a0.x + hv[1] * a0.y + hv[2] * a1.x + hv[3] * a1.y) + (hv[4] * b0.x + hv[5] * b0.y + hv[6] * b1.x + hv[7] * b1.y)
         + (hv[8] * c0.x + hv[9] * c0.y + hv[10] * c1.x + hv[11] * c1.y) + (hv[12] * d0.x + hv[13] * d0.y + hv[14] * d1.x + hv[15] * d1.y);
}
typedef unsigned u32x4n __attribute__((ext_vector_type(4)));
__device__ __forceinline__ long lo64n(const u32x4n v) { return (long)(((unsigned long long)v.y << 32) | v.x); }
__device__ __forceinline__ long hi64n(const u32x4n v) { return (long)(((unsigned long long)v.w << 32) | v.z); }
struct P8aRows { u32x4n a[16]; };
__device__ __forceinline__ void p8a_load(P8aRows& R, const unsigned char* U8, int eid, int gq) {
    const unsigned char* urow = U8 + (size_t)eid * 1024 + 16 * gq;
#pragma unroll
    for (int j = 0; j < 16; ++j) R.a[j] = *(const u32x4n*)(urow + 64 * j);
}
__device__ __forceinline__ void p8a_compute(const P8aRows& R, const char* hb, int gq, int cL, int eidD, float gateD, unsigned* dst) {
    unsigned off = 16u * (unsigned)gq;
    asm volatile("" : "+v"(off));
    f32x4 ahi = (f32x4){0.f, 0.f, 0.f, 0.f}, alo = (f32x4){0.f, 0.f, 0.f, 0.f};
#pragma unroll
    for (int j = 0; j < 16; ++j) {
        const u32x4n bh = *(const u32x4n*)(hb + off + 64 * j), bl = *(const u32x4n*)(hb + 1024 + off + 64 * j);
        ahi = __builtin_amdgcn_mfma_f32_16x16x32_fp8_fp8(lo64n(R.a[j]), lo64n(bh), ahi, 0, 0, 0);
        ahi = __builtin_amdgcn_mfma_f32_16x16x32_fp8_fp8(hi64n(R.a[j]), hi64n(bh), ahi, 0, 0, 0);
        alo = __builtin_amdgcn_mfma_f32_16x16x32_fp8_fp8(lo64n(R.a[j]), lo64n(bl), alo, 0, 0, 0);
        alo = __builtin_amdgcn_mfma_f32_16x16x32_fp8_fp8(hi64n(R.a[j]), hi64n(bl), alo, 0, 0, 0);
    }
    const int rs = cL & 3;
    const float d0 = ahi[0] + alo[0] * 0.0625f, d1 = ahi[1] + alo[1] * 0.0625f, d2 = ahi[2] + alo[2] * 0.0625f, d3 = ahi[3] + alo[3] * 0.0625f;
    const float dot = (rs == 0 ? d0 : (rs == 1 ? d1 : (rs == 2 ? d2 : d3))) * (1.f / 32.f);
    const float act = gelu_erf(dot) * gateD;
    if (cL < 4) dst[4 * gq + cL] = (unsigned)eidD | ((unsigned)f2bf(act) << 16);
}
__device__ __forceinline__ void phase8a(const Params& p, const XcdMap xm, char* smem) {
    const int lane = tid_op() & 63, w = tid_op() >> 6, cL = lane & 15, gq = lane >> 4;
    char* ws = p.ws;
    const unsigned char* U8 = (const unsigned char*)(ws + O_U8);
    const int* EIDX = (const int*)(ws + O_EIDX); const float* GATE = (const float*)(ws + O_GATE); unsigned* ACT = (unsigned*)(ws + O_ACT);
    const unsigned char* H8HI = (const unsigned char*)(ws + O_H8HI); const unsigned char* H8LO = (const unsigned char*)(ws + O_H8LO);
    char* hbuf = smem + w * 4096;
    const int stride = gridDim.x * 8;
    int row = blockIdx.x * 8 + w;
    if (row >= NTOK) return;
    const int offA = cL, offD = 4 * gq + (cL & 3);
#define P8A_META(EA, ED, GD, ROW, BLK) { const size_t mo_ = (size_t)(ROW) * 128 + 16 * (BLK); EA = EIDX[mo_ + offA]; ED = EIDX[mo_ + offD]; GD = GATE[mo_ + offD]; }
    int eA1, eD0, eD1, eA2, eD2; float gD0, gD1, gD2;
    { int eA0; P8A_META(eA0, eD0, gD0, row, 0) P8A_META(eA1, eD1, gD1, row, 1)
      const u32x4n hA = *(const u32x4n*)(H8HI + (size_t)row * 1024 + 16 * lane), hB = *(const u32x4n*)(H8LO + (size_t)row * 1024 + 16 * lane);
      *(u32x4n*)(hbuf + 16 * lane) = hA; *(u32x4n*)(hbuf + 1024 + 16 * lane) = hB;
      P8aRows R0, R1;
      p8a_load(R0, U8, eA0, gq);
      int par = 0;
      for (; row < NTOK; row += stride) {
        const int nrow = row + stride;
        const int prow = nrow < NTOK ? nrow : row;
        const u32x4n nhA = *(const u32x4n*)(H8HI + (size_t)prow * 1024 + 16 * lane), nhB = *(const u32x4n*)(H8LO + (size_t)prow * 1024 + 16 * lane);
        const char* hb = hbuf + par * 2048;
        unsigned* dst = ACT + (size_t)row * 128;
#define P8A_STEP(RC, RN, B, MROW, MBLK) \
        p8a_load(RN, U8, eA1, gq); P8A_META(eA2, eD2, gD2, MROW, MBLK) \
        p8a_compute(RC, hb, gq, cL, eD0, gD0, dst + 16 * (B)); \
        eD0 = eD1; gD0 = gD1; eA1 = eA2; eD1 = eD2; gD1 = gD2;
        P8A_STEP(R0, R1, 0, row, 2)
        P8A_STEP(R1, R0, 1, row, 3)
        P8A_STEP(R0, R1, 2, row, 4)
        P8A_STEP(R1, R0, 3, row, 5)
        P8A_STEP(R0, R1, 4, row, 6)
        P8A_STEP(R1, R0, 5, row, 7)
        *(u32x4n*)(hbuf + (par ^ 1) * 2048 + 16 * lane) = nhA; *(u32x4n*)(hbuf + (par ^ 1) * 2048 + 1024 + 16 * lane) = nhB;
        P8A_STEP(R0, R1, 6, prow, 0)
        P8A_STEP(R1, R0, 7, prow, 1)
        par ^= 1;
      }
    }
}
struct P8bRows { u32x4n v[8]; };
struct P8bMeta { u32x4n m[4]; };
__device__ __forceinline__ void p8b_meta(P8bMeta& M, const unsigned* ACT, int row, int e8) {
#pragma unroll
    for (int k = 0; k < 4; ++k) M.m[k] = *(const u32x4n*)(ACT + (size_t)row * 128 + e8 * 16 + 4 * k);
}
template <int HALF> __device__ __forceinline__ void p8b_load(P8bRows& R, const P8bMeta& M, const unsigned char* V8) {
#pragma unroll
    for (int k = 0; k < 2; ++k) {
        const u32x4n mm = M.m[2 * HALF + k];
        R.v[4 * k + 0] = *(const u32x4n*)(V8 + (size_t)(mm.x & 0xFFFFu) * 128); R.v[4 * k + 1] = *(const u32x4n*)(V8 + (size_t)(mm.y & 0xFFFFu) * 128);
        R.v[4 * k + 2] = *(const u32x4n*)(V8 + (size_t)(mm.z & 0xFFFFu) * 128); R.v[4 * k + 3] = *(const u32x4n*)(V8 + (size_t)(mm.w & 0xFFFFu) * 128);
    }
}
template <int HALF> __device__ __forceinline__ void p8b_accum(f32x2 (&acc)[8], const P8bRows& R, const P8bMeta& M) {
#pragma unroll
    for (int k = 0; k < 2; ++k) {
        const u32x4n mm = M.m[2 * HALF + k];
        const unsigned mw[4] = {mm.x, mm.y, mm.z, mm.w};
#pragma unroll
        for (int q = 0; q < 4; ++q) {
            const float a1 = __uint_as_float(mw[q] & 0xFFFF0000u);
            const f32x2 av = (f32x2){a1, a1};
            const u32x4n x = R.v[4 * k + q];
            acc[0] += av * __builtin_amdgcn_cvt_pk_f32_fp8((int)x.x, false); acc[1] += av * __builtin_amdgcn_cvt_pk_f32_fp8((int)x.x, true);
            acc[2] += av * __builtin_amdgcn_cvt_pk_f32_fp8((int)x.y, false); acc[3] += av * __builtin_amdgcn_cvt_pk_f32_fp8((int)x.y, true);
            acc[4] += av * __builtin_amdgcn_cvt_pk_f32_fp8((int)x.z, false); acc[5] += av * __builtin_amdgcn_cvt_pk_f32_fp8((int)x.z, true);
            acc[6] += av * __builtin_amdgcn_cvt_pk_f32_fp8((int)x.w, false); acc[7] += av * __builtin_amdgcn_cvt_pk_f32_fp8((int)x.w, true);
        }
    }
}
__device__ __forceinline__ void p8b_store(const f32x2 (&acc)[8], float* hr, int e8) {
    float r[16];
#pragma unroll
    for (int j = 0; j < 8; ++j) { r[2 * j] = acc[j].x; r[2 * j + 1] = acc[j].y; }
#pragma unroll
    for (int j = 0; j < 16; ++j) { r[j] += dpp_f<0x128, 0xF, true>(r[j]); r[j] = sum_x32(sum_x16(r[j])); }
    if (e8 == 0) {
#pragma unroll
        for (int j = 0; j < 4; ++j) {
            const float4 h0 = *(const float4*)(hr + 4 * j);
            *(float4*)(hr + 4 * j) = make_float4(ALPHA * h0.x + r[4 * j], ALPHA * h0.y + r[4 * j + 1], ALPHA * h0.z + r[4 * j + 2], ALPHA * h0.w + r[4 * j + 3]);
        }
    }
}
__device__ __forceinline__ void phase8b(const Params& p, const XcdMap xm, float* outp) {
    const int lane = tid_op() & 63, w = tid_op() >> 6, e8 = lane >> 3, c8 = lane & 7;
    char* ws = p.ws;
    const unsigned char* V8 = (const unsigned char*)(ws + O_V8) + (size_t)xm.slice * 16384 * 128 + 16 * c8;
    const unsigned* ACT = (const unsigned*)(ws + O_ACT);
    const int stride = xm.nloc * 8;
    int row = xm.rank * 8 + w;
    if (row >= NTOK) return;
    float* const hbase = outp + xm.slice * 128 + 16 * c8;
    P8bMeta Mc, Mn; P8bRows Ra, Rb;
    p8b_meta(Mc, ACT, row, e8);
    p8b_meta(Mn, ACT, (row + stride < NTOK) ? row + stride : row, e8);
    p8b_load<0>(Ra, Mc, V8);
    for (; row < NTOK; row += stride) {
        f32x2 acc[8];
#pragma unroll
        for (int j = 0; j < 8; ++j) acc[j] = (f32x2){0.f, 0.f};
        p8b_load<1>(Rb, Mc, V8);
        p8b_accum<0>(acc, Ra, Mc);
        p8b_load<0>(Ra, Mn, V8);
        p8b_accum<1>(acc, Rb, Mc);
        p8b_store(acc, hbase + (size_t)row * 1024, e8);
        Mc = Mn;
        const int r2 = row + 2 * stride;
        p8b_meta(Mn, ACT, r2 < NTOK ? r2 : row, e8);
    }
}
__device__ __forceinline__ void phase8c(const Params& p) {
    const int lane = tid_op() & 63, w = tid_op() >> 6;
    for (int row = blockIdx.x * 8 + w; row < NTOK; row += gridDim.x * 8) {
        float* yr = p.out + (size_t)row * 1024;
        float4 v[4]; float s = 0.f;
#pragma unroll
        for (int j = 0; j < 4; ++j) { v[j] = *(const float4*)(yr + 4 * lane + 256 * j); s += v[j].x + v[j].y + v[j].z + v[j].w; }
        const float mean = wave_sum(s) * (1.f / 1024.f);
        float q = 0.f;
#pragma unroll
        for (int j = 0; j < 4; ++j) { const float a = v[j].x - mean, b2 = v[j].y - mean, c2 = v[j].z - mean, d = v[j].w - mean; q += a * a + b2 * b2 + c2 * c2 + d * d; }
        const float rstd = rsqrtf(wave_sum(q) * (1.f / 1024.f) + LN_EPS);
#pragma unroll
        for (int j = 0; j < 4; ++j) {
            const int col = 4 * lane + 256 * j;
            const float4 gg = *(const float4*)(p.ln2_g + col), bb = *(const float4*)(p.ln2_b + col);
            float4 o;
            o.x = (v[j].x - mean) * rstd * gg.x + bb.x; o.y = (v[j].y - mean) * rstd * gg.y + bb.y; o.z = (v[j].z - mean) * rstd * gg.z + bb.z; o.w = (v[j].w - mean) * rstd * gg.w + bb.w;
            *(float4*)(yr + col) = o;
        }
    }
}

#if ONE_LAUNCH
__global__ void __launch_bounds__(512, 2) fwd_megakernel(Params p) {
    __shared__ __attribute__((aligned(16))) char smem[SMEM_BYTES];
    cg::grid_group grid = cg::this_grid();
    volatile LAS unsigned* st = (volatile LAS unsigned*)(smem + SMEM_BYTES - 16);
    if (threadIdx.x == 0) { st[0] = 0u; st[1] = 0u; st[2] = 0u; st[3] = 0u; }
    __syncthreads();
    const XcdBarrier xb = xcd_barrier_post((unsigned*)(p.ws + O_BAR), st);
#define GRID_BAR() do { if (p.use_cg) grid.sync(); else xcd_barrier(xb); } while (0)
#ifndef DUP
#define DUP -1
#endif
#define RUNPH(k, call) { int n_ = (DUP == k) ? 2 : 1; asm volatile("" : "+s"(n_)); _Pragma("unroll 1") for (int i_ = 0; i_ < n_; ++i_) { call; GRID_BAR(); } }
    RUNPH(0, phase0(p))
    XcdMap xm;
    if (st[2]) { xm.slice = (int)xb.x; xm.rank = (int)st[3]; xm.nloc = (int)st[0]; }
    else { xm.slice = blockIdx.x & 7; xm.rank = blockIdx.x >> 3; xm.nloc = gridDim.x >> 3; }
    xm.slice = __builtin_amdgcn_readfirstlane(xm.slice); xm.rank = __builtin_amdgcn_readfirstlane(xm.rank); xm.nloc = __builtin_amdgcn_readfirstlane(xm.nloc);
    RUNPH(1, phase1(p, smem, xm))
    RUNPH(2, phase2(p, smem))
    if (DUP == 20) { int wh_ = 1; asm volatile("" : "+s"(wh_)); phase2(p, smem, wh_); GRID_BAR(); }
    if (DUP == 21) { int wh_ = 2; asm volatile("" : "+s"(wh_)); phase2(p, smem, wh_); GRID_BAR(); }
    phase2c(p); GRID_BAR();
    RUNPH(3, phase3(p, smem))
    if (DUP == 30) { int wh_ = 1; asm volatile("" : "+s"(wh_)); phase3(p, smem, wh_); GRID_BAR(); }
    if (DUP == 31) { int wh_ = 2; asm volatile("" : "+s"(wh_)); phase3(p, smem, wh_); GRID_BAR(); }
    RUNPH(4, phase4(p, smem, xm))
    phase5(p); GRID_BAR();
    RUNPH(6, phase6(p, smem, xm))
    RUNPH(7, phase7(p))
#ifdef SCRAMBLE
    { const int x_ = xm.slice, r_ = xm.rank; xm.slice = (x_ + r_) & 7; xm.rank = (r_ >> 3) * 8 + x_; xm.nloc = 32; }
#endif
    RUNPH(8, phase8a(p, xm, smem))
    if (DUP == 9) { phase8b(p, xm, (float*)(p.ws + O_QP)); GRID_BAR(); }
    phase8b(p, xm, p.out); GRID_BAR();
    phase8c(p);
}
#else
__global__ void __launch_bounds__(512, 2) k_phase0(Params p) { phase0(p); }
__global__ void __launch_bounds__(512, 2) k_phase1(Params p) { __shared__ __attribute__((aligned(16))) char smem[SMEM_BYTES]; XcdMap xm; xm.slice = blockIdx.x & 7; xm.rank = blockIdx.x >> 3; xm.nloc = gridDim.x >> 3; phase1(p, smem, xm); }
__global__ void __launch_bounds__(512, 2) k_phase2(Params p) { __shared__ __attribute__((aligned(16))) char smem[SMEM_BYTES]; phase2(p, smem); }
__global__ void __launch_bounds__(512, 2) k_phase2c(Params p) { phase2c(p); }
__global__ void __launch_bounds__(512, 2) k_phase3(Params p) { __shared__ __attribute__((aligned(16))) char smem[SMEM_BYTES]; phase3(p, smem); }
__global__ void __launch_bounds__(512, 2) k_phase4(Params p) { __shared__ __attribute__((aligned(16))) char smem[SMEM_BYTES]; XcdMap xm; xm.slice = blockIdx.x & 7; xm.rank = blockIdx.x >> 3; xm.nloc = gridDim.x >> 3; phase4(p, smem, xm); }
__global__ void __launch_bounds__(512, 2) k_phase5(Params p) { phase5(p); }
__global__ void __launch_bounds__(512, 2) k_phase6(Params p) { __shared__ __attribute__((aligned(16))) char smem[SMEM_BYTES]; XcdMap xm; xm.slice = blockIdx.x & 7; xm.rank = blockIdx.x >> 3; xm.nloc = gridDim.x >> 3; phase6(p, smem, xm); }
__global__ void __launch_bounds__(512, 2) k_phase7(Params p) { phase7(p); }
__global__ void __launch_bounds__(512, 2) k_phase8a(Params p) { __shared__ __attribute__((aligned(16))) char smem_[SMEM_BYTES]; XcdMap xm; xm.slice = blockIdx.x & 7; xm.rank = blockIdx.x >> 3; xm.nloc = gridDim.x >> 3; phase8a(p, xm, smem_); }
__global__ void __launch_bounds__(512, 2) k_phase8b(Params p) { XcdMap xm; xm.slice = blockIdx.x & 7; xm.rank = blockIdx.x >> 3; xm.nloc = gridDim.x >> 3; phase8b(p, xm, p.out); }
__global__ void __launch_bounds__(512, 2) k_phase8c(Params p) { phase8c(p); }
#endif

extern "C" void kernel_launch(void* const* d_in, const int* in_sizes, int n_in, void* d_out, int out_size, void* d_ws, size_t ws_size, hipStream_t stream) {
    Params p{};
    p.x = (const float*)d_in[0]; p.pos = (const int*)d_in[1]; p.w_in = (const float*)d_in[2]; p.conv_w = (const float*)d_in[3]; p.conv_b = (const float*)d_in[4];
    p.dt_bias = (const float*)d_in[5]; p.a_log = (const float*)d_in[6]; p.d_skip = (const float*)d_in[7]; p.norm_w = (const float*)d_in[8]; p.w_out = (const float*)d_in[9];
    p.ln1_g = (const float*)d_in[10]; p.ln1_b = (const float*)d_in[11]; p.wq = (const float*)d_in[12]; p.k1 = (const float*)d_in[13]; p.k2 = (const float*)d_in[14];
    p.u = (const float*)d_in[15]; p.v = (const float*)d_in[16]; p.ln2_g = (const float*)d_in[17]; p.ln2_b = (const float*)d_in[18];
    p.out = (float*)d_out; p.ws = (char*)d_ws;
    if (ws_size < WS_NEEDED) { fprintf(stderr, "kernel_launch: workspace too small (%zu < %zu)\n", ws_size, (size_t)WS_NEEDED); return; }
#if ONE_LAUNCH
    static int grid_blocks = 0;
    if (!grid_blocks) {
        int dev = 0, cus = 0, per_cu = 0;
        hipGetDevice(&dev);
        hipDeviceGetAttribute(&cus, hipDeviceAttributeMultiprocessorCount, dev);
        hipOccupancyMaxActiveBlocksPerMultiprocessor(&per_cu, fwd_megakernel, 512, 0);
        if (per_cu > 1) per_cu = 1;
        if (per_cu < 1) per_cu = 1;
        grid_blocks = cus * per_cu;
    }
    (void)hipMemsetAsync((char*)d_ws + O_BAR, 0, XCD_BAR_WORDS * 4, stream);
    void* args[] = {&p};
    hipError_t e = hipLaunchCooperativeKernel((void*)fwd_megakernel, dim3(grid_blocks), dim3(512), args, 0, stream);
    if (e != hipSuccess) fprintf(stderr, "cooperative launch failed: %s (grid %d)\n", hipGetErrorString(e), grid_blocks);
#else
    const int G = 512;
    k_phase0<<<G, 512, 0, stream>>>(p);
    k_phase1<<<G, 512, 0, stream>>>(p);
    k_phase2<<<G, 512, 0, stream>>>(p);
    k_phase2c<<<G, 512, 0, stream>>>(p);
    k_phase3<<<G, 512, 0, stream>>>(p);
    k_phase4<<<G, 512, 0, stream>>>(p);
    k_phase5<<<G, 512, 0, stream>>>(p);
    k_phase6<<<G, 512, 0, stream>>>(p);
    k_phase7<<<G, 512, 0, stream>>>(p);
    k_phase8a<<<G, 512, 0, stream>>>(p);
    k_phase8b<<<G, 512, 0, stream>>>(p);
    k_phase8c<<<G, 512, 0, stream>>>(p);
#endif
}
```

```cpp
#include <hip/hip_runtime.h>
#include <hip/hip_cooperative_groups.h>
#include <stdint.h>
#include <stdio.h>
namespace cg = cooperative_groups;

typedef unsigned short bf16_t;
typedef short bf16x8 __attribute__((ext_vector_type(8)));
typedef short bf16x4 __attribute__((ext_vector_type(4)));
typedef float f32x4 __attribute__((ext_vector_type(4)));
typedef float f32x2 __attribute__((ext_vector_type(2)));

#ifndef ONE_LAUNCH
#define ONE_LAUNCH 1
#endif

constexpr int NB = 8, SEQ = 2048, DM = 1024, NTOK = NB * SEQ;
constexpr int NP = 3584;
constexpr int QOFF = 0, KOFF = 512, VOFF = 1024, IQOFF = 1536, MISCOFF = 1792, ZOFF = 1856, XBCOFF = 2368, NUSED = 3392;
constexpr float ALPHA = 1.189207115002721f;
constexpr float LN_EPS = 1e-5f;

constexpr size_t MB = 1024 * 1024;
constexpr size_t O_WIN_T = 0;
constexpr size_t O_WOUT_T = O_WIN_T + (size_t)NP * 1024 * 2;
constexpr size_t O_WQ_T = O_WOUT_T + 2 * MB;
constexpr size_t O_K1B = O_WQ_T + 4 * MB;
constexpr size_t O_K2B = O_K1B + 32768;
constexpr size_t O_CS64 = O_K2B + 32768;
constexpr size_t O_CS32 = O_CS64 + 4 * MB;
constexpr size_t O_BAR = O_CS32 + 2 * MB;
constexpr size_t O_MIX = O_BAR + 65536;
constexpr size_t O_R1 = O_MIX + 32 * MB;
constexpr size_t O_XB = O_R1;
constexpr size_t O_XT = O_R1;
constexpr size_t O_BRM = O_XT + 16 * MB;
constexpr size_t O_CRM = O_BRM + 8 * MB;
constexpr size_t O_QB = O_XB + 32 * MB;
constexpr size_t O_KB = O_QB + 16 * MB;
constexpr size_t O_VT = O_KB + 16 * MB;
constexpr size_t O_IQB = O_VT + 16 * MB;
constexpr size_t O_IKB = O_IQB + 8 * MB;
constexpr size_t O_IWF = O_IKB + 1 * MB;
constexpr size_t O_DTF = O_IWF + MB / 2;
constexpr size_t O_ZB = O_DTF + MB / 2;
constexpr size_t O_XBCT = O_ZB + 16 * MB;
constexpr size_t O_CAR = O_XBCT;
constexpr size_t O_ACUM = O_XBCT + 32 * MB;
constexpr size_t O_ATOT = O_ACUM + MB / 2;
constexpr size_t O_ST = O_ATOT + MB / 2;
constexpr size_t O_MASK = O_ST + 32 * MB;
constexpr size_t O_R1_END = O_MASK + 4 * MB;
constexpr size_t O_HB = O_R1;
constexpr size_t O_QP = O_HB + 32 * MB;
constexpr size_t O_EIDX = O_QP + 64 * MB;
constexpr size_t O_GATE = O_EIDX + 8 * MB;
constexpr size_t O_U8 = O_GATE + 8 * MB;
constexpr size_t O_V8 = O_U8 + 16 * MB;
constexpr size_t O_ACT = O_V8 + 16 * MB;
constexpr size_t O_H8HI = O_ACT + 8 * MB;
constexpr size_t O_H8LO = O_H8HI + 16 * MB;
constexpr size_t O_R2_END = O_H8LO + 16 * MB;
constexpr size_t WS_NEEDED = (O_R1_END > O_R2_END ? O_R1_END : O_R2_END);
static_assert(WS_NEEDED <= 256 * MB, "workspace too large");
static_assert(O_R2_END <= O_R1_END + 64 * MB, "region 2 too large");

struct Params {
    const float* x; const int* pos; const float* w_in; const float* conv_w; const float* conv_b; const float* dt_bias;
    const float* a_log; const float* d_skip; const float* norm_w; const float* w_out; const float* ln1_g; const float* ln1_b;
    const float* wq; const float* k1; const float* k2; const float* u; const float* v; const float* ln2_g; const float* ln2_b;
    float* out; char* ws; int use_cg; int pad_;
};

#define SMEM_BYTES 133120

__device__ __forceinline__ int tid_op() { int t = threadIdx.x; asm volatile("" : "+v"(t)); return t; }
__device__ __forceinline__ bf16_t f2bf(float f) {
    unsigned u = __float_as_uint(f);
    u += 0x7FFFu + ((u >> 16) & 1u);
    return (bf16_t)(u >> 16);
}
__device__ __forceinline__ float bf2f(bf16_t b) { return __uint_as_float(((unsigned)b) << 16); }
__device__ __forceinline__ unsigned pack2(float a, float b) { return (unsigned)f2bf(a) | ((unsigned)f2bf(b) << 16); }
__device__ __forceinline__ unsigned f2sort(float f) { unsigned u = __float_as_uint(f); return (u & 0x80000000u) ? ~u : (u | 0x80000000u); }
__device__ __forceinline__ float sort2f(unsigned s) { unsigned u = (s & 0x80000000u) ? (s & 0x7FFFFFFFu) : ~s; return __uint_as_float(u); }
__device__ __forceinline__ f32x4 mfma16(bf16x8 a, bf16x8 b, f32x4 c) { return __builtin_amdgcn_mfma_f32_16x16x32_bf16(a, b, c, 0, 0, 0); }
__device__ __forceinline__ float silu_f(float v) { return v / (1.f + __expf(-v)); }
__device__ __forceinline__ bf16x8 ld8(const bf16_t* p) { return *(const bf16x8*)p; }
__device__ __forceinline__ bf16x8 cat4(bf16x4 lo, bf16x4 hi) { return __builtin_shufflevector(lo, hi, 0, 1, 2, 3, 4, 5, 6, 7); }


template <int CTRL, int ROWMASK, bool BC> __device__ __forceinline__ int dpp_i(int v) { return __builtin_amdgcn_update_dpp(0, v, CTRL, ROWMASK, 0xF, BC); }
template <int CTRL, int ROWMASK, bool BC> __device__ __forceinline__ float dpp_f(float v) { return __builtin_bit_cast(float, __builtin_amdgcn_update_dpp(0, __builtin_bit_cast(int, v), CTRL, ROWMASK, 0xF, BC)); }
__device__ __forceinline__ float row_sum(float v) { v += dpp_f<0xB1, 0xF, true>(v); v += dpp_f<0x4E, 0xF, true>(v); v += dpp_f<0x141, 0xF, true>(v); v += dpp_f<0x140, 0xF, true>(v); return v; }
__device__ __forceinline__ unsigned row_sum_u(unsigned v) { v += (unsigned)dpp_i<0xB1, 0xF, true>((int)v); v += (unsigned)dpp_i<0x4E, 0xF, true>((int)v); v += (unsigned)dpp_i<0x141, 0xF, true>((int)v); v += (unsigned)dpp_i<0x140, 0xF, true>((int)v); return v; }
__device__ __forceinline__ unsigned row_max_u(unsigned v) {
    v = max(v, (unsigned)dpp_i<0xB1, 0xF, true>((int)v)); v = max(v, (unsigned)dpp_i<0x4E, 0xF, true>((int)v));
    v = max(v, (unsigned)dpp_i<0x141, 0xF, true>((int)v)); v = max(v, (unsigned)dpp_i<0x140, 0xF, true>((int)v)); return v;
}
__device__ __forceinline__ float wave_sum_u(float v) {
    v = row_sum(v);
    v += dpp_f<0x142, 0xA, false>(v);
    v += dpp_f<0x143, 0xC, false>(v);
    return __builtin_bit_cast(float, __builtin_amdgcn_readlane(__builtin_bit_cast(int, v), 63));
}
typedef unsigned u32x2_t __attribute__((ext_vector_type(2)));
__device__ __forceinline__ float sum_x16(float v) { const u32x2_t r = __builtin_amdgcn_permlane16_swap(__float_as_uint(v), __float_as_uint(v), false, false); return __uint_as_float(r.x) + __uint_as_float(r.y); }
__device__ __forceinline__ float sum_x32(float v) { const u32x2_t r = __builtin_amdgcn_permlane32_swap(__float_as_uint(v), __float_as_uint(v), false, false); return __uint_as_float(r.x) + __uint_as_float(r.y); }
__device__ __forceinline__ float max_x16(float v) { const u32x2_t r = __builtin_amdgcn_permlane16_swap(__float_as_uint(v), __float_as_uint(v), false, false); return fmaxf(__uint_as_float(r.x), __uint_as_float(r.y)); }
__device__ __forceinline__ float max_x32(float v) { const u32x2_t r = __builtin_amdgcn_permlane32_swap(__float_as_uint(v), __float_as_uint(v), false, false); return fmaxf(__uint_as_float(r.x), __uint_as_float(r.y)); }
__device__ __forceinline__ float wave_sum(float v) { return sum_x32(sum_x16(row_sum(v))); }

#define XB_TMO      128
#define XB_XCNT(j)  (256  + 64 * (j))
#define XB_XSUB(j)  (1280 + 64 * (j))
#define XB_XGEN(j)  (2304 + 64 * (j))
#define XB_TOP      3328
#define XB_TOPGEN   3392
#define XCD_BAR_WORDS 3456
#define XB_SPIN_CAP (1u << 22)
#define LAS __attribute__((address_space(3)))
__device__ __forceinline__ unsigned xb_ld(unsigned* p)              { return __hip_atomic_load(p, __ATOMIC_RELAXED, __HIP_MEMORY_SCOPE_AGENT); }
__device__ __forceinline__ unsigned xb_add(unsigned* p, unsigned v) { return __hip_atomic_fetch_add(p, v, __ATOMIC_RELAXED, __HIP_MEMORY_SCOPE_AGENT); }
__device__ __forceinline__ unsigned xb_xcc_id() { return (unsigned)__builtin_amdgcn_s_getreg((3 << 11) | 20) & 0xFu; }
#define XB_SPIN(cond, bar) do { unsigned _sp = 0; while (cond) { __builtin_amdgcn_s_sleep(1); \
    if ((++_sp & 255u) == 0u) { if (xb_ld(&(bar)[XB_TMO])) break; if (_sp > XB_SPIN_CAP) { atomicAdd(&(bar)[XB_TMO], 1u); break; } } } } while (0)
struct XcdBarrier { unsigned* bar; unsigned x; volatile LAS unsigned* st; };
__device__ __forceinline__ XcdBarrier xcd_barrier_post(unsigned* bar, volatile LAS unsigned* st) {
    XcdBarrier b; b.bar = bar; b.x = xb_xcc_id(); b.st = st;
    if (threadIdx.x == 0) st[3] = xb_add(&bar[XB_XCNT(b.x)], 1u);
    return b;
}
__device__ __forceinline__ void xcd_barrier_complete(unsigned* bar, unsigned x, unsigned& nloc, unsigned& nx, unsigned& low8) {
    const unsigned G = gridDim.x * gridDim.y * gridDim.z;
    unsigned sum, cnt, mine, lo, sp = 0u;
    for (;;) {
        sum = 0u; cnt = 0u; mine = 0u; lo = 0u;
#pragma unroll
        for (unsigned j = 0; j < 16; ++j) { const unsigned c = xb_ld(&bar[XB_XCNT(j)]); sum += c; cnt += (c > 0u) ? 1u : 0u; lo += (j < 8u && c > 0u) ? 1u : 0u; mine = (j == x) ? c : mine; }
        if (sum == G) break;
        __builtin_amdgcn_s_sleep(1);
        if ((++sp & 255u) == 0u) { if (xb_ld(&bar[XB_TMO])) break; if (sp > XB_SPIN_CAP) { atomicAdd(&bar[XB_TMO], 1u); break; } }
    }
    nloc = mine > 0u ? mine : 1u; nx = cnt > 0u ? cnt : 1u; low8 = (lo == 8u && cnt == 8u) ? 1u : 0u;
}
__device__ __forceinline__ void xcd_barrier(const XcdBarrier& b) {
    asm volatile("s_waitcnt vmcnt(0)" ::: "memory");
    __syncthreads();
    if (threadIdx.x == 0) {
        unsigned* bar = b.bar;
        __builtin_amdgcn_s_waitcnt(0);
        unsigned nloc = b.st[0], nx = b.st[1];
        if (nloc == 0u) { unsigned low8; xcd_barrier_complete(bar, b.x, nloc, nx, low8); b.st[0] = nloc; b.st[1] = nx; b.st[2] = low8; }
        const unsigned old = xb_add(&bar[XB_XSUB(b.x)], 1u);
        const unsigned gen = old / nloc;
        if (old + 1u == (gen + 1u) * nloc) {
            __builtin_amdgcn_fence(__ATOMIC_RELEASE, "agent");
            asm volatile("s_waitcnt vmcnt(0)" ::: "memory");
            const unsigned og = xb_add(&bar[XB_TOP], 1u);
            const unsigned tg = og / nx;
            if (og + 1u == (tg + 1u) * nx) xb_add(&bar[XB_TOPGEN], 1u);
            else XB_SPIN(xb_ld(&bar[XB_TOPGEN]) == tg, bar);
            __builtin_amdgcn_fence(__ATOMIC_ACQUIRE, "agent");
            xb_add(&bar[XB_XGEN(b.x)], 1u);
            asm volatile("s_waitcnt vmcnt(0)" ::: "memory");
        } else {
            XB_SPIN(xb_ld(&bar[XB_XGEN(b.x)]) == gen, bar);
            __builtin_amdgcn_fence(__ATOMIC_ACQUIRE, "agent");
            asm volatile("s_waitcnt vmcnt(0)" ::: "memory");
        }
    }
    __syncthreads();
}

__device__ __forceinline__ int rot_perm(int gcol, int H) { const int j = (gcol % H) >> 3, e = gcol & 7; return (gcol / H) * H + 4 * j + (e & 3) + ((e >> 2) ? H / 2 : 0); }
__device__ __forceinline__ int win_src_col(int n) {
    if (n < 1024) return rot_perm(n, 64);
    if (n < 1536) return n;
    if (n < 1824) return 1536 + rot_perm(n - 1536, 32);
    if (n < 1832) return n;
    if (n < 1840) return 3368 + (n - 1832);
    if (n < 1856) return -1;
    if (n < 2368) return 1832 + (n - 1856);
    if (n < 3392) return 2344 + (n - 2368);
    return -1;
}
__device__ __forceinline__ void p0_transpose(const float* __restrict__ W, int N, int Nout, bool remap, bf16_t* __restrict__ Wt, int gtid, int gsz) {
    const int items = Nout * 128;
    for (int it = gtid; it < items; it += gsz) {
        const int n = it % Nout, kc = it / Nout;
        const int src = remap ? win_src_col(n) : n;
        unsigned w[4] = {0, 0, 0, 0};
        if (src >= 0) {
            float f[8];
#pragma unroll
            for (int j = 0; j < 8; ++j) f[j] = W[(size_t)(kc * 8 + j) * N + src];
#pragma unroll
            for (int j = 0; j < 4; ++j) w[j] = pack2(f[2 * j], f[2 * j + 1]);
        }
        *(uint4*)(Wt + (size_t)n * 1024 + kc * 8) = make_uint4(w[0], w[1], w[2], w[3]);
    }
}
__device__ __forceinline__ void p0_convert(const float* __restrict__ src, bf16_t* __restrict__ dst, size_t n4, size_t gtid, size_t gsz) {
    for (size_t i = gtid; i < n4; i += gsz) {
        const float4 f = ((const float4*)src)[i];
        ((uint2*)dst)[i] = make_uint2(pack2(f.x, f.y), pack2(f.z, f.w));
    }
}
__device__ __forceinline__ void phase0(const Params& p) {
    const int gtid = blockIdx.x * blockDim.x + tid_op(), gsz = gridDim.x * blockDim.x;
    p0_transpose(p.w_in, 3376, NP, true, (bf16_t*)(p.ws + O_WIN_T), gtid, gsz);
    p0_transpose(p.w_out, 1024, 1024, false, (bf16_t*)(p.ws + O_WOUT_T), gtid, gsz);
    p0_transpose(p.wq, 2048, 2048, false, (bf16_t*)(p.ws + O_WQ_T), gtid, gsz);
    p0_convert(p.k1, (bf16_t*)(p.ws + O_K1B), 128 * 128 / 4, gtid, gsz);
    p0_convert(p.k2, (bf16_t*)(p.ws + O_K2B), 128 * 128 / 4, gtid, gsz);
    p0_convert(p.x, (bf16_t*)(p.ws + O_XB), (size_t)NTOK * DM / 4, gtid, gsz);
    float2* cs64 = (float2*)(p.ws + O_CS64); float2* cs32 = (float2*)(p.ws + O_CS32);
    for (int it = gtid; it < NTOK * 48; it += gsz) {
        const int m = it / 48, i = it % 48;
        const float ps = (float)p.pos[m];
        if (i < 32) { const float inv = powf(10000.f, -(float)(2 * i) / 64.f); const float a = ps * inv; cs64[m * 32 + i] = make_float2(cosf(a), sinf(a)); }
        else { const int k = i - 32; const float inv = powf(10000.f, -(float)(2 * k) / 32.f); const float a = ps * inv; cs32[m * 16 + k] = make_float2(cosf(a), sinf(a)); }
    }
}

struct XcdMap { int slice, rank, nloc; };
__device__ __forceinline__ bool gemm_next_tile(const XcdMap& xm, int it, int ntn, int& tm, int& tn) {
    const int j = xm.rank + xm.nloc * it;
    if (j >= 8 * ntn) return false;
    tm = 8 * xm.slice + j / ntn; tn = j % ntn; return true;
}
#define GEMM_LDK 80
#define GEMM_LDS_A (256 * GEMM_LDK * 2)
#define GEMM_LDS_STAGE (GEMM_LDS_A + 128 * GEMM_LDK * 2)
typedef unsigned u32x4g __attribute__((ext_vector_type(4)));
struct GemmRegs { u32x4g a0, a1, a2, a3, b0, b1; };
__device__ __forceinline__ void gemm_gload(GemmRegs& r, const bf16_t* ga, const bf16_t* gb, size_t astep) {
    r.a0 = *(const u32x4g*)(ga); r.a1 = *(const u32x4g*)(ga + astep); r.a2 = *(const u32x4g*)(ga + 2 * astep); r.a3 = *(const u32x4g*)(ga + 3 * astep);
    r.b0 = *(const u32x4g*)(gb); r.b1 = *(const u32x4g*)(gb + astep);
}
__device__ __forceinline__ void gemm_lstore(const GemmRegs& r, bf16_t* wa, bf16_t* wb) {
    *(u32x4g*)(wa) = r.a0; *(u32x4g*)(wa + 64 * GEMM_LDK) = r.a1; *(u32x4g*)(wa + 128 * GEMM_LDK) = r.a2; *(u32x4g*)(wa + 192 * GEMM_LDK) = r.a3;
    *(u32x4g*)(wb) = r.b0; *(u32x4g*)(wb + 64 * GEMM_LDK) = r.b1;
}
__device__ __forceinline__ void gemm_compute(f32x4 (&acc)[4][4], const bf16_t* sA, const bf16_t* sB, int wm, int wn, int lane) {
#pragma unroll
    for (int ks = 0; ks < 2; ++ks) {
        bf16x8 a[4], b[4];
#pragma unroll
        for (int i = 0; i < 4; ++i) a[i] = ld8(sA + (wm * 64 + i * 16 + (lane & 15)) * GEMM_LDK + ks * 32 + (lane >> 4) * 8);
#pragma unroll
        for (int i = 0; i < 4; ++i) b[i] = ld8(sB + (wn * 64 + i * 16 + (lane & 15)) * GEMM_LDK + ks * 32 + (lane >> 4) * 8);
#pragma unroll
        for (int i = 0; i < 4; ++i)
#pragma unroll
            for (int j = 0; j < 4; ++j) acc[i][j] = mfma16(a[i], b[j], acc[i][j]);
    }
}
template <class Epi>
__device__ __forceinline__ void gemm_tile(const bf16_t* __restrict__ A, const bf16_t* __restrict__ Bt, int K, int m0, int n0, const Epi& epi, char* smem) {
    const int tid = tid_op(), lane = tid & 63, w = tid >> 6, wm = w >> 1, wn = w & 1;
    f32x4 acc[4][4];
#pragma unroll
    for (int i = 0; i < 4; ++i)
#pragma unroll
        for (int j = 0; j < 4; ++j) acc[i][j] = (f32x4){0.f, 0.f, 0.f, 0.f};
    const int lrow = tid >> 3, lkc = (tid & 7) * 8;
    const bf16_t* ga = A + (size_t)(m0 + lrow) * K + lkc;
    const bf16_t* gb = Bt + (size_t)(n0 + lrow) * K + lkc;
    const size_t astep = (size_t)64 * K;
    bf16_t* sA0 = (bf16_t*)smem; bf16_t* sB0 = (bf16_t*)(smem + GEMM_LDS_A);
    bf16_t* sA1 = (bf16_t*)(smem + GEMM_LDS_STAGE); bf16_t* sB1 = (bf16_t*)(smem + GEMM_LDS_STAGE + GEMM_LDS_A);
    const int woff = lrow * GEMM_LDK + lkc;
    GemmRegs r0, r1;
    gemm_gload(r0, ga, gb, astep);
    gemm_gload(r1, ga + 64, gb + 64, astep);
    __syncthreads();
    gemm_lstore(r0, sA0 + woff, sB0 + woff);
    __syncthreads();
    const int nk = K / 64;
    for (int k = 0; k < nk; k += 2) {
        { const int kk = (k + 2 < nk) ? k + 2 : nk - 1; gemm_gload(r0, ga + kk * 64, gb + kk * 64, astep); }
        gemm_compute(acc, sA0, sB0, wm, wn, lane);
        gemm_lstore(r1, sA1 + woff, sB1 + woff);
        __syncthreads();
        { const int kk = (k + 3 < nk) ? k + 3 : nk - 1; gemm_gload(r1, ga + kk * 64, gb + kk * 64, astep); }
        gemm_compute(acc, sA1, sB1, wm, wn, lane);
        gemm_lstore(r0, sA0 + woff, sB0 + woff);
        __syncthreads();
    }
    epi(acc, m0 + wm * 64, n0 + wn * 64, lane, smem + w * 9216);
}

namespace pg8 {
#define PG8_LAS __attribute__((address_space(3)))
typedef unsigned short bf16_t;
typedef short bf16x8 __attribute__((ext_vector_type(8)));
typedef float f32x4 __attribute__((ext_vector_type(4)));
typedef unsigned u32x4 __attribute__((ext_vector_type(4)));
constexpr int BM = 256, BK = 64, HALF = 128, HTB = HALF * BK * 2  , STAGE_BYTES = 8 * HTB, NXCD = 8, WGM = 8;

__host__ __device__ __forceinline__ int lds_byte(int r, int c) { const int st = (r >> 4) * 2 + (c >> 5), rr = r & 15, cc = c & 31, ob = rr * 64 + cc * 2; return st * 1024 + (ob ^ (((ob >> 9) & 1) << 5)); }
__host__ __device__ __forceinline__ void stage_rc(int b, int& R, int& C) { const int st = b / 1024, sb = b % 1024, swz = sb ^ (((sb >> 9) & 1) << 5); R = (st >> 1) * 16 + swz / 64; C = (st & 1) * 32 + (swz % 64) / 2; }
__host__ __device__ __forceinline__ int perm32(int rho) { const int n = rho >> 4, i = rho & 15; return 8 * (i >> 2) + 4 * n + (i & 3); }

struct Unit { int pm, pn; };
struct Gemm { const bf16_t* A; const bf16_t* Bt; int M, N, K; };

struct StaticOrder {
    int nM, nN, nwg, G, c;
    __host__ __device__ void init(int M, int N, int G_, int c_) { nM = M / BM; nN = N / BM; nwg = nM * nN; G = G_; c = c_; }
    __host__ __device__ bool next(int i, Unit& u) const {
        const long L = (long)i * G + c; if (L >= nwg) return false;
        int wgid = (int)L; { const int q = nwg / NXCD, r = nwg % NXCD, xcd = wgid % NXCD, off = wgid / NXCD; wgid = (xcd < r ? xcd * (q + 1) : r * (q + 1) + (xcd - r) * q) + off; }
        const int nig = WGM * nN, gid = wgid / nig, fm = gid * WGM, gsz = (nM - fm) < WGM ? (nM - fm) : WGM;
        u.pm = fm + ((wgid % nig) % gsz); u.pn = (wgid % nig) / gsz; return true;
    }
    __device__ __forceinline__ void a_ready(const Unit&) const {}
    __device__ __forceinline__ void done(const Unit&) const {}
};
__device__ __forceinline__ unsigned cvt_pk_bf16(float lo, float hi) { unsigned r; asm volatile("v_cvt_pk_bf16_f32 %0, %1, %2" : "=v"(r) : "v"(lo), "v"(hi)); return r; }

struct EpiBf16Plain {
    static constexpr bool PERM = true, AFTER_DRAIN = false;
    bf16_t* O; int ldc;
    __device__ __forceinline__ void operator()(const f32x4 (&acc)[2][2][4][2], const Unit& u, int wr, int wc, int fr, int fq) const {
        const int row0 = u.pm * BM + wr * 64 + fr, col0 = u.pn * BM + wc * 32 + 8 * fq;
#pragma unroll
        for (int ai = 0; ai < 2; ++ai)
#pragma unroll
            for (int m = 0; m < 4; ++m) { bf16_t* rowp = O + (size_t)(row0 + ai * HALF + m * 16) * ldc + col0;
#pragma unroll
                for (int bj = 0; bj < 2; ++bj) { const f32x4 v0 = acc[ai][bj][m][0], v1 = acc[ai][bj][m][1];
                    u32x4 w; w.x = cvt_pk_bf16(v0[0], v0[1]); w.y = cvt_pk_bf16(v0[2], v0[3]); w.z = cvt_pk_bf16(v1[0], v1[1]); w.w = cvt_pk_bf16(v1[2], v1[3]);
                    *(u32x4*)(rowp + bj * HALF) = w; } }
    }
};
struct EpiResF32 {
    static constexpr bool PERM = false, AFTER_DRAIN = false;
    float* Y; const float* X; int ldc; float alpha;
    __device__ __forceinline__ void operator()(const f32x4 (&acc)[2][2][4][2], const Unit& u, int wr, int wc, int fr, int fq) const {
        const int row0 = u.pm * BM + wr * 64 + fr, col0 = u.pn * BM + wc * 32 + 4 * fq;
#pragma unroll
        for (int ai = 0; ai < 2; ++ai)
#pragma unroll
            for (int m = 0; m < 4; ++m) { const size_t ro = (size_t)(row0 + ai * HALF + m * 16) * ldc + col0;
#pragma unroll
                for (int bj = 0; bj < 2; ++bj)
#pragma unroll
                    for (int n = 0; n < 2; ++n) { const f32x4 xv = *(const f32x4*)(X + ro + bj * HALF + n * 16); *(f32x4*)(Y + ro + bj * HALF + n * 16) = xv * alpha + acc[ai][bj][m][n]; } }
    }
};
template <class Epi, class Sched, bool STAMP = false>
__device__ __forceinline__ void gemm_phase(PG8_LAS unsigned char* lds, const Gemm g, const Sched& S, const Epi& E, unsigned long long* stamps) {
    const int tid = tid_op(), wid = __builtin_amdgcn_readfirstlane(tid >> 6), lane = tid & 63, wr = wid >> 2, wc = wid & 3, fr = lane & 15, fq = lane >> 4;
    const int K = g.K, nt = K / BK;
    int ts_lo = 0, ts_hi = 0, nts = 0; const unsigned long long rt_entry = STAMP ? (unsigned long long)wall_clock64() : 0ull;
#define PG8_STAMP() do { if (STAMP && wid == 0 && nts < 64) { const unsigned long long _c = (unsigned long long)clock64(); \
        ts_lo = (lane == nts) ? (int)(unsigned)_c : ts_lo; ts_hi = (lane == nts) ? (int)(unsigned)(_c >> 32) : ts_hi; ++nts; } } while (0)
    PG8_STAMP();
    unsigned voffA[2], voffB[2];
#pragma unroll
    for (int i = 0; i < 2; ++i) { int R, C; stage_rc(tid * 16 + i * 8192, R, C); const int Rb = Epi::PERM ? ((R & ~31) + perm32(R & 31)) : R;
        voffA[i] = (unsigned)(R * K + C) * 2u; voffB[i] = (unsigned)(Rb * K + C) * 2u; }
    const size_t kstep = (size_t)(BK * 2);
    const size_t hstep = (size_t)HALF * K * 2;
    const size_t tstep = 2 * hstep;
    const unsigned ldsw = (unsigned)wid * 1024u;
    const int aoff = lds_byte(wr * 64 + fr, fq * 8), boff = lds_byte(wc * 32 + fr, fq * 8);
#define PG8_SA(b, h) (((b) * 2 + (h)) * HTB)
#define PG8_SB(b, h) ((4 + (b) * 2 + (h)) * HTB)
#define PG8_STAGE(bufoff, gbase, voff) do { _Pragma("unroll") for (int _i = 0; _i < 2; ++_i) \
        __builtin_amdgcn_global_load_lds((const unsigned*)((const char*)(gbase) + (voff)[_i]), (PG8_LAS unsigned*)(lds + (bufoff) + ldsw + _i * 8192), 16, 0, 0); } while (0)
#define PG8_LDA(dst, b, h) do { _Pragma("unroll") for (int m = 0; m < 4; ++m) _Pragma("unroll") for (int k = 0; k < 2; ++k) dst[m][k] = *(const PG8_LAS bf16x8*)(lds + PG8_SA(b, h) + aoff + m * 2048 + k * 1024); } while (0)
#define PG8_LDB(dst, b, h) do { _Pragma("unroll") for (int n = 0; n < 2; ++n) _Pragma("unroll") for (int k = 0; k < 2; ++k) dst[n][k] = *(const PG8_LAS bf16x8*)(lds + PG8_SB(b, h) + boff + n * 2048 + k * 1024); } while (0)
#define PG8_MMA(ai, bj, At, Bt) do { __builtin_amdgcn_s_setprio(1); _Pragma("unroll") for (int m = 0; m < 4; ++m) _Pragma("unroll") for (int n = 0; n < 2; ++n) _Pragma("unroll") for (int k = 0; k < 2; ++k) \
        acc[ai][bj][m][n] = __builtin_amdgcn_mfma_f32_16x16x32_bf16(Bt[n][k], At[m][k], acc[ai][bj][m][n], 0, 0, 0); __builtin_amdgcn_s_setprio(0); } while (0)
#define PG8_WAIT_V(n) asm volatile("s_waitcnt vmcnt(" #n ")" ::: "memory")
#define PG8_WAIT_L(n) asm volatile("s_waitcnt lgkmcnt(" #n ")" ::: "memory")
#define PG8_BAR __builtin_amdgcn_s_barrier()
#define PG8_SCHED __builtin_amdgcn_sched_barrier(0)
    Unit cur, nxt; int ui = 0;
    if (!S.next(0, cur)) return;
    f32x4 acc[2][2][4][2];
#pragma unroll
    for (int a = 0; a < 2; ++a)
#pragma unroll
        for (int b = 0; b < 2; ++b)
#pragma unroll
            for (int m = 0; m < 4; ++m)
#pragma unroll
                for (int n = 0; n < 2; ++n) acc[a][b][m][n] = (f32x4){0.f, 0.f, 0.f, 0.f};
    bf16x8 At[4][2], B0[2][2], B1[2][2];
    const char* cA = (const char*)g.A + (size_t)cur.pm * tstep; const char* cB = (const char*)g.Bt + (size_t)cur.pn * tstep;
    S.a_ready(cur);
    PG8_STAGE(PG8_SB(0, 0), cB, voffB); PG8_STAGE(PG8_SA(0, 0), cA, voffA); PG8_STAGE(PG8_SB(0, 1), cB + hstep, voffB); PG8_STAGE(PG8_SA(0, 1), cA + hstep, voffA);
    if (wr == 1) PG8_BAR;
    PG8_WAIT_V(4); PG8_BAR;
    PG8_STAGE(PG8_SB(1, 0), cB + kstep, voffB); PG8_STAGE(PG8_SA(1, 0), cA + kstep, voffA); PG8_STAGE(PG8_SB(1, 1), cB + hstep + kstep, voffB);
    PG8_WAIT_V(6); PG8_BAR;
    PG8_STAMP();
    for (;;) {
        const bool has_next = S.next(ui + 1, nxt);
        const char* nA = has_next ? (const char*)g.A + (size_t)nxt.pm * tstep : cA; const char* nB = has_next ? (const char*)g.Bt + (size_t)nxt.pn * tstep : cB;
        for (int t = 0; t < nt; t += 2) {
            const bool last = (t == nt - 2);
            const char* a1 = cA + (size_t)(t + 1) * kstep;
            const char* a2 = last ? nA : cA + (size_t)(t + 2) * kstep; const char* b2 = last ? nB : cB + (size_t)(t + 2) * kstep;
            const char* a3 = a2 + kstep; const char* b3 = b2 + kstep;
            if (last && has_next) S.a_ready(nxt);
            PG8_LDB(B0, 0, 0); PG8_SCHED; PG8_LDA(At, 0, 0); PG8_STAGE(PG8_SA(1, 1), a1 + hstep, voffA);
            PG8_WAIT_L(8); PG8_BAR; PG8_WAIT_L(0); PG8_MMA(0, 0, At, B0); PG8_BAR; PG8_SCHED;
            PG8_LDB(B1, 0, 1); PG8_STAGE(PG8_SB(0, 0), b2, voffB);
            PG8_BAR; PG8_WAIT_L(0); PG8_MMA(0, 1, At, B1); PG8_BAR;
            PG8_LDA(At, 0, 1); PG8_STAGE(PG8_SA(0, 0), a2, voffA);
            PG8_BAR; PG8_WAIT_L(0); PG8_MMA(1, 0, At, B0); PG8_BAR; PG8_SCHED;
            PG8_STAGE(PG8_SB(0, 1), b2 + hstep, voffB);
            PG8_WAIT_V(6); PG8_BAR; PG8_MMA(1, 1, At, B1); PG8_BAR;
            PG8_LDB(B0, 1, 0); PG8_SCHED; PG8_LDA(At, 1, 0); PG8_STAGE(PG8_SA(0, 1), a2 + hstep, voffA);
            PG8_WAIT_L(8); PG8_BAR; PG8_WAIT_L(0); PG8_MMA(0, 0, At, B0); PG8_BAR; PG8_SCHED;
            PG8_LDB(B1, 1, 1); PG8_STAGE(PG8_SB(1, 0), b3, voffB);
            PG8_BAR; PG8_WAIT_L(0); PG8_MMA(0, 1, At, B1); PG8_BAR;
            PG8_LDA(At, 1, 1); PG8_STAGE(PG8_SA(1, 0), a3, voffA);
            PG8_BAR; PG8_WAIT_L(0); PG8_MMA(1, 0, At, B0); PG8_BAR; PG8_SCHED;
            PG8_STAGE(PG8_SB(1, 1), b3 + hstep, voffB);
            PG8_WAIT_V(6); PG8_BAR; PG8_MMA(1, 1, At, B1); PG8_BAR;
        }
        PG8_STAMP();
        if constexpr (!Epi::AFTER_DRAIN) { E(acc, cur, wr, wc, fr, fq); S.done(cur); }
        PG8_STAMP();
        if (!has_next) break;
#pragma unroll
        for (int a = 0; a < 2; ++a)
#pragma unroll
            for (int b = 0; b < 2; ++b)
#pragma unroll
                for (int m = 0; m < 4; ++m)
#pragma unroll
                    for (int n = 0; n < 2; ++n) acc[a][b][m][n] = (f32x4){0.f, 0.f, 0.f, 0.f};
        cur = nxt; cA = nA; cB = nB; ++ui;
    }
    PG8_WAIT_V(0);
    if (wr == 0) PG8_BAR;
    PG8_BAR;
    if constexpr (Epi::AFTER_DRAIN) { E.fused(acc, cur, wr, wc, fr, fq, lds, wid, lane); S.done(cur); }
    PG8_STAMP();
    if (STAMP && wid == 0) { stamps[lane] = lane < nts ? (((unsigned long long)(unsigned)ts_hi << 32) | (unsigned)ts_lo) : 0ull;
        if (lane == 62) stamps[62] = rt_entry; if (lane == 63) stamps[63] = (unsigned long long)wall_clock64(); }
#undef PG8_STAMP
#undef PG8_SA
#undef PG8_SB
#undef PG8_STAGE
#undef PG8_LDA
#undef PG8_LDB
#undef PG8_MMA
#undef PG8_WAIT_V
#undef PG8_WAIT_L
#undef PG8_BAR
#undef PG8_SCHED
}
}

struct ProjEpi8 {
    static constexpr bool PERM = true, AFTER_DRAIN = false;
    char* ws; const float* dt_bias;
    __device__ __forceinline__ uint4 rot8(const pg8::f32x4 v0, const pg8::f32x4 v1, const float* tab, float sc) const {
        const float4 c01 = *(const float4*)tab, c23 = *(const float4*)(tab + 4);
        const float o10 = (v0[0] * c01.x - v1[0] * c01.y) * sc, o11 = (v0[1] * c01.z - v1[1] * c01.w) * sc, o12 = (v0[2] * c23.x - v1[2] * c23.y) * sc, o13 = (v0[3] * c23.z - v1[3] * c23.w) * sc;
        const float o20 = (v1[0] * c01.x + v0[0] * c01.y) * sc, o21 = (v1[1] * c01.z + v0[1] * c01.w) * sc, o22 = (v1[2] * c23.x + v0[2] * c23.y) * sc, o23 = (v1[3] * c23.z + v0[3] * c23.w) * sc;
        return make_uint4(pack2(o10, o11), pack2(o12, o13), pack2(o20, o21), pack2(o22, o23));
    }
    template <int SEG> __device__ __forceinline__ void store_row(const pg8::f32x4 v0, const pg8::f32x4 v1, const int cg, const int row) const {
        const int b = row >> 11, t = row & 2047;
        if (SEG == 0) {
            const bool isq = cg < 512; const int head = (cg & 511) >> 6, j = (cg & 63) >> 3;
            bf16_t* dst = (bf16_t*)(ws + (isq ? O_QB : O_KB)) + ((size_t)(b * 8 + head) * 2048 + t) * 64 + 8 * j;
            *(uint4*)dst = rot8(v0, v1, (const float*)(ws + O_CS64) + ((size_t)row * 32 + 4 * j) * 2, isq ? 0.125f * 1.4426950408889634f : 1.f);
        } else if (SEG == 1) {
            bf16_t* dst = (bf16_t*)(ws + O_VT) + ((size_t)(b * 8 + ((cg - 1024) >> 6)) * 64 + (cg & 63)) * 2048 + t;
#pragma unroll
            for (int e = 0; e < 4; ++e) { dst[(size_t)e * 2048] = f2bf(v0[e]); dst[(size_t)(e + 4) * 2048] = f2bf(v1[e]); }
        } else if (SEG == 2) {
            const int j = (cg & 31) >> 3;
            *(uint4*)((bf16_t*)(ws + O_IQB) + ((size_t)row * 8 + ((cg - 1536) >> 5)) * 32 + 8 * j) = rot8(v0, v1, (const float*)(ws + O_CS32) + ((size_t)row * 16 + 4 * j) * 2, 0.17677669529663687f);
        } else if (SEG == 3) {
            if (cg < 1824) {
                const int j = (cg & 31) >> 3;
                *(uint4*)((bf16_t*)(ws + O_IKB) + (size_t)row * 32 + 8 * j) = rot8(v0, v1, (const float*)(ws + O_CS32) + ((size_t)row * 16 + 4 * j) * 2, 1.f);
            } else if (cg == 1824) {
                const float k8 = 0.35355339059327373f; float* d = (float*)(ws + O_IWF) + (size_t)row * 8;
                *(float4*)d = make_float4(v0[0] * k8, v0[1] * k8, v0[2] * k8, v0[3] * k8); *(float4*)(d + 4) = make_float4(v1[0] * k8, v1[1] * k8, v1[2] * k8, v1[3] * k8);
            } else if (cg == 1832) {
                float o[8];
#pragma unroll
                for (int e = 0; e < 4; ++e) { const float a0 = v0[e] + dt_bias[e], a1 = v1[e] + dt_bias[4 + e]; o[e] = (a0 > 20.f) ? a0 : __logf(1.f + __expf(a0)); o[4 + e] = (a1 > 20.f) ? a1 : __logf(1.f + __expf(a1)); }
                float* d = (float*)(ws + O_DTF) + (size_t)row * 8;
                *(float4*)d = make_float4(o[0], o[1], o[2], o[3]); *(float4*)(d + 4) = make_float4(o[4], o[5], o[6], o[7]);
            }
        } else if (SEG == 4) {
            *(uint4*)((bf16_t*)(ws + O_ZB) + (size_t)row * 512 + (cg - ZOFF)) = make_uint4(pack2(v0[0], v0[1]), pack2(v0[2], v0[3]), pack2(v1[0], v1[1]), pack2(v1[2], v1[3]));
        } else {
            bf16_t* dst = (bf16_t*)(ws + O_XBCT) + ((size_t)b * 1024 + (cg - XBCOFF)) * 2048 + t;
#pragma unroll
            for (int e = 0; e < 4; ++e) { dst[(size_t)e * 2048] = f2bf(v0[e]); dst[(size_t)(e + 4) * 2048] = f2bf(v1[e]); }
        }
    }
    template <int SEG, int BJ> __device__ __forceinline__ void rows8(const pg8::f32x4 (&acc)[2][2][4][2], const int cg, const int row0) const {
#pragma unroll
        for (int ai = 0; ai < 2; ++ai)
#pragma unroll
            for (int m = 0; m < 4; ++m) store_row<SEG>(acc[ai][BJ][m][0], acc[ai][BJ][m][1], cg, row0 + ai * 128 + m * 16);
    }
    template <int BJ> __device__ __forceinline__ void half(const pg8::f32x4 (&acc)[2][2][4][2], const pg8::Unit& u, int wr, int wc, int fr, int fq) const {
        const int cw = u.pn * 256 + BJ * 128 + wc * 32;
        const int cg = cw + 8 * fq, row0 = u.pm * 256 + wr * 64 + fr;
        if (cw < 1024) rows8<0, BJ>(acc, cg, row0);
        else if (cw < 1536) rows8<1, BJ>(acc, cg, row0);
        else if (cw < 1792) rows8<2, BJ>(acc, cg, row0);
        else if (cw < 1856) rows8<3, BJ>(acc, cg, row0);
        else if (cw < 2368) rows8<4, BJ>(acc, cg, row0);
        else if (cw < NUSED) rows8<5, BJ>(acc, cg, row0);
    }
    __device__ __forceinline__ void operator()(const pg8::f32x4 (&acc)[2][2][4][2], const pg8::Unit& u, int wr, int wc, int fr, int fq) const {
        half<0>(acc, u, wr, wc, fr, fq); half<1>(acc, u, wr, wc, fr, fq);
    }
};
__device__ __forceinline__ void phase1(const Params& p, char* smem, const XcdMap xm) {
    char* ws = p.ws;
    ProjEpi8 e; e.ws = ws; e.dt_bias = p.dt_bias;
    pg8::Gemm g{(const bf16_t*)(ws + O_XB), (const bf16_t*)(ws + O_WIN_T), NTOK, NP, 1024};
    pg8::StaticOrder S; S.init(NTOK, NP, (int)gridDim.x, (int)blockIdx.x);
    pg8::gemm_phase<ProjEpi8, pg8::StaticOrder, false>((PG8_LAS unsigned char*)smem, g, S, e, nullptr);
}

#define IDX_NT 16
#define IDX_LDS_SCORES (16 * 2048 * 4)
__device__ __forceinline__ unsigned wave_sum_cnt(unsigned v) {
    v = row_sum_u(v);
    v += (unsigned)dpp_i<0x142, 0xA, false>((int)v);
    v += (unsigned)dpp_i<0x143, 0xC, false>((int)v);
    return (unsigned)__builtin_amdgcn_readlane((int)v, 63);
}
template <int NR> __device__ __forceinline__ unsigned idx_count_ge(const unsigned (&k)[NR], unsigned cand) {
    unsigned n = 0u;
#pragma unroll
    for (int i = 0; i < NR; ++i) n += (k[i] >= cand) ? 1u : 0u;
    return wave_sum_cnt(n);
}
template <int NR> __device__ __forceinline__ unsigned long long idx_words(const unsigned (&k)[NR], unsigned K, bool exact, int lane) {
    unsigned long long wd = 0ull;
    if (exact) {
#pragma unroll
        for (int i = 0; i < NR; ++i) { const unsigned long long bal = __ballot(k[i] >= K); if (lane == i) wd = bal; }
    } else {
        unsigned n = 0u;
#pragma unroll
        for (int i = 0; i < NR; ++i) n += (k[i] > K) ? 1u : 0u;
        unsigned rem = 256u - wave_sum_cnt(n);
#pragma unroll 1
        for (int i = 0; i < NR; ++i) {
            unsigned ki = k[0];
#pragma unroll
            for (int j = 1; j < NR; ++j) ki = (j == i) ? k[j] : ki;
            const unsigned long long gt = __ballot(ki > K), eq = __ballot(ki == K);
            unsigned long long take = 0ull, e = eq;
            while (rem > 0u && e) { take |= e & (~e + 1ull); e &= e - 1ull; --rem; }
            if (lane == i) wd = gt | take;
        }
    }
    return wd;
}
template <int NR> __device__ __forceinline__ void idx_select(const unsigned* Sa, unsigned long long* mrow, int lane) {
    unsigned ka[NR], kb[NR];
#pragma unroll
    for (int i = 0; i < NR; ++i) { ka[i] = Sa[64 * i]; kb[i] = Sa[2048 + 64 * i]; }
    unsigned Ka = 0u, Kb = 0u; bool da = false, db = false;
    for (int bit = 31; bit >= 0; --bit) {
        const unsigned ca = Ka | (1u << bit), cb = Kb | (1u << bit);
        const unsigned ta = idx_count_ge<NR>(ka, ca), tb = idx_count_ge<NR>(kb, cb);
        if (!da && ta >= 256u) { Ka = ca; da = (ta == 256u); }
        if (!db && tb >= 256u) { Kb = cb; db = (tb == 256u); }
        if (da && db) break;
    }
    const unsigned long long wa = idx_words<NR>(ka, Ka, da, lane), wb = idx_words<NR>(kb, Kb, db, lane);
    if (lane < NR) { mrow[lane] = wa; mrow[32 + lane] = wb; }
}
__device__ __forceinline__ void indexer_unit(const Params& p, int unit, char* smem) {
    const int tid = tid_op(), lane = tid & 63, w = tid >> 6, c = lane & 15, g = lane >> 4;
    const int b = unit & 7, grp = 127 - (unit >> 3), t0 = grp * 16;
    char* ws = p.ws;
    unsigned long long* mask64 = (unsigned long long*)(ws + O_MASK) + (size_t)(b * 2048 + t0) * 32;
    const int nblk64 = (t0 + 16 + 63) >> 6;
    if (t0 < 256) {
        for (int i = tid; i < 16 * nblk64; i += 512) {
            const int q = i / nblk64, wd = i % nblk64, t = t0 + q, s0 = wd * 64;
            const unsigned long long bits = (t >= s0 + 63) ? ~0ull : (t < s0 ? 0ull : ((1ull << (t - s0 + 1)) - 1ull));
            mask64[q * 32 + wd] = bits;
        }
        return;
    }
    const int ntile = (nblk64 + 1) >> 1;
    const bf16_t* IQb = (const bf16_t*)(ws + O_IQB); const bf16_t* IKb = (const bf16_t*)(ws + O_IKB); const float* IWf = (const float*)(ws + O_IWF);
    unsigned* S = (unsigned*)smem;
    float* siw = (float*)(smem + IDX_LDS_SCORES);
    __syncthreads();
    if (tid < 128) siw[tid] = IWf[(size_t)(b * 2048 + t0) * 8 + tid];
    {
        const int nr = (nblk64 <= 8) ? 8 : (nblk64 <= 16) ? 16 : (nblk64 <= 24) ? 24 : 32, kfrom = 8 * ntile * 16, kto = nr * 64;
        for (int i = tid; i < 16 * (kto - kfrom); i += 512) { const int q = i / (kto - kfrom), k = kfrom + i % (kto - kfrom); S[q * 2048 + k] = 0u; }
    }
    __syncthreads();
    {
        bf16x8 aq[8];
#pragma unroll
        for (int h = 0; h < 8; ++h) aq[h] = ld8(IQb + ((size_t)(b * 2048 + t0 + c) * 8 + h) * 32 + g * 8);
        float wq[4][8];
#pragma unroll
        for (int r = 0; r < 4; ++r)
#pragma unroll
            for (int h = 0; h < 8; ++h) wq[r][h] = siw[(4 * g + r) * 8 + h];
        bf16x8 bk[IDX_NT];
#pragma unroll
        for (int i = 0; i < IDX_NT; ++i) {
            const int ti = (i < ntile) ? (w * ntile + i) : (w * ntile);
            bk[i] = ld8(IKb + (size_t)(b * 2048 + ti * 16 + c) * 32 + g * 8);
        }
#pragma unroll
        for (int i = 0; i < IDX_NT; ++i) {
            if (i < ntile) {
                const int s0 = (w * ntile + i) * 16;
                float sc[4] = {0.f, 0.f, 0.f, 0.f};
#pragma unroll
                for (int h = 0; h < 8; ++h) {
                    const f32x4 o = mfma16(aq[h], bk[i], (f32x4){0.f, 0.f, 0.f, 0.f});
#pragma unroll
                    for (int r = 0; r < 4; ++r) sc[r] += wq[r][h] * fmaxf(o[r], 0.f);
                }
#pragma unroll
                for (int r = 0; r < 4; ++r) S[(4 * g + r) * 2048 + s0 + c] = (s0 + c <= t0 + 4 * g + r) ? f2sort(sc[r]) : 0u;
            }
        }
    }
    __syncthreads();
    if (nblk64 <= 8) idx_select<8>(S + (2 * w) * 2048 + lane, mask64 + (2 * w) * 32, lane);
    else if (nblk64 <= 16) idx_select<16>(S + (2 * w) * 2048 + lane, mask64 + (2 * w) * 32, lane);
    else if (nblk64 <= 24) idx_select<24>(S + (2 * w) * 2048 + lane, mask64 + (2 * w) * 32, lane);
    else idx_select<32>(S + (2 * w) * 2048 + lane, mask64 + (2 * w) * 32, lane);
}

__device__ __forceinline__ void ssd_prep_unit(const Params& p, int unit, char* smem) {
    const int tid = tid_op(), lane = tid & 63, w = tid >> 6, cL = lane & 15, gq = lane >> 4;
    const int h = unit & 7, c = (unit >> 3) & 15, b = unit >> 7, g = h >> 2;
    char* ws = p.ws;
    float* s_acum = (float*)smem; float* s_dt = s_acum + 128; float* s_w = s_dt + 128;
    bf16_t* sXw = (bf16_t*)(smem + 2048); bf16_t* sBt = sXw + 64 * 136;
    const int tok0 = b * 2048 + c * 128;
    const float a_h = -expf(p.a_log[h]);
    const float* DTf = (const float*)(ws + O_DTF);
    __syncthreads();
    if (tid < 128) s_dt[tid] = DTf[(size_t)(tok0 + tid) * 8 + h];
    __syncthreads();
    if (tid < 128) {
        float s = 0.f;
        for (int k = 0; k <= tid; ++k) s += s_dt[k] * a_h;
        s_acum[tid] = s;
        ((float*)(ws + O_ACUM))[(size_t)(b * 8 + h) * 2048 + c * 128 + tid] = s;
    }
    __syncthreads();
    if (tid < 128) {
        const float tot = s_acum[127];
        s_w[tid] = s_dt[tid] * __expf(tot - s_acum[tid]);
        if (tid == 0) ((float*)(ws + O_ATOT))[(b * 8 + h) * 16 + c] = tot;
    }
    __syncthreads();
    const bf16_t* XBCt = (const bf16_t*)(ws + O_XBCT);
    bf16_t* Xt = (bf16_t*)(ws + O_XT); bf16_t* Brm = (bf16_t*)(ws + O_BRM); bf16_t* Crm = (bf16_t*)(ws + O_CRM);
#pragma unroll
    for (int bt = 0; bt < 2; ++bt) {
    const int it0 = bt * 4, itn = bt ? 3 : 4;
    u32x4g cur7[4], prv7[4]; float cw7[4][5];
#pragma unroll
    for (int it = 0; it < 4; ++it) if (it < itn) {
        const int item = tid + 512 * (it0 + it);
        int ch; const int tc = item & 15;
        if (item < 1024) ch = h * 64 + (item >> 4);
        else if (item < 3072) ch = 512 + g * 128 + ((item - 1024) >> 4);
        else ch = 768 + g * 128 + (h & 3) * 32 + ((item - 3072) >> 4);
        const bf16_t* src = XBCt + ((size_t)b * 1024 + ch) * 2048 + c * 128 + tc * 8;
        cur7[it] = *(const u32x4g*)src;
        const bool hasprev = (c * 128 + tc * 8 >= 8);
        prv7[it] = *(const u32x4g*)(hasprev ? src - 8 : src);
        if (!hasprev) prv7[it] = (u32x4g){0u, 0u, 0u, 0u};
        cw7[it][0] = p.conv_w[ch]; cw7[it][1] = p.conv_w[1024 + ch]; cw7[it][2] = p.conv_w[2048 + ch]; cw7[it][3] = p.conv_w[3072 + ch]; cw7[it][4] = p.conv_b[ch];
    }
#pragma unroll
    for (int it = 0; it < 4; ++it) if (it < itn) {
        const int item = tid + 512 * (it0 + it);
        int kind, idx, ch; const int tc = item & 15;
        if (item < 1024) { kind = 0; idx = item >> 4; ch = h * 64 + idx; }
        else if (item < 3072) { kind = 1; idx = (item - 1024) >> 4; ch = 512 + g * 128 + idx; }
        else { kind = 2; idx = (h & 3) * 32 + ((item - 3072) >> 4); ch = 768 + g * 128 + idx; }
        const u32x4g cur = cur7[it], prv = prv7[it];
        float xv[11];
        xv[0] = bf2f((bf16_t)(prv.z >> 16)); xv[1] = bf2f((bf16_t)(prv.w & 0xFFFF)); xv[2] = bf2f((bf16_t)(prv.w >> 16));
        xv[3] = bf2f((bf16_t)(cur.x & 0xFFFF)); xv[4] = bf2f((bf16_t)(cur.x >> 16)); xv[5] = bf2f((bf16_t)(cur.y & 0xFFFF)); xv[6] = bf2f((bf16_t)(cur.y >> 16));
        xv[7] = bf2f((bf16_t)(cur.z & 0xFFFF)); xv[8] = bf2f((bf16_t)(cur.z >> 16)); xv[9] = bf2f((bf16_t)(cur.w & 0xFFFF)); xv[10] = bf2f((bf16_t)(cur.w >> 16));
        const float w0 = cw7[it][0], w1 = cw7[it][1], w2 = cw7[it][2], w3 = cw7[it][3], bias = cw7[it][4];
        float o[8];
#pragma unroll
        for (int j = 0; j < 8; ++j) { const float v = bias + w0 * xv[j] + w1 * xv[j + 1] + w2 * xv[j + 2] + w3 * xv[j + 3]; o[j] = bf2f(f2bf(silu_f(v))); }
        if (kind == 0) {
            *(uint4*)(Xt + ((size_t)b * 512 + ch) * 2048 + c * 128 + tc * 8) = make_uint4(pack2(o[0], o[1]), pack2(o[2], o[3]), pack2(o[4], o[5]), pack2(o[6], o[7]));
            float q[8];
#pragma unroll
            for (int j = 0; j < 8; ++j) q[j] = o[j] * s_w[tc * 8 + j];
            *(uint4*)(sXw + idx * 136 + tc * 8) = make_uint4(pack2(q[0], q[1]), pack2(q[2], q[3]), pack2(q[4], q[5]), pack2(q[6], q[7]));
        } else if (kind == 1) {
            *(uint4*)(sBt + idx * 136 + tc * 8) = make_uint4(pack2(o[0], o[1]), pack2(o[2], o[3]), pack2(o[4], o[5]), pack2(o[6], o[7]));
            if ((h & 3) == 0) {
#pragma unroll
                for (int j = 0; j < 8; ++j) Brm[(size_t)(tok0 + tc * 8 + j) * 256 + g * 128 + idx] = f2bf(o[j]);
            }
        } else {
#pragma unroll
            for (int j = 0; j < 8; ++j) Crm[(size_t)(tok0 + tc * 8 + j) * 256 + g * 128 + idx] = f2bf(o[j]);
        }
    }
    }
    __syncthreads();
    f32x4 acc[4];
#pragma unroll
    for (int i = 0; i < 4; ++i) acc[i] = (f32x4){0.f, 0.f, 0.f, 0.f};
#pragma unroll
    for (int ks = 0; ks < 4; ++ks) {
        const bf16x8 bb = ld8(sBt + (16 * w + cL) * 136 + ks * 32 + gq * 8);
#pragma unroll
        for (int pt = 0; pt < 4; ++pt) acc[pt] = mfma16(ld8(sXw + (16 * pt + cL) * 136 + ks * 32 + gq * 8), bb, acc[pt]);
    }
    float* ST = (float*)(ws + O_ST) + ((size_t)((b * 16 + c) * 8 + h)) * 8192;
#pragma unroll
    for (int pt = 0; pt < 4; ++pt)
#pragma unroll
        for (int r = 0; r < 4; ++r) ST[(16 * pt + 4 * gq + r) * 128 + 16 * w + cL] = acc[pt][r];
}

__device__ __forceinline__ void phase2c(const Params& p) {
    char* ws = p.ws;
    const int idx = blockIdx.x * 512 + tid_op();
    if (idx >= 64 * 2048) return;
    const int bh = idx >> 11, e4 = idx & 2047, b = bh >> 3, h = bh & 7;
    const float* ST = (const float*)(ws + O_ST); const float* ATOT = (const float*)(ws + O_ATOT);
    float4 sv[16]; float4 at4[4];
#pragma unroll
    for (int c = 0; c < 16; ++c) sv[c] = *(const float4*)(ST + ((size_t)((b * 16 + c) * 8 + h)) * 8192 + (size_t)e4 * 4);
#pragma unroll
    for (int k = 0; k < 4; ++k) at4[k] = *(const float4*)(ATOT + bh * 16 + 4 * k);
    const float at[16] = {at4[0].x, at4[0].y, at4[0].z, at4[0].w, at4[1].x, at4[1].y, at4[1].z, at4[1].w, at4[2].x, at4[2].y, at4[2].z, at4[2].w, at4[3].x, at4[3].y, at4[3].z, at4[3].w};
    float4 car = make_float4(0.f, 0.f, 0.f, 0.f);
    bf16_t* CAR = (bf16_t*)(ws + O_CAR);
#pragma unroll
    for (int c = 0; c < 16; ++c) {
        *(uint2*)(CAR + ((size_t)((b * 16 + c) * 8 + h)) * 8192 + (size_t)e4 * 4) = make_uint2(pack2(car.x, car.y), pack2(car.z, car.w));
        const float dec = __expf(at[c]);
        car.x = dec * car.x + sv[c].x; car.y = dec * car.y + sv[c].y; car.z = dec * car.z + sv[c].z; car.w = dec * car.w + sv[c].w;
    }
}

#define ATT_LDK 80
#define ATT_LDV 72
__device__ __forceinline__ void attn_unit(const Params& p, int unit, char* smem) {
    const int tid = tid_op(), lane = tid & 63, w = tid >> 6, cL = lane & 15, gq = lane >> 4;
    const int qb = 15 - (unit >> 6), bh = unit & 63, b = bh >> 3, h = bh & 7;
    char* ws = p.ws;
    const int q0 = qb * 128 + 16 * w;
    const int ktmax = (q0 + 15) >> 6;
    const int ntile = 2 * qb + 2;
    const bf16_t* Q = (const bf16_t*)(ws + O_QB) + (size_t)bh * 2048 * 64;
    const bf16_t* Kp = (const bf16_t*)(ws + O_KB) + (size_t)bh * 2048 * 64;
    const bf16_t* V = (const bf16_t*)(ws + O_VT) + (size_t)bh * 64 * 2048;
    const unsigned short* mrow = (const unsigned short*)(ws + O_MASK) + (size_t)(b * 2048 + q0 + cL) * 128;
    bf16_t* sK = (bf16_t*)smem;
    bf16_t* sV = (bf16_t*)(smem + 2 * 64 * ATT_LDK * 2);
    const int lr = tid >> 3, lc = (tid & 7) * 8;
    bf16x8 qf[2];
    qf[0] = ld8(Q + (size_t)(q0 + cL) * 64 + gq * 8); qf[1] = ld8(Q + (size_t)(q0 + cL) * 64 + 32 + gq * 8);
    float m_run = -1e30f, l_run = 0.f;
    f32x4 o[4];
#pragma unroll
    for (int i = 0; i < 4; ++i) o[i] = (f32x4){0.f, 0.f, 0.f, 0.f};
    u32x4g rk = *(const u32x4g*)(Kp + (size_t)lr * 64 + lc);
    u32x4g rv = *(const u32x4g*)(V + (size_t)lr * 2048 + lc);
    u32x4g rk1 = *(const u32x4g*)(Kp + (size_t)(64 + lr) * 64 + lc);
    u32x4g rv1 = *(const u32x4g*)(V + (size_t)lr * 2048 + 64 + lc);
    __syncthreads();
    *(u32x4g*)(sK + lr * ATT_LDK + lc) = rk; *(u32x4g*)(sV + lr * ATT_LDV + lc) = rv;
    __syncthreads();
    for (int kt = 0; kt < ntile; ++kt) {
        const int s0 = kt * 64, cur = kt & 1;
        rk = rk1; rv = rv1;
        { const int t2 = (kt + 2 < ntile) ? kt + 2 : ntile - 1; rk1 = *(const u32x4g*)(Kp + (size_t)(t2 * 64 + lr) * 64 + lc); rv1 = *(const u32x4g*)(V + (size_t)lr * 2048 + t2 * 64 + lc); }
        if (kt <= ktmax) {
            const bf16_t* tK = sK + cur * 64 * ATT_LDK; const bf16_t* tV = sV + cur * 64 * ATT_LDV;
            const unsigned long long mb = *(const unsigned long long*)(mrow + kt * 4);
            f32x4 st[4];
#pragma unroll
            for (int j = 0; j < 4; ++j) {
                f32x4 a = (f32x4){0.f, 0.f, 0.f, 0.f};
                const bf16_t* kr = tK + (16 * j + cL) * ATT_LDK + gq * 8;
                a = mfma16(ld8(kr), qf[0], a); a = mfma16(ld8(kr + 32), qf[1], a);
                st[j] = a;
            }
            float mx = m_run;
            const unsigned mlo = (unsigned)mb >> (4 * gq), mhi = (unsigned)(mb >> 32) >> (4 * gq);
#pragma unroll
            for (int j = 0; j < 4; ++j)
#pragma unroll
                for (int r = 0; r < 4; ++r) {
                    const bool bit = ((j < 2 ? mlo : mhi) & (1u << (16 * (j & 1) + r))) != 0u;
                    const float v = bit ? st[j][r] : -INFINITY;
                    st[j][r] = v; mx = fmaxf(mx, v);
                }
            mx = max_x32(max_x16(mx));
            const float alpha = __builtin_amdgcn_exp2f(m_run - mx); m_run = mx;
            float ls = 0.f;
#pragma unroll
            for (int j = 0; j < 4; ++j)
#pragma unroll
                for (int r = 0; r < 4; ++r) { const float pv = __builtin_amdgcn_exp2f(st[j][r] - mx); st[j][r] = pv; ls += pv; }
            ls = sum_x32(sum_x16(ls));
            l_run = l_run * alpha + ls;
#pragma unroll
            for (int i = 0; i < 4; ++i) o[i] = o[i] * alpha;
#pragma unroll
            for (int kk = 0; kk < 2; ++kk) {
                bf16x8 pf;
#pragma unroll
                for (int r = 0; r < 4; ++r) { pf[r] = (short)f2bf(st[2 * kk][r]); pf[4 + r] = (short)f2bf(st[2 * kk + 1][r]); }
#pragma unroll
                for (int dt = 0; dt < 4; ++dt) {
                    const bf16_t* vr = tV + (16 * dt + cL) * ATT_LDV + 32 * kk + 4 * gq;
                    o[dt] = mfma16(cat4(*(const bf16x4*)vr, *(const bf16x4*)(vr + 16)), pf, o[dt]);
                }
            }
        }
        if (kt + 1 < ntile) {
            const int nxt = cur ^ 1;
            *(u32x4g*)(sK + nxt * 64 * ATT_LDK + lr * ATT_LDK + lc) = rk; *(u32x4g*)(sV + nxt * 64 * ATT_LDV + lr * ATT_LDV + lc) = rv;
        }
        __syncthreads();
    }
    const float inv = 1.f / l_run;
    bf16_t* mix = (bf16_t*)(ws + O_MIX) + (size_t)(b * 2048 + q0 + cL) * 1024 + h * 64;
#pragma unroll
    for (int dt = 0; dt < 4; ++dt)
        *(uint2*)(mix + 16 * dt + 4 * gq) = make_uint2(pack2(o[dt][0] * inv, o[dt][1] * inv), pack2(o[dt][2] * inv, o[dt][3] * inv));
}

#define SSD_CAR_BYTES (4 * 64 * 136 * 2)
__device__ __forceinline__ void ssd_main_unit(const Params& p, int unit, char* smem) {
    const int tid = tid_op(), lane = tid & 63, w = tid >> 6, cL = lane & 15, gq = lane >> 4;
    const int g = unit & 1, c = (unit >> 1) & 15, b = unit >> 5;
    char* ws = p.ws;
    float* sAc = (float*)smem;
    float* sDt = sAc + 512;
    const int tok0 = b * 2048 + c * 128;
    const float* ATOT = (const float*)(ws + O_ATOT); const float* ACUM = (const float*)(ws + O_ACUM); const float* DTf = (const float*)(ws + O_DTF);
    const bf16_t* Xt = (const bf16_t*)(ws + O_XT); const bf16_t* Brm = (const bf16_t*)(ws + O_BRM); const bf16_t* Crm = (const bf16_t*)(ws + O_CRM);
    const bf16_t* Zb = (const bf16_t*)(ws + O_ZB);
    __syncthreads();
    {
        const int hh = tid >> 7, l = tid & 127;
        sAc[tid] = ACUM[(size_t)(b * 8 + 4 * g + hh) * 2048 + c * 128 + l];
        sDt[tid] = DTf[(size_t)(tok0 + l) * 8 + 4 * g + hh];
    }
    __syncthreads();
    bf16_t* mix = (bf16_t*)(ws + O_MIX);
    const int lt = w;
    const int ltok = tok0 + 16 * lt + cL;
    bf16x8 Cq[4];
#pragma unroll
    for (int ks = 0; ks < 4; ++ks) Cq[ks] = ld8(Crm + (size_t)ltok * 256 + g * 128 + ks * 32 + gq * 8);
    f32x4 cbT[8];
#pragma unroll
    for (int st = 0; st < 8; ++st) {
        cbT[st] = (f32x4){0.f, 0.f, 0.f, 0.f};
        if (st <= lt) {
            const bf16_t* br = Brm + (size_t)(tok0 + 16 * st + cL) * 256 + g * 128 + gq * 8;
#pragma unroll
            for (int ks = 0; ks < 4; ++ks) cbT[st] = mfma16(ld8(br + ks * 32), Cq[ks], cbT[st]);
        }
    }
    float ssq = 0.f;
#pragma unroll 1
    for (int hh = 0; hh < 4; ++hh) {
        const int h = 4 * g + hh;
        const float* ac = sAc + hh * 128; const float* dtl = sDt + hh * 128;
        const float al = ac[16 * lt + cL];
        const bf16_t* xh = Xt + ((size_t)b * 512 + h * 64) * 2048 + c * 128;
        const bf16_t* zh = Zb + (size_t)tok0 * 512 + h * 64;
        const bf16_t* carh = (const bf16_t*)(ws + O_CAR) + ((size_t)((b * 16 + c) * 8 + h)) * 8192;
        bf16x8 xf[4][4];
#pragma unroll
        for (int kk = 0; kk < 4; ++kk)
#pragma unroll
            for (int pt = 0; pt < 4; ++pt) {
                const int kc = (2 * kk <= lt) ? kk : 0;
                const unsigned xo = (unsigned)((16 * pt + cL) * 2048 + 32 * kc + 4 * gq);
                xf[kk][pt] = cat4(*(const bf16x4*)(xh + xo), *(const bf16x4*)(xh + xo + 16));
            }
        f32x4 acc1[4], acc2[4];
#pragma unroll
        for (int i = 0; i < 4; ++i) { acc1[i] = (f32x4){0.f, 0.f, 0.f, 0.f}; acc2[i] = (f32x4){0.f, 0.f, 0.f, 0.f}; }
#pragma unroll
        for (int kk = 0; kk < 4; ++kk) {
            if (2 * kk <= lt) {
                bf16x8 mf;
#pragma unroll
                for (int half = 0; half < 2; ++half) {
                    const int st = 2 * kk + half;
#pragma unroll
                    for (int r = 0; r < 4; ++r) {
                        const int sl = 16 * st + 4 * gq + r;
                        float v = 0.f;
                        if (st <= lt && sl <= 16 * lt + cL) v = cbT[st][r] * __expf(al - ac[sl]) * dtl[sl];
                        mf[half * 4 + r] = (short)f2bf(v);
                    }
                }
#pragma unroll
                for (int pt = 0; pt < 4; ++pt) acc1[pt] = mfma16(xf[kk][pt], mf, acc1[pt]);
            }
        }
        uint2 zz[4]; bf16_t xsv[4][4];
#pragma unroll
        for (int pt = 0; pt < 4; ++pt) {
            zz[pt] = *(const uint2*)(zh + (unsigned)((16 * lt + cL) * 512 + 16 * pt + 4 * gq));
#pragma unroll
            for (int r = 0; r < 4; ++r) xsv[pt][r] = xh[(unsigned)((16 * pt + 4 * gq + r) * 2048 + 16 * lt + cL)];
        }
#pragma unroll
        for (int ks = 0; ks < 4; ++ks)
#pragma unroll
            for (int pt = 0; pt < 4; ++pt) acc2[pt] = mfma16(ld8(carh + (unsigned)((16 * pt + cL) * 128 + ks * 32 + gq * 8)), Cq[ks], acc2[pt]);
        const float el = __expf(al), dsk = p.d_skip[h];
#pragma unroll
        for (int pt = 0; pt < 4; ++pt) {
            const float zf[4] = {bf2f((bf16_t)(zz[pt].x & 0xFFFF)), bf2f((bf16_t)(zz[pt].x >> 16)), bf2f((bf16_t)(zz[pt].y & 0xFFFF)), bf2f((bf16_t)(zz[pt].y >> 16))};
            float yv[4];
#pragma unroll
            for (int r = 0; r < 4; ++r) {
                float t = acc1[pt][r] + el * acc2[pt][r] + bf2f(xsv[pt][r]) * dsk;
                t *= silu_f(zf[r]);
                yv[r] = t; ssq += t * t;
            }
            *(uint2*)(mix + (size_t)ltok * 1024 + 512 + h * 64 + 16 * pt + 4 * gq) = make_uint2(pack2(yv[0], yv[1]), pack2(yv[2], yv[3]));
        }
    }
    ssq = sum_x32(sum_x16(ssq));
    const float rstd = rsqrtf(ssq * (1.f / 256.f) + LN_EPS);
#pragma unroll
    for (int hh = 0; hh < 4; ++hh)
#pragma unroll
        for (int pt = 0; pt < 4; ++pt) {
            const int ch = (4 * g + hh) * 64 + 16 * pt + 4 * gq;
            const float4 nw = *(const float4*)(p.norm_w + ch);
            const uint2 yy = *(const uint2*)(mix + (size_t)ltok * 1024 + 512 + ch);
            const float y0 = bf2f((bf16_t)(yy.x & 0xFFFF)), y1 = bf2f((bf16_t)(yy.x >> 16)), y2 = bf2f((bf16_t)(yy.y & 0xFFFF)), y3 = bf2f((bf16_t)(yy.y >> 16));
            *(uint2*)(mix + (size_t)ltok * 1024 + 512 + ch) = make_uint2(pack2(y0 * rstd * nw.x, y1 * rstd * nw.y), pack2(y2 * rstd * nw.z, y3 * rstd * nw.w));
        }
}

__device__ __forceinline__ void phase2(const Params& p, char* smem, int which = 3) {
    const int G = gridDim.x;
    for (int k = 0; k * G < 2048; ++k) {
        const int u = k * G + ((k & 1) ? (G - 1 - (int)blockIdx.x) : (int)blockIdx.x);
        if (u >= 2048) continue;
        if (u < 1024) { if (which & 1) indexer_unit(p, u, smem); } else { if (which & 2) ssd_prep_unit(p, u - 1024, smem); }
    }
}
__device__ __forceinline__ void phase3(const Params& p, char* smem, int which = 3) {
    const int G = gridDim.x;
    for (int k = 0; k * G < 1024 + 256; ++k) {
        const int u = k * G + ((k & 1) ? (G - 1 - (int)blockIdx.x) : (int)blockIdx.x);
        if (u >= 1024 + 256) continue;
        if (u < 256) { if (which & 1) ssd_main_unit(p, u, smem); } else { if (which & 2) attn_unit(p, u - 256, smem); }
    }
}

struct OutEpi {
    const float* x; float* y;
    __device__ __forceinline__ void operator()(const f32x4 (&acc)[4][4], int mb, int nb, int lane, char* lds) const {
        const int c = lane & 15, g = lane >> 4;
        float* L = (float*)lds;
#pragma unroll
        for (int half = 0; half < 2; ++half) {
#pragma unroll
            for (int mi2 = 0; mi2 < 2; ++mi2)
#pragma unroll
                for (int r = 0; r < 4; ++r)
#pragma unroll
                    for (int ni = 0; ni < 4; ++ni) L[(16 * mi2 + 4 * g + r) * 68 + 16 * ni + c] = acc[2 * half + mi2][ni][r];
#pragma unroll
            for (int i = 0; i < 8; ++i) {
                const int row = 4 * i + g;
                const float4 a = *(const float4*)(L + row * 68 + 4 * c);
                const size_t o = (size_t)(mb + 32 * half + row) * 1024 + nb + 4 * c;
                const float4 xv = *(const float4*)(x + o);
                *(float4*)(y + o) = make_float4(ALPHA * xv.x + a.x, ALPHA * xv.y + a.y, ALPHA * xv.z + a.z, ALPHA * xv.w + a.w);
            }
        }
    }
};
__device__ __forceinline__ void phase4(const Params& p, char* smem, const XcdMap xm) {
    pg8::Gemm g{(const bf16_t*)(p.ws + O_MIX), (const bf16_t*)(p.ws + O_WOUT_T), NTOK, 1024, 1024};
    pg8::StaticOrder S; S.init(NTOK, 1024, (int)gridDim.x, (int)blockIdx.x);
    pg8::EpiResF32 E{p.out, p.x, 1024, ALPHA};
    pg8::gemm_phase<pg8::EpiResF32, pg8::StaticOrder, false>((PG8_LAS unsigned char*)smem, g, S, E, nullptr);
}

__device__ __forceinline__ void phase5(const Params& p) {
    const int lane = tid_op() & 63, w = tid_op() >> 6;
    bf16_t* hb = (bf16_t*)(p.ws + O_HB);
    for (int row = blockIdx.x * 8 + w; row < NTOK; row += gridDim.x * 8) {
        float* yr = p.out + (size_t)row * 1024;
        float4 v[4]; float s = 0.f;
#pragma unroll
        for (int j = 0; j < 4; ++j) { v[j] = *(const float4*)(yr + 4 * lane + 256 * j); s += v[j].x + v[j].y + v[j].z + v[j].w; }
        const float mean = wave_sum(s) * (1.f / 1024.f);
        float q = 0.f;
#pragma unroll
        for (int j = 0; j < 4; ++j) { const float a = v[j].x - mean, b2 = v[j].y - mean, c2 = v[j].z - mean, d = v[j].w - mean; q += a * a + b2 * b2 + c2 * c2 + d * d; }
        const float rstd = rsqrtf(wave_sum(q) * (1.f / 1024.f) + LN_EPS);
#pragma unroll
        for (int j = 0; j < 4; ++j) {
            const int col = 4 * lane + 256 * j;
            const float4 gg = *(const float4*)(p.ln1_g + col), bb = *(const float4*)(p.ln1_b + col);
            float4 o;
            o.x = (v[j].x - mean) * rstd * gg.x + bb.x; o.y = (v[j].y - mean) * rstd * gg.y + bb.y; o.z = (v[j].z - mean) * rstd * gg.z + bb.z; o.w = (v[j].w - mean) * rstd * gg.w + bb.w;
            *(float4*)(yr + col) = o;
            *(uint2*)(hb + (size_t)row * 1024 + col) = make_uint2(pack2(o.x, o.y), pack2(o.z, o.w));
            int ph = __builtin_amdgcn_cvt_pk_fp8_f32(o.x, o.y, 0, false); ph = __builtin_amdgcn_cvt_pk_fp8_f32(o.z, o.w, ph, true);
            const f32x2 b01 = __builtin_amdgcn_cvt_pk_f32_fp8(ph, false), b23 = __builtin_amdgcn_cvt_pk_f32_fp8(ph, true);
            int pl = __builtin_amdgcn_cvt_pk_fp8_f32((o.x - b01.x) * 16.f, (o.y - b01.y) * 16.f, 0, false); pl = __builtin_amdgcn_cvt_pk_fp8_f32((o.z - b23.x) * 16.f, (o.w - b23.y) * 16.f, pl, true);
            *(int*)(p.ws + O_H8HI + (size_t)row * 1024 + col) = ph; *(int*)(p.ws + O_H8LO + (size_t)row * 1024 + col) = pl;
        }
    }
    const size_t gtid = (size_t)blockIdx.x * blockDim.x + tid_op(), gsz = (size_t)gridDim.x * blockDim.x;
    {
        unsigned* u8 = (unsigned*)(p.ws + O_U8); unsigned* v8 = (unsigned*)(p.ws + O_V8);
        for (size_t i = gtid; i < (size_t)16384 * 256; i += gsz) {
            const float4 fu = ((const float4*)p.u)[i];
            int pk = __builtin_amdgcn_cvt_pk_fp8_f32(fu.x * 32.f, fu.y * 32.f, 0, false); pk = __builtin_amdgcn_cvt_pk_fp8_f32(fu.z * 32.f, fu.w * 32.f, pk, true);
            u8[i] = (unsigned)pk;
            const float4 fv = ((const float4*)p.v)[i];
            int pv = __builtin_amdgcn_cvt_pk_fp8_f32(fv.x, fv.y, 0, false); pv = __builtin_amdgcn_cvt_pk_fp8_f32(fv.z, fv.w, pv, true);
            const size_t e = i >> 8, c4 = i & 255;
            v8[((c4 >> 5) * 16384 + e) * 32 + (c4 & 31)] = (unsigned)pv;
        }
    }
}

struct QpEpi {
    bf16_t* qp;
    __device__ __forceinline__ void operator()(const f32x4 (&acc)[4][4], int mb, int nb, int lane, char* lds) const {
        const int c = lane & 15, g = lane >> 4;
        bf16_t* L = (bf16_t*)lds;
#pragma unroll
        for (int mi = 0; mi < 4; ++mi)
#pragma unroll
            for (int r = 0; r < 4; ++r)
#pragma unroll
                for (int ni = 0; ni < 4; ++ni) L[(16 * mi + 4 * g + r) * 72 + 16 * ni + c] = f2bf(acc[mi][ni][r]);
#pragma unroll
        for (int i = 0; i < 8; ++i) {
            const int row = 8 * i + (lane >> 3), cc = (lane & 7) * 8;
            *(uint4*)(qp + (size_t)(mb + row) * 2048 + nb + cc) = *(const uint4*)(L + row * 72 + cc);
        }
    }
};
__device__ __forceinline__ void phase6(const Params& p, char* smem, const XcdMap xm) {
    pg8::Gemm g{(const bf16_t*)(p.ws + O_HB), (const bf16_t*)(p.ws + O_WQ_T), NTOK, 2048, 1024};
    pg8::StaticOrder S; S.init(NTOK, 2048, (int)gridDim.x, (int)blockIdx.x);
    pg8::EpiBf16Plain E{(bf16_t*)(p.ws + O_QP), 2048};
    pg8::gemm_phase<pg8::EpiBf16Plain, pg8::StaticOrder, false>((PG8_LAS unsigned char*)smem, g, S, E, nullptr);
}

__constant__ unsigned char CAND_I[64] = {0,0,0,0,0,0,0,0,0,0,0,0,0,0,0,0, 1,1,1,1,1,1,1,1, 2,2,2,2,2, 3,3,3,3, 4,4,4, 5,5, 6,6, 7,7, 8,9,10,11,12,13,14,15, 0,0,0,0,0,0,0,0,0,0,0,0,0,0};
__constant__ unsigned char CAND_J[64] = {0,1,2,3,4,5,6,7,8,9,10,11,12,13,14,15, 0,1,2,3,4,5,6,7, 0,1,2,3,4, 0,1,2,3, 0,1,2, 0,1, 0,1, 0,1, 0,0,0,0,0,0,0,0, 0,0,0,0,0,0,0,0,0,0,0,0,0,0};
__device__ __forceinline__ unsigned rowmax_u(unsigned v) { return row_max_u(v); }
__device__ __forceinline__ void peer_select_wave(const Params& p, int wunit) {
    const int lane = tid_op() & 63, cL = lane & 15, gq = lane >> 4, rowbase = lane & 48;
    const int tg = wunit >> 3, h = wunit & 7, tok0 = tg * 16;
    char* ws = p.ws;
    const bf16_t* QP = (const bf16_t*)(ws + O_QP);
    unsigned top[2][4];
#pragma unroll
    for (int half = 0; half < 2; ++half) {
        const bf16_t* KB = (const bf16_t*)(ws + (half ? O_K2B : O_K1B));
        bf16x8 a[4];
#pragma unroll
        for (int ks = 0; ks < 4; ++ks) a[ks] = ld8(QP + (size_t)(tok0 + cL) * 2048 + h * 256 + half * 128 + ks * 32 + gq * 8);
        unsigned pk[8][4];
#pragma unroll
        for (int nt = 0; nt < 8; ++nt) {
            f32x4 acc = (f32x4){0.f, 0.f, 0.f, 0.f};
#pragma unroll
            for (int ks = 0; ks < 4; ++ks) acc = mfma16(a[ks], ld8(KB + (size_t)(16 * nt + cL) * 128 + ks * 32 + gq * 8), acc);
#pragma unroll
            for (int r = 0; r < 4; ++r) pk[nt][r] = (f2sort(acc[r]) & ~0x7Fu) | (unsigned)(127 - (16 * nt + cL));
        }
#pragma unroll
        for (int r = 0; r < 4; ++r) top[half][r] = 0u;
        for (int it = 0; it < 16; ++it) {
#pragma unroll
            for (int r = 0; r < 4; ++r) {
                unsigned lm = pk[0][r];
#pragma unroll
                for (int nt = 1; nt < 8; ++nt) lm = max(lm, pk[nt][r]);
                const unsigned gm = rowmax_u(lm);
                if (cL == it) top[half][r] = gm;
#pragma unroll
                for (int nt = 0; nt < 8; ++nt) pk[nt][r] = (pk[nt][r] == gm) ? 0u : pk[nt][r];
            }
        }
    }
    unsigned ck[4][4];
#pragma unroll
    for (int s = 0; s < 4; ++s) {
        const int q = s * 16 + cL; const int ci = CAND_I[q], cj = CAND_J[q];
#pragma unroll
        for (int r = 0; r < 4; ++r) {
            const unsigned t1 = (unsigned)__shfl((int)top[0][r], rowbase + ci), t2 = (unsigned)__shfl((int)top[1][r], rowbase + cj);
            const float f = sort2f(t1 & ~0x7Fu) + sort2f(t2 & ~0x7Fu);
            ck[s][r] = (q < 50) ? ((f2sort(f) & ~0x3Fu) | (unsigned)(63 - q)) : 0u;
        }
    }
    unsigned best[4] = {0u, 0u, 0u, 0u};
    for (int it = 0; it < 16; ++it) {
#pragma unroll
        for (int r = 0; r < 4; ++r) {
            const unsigned lm = max(max(ck[0][r], ck[1][r]), max(ck[2][r], ck[3][r]));
            const unsigned gm = rowmax_u(lm);
            if (cL == it) best[r] = gm;
#pragma unroll
            for (int s = 0; s < 4; ++s) ck[s][r] = (ck[s][r] == gm) ? 0u : ck[s][r];
        }
    }
    int* EIDX = (int*)(ws + O_EIDX); float* GATE = (float*)(ws + O_GATE);
#pragma unroll
    for (int r = 0; r < 4; ++r) {
        const float fv = sort2f(best[r] & ~0x3Fu);
        const int q = 63 - (int)(best[r] & 63u);
        const int ci = CAND_I[q], cj = CAND_J[q];
        const unsigned t1 = (unsigned)__shfl((int)top[0][r], rowbase + ci), t2 = (unsigned)__shfl((int)top[1][r], rowbase + cj);
        const int e = (127 - (int)(t1 & 127u)) * 128 + (127 - (int)(t2 & 127u));
        const float mx = __shfl(fv, rowbase);
        const float ex = __expf(fv - mx);
        const float sm = row_sum(ex);
        const size_t o = (size_t)(tok0 + 4 * gq + r) * 128 + h * 16 + cL;
        EIDX[o] = e; GATE[o] = ex / sm;
    }
}
__device__ __forceinline__ void phase7(const Params& p) {
    const int w = tid_op() >> 6;
    for (int u = blockIdx.x * 8 + w; u < 8192; u += gridDim.x * 8) peer_select_wave(p, u);
}

#define P8A_T 24
__device__ __forceinline__ float gelu_erf(float d) { return 0.5f * d * (1.f + erff(d * 0.70710678118654752f)); }
__device__ __forceinline__ float dot16_fp8(const uint4& r, const float (&hv)[16]) {
    const f32x2 a0 = __builtin_amdgcn_cvt_pk_f32_fp8((int)r.x, false), a1 = __builtin_amdgcn_cvt_pk_f32_fp8((int)r.x, true);
    const f32x2 b0 = __builtin_amdgcn_cvt_pk_f32_fp8((int)r.y, false), b1 = __builtin_amdgcn_cvt_pk_f32_fp8((int)r.y, true);
    const f32x2 c0 = __builtin_amdgcn_cvt_pk_f32_fp8((int)r.z, false), c1 = __builtin_amdgcn_cvt_pk_f32_fp8((int)r.z, true);
    const f32x2 d0 = __builtin_amdgcn_cvt_pk_f32_fp8((int)r.w, false), d1 = __builtin_amdgcn_cvt_pk_f32_fp8((int)r.w, true);
    return (hv[0] * a0.x + hv[1] * a0.y + hv[2] * a1.x + hv[3] * a1.y) + (hv[4] * b0.x + hv[5] * b0.y + hv[6] * b1.x + hv[7] * b1.y)
         + (hv[8] * c0.x + hv[9] * c0.y + hv[10] * c1.x + hv[11] * c1.y) + (hv[12] * d0.x + hv[13] * d0.y + hv[14] * d1.x + hv[15] * d1.y);
}
typedef unsigned u32x4n __attribute__((ext_vector_type(4)));
__device__ __forceinline__ long lo64n(const u32x4n v) { return (long)(((unsigned long long)v.y << 32) | v.x); }
__device__ __forceinline__ long hi64n(const u32x4n v) { return (long)(((unsigned long long)v.w << 32) | v.z); }
struct P8aRows { u32x4n a[16]; };
__device__ __forceinline__ void p8a_load(P8aRows& R, const unsigned char* U8, int eid, int gq) {
    const unsigned char* urow = U8 + (size_t)eid * 1024 + 16 * gq;
#pragma unroll
    for (int j = 0; j < 16; ++j) R.a[j] = *(const u32x4n*)(urow + 64 * j);
}
__device__ __forceinline__ void p8a_compute(const P8aRows& R, const char* hb, int gq, int cL, int eidD, float gateD, unsigned* dst) {
    unsigned off = 16u * (unsigned)gq;
    asm volatile("" : "+v"(off));
    f32x4 ahi = (f32x4){0.f, 0.f, 0.f, 0.f}, alo = (f32x4){0.f, 0.f, 0.f, 0.f};
#pragma unroll
    for (int j = 0; j < 16; ++j) {
        const u32x4n bh = *(const u32x4n*)(hb + off + 64 * j), bl = *(const u32x4n*)(hb + 1024 + off + 64 * j);
        ahi = __builtin_amdgcn_mfma_f32_16x16x32_fp8_fp8(lo64n(R.a[j]), lo64n(bh), ahi, 0, 0, 0);
        ahi = __builtin_amdgcn_mfma_f32_16x16x32_fp8_fp8(hi64n(R.a[j]), hi64n(bh), ahi, 0, 0, 0);
        alo = __builtin_amdgcn_mfma_f32_16x16x32_fp8_fp8(lo64n(R.a[j]), lo64n(bl), alo, 0, 0, 0);
        alo = __builtin_amdgcn_mfma_f32_16x16x32_fp8_fp8(hi64n(R.a[j]), hi64n(bl), alo, 0, 0, 0);
    }
    const int rs = cL & 3;
    const float d0 = ahi[0] + alo[0] * 0.0625f, d1 = ahi[1] + alo[1] * 0.0625f, d2 = ahi[2] + alo[2] * 0.0625f, d3 = ahi[3] + alo[3] * 0.0625f;
    const float dot = (rs == 0 ? d0 : (rs == 1 ? d1 : (rs == 2 ? d2 : d3))) * (1.f / 32.f);
    const float act = gelu_erf(dot) * gateD;
    if (cL < 4) dst[4 * gq + cL] = (unsigned)eidD | ((unsigned)f2bf(act) << 16);
}
__device__ __forceinline__ void phase8a(const Params& p, const XcdMap xm, char* smem) {
    const int lane = tid_op() & 63, w = tid_op() >> 6, cL = lane & 15, gq = lane >> 4;
    char* ws = p.ws;
    const unsigned char* U8 = (const unsigned char*)(ws + O_U8);
    const int* EIDX = (const int*)(ws + O_EIDX); const float* GATE = (const float*)(ws + O_GATE); unsigned* ACT = (unsigned*)(ws + O_ACT);
    const unsigned char* H8HI = (const unsigned char*)(ws + O_H8HI); const unsigned char* H8LO = (const unsigned char*)(ws + O_H8LO);
    char* hbuf = smem + w * 4096;
    const int stride = gridDim.x * 8;
    int row = blockIdx.x * 8 + w;
    if (row >= NTOK) return;
    const int offA = cL, offD = 4 * gq + (cL & 3);
#define P8A_META(EA, ED, GD, ROW, BLK) { const size_t mo_ = (size_t)(ROW) * 128 + 16 * (BLK); EA = EIDX[mo_ + offA]; ED = EIDX[mo_ + offD]; GD = GATE[mo_ + offD]; }
    int eA1, eD0, eD1, eA2, eD2; float gD0, gD1, gD2;
    { int eA0; P8A_META(eA0, eD0, gD0, row, 0) P8A_META(eA1, eD1, gD1, row, 1)
      const u32x4n hA = *(const u32x4n*)(H8HI + (size_t)row * 1024 + 16 * lane), hB = *(const u32x4n*)(H8LO + (size_t)row * 1024 + 16 * lane);
      *(u32x4n*)(hbuf + 16 * lane) = hA; *(u32x4n*)(hbuf + 1024 + 16 * lane) = hB;
      P8aRows R0, R1;
      p8a_load(R0, U8, eA0, gq);
      int par = 0;
      for (; row < NTOK; row += stride) {
        const int nrow = row + stride;
        const int prow = nrow < NTOK ? nrow : row;
        const u32x4n nhA = *(const u32x4n*)(H8HI + (size_t)prow * 1024 + 16 * lane), nhB = *(const u32x4n*)(H8LO + (size_t)prow * 1024 + 16 * lane);
        const char* hb = hbuf + par * 2048;
        unsigned* dst = ACT + (size_t)row * 128;
#define P8A_STEP(RC, RN, B, MROW, MBLK) \
        p8a_load(RN, U8, eA1, gq); P8A_META(eA2, eD2, gD2, MROW, MBLK) \
        p8a_compute(RC, hb, gq, cL, eD0, gD0, dst + 16 * (B)); \
        eD0 = eD1; gD0 = gD1; eA1 = eA2; eD1 = eD2; gD1 = gD2;
        P8A_STEP(R0, R1, 0, row, 2)
        P8A_STEP(R1, R0, 1, row, 3)
        P8A_STEP(R0, R1, 2, row, 4)
        P8A_STEP(R1, R0, 3, row, 5)
        P8A_STEP(R0, R1, 4, row, 6)
        P8A_STEP(R1, R0, 5, row, 7)
        *(u32x4n*)(hbuf + (par ^ 1) * 2048 + 16 * lane) = nhA; *(u32x4n*)(hbuf + (par ^ 1) * 2048 + 1024 + 16 * lane) = nhB;
        P8A_STEP(R0, R1, 6, prow, 0)
        P8A_STEP(R1, R0, 7, prow, 1)
        par ^= 1;
      }
    }
}
struct P8bRows { u32x4n v[8]; };
struct P8bMeta { u32x4n m[4]; };
__device__ __forceinline__ void p8b_meta(P8bMeta& M, const unsigned* ACT, int row, int e8) {
#pragma unroll
    for (int k = 0; k < 4; ++k) M.m[k] = *(const u32x4n*)(ACT + (size_t)row * 128 + e8 * 16 + 4 * k);
}
template <int HALF> __device__ __forceinline__ void p8b_load(P8bRows& R, const P8bMeta& M, const unsigned char* V8) {
#pragma unroll
    for (int k = 0; k < 2; ++k) {
        const u32x4n mm = M.m[2 * HALF + k];
        R.v[4 * k + 0] = *(const u32x4n*)(V8 + (size_t)(mm.x & 0xFFFFu) * 128); R.v[4 * k + 1] = *(const u32x4n*)(V8 + (size_t)(mm.y & 0xFFFFu) * 128);
        R.v[4 * k + 2] = *(const u32x4n*)(V8 + (size_t)(mm.z & 0xFFFFu) * 128); R.v[4 * k + 3] = *(const u32x4n*)(V8 + (size_t)(mm.w & 0xFFFFu) * 128);
    }
}
template <int HALF> __device__ __forceinline__ void p8b_accum(f32x2 (&acc)[8], const P8bRows& R, const P8bMeta& M) {
#pragma unroll
    for (int k = 0; k < 2; ++k) {
        const u32x4n mm = M.m[2 * HALF + k];
        const unsigned mw[4] = {mm.x, mm.y, mm.z, mm.w};
#pragma unroll
        for (int q = 0; q < 4; ++q) {
            const float a1 = __uint_as_float(mw[q] & 0xFFFF0000u);
            const f32x2 av = (f32x2){a1, a1};
            const u32x4n x = R.v[4 * k + q];
            acc[0] += av * __builtin_amdgcn_cvt_pk_f32_fp8((int)x.x, false); acc[1] += av * __builtin_amdgcn_cvt_pk_f32_fp8((int)x.x, true);
            acc[2] += av * __builtin_amdgcn_cvt_pk_f32_fp8((int)x.y, false); acc[3] += av * __builtin_amdgcn_cvt_pk_f32_fp8((int)x.y, true);
            acc[4] += av * __builtin_amdgcn_cvt_pk_f32_fp8((int)x.z, false); acc[5] += av * __builtin_amdgcn_cvt_pk_f32_fp8((int)x.z, true);
            acc[6] += av * __builtin_amdgcn_cvt_pk_f32_fp8((int)x.w, false); acc[7] += av * __builtin_amdgcn_cvt_pk_f32_fp8((int)x.w, true);
        }
    }
}
__device__ __forceinline__ void p8b_store(const f32x2 (&acc)[8], float* hr, int e8) {
    float r[16];
#pragma unroll
    for (int j = 0; j < 8; ++j) { r[2 * j] = acc[j].x; r[2 * j + 1] = acc[j].y; }
#pragma unroll
    for (int j = 0; j < 16; ++j) { r[j] += dpp_f<0x128, 0xF, true>(r[j]); r[j] = sum_x32(sum_x16(r[j])); }
    if (e8 == 0) {
#pragma unroll
        for (int j = 0; j < 4; ++j) {
            const float4 h0 = *(const float4*)(hr + 4 * j);
            *(float4*)(hr + 4 * j) = make_float4(ALPHA * h0.x + r[4 * j], ALPHA * h0.y + r[4 * j + 1], ALPHA * h0.z + r[4 * j + 2], ALPHA * h0.w + r[4 * j + 3]);
        }
    }
}
__device__ __forceinline__ void phase8b(const Params& p, const XcdMap xm, float* outp) {
    const int lane = tid_op() & 63, w = tid_op() >> 6, e8 = lane >> 3, c8 = lane & 7;
    char* ws = p.ws;
    const unsigned char* V8 = (const unsigned char*)(ws + O_V8) + (size_t)xm.slice * 16384 * 128 + 16 * c8;
    const unsigned* ACT = (const unsigned*)(ws + O_ACT);
    const int stride = xm.nloc * 8;
    int row = xm.rank * 8 + w;
    if (row >= NTOK) return;
    float* const hbase = outp + xm.slice * 128 + 16 * c8;
    P8bMeta Mc, Mn; P8bRows Ra, Rb;
    p8b_meta(Mc, ACT, row, e8);
    p8b_meta(Mn, ACT, (row + stride < NTOK) ? row + stride : row, e8);
    p8b_load<0>(Ra, Mc, V8);
    for (; row < NTOK; row += stride) {
        f32x2 acc[8];
#pragma unroll
        for (int j = 0; j < 8; ++j) acc[j] = (f32x2){0.f, 0.f};
        p8b_load<1>(Rb, Mc, V8);
        p8b_accum<0>(acc, Ra, Mc);
        p8b_load<0>(Ra, Mn, V8);
        p8b_accum<1>(acc, Rb, Mc);
        p8b_store(acc, hbase + (size_t)row * 1024, e8);
        Mc = Mn;
        const int r2 = row + 2 * stride;
        p8b_meta(Mn, ACT, r2 < NTOK ? r2 : row, e8);
    }
}
__device__ __forceinline__ void phase8c(const Params& p) {
    const int lane = tid_op() & 63, w = tid_op() >> 6;
    for (int row = blockIdx.x * 8 + w; row < NTOK; row += gridDim.x * 8) {
        float* yr = p.out + (size_t)row * 1024;
        float4 v[4]; float s = 0.f;
#pragma unroll
        for (int j = 0; j < 4; ++j) { v[j] = *(const float4*)(yr + 4 * lane + 256 * j); s += v[j].x + v[j].y + v[j].z + v[j].w; }
        const float mean = wave_sum(s) * (1.f / 1024.f);
        float q = 0.f;
#pragma unroll
        for (int j = 0; j < 4; ++j) { const float a = v[j].x - mean, b2 = v[j].y - mean, c2 = v[j].z - mean, d = v[j].w - mean; q += a * a + b2 * b2 + c2 * c2 + d * d; }
        const float rstd = rsqrtf(wave_sum(q) * (1.f / 1024.f) + LN_EPS);
#pragma unroll
        for (int j = 0; j < 4; ++j) {
            const int col = 4 * lane + 256 * j;
            const float4 gg = *(const float4*)(p.ln2_g + col), bb = *(const float4*)(p.ln2_b + col);
            float4 o;
            o.x = (v[j].x - mean) * rstd * gg.x + bb.x; o.y = (v[j].y - mean) * rstd * gg.y + bb.y; o.z = (v[j].z - mean) * rstd * gg.z + bb.z; o.w = (v[j].w - mean) * rstd * gg.w + bb.w;
            *(float4*)(yr + col) = o;
        }
    }
}

typedef const __attribute__((address_space(4))) Params* ParamsK;
__device__ __forceinline__ Params params_reload() {
#if defined(__HIP_DEVICE_COMPILE__)
    auto ka = __builtin_amdgcn_kernarg_segment_ptr();
    asm volatile("" : "+s"(ka));
    Params r; __builtin_memcpy(&r, (const __attribute__((address_space(4))) void*)ka, sizeof(Params));
    return r;
#else
    return Params{};
#endif
}
#if ONE_LAUNCH
__global__ void __launch_bounds__(512, 2) fwd_megakernel(Params p) {
    __shared__ __attribute__((aligned(16))) char smem[SMEM_BYTES];
    cg::grid_group grid = cg::this_grid();
    volatile LAS unsigned* st = (volatile LAS unsigned*)(smem + SMEM_BYTES - 16);
    if (threadIdx.x == 0) { st[0] = 0u; st[1] = 0u; st[2] = 0u; st[3] = 0u; }
    __syncthreads();
    const XcdBarrier xb = xcd_barrier_post((unsigned*)(p.ws + O_BAR), st);
#define GRID_BAR() do { if (p.use_cg) grid.sync(); else xcd_barrier(xb); } while (0)
#ifndef DUP
#define DUP -1
#endif
#define PP (params_reload())
#define RUNPH(k, call) { int n_ = (DUP == k) ? 2 : 1; asm volatile("" : "+s"(n_)); _Pragma("unroll 1") for (int i_ = 0; i_ < n_; ++i_) { call; GRID_BAR(); } }
    RUNPH(0, phase0(PP))
    XcdMap xm;
    if (st[2]) { xm.slice = (int)xb.x; xm.rank = (int)st[3]; xm.nloc = (int)st[0]; }
    else { xm.slice = blockIdx.x & 7; xm.rank = blockIdx.x >> 3; xm.nloc = gridDim.x >> 3; }
    xm.slice = __builtin_amdgcn_readfirstlane(xm.slice); xm.rank = __builtin_amdgcn_readfirstlane(xm.rank); xm.nloc = __builtin_amdgcn_readfirstlane(xm.nloc);
    RUNPH(1, phase1(PP, smem, xm))
    RUNPH(2, phase2(PP, smem))
    if (DUP == 20) { int wh_ = 1; asm volatile("" : "+s"(wh_)); phase2(PP, smem, wh_); GRID_BAR(); }
    if (DUP == 21) { int wh_ = 2; asm volatile("" : "+s"(wh_)); phase2(PP, smem, wh_); GRID_BAR(); }
    phase2c(PP); GRID_BAR();
    RUNPH(3, phase3(PP, smem))
    if (DUP == 30) { int wh_ = 1; asm volatile("" : "+s"(wh_)); phase3(PP, smem, wh_); GRID_BAR(); }
    if (DUP == 31) { int wh_ = 2; asm volatile("" : "+s"(wh_)); phase3(PP, smem, wh_); GRID_BAR(); }
    RUNPH(4, phase4(PP, smem, xm))
    phase5(PP); GRID_BAR();
    RUNPH(6, phase6(PP, smem, xm))
    RUNPH(7, phase7(PP))
#ifdef SCRAMBLE
    { const int x_ = xm.slice, r_ = xm.rank; xm.slice = (x_ + r_) & 7; xm.rank = (r_ >> 3) * 8 + x_; xm.nloc = 32; }
#endif
    RUNPH(8, phase8a(PP, xm, smem))
    if (DUP == 9) { phase8b(PP, xm, (float*)(PP.ws + O_QP)); GRID_BAR(); }
    phase8b(PP, xm, PP.out); GRID_BAR();
    phase8c(PP);
}
#else
__global__ void __launch_bounds__(512, 2) k_phase0(Params p) { phase0(p); }
__global__ void __launch_bounds__(512, 2) k_phase1(Params p) { __shared__ __attribute__((aligned(16))) char smem[SMEM_BYTES]; XcdMap xm; xm.slice = blockIdx.x & 7; xm.rank = blockIdx.x >> 3; xm.nloc = gridDim.x >> 3; phase1(p, smem, xm); }
__global__ void __launch_bounds__(512, 2) k_phase2(Params p) { __shared__ __attribute__((aligned(16))) char smem[SMEM_BYTES]; phase2(p, smem); }
__global__ void __launch_bounds__(512, 2) k_phase2c(Params p) { phase2c(p); }
__global__ void __launch_bounds__(512, 2) k_phase3(Params p) { __shared__ __attribute__((aligned(16))) char smem[SMEM_BYTES]; phase3(p, smem); }
__global__ void __launch_bounds__(512, 2) k_phase4(Params p) { __shared__ __attribute__((aligned(16))) char smem[SMEM_BYTES]; XcdMap xm; xm.slice = blockIdx.x & 7; xm.rank = blockIdx.x >> 3; xm.nloc = gridDim.x >> 3; phase4(p, smem, xm); }
__global__ void __launch_bounds__(512, 2) k_phase5(Params p) { phase5(p); }
__global__ void __launch_bounds__(512, 2) k_phase6(Params p) { __shared__ __attribute__((aligned(16))) char smem[SMEM_BYTES]; XcdMap xm; xm.slice = blockIdx.x & 7; xm.rank = blockIdx.x >> 3; xm.nloc = gridDim.x >> 3; phase6(p, smem, xm); }
__global__ void __launch_bounds__(512, 2) k_phase7(Params p) { phase7(p); }
__global__ void __launch_bounds__(512, 2) k_phase8a(Params p) { __shared__ __attribute__((aligned(16))) char smem_[SMEM_BYTES]; XcdMap xm; xm.slice = blockIdx.x & 7; xm.rank = blockIdx.x >> 3; xm.nloc = gridDim.x >> 3; phase8a(p, xm, smem_); }
__global__ void __launch_bounds__(512, 2) k_phase8b(Params p) { XcdMap xm; xm.slice = blockIdx.x & 7; xm.rank = blockIdx.x >> 3; xm.nloc = gridDim.x >> 3; phase8b(p, xm, p.out); }
__global__ void __launch_bounds__(512, 2) k_phase8c(Params p) { phase8c(p); }
#endif

extern "C" void kernel_launch(void* const* d_in, const int* in_sizes, int n_in, void* d_out, int out_size, void* d_ws, size_t ws_size, hipStream_t stream) {
    Params p{};
    p.x = (const float*)d_in[0]; p.pos = (const int*)d_in[1]; p.w_in = (const float*)d_in[2]; p.conv_w = (const float*)d_in[3]; p.conv_b = (const float*)d_in[4];
    p.dt_bias = (const float*)d_in[5]; p.a_log = (const float*)d_in[6]; p.d_skip = (const float*)d_in[7]; p.norm_w = (const float*)d_in[8]; p.w_out = (const float*)d_in[9];
    p.ln1_g = (const float*)d_in[10]; p.ln1_b = (const float*)d_in[11]; p.wq = (const float*)d_in[12]; p.k1 = (const float*)d_in[13]; p.k2 = (const float*)d_in[14];
    p.u = (const float*)d_in[15]; p.v = (const float*)d_in[16]; p.ln2_g = (const float*)d_in[17]; p.ln2_b = (const float*)d_in[18];
    p.out = (float*)d_out; p.ws = (char*)d_ws;
    if (ws_size < WS_NEEDED) { fprintf(stderr, "kernel_launch: workspace too small (%zu < %zu)\n", ws_size, (size_t)WS_NEEDED); return; }
#if ONE_LAUNCH
    static int grid_blocks = 0;
    if (!grid_blocks) {
        int dev = 0, cus = 0, per_cu = 0;
        hipGetDevice(&dev);
        hipDeviceGetAttribute(&cus, hipDeviceAttributeMultiprocessorCount, dev);
        hipOccupancyMaxActiveBlocksPerMultiprocessor(&per_cu, fwd_megakernel, 512, 0);
        if (per_cu > 1) per_cu = 1;
        if (per_cu < 1) per_cu = 1;
        grid_blocks = cus * per_cu;
    }
    (void)hipMemsetAsync((char*)d_ws + O_BAR, 0, XCD_BAR_WORDS * 4, stream);
    void* args[] = {&p};
    hipError_t e = hipLaunchCooperativeKernel((void*)fwd_megakernel, dim3(grid_blocks), dim3(512), args, 0, stream);
    if (e != hipSuccess) fprintf(stderr, "cooperative launch failed: %s (grid %d)\n", hipGetErrorString(e), grid_blocks);
#else
    const int G = 512;
    k_phase0<<<G, 512, 0, stream>>>(p);
    k_phase1<<<G, 512, 0, stream>>>(p);
    k_phase2<<<G, 512, 0, stream>>>(p);
    k_phase2c<<<G, 512, 0, stream>>>(p);
    k_phase3<<<G, 512, 0, stream>>>(p);
    k_phase4<<<G, 512, 0, stream>>>(p);
    k_phase5<<<G, 512, 0, stream>>>(p);
    k_phase6<<<G, 512, 0, stream>>>(p);
    k_phase7<<<G, 512, 0, stream>>>(p);
    k_phase8a<<<G, 512, 0, stream>>>(p);
    k_phase8b<<<G, 512, 0, stream>>>(p);
    k_phase8c<<<G, 512, 0, stream>>>(p);
#endif
}
```

```cpp
#include <hip/hip_runtime.h>
#include <hip/hip_cooperative_groups.h>
#include <stdint.h>
#include <stdio.h>
namespace cg = cooperative_groups;

typedef unsigned short bf16_t;
typedef short bf16x8 __attribute__((ext_vector_type(8)));
typedef short bf16x4 __attribute__((ext_vector_type(4)));
typedef float f32x4 __attribute__((ext_vector_type(4)));
typedef float f32x2 __attribute__((ext_vector_type(2)));

#ifndef ONE_LAUNCH
#define ONE_LAUNCH 1
#endif

constexpr int NB = 8, SEQ = 2048, DM = 1024, NTOK = NB * SEQ;
constexpr int NP = 3584;
constexpr int QOFF = 0, KOFF = 512, VOFF = 1024, IQOFF = 1536, MISCOFF = 1792, ZOFF = 1856, XBCOFF = 2368, NUSED = 3392;
constexpr float ALPHA = 1.189207115002721f;
constexpr float LN_EPS = 1e-5f;

constexpr size_t MB = 1024 * 1024;
constexpr size_t O_WIN_T = 0;
constexpr size_t O_WOUT_T = O_WIN_T + (size_t)NP * 1024 * 2;
constexpr size_t O_WQ_T = O_WOUT_T + 2 * MB;
constexpr size_t O_K1B = O_WQ_T + 4 * MB;
constexpr size_t O_K2B = O_K1B + 32768;
constexpr size_t O_CS64 = O_K2B + 32768;
constexpr size_t O_CS32 = O_CS64 + 4 * MB;
constexpr size_t O_BAR = O_CS32 + 2 * MB;
constexpr size_t O_MIX = O_BAR + 65536;
constexpr size_t O_R1 = O_MIX + 32 * MB;
constexpr size_t O_XB = O_R1;
constexpr size_t O_XT = O_R1;
constexpr size_t O_BRM = O_XT + 16 * MB;
constexpr size_t O_CRM = O_BRM + 8 * MB;
constexpr size_t O_QB = O_XB + 32 * MB;
constexpr size_t O_KB = O_QB + 16 * MB;
constexpr size_t O_VT = O_KB + 16 * MB;
constexpr size_t O_IQB = O_VT + 16 * MB;
constexpr size_t O_IKB = O_IQB + 8 * MB;
constexpr size_t O_IWF = O_IKB + 1 * MB;
constexpr size_t O_DTF = O_IWF + MB / 2;
constexpr size_t O_ZB = O_DTF + MB / 2;
constexpr size_t O_XBCT = O_ZB + 16 * MB;
constexpr size_t O_CAR = O_XBCT;
constexpr size_t O_ACUM = O_XBCT + 32 * MB;
constexpr size_t O_ATOT = O_ACUM + MB / 2;
constexpr size_t O_ST = O_ATOT + MB / 2;
constexpr size_t O_MASK = O_ST + 32 * MB;
constexpr size_t O_R1_END = O_MASK + 4 * MB;
constexpr size_t O_HB = O_R1;
constexpr size_t O_QP = O_HB + 32 * MB;
constexpr size_t O_EIDX = O_QP + 64 * MB;
constexpr size_t O_GATE = O_EIDX + 8 * MB;
constexpr size_t O_U8 = O_GATE + 8 * MB;
constexpr size_t O_V8 = O_U8 + 16 * MB;
constexpr size_t O_ACT = O_V8 + 16 * MB;
constexpr size_t O_H8HI = O_ACT + 8 * MB;
constexpr size_t O_H8LO = O_H8HI + 16 * MB;
constexpr size_t O_R2_END = O_H8LO + 16 * MB;
constexpr size_t WS_NEEDED = (O_R1_END > O_R2_END ? O_R1_END : O_R2_END);
static_assert(WS_NEEDED <= 256 * MB, "workspace too large");
static_assert(O_R2_END <= O_R1_END + 64 * MB, "region 2 too large");

struct Params {
    const float* x; const int* pos; const float* w_in; const float* conv_w; const float* conv_b; const float* dt_bias;
    const float* a_log; const float* d_skip; const float* norm_w; const float* w_out; const float* ln1_g; const float* ln1_b;
    const float* wq; const float* k1; const float* k2; const float* u; const float* v; const float* ln2_g; const float* ln2_b;
    float* out; char* ws; int use_cg; int pad_;
};

#define SMEM_BYTES 133120

__device__ __forceinline__ int tid_op() { int t = threadIdx.x; asm volatile("" : "+v"(t)); return t; }
__device__ __forceinline__ bf16_t f2bf(float f) {
    unsigned u = __float_as_uint(f);
    u += 0x7FFFu + ((u >> 16) & 1u);
    return (bf16_t)(u >> 16);
}
__device__ __forceinline__ float bf2f(bf16_t b) { return __uint_as_float(((unsigned)b) << 16); }
__device__ __forceinline__ unsigned pack2(float a, float b) { return (unsigned)f2bf(a) | ((unsigned)f2bf(b) << 16); }
__device__ __forceinline__ unsigned f2sort(float f) { unsigned u = __float_as_uint(f); return (u & 0x80000000u) ? ~u : (u | 0x80000000u); }
__device__ __forceinline__ float sort2f(unsigned s) { unsigned u = (s & 0x80000000u) ? (s & 0x7FFFFFFFu) : ~s; return __uint_as_float(u); }
__device__ __forceinline__ f32x4 mfma16(bf16x8 a, bf16x8 b, f32x4 c) { return __builtin_amdgcn_mfma_f32_16x16x32_bf16(a, b, c, 0, 0, 0); }
__device__ __forceinline__ float silu_f(float v) { return v / (1.f + __expf(-v)); }
__device__ __forceinline__ bf16x8 ld8(const bf16_t* p) { return *(const bf16x8*)p; }
__device__ __forceinline__ bf16x8 cat4(bf16x4 lo, bf16x4 hi) { return __builtin_shufflevector(lo, hi, 0, 1, 2, 3, 4, 5, 6, 7); }


template <int CTRL, int ROWMASK, bool BC> __device__ __forceinline__ int dpp_i(int v) { return __builtin_amdgcn_update_dpp(0, v, CTRL, ROWMASK, 0xF, BC); }
template <int CTRL, int ROWMASK, bool BC> __device__ __forceinline__ float dpp_f(float v) { return __builtin_bit_cast(float, __builtin_amdgcn_update_dpp(0, __builtin_bit_cast(int, v), CTRL, ROWMASK, 0xF, BC)); }
__device__ __forceinline__ float row_sum(float v) { v += dpp_f<0xB1, 0xF, true>(v); v += dpp_f<0x4E, 0xF, true>(v); v += dpp_f<0x141, 0xF, true>(v); v += dpp_f<0x140, 0xF, true>(v); return v; }
__device__ __forceinline__ unsigned row_sum_u(unsigned v) { v += (unsigned)dpp_i<0xB1, 0xF, true>((int)v); v += (unsigned)dpp_i<0x4E, 0xF, true>((int)v); v += (unsigned)dpp_i<0x141, 0xF, true>((int)v); v += (unsigned)dpp_i<0x140, 0xF, true>((int)v); return v; }
__device__ __forceinline__ unsigned row_max_u(unsigned v) {
    v = max(v, (unsigned)dpp_i<0xB1, 0xF, true>((int)v)); v = max(v, (unsigned)dpp_i<0x4E, 0xF, true>((int)v));
    v = max(v, (unsigned)dpp_i<0x141, 0xF, true>((int)v)); v = max(v, (unsigned)dpp_i<0x140, 0xF, true>((int)v)); return v;
}
__device__ __forceinline__ float wave_sum_u(float v) {
    v = row_sum(v);
    v += dpp_f<0x142, 0xA, false>(v);
    v += dpp_f<0x143, 0xC, false>(v);
    return __builtin_bit_cast(float, __builtin_amdgcn_readlane(__builtin_bit_cast(int, v), 63));
}
typedef unsigned u32x2_t __attribute__((ext_vector_type(2)));
__device__ __forceinline__ float sum_x16(float v) { const u32x2_t r = __builtin_amdgcn_permlane16_swap(__float_as_uint(v), __float_as_uint(v), false, false); return __uint_as_float(r.x) + __uint_as_float(r.y); }
__device__ __forceinline__ float sum_x32(float v) { const u32x2_t r = __builtin_amdgcn_permlane32_swap(__float_as_uint(v), __float_as_uint(v), false, false); return __uint_as_float(r.x) + __uint_as_float(r.y); }
__device__ __forceinline__ float max_x16(float v) { const u32x2_t r = __builtin_amdgcn_permlane16_swap(__float_as_uint(v), __float_as_uint(v), false, false); return fmaxf(__uint_as_float(r.x), __uint_as_float(r.y)); }
__device__ __forceinline__ float max_x32(float v) { const u32x2_t r = __builtin_amdgcn_permlane32_swap(__float_as_uint(v), __float_as_uint(v), false, false); return fmaxf(__uint_as_float(r.x), __uint_as_float(r.y)); }
__device__ __forceinline__ float wave_sum(float v) { return sum_x32(sum_x16(row_sum(v))); }

#define XB_TMO      128
#define XB_XCNT(j)  (256  + 64 * (j))
#define XB_XSUB(j)  (1280 + 64 * (j))
#define XB_XGEN(j)  (2304 + 64 * (j))
#define XB_TOP      3328
#define XB_TOPGEN   3392
#define XCD_BAR_WORDS 3456
#define XB_SPIN_CAP (1u << 22)
#define LAS __attribute__((address_space(3)))
__device__ __forceinline__ unsigned xb_ld(unsigned* p)              { return __hip_atomic_load(p, __ATOMIC_RELAXED, __HIP_MEMORY_SCOPE_AGENT); }
__device__ __forceinline__ unsigned xb_add(unsigned* p, unsigned v) { return __hip_atomic_fetch_add(p, v, __ATOMIC_RELAXED, __HIP_MEMORY_SCOPE_AGENT); }
__device__ __forceinline__ unsigned xb_xcc_id() { return (unsigned)__builtin_amdgcn_s_getreg((3 << 11) | 20) & 0xFu; }
#define XB_SPIN(cond, bar) do { unsigned _sp = 0; while (cond) { __builtin_amdgcn_s_sleep(1); \
    if ((++_sp & 255u) == 0u) { if (xb_ld(&(bar)[XB_TMO])) break; if (_sp > XB_SPIN_CAP) { atomicAdd(&(bar)[XB_TMO], 1u); break; } } } } while (0)
struct XcdBarrier { unsigned* bar; unsigned x; volatile LAS unsigned* st; };
__device__ __forceinline__ XcdBarrier xcd_barrier_post(unsigned* bar, volatile LAS unsigned* st) {
    XcdBarrier b; b.bar = bar; b.x = xb_xcc_id(); b.st = st;
    if (threadIdx.x == 0) st[3] = xb_add(&bar[XB_XCNT(b.x)], 1u);
    return b;
}
__device__ __forceinline__ void xcd_barrier_complete(unsigned* bar, unsigned x, unsigned& nloc, unsigned& nx, unsigned& low8) {
    const unsigned G = gridDim.x * gridDim.y * gridDim.z;
    unsigned sum, cnt, mine, lo, sp = 0u;
    for (;;) {
        sum = 0u; cnt = 0u; mine = 0u; lo = 0u;
#pragma unroll
        for (unsigned j = 0; j < 16; ++j) { const unsigned c = xb_ld(&bar[XB_XCNT(j)]); sum += c; cnt += (c > 0u) ? 1u : 0u; lo += (j < 8u && c > 0u) ? 1u : 0u; mine = (j == x) ? c : mine; }
        if (sum == G) break;
        __builtin_amdgcn_s_sleep(1);
        if ((++sp & 255u) == 0u) { if (xb_ld(&bar[XB_TMO])) break; if (sp > XB_SPIN_CAP) { atomicAdd(&bar[XB_TMO], 1u); break; } }
    }
    nloc = mine > 0u ? mine : 1u; nx = cnt > 0u ? cnt : 1u; low8 = (lo == 8u && cnt == 8u) ? 1u : 0u;
}
__device__ __forceinline__ void xcd_barrier(const XcdBarrier& b) {
    asm volatile("s_waitcnt vmcnt(0)" ::: "memory");
    __syncthreads();
    if (threadIdx.x == 0) {
        unsigned* bar = b.bar;
        __builtin_amdgcn_s_waitcnt(0);
        unsigned nloc = b.st[0], nx = b.st[1];
        if (nloc == 0u) { unsigned low8; xcd_barrier_complete(bar, b.x, nloc, nx, low8); b.st[0] = nloc; b.st[1] = nx; b.st[2] = low8; }
        const unsigned old = xb_add(&bar[XB_XSUB(b.x)], 1u);
        const unsigned gen = old / nloc;
        if (old + 1u == (gen + 1u) * nloc) {
            __builtin_amdgcn_fence(__ATOMIC_RELEASE, "agent");
            asm volatile("s_waitcnt vmcnt(0)" ::: "memory");
            const unsigned og = xb_add(&bar[XB_TOP], 1u);
            const unsigned tg = og / nx;
            if (og + 1u == (tg + 1u) * nx) xb_add(&bar[XB_TOPGEN], 1u);
            else XB_SPIN(xb_ld(&bar[XB_TOPGEN]) == tg, bar);
            __builtin_amdgcn_fence(__ATOMIC_ACQUIRE, "agent");
            xb_add(&bar[XB_XGEN(b.x)], 1u);
            asm volatile("s_waitcnt vmcnt(0)" ::: "memory");
        } else {
            XB_SPIN(xb_ld(&bar[XB_XGEN(b.x)]) == gen, bar);
            __builtin_amdgcn_fence(__ATOMIC_ACQUIRE, "agent");
            asm volatile("s_waitcnt vmcnt(0)" ::: "memory");
        }
    }
    __syncthreads();
}

__device__ __forceinline__ int rot_perm(int gcol, int H) { const int j = (gcol % H) >> 3, e = gcol & 7; return (gcol / H) * H + 4 * j + (e & 3) + ((e >> 2) ? H / 2 : 0); }
__device__ __forceinline__ int win_src_col(int n) {
    if (n < 1024) return rot_perm(n, 64);
    if (n < 1536) return n;
    if (n < 1824) return 1536 + rot_perm(n - 1536, 32);
    if (n < 1832) return n;
    if (n < 1840) return 3368 + (n - 1832);
    if (n < 1856) return -1;
    if (n < 2368) return 1832 + (n - 1856);
    if (n < 3392) return 2344 + (n - 2368);
    return -1;
}
__device__ __forceinline__ void p0_transpose(const float* __restrict__ W, int N, int Nout, bool remap, bf16_t* __restrict__ Wt, int gtid, int gsz) {
    const int items = Nout * 128;
    for (int it = gtid; it < items; it += gsz) {
        const int n = it % Nout, kc = it / Nout;
        const int src = remap ? win_src_col(n) : n;
        unsigned w[4] = {0, 0, 0, 0};
        if (src >= 0) {
            float f[8];
#pragma unroll
            for (int j = 0; j < 8; ++j) f[j] = W[(size_t)(kc * 8 + j) * N + src];
#pragma unroll
            for (int j = 0; j < 4; ++j) w[j] = pack2(f[2 * j], f[2 * j + 1]);
        }
        *(uint4*)(Wt + (size_t)n * 1024 + kc * 8) = make_uint4(w[0], w[1], w[2], w[3]);
    }
}
__device__ __forceinline__ void p0_convert(const float* __restrict__ src, bf16_t* __restrict__ dst, size_t n4, size_t gtid, size_t gsz) {
    for (size_t i = gtid; i < n4; i += gsz) {
        const float4 f = ((const float4*)src)[i];
        ((uint2*)dst)[i] = make_uint2(pack2(f.x, f.y), pack2(f.z, f.w));
    }
}
__device__ __forceinline__ void phase0(const Params& p) {
    const int gtid = blockIdx.x * blockDim.x + tid_op(), gsz = gridDim.x * blockDim.x;
    p0_transpose(p.w_in, 3376, NP, true, (bf16_t*)(p.ws + O_WIN_T), gtid, gsz);
    p0_transpose(p.w_out, 1024, 1024, false, (bf16_t*)(p.ws + O_WOUT_T), gtid, gsz);
    p0_transpose(p.wq, 2048, 2048, false, (bf16_t*)(p.ws + O_WQ_T), gtid, gsz);
    p0_convert(p.k1, (bf16_t*)(p.ws + O_K1B), 128 * 128 / 4, gtid, gsz);
    p0_convert(p.k2, (bf16_t*)(p.ws + O_K2B), 128 * 128 / 4, gtid, gsz);
    p0_convert(p.x, (bf16_t*)(p.ws + O_XB), (size_t)NTOK * DM / 4, gtid, gsz);
    float2* cs64 = (float2*)(p.ws + O_CS64); float2* cs32 = (float2*)(p.ws + O_CS32);
    for (int it = gtid; it < NTOK * 48; it += gsz) {
        const int m = it / 48, i = it % 48;
        const float ps = (float)p.pos[m];
        if (i < 32) { const float inv = powf(10000.f, -(float)(2 * i) / 64.f); const float a = ps * inv; cs64[m * 32 + i] = make_float2(cosf(a), sinf(a)); }
        else { const int k = i - 32; const float inv = powf(10000.f, -(float)(2 * k) / 32.f); const float a = ps * inv; cs32[m * 16 + k] = make_float2(cosf(a), sinf(a)); }
    }
}

struct XcdMap { int slice, rank, nloc; };
__device__ __forceinline__ bool gemm_next_tile(const XcdMap& xm, int it, int ntn, int& tm, int& tn) {
    const int j = xm.rank + xm.nloc * it;
    if (j >= 8 * ntn) return false;
    tm = 8 * xm.slice + j / ntn; tn = j % ntn; return true;
}
#define GEMM_LDK 80
#define GEMM_LDS_A (256 * GEMM_LDK * 2)
#define GEMM_LDS_STAGE (GEMM_LDS_A + 128 * GEMM_LDK * 2)
typedef unsigned u32x4g __attribute__((ext_vector_type(4)));
struct GemmRegs { u32x4g a0, a1, a2, a3, b0, b1; };
__device__ __forceinline__ void gemm_gload(GemmRegs& r, const bf16_t* ga, const bf16_t* gb, size_t astep) {
    r.a0 = *(const u32x4g*)(ga); r.a1 = *(const u32x4g*)(ga + astep); r.a2 = *(const u32x4g*)(ga + 2 * astep); r.a3 = *(const u32x4g*)(ga + 3 * astep);
    r.b0 = *(const u32x4g*)(gb); r.b1 = *(const u32x4g*)(gb + astep);
}
__device__ __forceinline__ void gemm_lstore(const GemmRegs& r, bf16_t* wa, bf16_t* wb) {
    *(u32x4g*)(wa) = r.a0; *(u32x4g*)(wa + 64 * GEMM_LDK) = r.a1; *(u32x4g*)(wa + 128 * GEMM_LDK) = r.a2; *(u32x4g*)(wa + 192 * GEMM_LDK) = r.a3;
    *(u32x4g*)(wb) = r.b0; *(u32x4g*)(wb + 64 * GEMM_LDK) = r.b1;
}
__device__ __forceinline__ void gemm_compute(f32x4 (&acc)[4][4], const bf16_t* sA, const bf16_t* sB, int wm, int wn, int lane) {
#pragma unroll
    for (int ks = 0; ks < 2; ++ks) {
        bf16x8 a[4], b[4];
#pragma unroll
        for (int i = 0; i < 4; ++i) a[i] = ld8(sA + (wm * 64 + i * 16 + (lane & 15)) * GEMM_LDK + ks * 32 + (lane >> 4) * 8);
#pragma unroll
        for (int i = 0; i < 4; ++i) b[i] = ld8(sB + (wn * 64 + i * 16 + (lane & 15)) * GEMM_LDK + ks * 32 + (lane >> 4) * 8);
#pragma unroll
        for (int i = 0; i < 4; ++i)
#pragma unroll
            for (int j = 0; j < 4; ++j) acc[i][j] = mfma16(a[i], b[j], acc[i][j]);
    }
}
template <class Epi>
__device__ __forceinline__ void gemm_tile(const bf16_t* __restrict__ A, const bf16_t* __restrict__ Bt, int K, int m0, int n0, const Epi& epi, char* smem) {
    const int tid = tid_op(), lane = tid & 63, w = tid >> 6, wm = w >> 1, wn = w & 1;
    f32x4 acc[4][4];
#pragma unroll
    for (int i = 0; i < 4; ++i)
#pragma unroll
        for (int j = 0; j < 4; ++j) acc[i][j] = (f32x4){0.f, 0.f, 0.f, 0.f};
    const int lrow = tid >> 3, lkc = (tid & 7) * 8;
    const bf16_t* ga = A + (size_t)(m0 + lrow) * K + lkc;
    const bf16_t* gb = Bt + (size_t)(n0 + lrow) * K + lkc;
    const size_t astep = (size_t)64 * K;
    bf16_t* sA0 = (bf16_t*)smem; bf16_t* sB0 = (bf16_t*)(smem + GEMM_LDS_A);
    bf16_t* sA1 = (bf16_t*)(smem + GEMM_LDS_STAGE); bf16_t* sB1 = (bf16_t*)(smem + GEMM_LDS_STAGE + GEMM_LDS_A);
    const int woff = lrow * GEMM_LDK + lkc;
    GemmRegs r0, r1;
    gemm_gload(r0, ga, gb, astep);
    gemm_gload(r1, ga + 64, gb + 64, astep);
    __syncthreads();
    gemm_lstore(r0, sA0 + woff, sB0 + woff);
    __syncthreads();
    const int nk = K / 64;
    for (int k = 0; k < nk; k += 2) {
        { const int kk = (k + 2 < nk) ? k + 2 : nk - 1; gemm_gload(r0, ga + kk * 64, gb + kk * 64, astep); }
        gemm_compute(acc, sA0, sB0, wm, wn, lane);
        gemm_lstore(r1, sA1 + woff, sB1 + woff);
        __syncthreads();
        { const int kk = (k + 3 < nk) ? k + 3 : nk - 1; gemm_gload(r1, ga + kk * 64, gb + kk * 64, astep); }
        gemm_compute(acc, sA1, sB1, wm, wn, lane);
        gemm_lstore(r0, sA0 + woff, sB0 + woff);
        __syncthreads();
    }
    epi(acc, m0 + wm * 64, n0 + wn * 64, lane, smem + w * 9216);
}

namespace pg8 {
#define PG8_LAS __attribute__((address_space(3)))
typedef unsigned short bf16_t;
typedef short bf16x8 __attribute__((ext_vector_type(8)));
typedef float f32x4 __attribute__((ext_vector_type(4)));
typedef unsigned u32x4 __attribute__((ext_vector_type(4)));
constexpr int BM = 256, BK = 64, HALF = 128, HTB = HALF * BK * 2  , STAGE_BYTES = 8 * HTB, NXCD = 8, WGM = 8;

__host__ __device__ __forceinline__ int lds_byte(int r, int c) { const int st = (r >> 4) * 2 + (c >> 5), rr = r & 15, cc = c & 31, ob = rr * 64 + cc * 2; return st * 1024 + (ob ^ (((ob >> 9) & 1) << 5)); }
__host__ __device__ __forceinline__ void stage_rc(int b, int& R, int& C) { const int st = b / 1024, sb = b % 1024, swz = sb ^ (((sb >> 9) & 1) << 5); R = (st >> 1) * 16 + swz / 64; C = (st & 1) * 32 + (swz % 64) / 2; }
__host__ __device__ __forceinline__ int perm32(int rho) { const int n = rho >> 4, i = rho & 15; return 8 * (i >> 2) + 4 * n + (i & 3); }

struct Unit { int pm, pn; };
struct Gemm { const bf16_t* A; const bf16_t* Bt; int M, N, K; };

struct StaticOrder {
    int nM, nN, nwg, G, c;
    __host__ __device__ void init(int M, int N, int G_, int c_) { nM = M / BM; nN = N / BM; nwg = nM * nN; G = G_; c = c_; }
    __host__ __device__ bool next(int i, Unit& u) const {
        const long L = (long)i * G + c; if (L >= nwg) return false;
        int wgid = (int)L; { const int q = nwg / NXCD, r = nwg % NXCD, xcd = wgid % NXCD, off = wgid / NXCD; wgid = (xcd < r ? xcd * (q + 1) : r * (q + 1) + (xcd - r) * q) + off; }
        const int nig = WGM * nN, gid = wgid / nig, fm = gid * WGM, gsz = (nM - fm) < WGM ? (nM - fm) : WGM;
        u.pm = fm + ((wgid % nig) % gsz); u.pn = (wgid % nig) / gsz; return true;
    }
    __device__ __forceinline__ void a_ready(const Unit&) const {}
    __device__ __forceinline__ void done(const Unit&) const {}
};
__device__ __forceinline__ unsigned cvt_pk_bf16(float lo, float hi) { unsigned r; asm volatile("v_cvt_pk_bf16_f32 %0, %1, %2" : "=v"(r) : "v"(lo), "v"(hi)); return r; }

struct EpiBf16Plain {
    static constexpr bool PERM = true, AFTER_DRAIN = false;
    bf16_t* O; int ldc;
    __device__ __forceinline__ void operator()(const f32x4 (&acc)[2][2][4][2], const Unit& u, int wr, int wc, int fr, int fq) const {
        const int row0 = u.pm * BM + wr * 64 + fr, col0 = u.pn * BM + wc * 32 + 8 * fq;
#pragma unroll
        for (int ai = 0; ai < 2; ++ai)
#pragma unroll
            for (int m = 0; m < 4; ++m) { bf16_t* rowp = O + (size_t)(row0 + ai * HALF + m * 16) * ldc + col0;
#pragma unroll
                for (int bj = 0; bj < 2; ++bj) { const f32x4 v0 = acc[ai][bj][m][0], v1 = acc[ai][bj][m][1];
                    u32x4 w; w.x = cvt_pk_bf16(v0[0], v0[1]); w.y = cvt_pk_bf16(v0[2], v0[3]); w.z = cvt_pk_bf16(v1[0], v1[1]); w.w = cvt_pk_bf16(v1[2], v1[3]);
                    *(u32x4*)(rowp + bj * HALF) = w; } }
    }
};
struct EpiResF32 {
    static constexpr bool PERM = false, AFTER_DRAIN = false;
    float* Y; const float* X; int ldc; float alpha;
    __device__ __forceinline__ void operator()(const f32x4 (&acc)[2][2][4][2], const Unit& u, int wr, int wc, int fr, int fq) const {
        const int row0 = u.pm * BM + wr * 64 + fr, col0 = u.pn * BM + wc * 32 + 4 * fq;
#pragma unroll
        for (int ai = 0; ai < 2; ++ai)
#pragma unroll
            for (int m = 0; m < 4; ++m) { const size_t ro = (size_t)(row0 + ai * HALF + m * 16) * ldc + col0;
#pragma unroll
                for (int bj = 0; bj < 2; ++bj)
#pragma unroll
                    for (int n = 0; n < 2; ++n) { const f32x4 xv = *(const f32x4*)(X + ro + bj * HALF + n * 16); *(f32x4*)(Y + ro + bj * HALF + n * 16) = xv * alpha + acc[ai][bj][m][n]; } }
    }
};
template <class Epi, class Sched, bool STAMP = false>
__device__ __forceinline__ void gemm_phase(PG8_LAS unsigned char* lds, const Gemm g, const Sched& S, const Epi& E, unsigned long long* stamps) {
    const int tid = tid_op(), wid = __builtin_amdgcn_readfirstlane(tid >> 6), lane = tid & 63, wr = wid >> 2, wc = wid & 3, fr = lane & 15, fq = lane >> 4;
    const int K = g.K, nt = K / BK;
    int ts_lo = 0, ts_hi = 0, nts = 0; const unsigned long long rt_entry = STAMP ? (unsigned long long)wall_clock64() : 0ull;
#define PG8_STAMP() do { if (STAMP && wid == 0 && nts < 64) { const unsigned long long _c = (unsigned long long)clock64(); \
        ts_lo = (lane == nts) ? (int)(unsigned)_c : ts_lo; ts_hi = (lane == nts) ? (int)(unsigned)(_c >> 32) : ts_hi; ++nts; } } while (0)
    PG8_STAMP();
    unsigned voffA[2], voffB[2];
#pragma unroll
    for (int i = 0; i < 2; ++i) { int R, C; stage_rc(tid * 16 + i * 8192, R, C); const int Rb = Epi::PERM ? ((R & ~31) + perm32(R & 31)) : R;
        voffA[i] = (unsigned)(R * K + C) * 2u; voffB[i] = (unsigned)(Rb * K + C) * 2u; }
    const size_t kstep = (size_t)(BK * 2);
    const size_t hstep = (size_t)HALF * K * 2;
    const size_t tstep = 2 * hstep;
    const unsigned ldsw = (unsigned)wid * 1024u;
    const int aoff = lds_byte(wr * 64 + fr, fq * 8), boff = lds_byte(wc * 32 + fr, fq * 8);
#define PG8_SA(b, h) (((b) * 2 + (h)) * HTB)
#define PG8_SB(b, h) ((4 + (b) * 2 + (h)) * HTB)
#define PG8_STAGE(bufoff, gbase, voff) do { _Pragma("unroll") for (int _i = 0; _i < 2; ++_i) \
        __builtin_amdgcn_global_load_lds((const unsigned*)((const char*)(gbase) + (voff)[_i]), (PG8_LAS unsigned*)(lds + (bufoff) + ldsw + _i * 8192), 16, 0, 0); } while (0)
#define PG8_LDA(dst, b, h) do { _Pragma("unroll") for (int m = 0; m < 4; ++m) _Pragma("unroll") for (int k = 0; k < 2; ++k) dst[m][k] = *(const PG8_LAS bf16x8*)(lds + PG8_SA(b, h) + aoff + m * 2048 + k * 1024); } while (0)
#define PG8_LDB(dst, b, h) do { _Pragma("unroll") for (int n = 0; n < 2; ++n) _Pragma("unroll") for (int k = 0; k < 2; ++k) dst[n][k] = *(const PG8_LAS bf16x8*)(lds + PG8_SB(b, h) + boff + n * 2048 + k * 1024); } while (0)
#define PG8_MMA(ai, bj, At, Bt) do { __builtin_amdgcn_s_setprio(1); _Pragma("unroll") for (int m = 0; m < 4; ++m) _Pragma("unroll") for (int n = 0; n < 2; ++n) _Pragma("unroll") for (int k = 0; k < 2; ++k) \
        acc[ai][bj][m][n] = __builtin_amdgcn_mfma_f32_16x16x32_bf16(Bt[n][k], At[m][k], acc[ai][bj][m][n], 0, 0, 0); __builtin_amdgcn_s_setprio(0); } while (0)
#define PG8_WAIT_V(n) asm volatile("s_waitcnt vmcnt(" #n ")" ::: "memory")
#define PG8_WAIT_L(n) asm volatile("s_waitcnt lgkmcnt(" #n ")" ::: "memory")
#define PG8_BAR __builtin_amdgcn_s_barrier()
#define PG8_SCHED __builtin_amdgcn_sched_barrier(0)
    Unit cur, nxt; int ui = 0;
    if (!S.next(0, cur)) return;
    f32x4 acc[2][2][4][2];
#pragma unroll
    for (int a = 0; a < 2; ++a)
#pragma unroll
        for (int b = 0; b < 2; ++b)
#pragma unroll
            for (int m = 0; m < 4; ++m)
#pragma unroll
                for (int n = 0; n < 2; ++n) acc[a][b][m][n] = (f32x4){0.f, 0.f, 0.f, 0.f};
    bf16x8 At[4][2], B0[2][2], B1[2][2];
    const char* cA = (const char*)g.A + (size_t)cur.pm * tstep; const char* cB = (const char*)g.Bt + (size_t)cur.pn * tstep;
    S.a_ready(cur);
    PG8_STAGE(PG8_SB(0, 0), cB, voffB); PG8_STAGE(PG8_SA(0, 0), cA, voffA); PG8_STAGE(PG8_SB(0, 1), cB + hstep, voffB); PG8_STAGE(PG8_SA(0, 1), cA + hstep, voffA);
    if (wr == 1) PG8_BAR;
    PG8_WAIT_V(4); PG8_BAR;
    PG8_STAGE(PG8_SB(1, 0), cB + kstep, voffB); PG8_STAGE(PG8_SA(1, 0), cA + kstep, voffA); PG8_STAGE(PG8_SB(1, 1), cB + hstep + kstep, voffB);
    PG8_WAIT_V(6); PG8_BAR;
    PG8_STAMP();
    for (;;) {
        const bool has_next = S.next(ui + 1, nxt);
        const char* nA = has_next ? (const char*)g.A + (size_t)nxt.pm * tstep : cA; const char* nB = has_next ? (const char*)g.Bt + (size_t)nxt.pn * tstep : cB;
        for (int t = 0; t < nt; t += 2) {
            const bool last = (t == nt - 2);
            const char* a1 = cA + (size_t)(t + 1) * kstep;
            const char* a2 = last ? nA : cA + (size_t)(t + 2) * kstep; const char* b2 = last ? nB : cB + (size_t)(t + 2) * kstep;
            const char* a3 = a2 + kstep; const char* b3 = b2 + kstep;
            if (last && has_next) S.a_ready(nxt);
            PG8_LDB(B0, 0, 0); PG8_SCHED; PG8_LDA(At, 0, 0); PG8_STAGE(PG8_SA(1, 1), a1 + hstep, voffA);
            PG8_WAIT_L(8); PG8_BAR; PG8_WAIT_L(0); PG8_MMA(0, 0, At, B0); PG8_BAR; PG8_SCHED;
            PG8_LDB(B1, 0, 1); PG8_STAGE(PG8_SB(0, 0), b2, voffB);
            PG8_BAR; PG8_WAIT_L(0); PG8_MMA(0, 1, At, B1); PG8_BAR;
            PG8_LDA(At, 0, 1); PG8_STAGE(PG8_SA(0, 0), a2, voffA);
            PG8_BAR; PG8_WAIT_L(0); PG8_MMA(1, 0, At, B0); PG8_BAR; PG8_SCHED;
            PG8_STAGE(PG8_SB(0, 1), b2 + hstep, voffB);
            PG8_WAIT_V(6); PG8_BAR; PG8_MMA(1, 1, At, B1); PG8_BAR;
            PG8_LDB(B0, 1, 0); PG8_SCHED; PG8_LDA(At, 1, 0); PG8_STAGE(PG8_SA(0, 1), a2 + hstep, voffA);
            PG8_WAIT_L(8); PG8_BAR; PG8_WAIT_L(0); PG8_MMA(0, 0, At, B0); PG8_BAR; PG8_SCHED;
            PG8_LDB(B1, 1, 1); PG8_STAGE(PG8_SB(1, 0), b3, voffB);
            PG8_BAR; PG8_WAIT_L(0); PG8_MMA(0, 1, At, B1); PG8_BAR;
            PG8_LDA(At, 1, 1); PG8_STAGE(PG8_SA(1, 0), a3, voffA);
            PG8_BAR; PG8_WAIT_L(0); PG8_MMA(1, 0, At, B0); PG8_BAR; PG8_SCHED;
            PG8_STAGE(PG8_SB(1, 1), b3 + hstep, voffB);
            PG8_WAIT_V(6); PG8_BAR; PG8_MMA(1, 1, At, B1); PG8_BAR;
        }
        PG8_STAMP();
        if constexpr (!Epi::AFTER_DRAIN) { E(acc, cur, wr, wc, fr, fq); S.done(cur); }
        PG8_STAMP();
        if (!has_next) break;
#pragma unroll
        for (int a = 0; a < 2; ++a)
#pragma unroll
            for (int b = 0; b < 2; ++b)
#pragma unroll
                for (int m = 0; m < 4; ++m)
#pragma unroll
                    for (int n = 0; n < 2; ++n) acc[a][b][m][n] = (f32x4){0.f, 0.f, 0.f, 0.f};
        cur = nxt; cA = nA; cB = nB; ++ui;
    }
    PG8_WAIT_V(0);
    if (wr == 0) PG8_BAR;
    PG8_BAR;
    if constexpr (Epi::AFTER_DRAIN) { E.fused(acc, cur, wr, wc, fr, fq, lds, wid, lane); S.done(cur); }
    PG8_STAMP();
    if (STAMP && wid == 0) { stamps[lane] = lane < nts ? (((unsigned long long)(unsigned)ts_hi << 32) | (unsigned)ts_lo) : 0ull;
        if (lane == 62) stamps[62] = rt_entry; if (lane == 63) stamps[63] = (unsigned long long)wall_clock64(); }
#undef PG8_STAMP
#undef PG8_SA
#undef PG8_SB
#undef PG8_STAGE
#undef PG8_LDA
#undef PG8_LDB
#undef PG8_MMA
#undef PG8_WAIT_V
#undef PG8_WAIT_L
#undef PG8_BAR
#undef PG8_SCHED
}
}

struct ProjEpi8 {
    static constexpr bool PERM = true, AFTER_DRAIN = false;
    char* ws; const float* dt_bias;
    __device__ __forceinline__ uint4 rot8(const pg8::f32x4 v0, const pg8::f32x4 v1, const float* tab, float sc) const {
        const float4 c01 = *(const float4*)tab, c23 = *(const float4*)(tab + 4);
        const float o10 = (v0[0] * c01.x - v1[0] * c01.y) * sc, o11 = (v0[1] * c01.z - v1[1] * c01.w) * sc, o12 = (v0[2] * c23.x - v1[2] * c23.y) * sc, o13 = (v0[3] * c23.z - v1[3] * c23.w) * sc;
        const float o20 = (v1[0] * c01.x + v0[0] * c01.y) * sc, o21 = (v1[1] * c01.z + v0[1] * c01.w) * sc, o22 = (v1[2] * c23.x + v0[2] * c23.y) * sc, o23 = (v1[3] * c23.z + v0[3] * c23.w) * sc;
        return make_uint4(pack2(o10, o11), pack2(o12, o13), pack2(o20, o21), pack2(o22, o23));
    }
    template <int SEG> __device__ __forceinline__ void store_row(const pg8::f32x4 v0, const pg8::f32x4 v1, const int cg, const int row) const {
        const int b = row >> 11, t = row & 2047;
        if (SEG == 0) {
            const bool isq = cg < 512; const int head = (cg & 511) >> 6, j = (cg & 63) >> 3;
            bf16_t* dst = (bf16_t*)(ws + (isq ? O_QB : O_KB)) + ((size_t)(b * 8 + head) * 2048 + t) * 64 + 8 * j;
            *(uint4*)dst = rot8(v0, v1, (const float*)(ws + O_CS64) + ((size_t)row * 32 + 4 * j) * 2, isq ? 0.125f * 1.4426950408889634f : 1.f);
        } else if (SEG == 1) {
            bf16_t* dst = (bf16_t*)(ws + O_VT) + ((size_t)(b * 8 + ((cg - 1024) >> 6)) * 64 + (cg & 63)) * 2048 + t;
#pragma unroll
            for (int e = 0; e < 4; ++e) { dst[(size_t)e * 2048] = f2bf(v0[e]); dst[(size_t)(e + 4) * 2048] = f2bf(v1[e]); }
        } else if (SEG == 2) {
            const int j = (cg & 31) >> 3;
            *(uint4*)((bf16_t*)(ws + O_IQB) + ((size_t)row * 8 + ((cg - 1536) >> 5)) * 32 + 8 * j) = rot8(v0, v1, (const float*)(ws + O_CS32) + ((size_t)row * 16 + 4 * j) * 2, 0.17677669529663687f);
        } else if (SEG == 3) {
            if (cg < 1824) {
                const int j = (cg & 31) >> 3;
                *(uint4*)((bf16_t*)(ws + O_IKB) + (size_t)row * 32 + 8 * j) = rot8(v0, v1, (const float*)(ws + O_CS32) + ((size_t)row * 16 + 4 * j) * 2, 1.f);
            } else if (cg == 1824) {
                const float k8 = 0.35355339059327373f; float* d = (float*)(ws + O_IWF) + (size_t)row * 8;
                *(float4*)d = make_float4(v0[0] * k8, v0[1] * k8, v0[2] * k8, v0[3] * k8); *(float4*)(d + 4) = make_float4(v1[0] * k8, v1[1] * k8, v1[2] * k8, v1[3] * k8);
            } else if (cg == 1832) {
                float o[8];
#pragma unroll
                for (int e = 0; e < 4; ++e) { const float a0 = v0[e] + dt_bias[e], a1 = v1[e] + dt_bias[4 + e]; o[e] = (a0 > 20.f) ? a0 : __logf(1.f + __expf(a0)); o[4 + e] = (a1 > 20.f) ? a1 : __logf(1.f + __expf(a1)); }
                float* d = (float*)(ws + O_DTF) + (size_t)row * 8;
                *(float4*)d = make_float4(o[0], o[1], o[2], o[3]); *(float4*)(d + 4) = make_float4(o[4], o[5], o[6], o[7]);
            }
        } else if (SEG == 4) {
            *(uint4*)((bf16_t*)(ws + O_ZB) + (size_t)row * 512 + (cg - ZOFF)) = make_uint4(pack2(v0[0], v0[1]), pack2(v0[2], v0[3]), pack2(v1[0], v1[1]), pack2(v1[2], v1[3]));
        } else {
            bf16_t* dst = (bf16_t*)(ws + O_XBCT) + ((size_t)b * 1024 + (cg - XBCOFF)) * 2048 + t;
#pragma unroll
            for (int e = 0; e < 4; ++e) { dst[(size_t)e * 2048] = f2bf(v0[e]); dst[(size_t)(e + 4) * 2048] = f2bf(v1[e]); }
        }
    }
    template <int SEG, int BJ> __device__ __forceinline__ void rows8(const pg8::f32x4 (&acc)[2][2][4][2], const int cg, const int row0) const {
#pragma unroll
        for (int ai = 0; ai < 2; ++ai)
#pragma unroll
            for (int m = 0; m < 4; ++m) store_row<SEG>(acc[ai][BJ][m][0], acc[ai][BJ][m][1], cg, row0 + ai * 128 + m * 16);
    }
    template <int BJ> __device__ __forceinline__ void half(const pg8::f32x4 (&acc)[2][2][4][2], const pg8::Unit& u, int wr, int wc, int fr, int fq) const {
        const int cw = u.pn * 256 + BJ * 128 + wc * 32;
        const int cg = cw + 8 * fq, row0 = u.pm * 256 + wr * 64 + fr;
        if (cw < 1024) rows8<0, BJ>(acc, cg, row0);
        else if (cw < 1536) rows8<1, BJ>(acc, cg, row0);
        else if (cw < 1792) rows8<2, BJ>(acc, cg, row0);
        else if (cw < 1856) rows8<3, BJ>(acc, cg, row0);
        else if (cw < 2368) rows8<4, BJ>(acc, cg, row0);
        else if (cw < NUSED) rows8<5, BJ>(acc, cg, row0);
    }
    __device__ __forceinline__ void operator()(const pg8::f32x4 (&acc)[2][2][4][2], const pg8::Unit& u, int wr, int wc, int fr, int fq) const {
        half<0>(acc, u, wr, wc, fr, fq); half<1>(acc, u, wr, wc, fr, fq);
    }
};
__device__ __forceinline__ void phase1(const Params& p, char* smem, const XcdMap xm) {
    char* ws = p.ws;
    ProjEpi8 e; e.ws = ws; e.dt_bias = p.dt_bias;
    pg8::Gemm g{(const bf16_t*)(ws + O_XB), (const bf16_t*)(ws + O_WIN_T), NTOK, NP, 1024};
    pg8::StaticOrder S; S.init(NTOK, NP, (int)gridDim.x, (int)blockIdx.x);
    pg8::gemm_phase<ProjEpi8, pg8::StaticOrder, false>((PG8_LAS unsigned char*)smem, g, S, e, nullptr);
}

#define IDX_NT 16
#define IDX_LDS_SCORES (16 * 2048 * 4)
__device__ __forceinline__ unsigned wave_sum_cnt(unsigned v) {
    v = row_sum_u(v);
    v += (unsigned)dpp_i<0x142, 0xA, false>((int)v);
    v += (unsigned)dpp_i<0x143, 0xC, false>((int)v);
    return (unsigned)__builtin_amdgcn_readlane((int)v, 63);
}
template <int NR> __device__ __forceinline__ unsigned idx_count_ge(const unsigned (&k)[NR], unsigned cand) {
    unsigned n = 0u;
#pragma unroll
    for (int i = 0; i < NR; ++i) n += (k[i] >= cand) ? 1u : 0u;
    return wave_sum_cnt(n);
}
template <int NR> __device__ __forceinline__ unsigned long long idx_words(const unsigned (&k)[NR], unsigned K, bool exact, int lane) {
    unsigned long long wd = 0ull;
    if (exact) {
#pragma unroll
        for (int i = 0; i < NR; ++i) { const unsigned long long bal = __ballot(k[i] >= K); if (lane == i) wd = bal; }
    } else {
        unsigned n = 0u;
#pragma unroll
        for (int i = 0; i < NR; ++i) n += (k[i] > K) ? 1u : 0u;
        unsigned rem = 256u - wave_sum_cnt(n);
#pragma unroll 1
        for (int i = 0; i < NR; ++i) {
            unsigned ki = k[0];
#pragma unroll
            for (int j = 1; j < NR; ++j) ki = (j == i) ? k[j] : ki;
            const unsigned long long gt = __ballot(ki > K), eq = __ballot(ki == K);
            unsigned long long take = 0ull, e = eq;
            while (rem > 0u && e) { take |= e & (~e + 1ull); e &= e - 1ull; --rem; }
            if (lane == i) wd = gt | take;
        }
    }
    return wd;
}
template <int NR> __device__ __forceinline__ void idx_select(const unsigned* Sa, unsigned long long* mrow, int lane) {
    unsigned ka[NR], kb[NR];
#pragma unroll
    for (int i = 0; i < NR; ++i) { ka[i] = Sa[64 * i]; kb[i] = Sa[2048 + 64 * i]; }
    unsigned Ka = 0u, Kb = 0u; bool da = false, db = false;
    for (int bit = 31; bit >= 0; --bit) {
        const unsigned ca = Ka | (1u << bit), cb = Kb | (1u << bit);
        const unsigned ta = idx_count_ge<NR>(ka, ca), tb = idx_count_ge<NR>(kb, cb);
        if (!da && ta >= 256u) { Ka = ca; da = (ta == 256u); }
        if (!db && tb >= 256u) { Kb = cb; db = (tb == 256u); }
        if (da && db) break;
    }
    const unsigned long long wa = idx_words<NR>(ka, Ka, da, lane), wb = idx_words<NR>(kb, Kb, db, lane);
    if (lane < NR) { mrow[lane] = wa; mrow[32 + lane] = wb; }
}
__device__ __forceinline__ void indexer_unit(const Params& p, int unit, char* smem) {
    const int tid = tid_op(), lane = tid & 63, w = tid >> 6, c = lane & 15, g = lane >> 4;
    const int b = unit & 7, grp = 127 - (unit >> 3), t0 = grp * 16;
    char* ws = p.ws;
    unsigned long long* mask64 = (unsigned long long*)(ws + O_MASK) + (size_t)(b * 2048 + t0) * 32;
    const int nblk64 = (t0 + 16 + 63) >> 6;
    if (t0 < 256) {
        for (int i = tid; i < 16 * nblk64; i += 512) {
            const int q = i / nblk64, wd = i % nblk64, t = t0 + q, s0 = wd * 64;
            const unsigned long long bits = (t >= s0 + 63) ? ~0ull : (t < s0 ? 0ull : ((1ull << (t - s0 + 1)) - 1ull));
            mask64[q * 32 + wd] = bits;
        }
        return;
    }
    const int ntile = (nblk64 + 1) >> 1;
    const bf16_t* IQb = (const bf16_t*)(ws + O_IQB); const bf16_t* IKb = (const bf16_t*)(ws + O_IKB); const float* IWf = (const float*)(ws + O_IWF);
    unsigned* S = (unsigned*)smem;
    float* siw = (float*)(smem + IDX_LDS_SCORES);
    __syncthreads();
    if (tid < 128) siw[tid] = IWf[(size_t)(b * 2048 + t0) * 8 + tid];
    {
        const int nr = (nblk64 <= 8) ? 8 : (nblk64 <= 16) ? 16 : (nblk64 <= 24) ? 24 : 32, kfrom = 8 * ntile * 16, kto = nr * 64;
        for (int i = tid; i < 16 * (kto - kfrom); i += 512) { const int q = i / (kto - kfrom), k = kfrom + i % (kto - kfrom); S[q * 2048 + k] = 0u; }
    }
    __syncthreads();
    {
        bf16x8 aq[8];
#pragma unroll
        for (int h = 0; h < 8; ++h) aq[h] = ld8(IQb + ((size_t)(b * 2048 + t0 + c) * 8 + h) * 32 + g * 8);
        float wq[4][8];
#pragma unroll
        for (int r = 0; r < 4; ++r)
#pragma unroll
            for (int h = 0; h < 8; ++h) wq[r][h] = siw[(4 * g + r) * 8 + h];
        bf16x8 bk[IDX_NT];
#pragma unroll
        for (int i = 0; i < IDX_NT; ++i) {
            const int ti = (i < ntile) ? (w * ntile + i) : (w * ntile);
            bk[i] = ld8(IKb + (size_t)(b * 2048 + ti * 16 + c) * 32 + g * 8);
        }
#pragma unroll
        for (int i = 0; i < IDX_NT; ++i) {
            if (i < ntile) {
                const int s0 = (w * ntile + i) * 16;
                float sc[4] = {0.f, 0.f, 0.f, 0.f};
#pragma unroll
                for (int h = 0; h < 8; ++h) {
                    const f32x4 o = mfma16(aq[h], bk[i], (f32x4){0.f, 0.f, 0.f, 0.f});
#pragma unroll
                    for (int r = 0; r < 4; ++r) sc[r] += wq[r][h] * fmaxf(o[r], 0.f);
                }
#pragma unroll
                for (int r = 0; r < 4; ++r) S[(4 * g + r) * 2048 + s0 + c] = (s0 + c <= t0 + 4 * g + r) ? f2sort(sc[r]) : 0u;
            }
        }
    }
    __syncthreads();
    if (nblk64 <= 8) idx_select<8>(S + (2 * w) * 2048 + lane, mask64 + (2 * w) * 32, lane);
    else if (nblk64 <= 16) idx_select<16>(S + (2 * w) * 2048 + lane, mask64 + (2 * w) * 32, lane);
    else if (nblk64 <= 24) idx_select<24>(S + (2 * w) * 2048 + lane, mask64 + (2 * w) * 32, lane);
    else idx_select<32>(S + (2 * w) * 2048 + lane, mask64 + (2 * w) * 32, lane);
}

__device__ __forceinline__ void ssd_prep_unit(const Params& p, int unit, char* smem) {
    const int tid = tid_op(), lane = tid & 63, w = tid >> 6, cL = lane & 15, gq = lane >> 4;
    const int h = unit & 7, c = (unit >> 3) & 15, b = unit >> 7, g = h >> 2;
    char* ws = p.ws;
    float* s_acum = (float*)smem; float* s_dt = s_acum + 128; float* s_w = s_dt + 128;
    bf16_t* sXw = (bf16_t*)(smem + 2048); bf16_t* sBt = sXw + 64 * 136;
    const int tok0 = b * 2048 + c * 128;
    const float a_h = -expf(p.a_log[h]);
    const float* DTf = (const float*)(ws + O_DTF);
    __syncthreads();
    if (tid < 128) s_dt[tid] = DTf[(size_t)(tok0 + tid) * 8 + h];
    __syncthreads();
    if (tid < 128) {
        float s = 0.f;
        for (int k = 0; k <= tid; ++k) s += s_dt[k] * a_h;
        s_acum[tid] = s;
        ((float*)(ws + O_ACUM))[(size_t)(b * 8 + h) * 2048 + c * 128 + tid] = s;
    }
    __syncthreads();
    if (tid < 128) {
        const float tot = s_acum[127];
        s_w[tid] = s_dt[tid] * __expf(tot - s_acum[tid]);
        if (tid == 0) ((float*)(ws + O_ATOT))[(b * 8 + h) * 16 + c] = tot;
    }
    __syncthreads();
    const bf16_t* XBCt = (const bf16_t*)(ws + O_XBCT);
    bf16_t* Xt = (bf16_t*)(ws + O_XT); bf16_t* Brm = (bf16_t*)(ws + O_BRM); bf16_t* Crm = (bf16_t*)(ws + O_CRM);
#pragma unroll
    for (int bt = 0; bt < 2; ++bt) {
    const int it0 = bt * 4, itn = bt ? 3 : 4;
    u32x4g cur7[4], prv7[4]; float cw7[4][5];
#pragma unroll
    for (int it = 0; it < 4; ++it) if (it < itn) {
        const int item = tid + 512 * (it0 + it);
        int ch; const int tc = item & 15;
        if (item < 1024) ch = h * 64 + (item >> 4);
        else if (item < 3072) ch = 512 + g * 128 + ((item - 1024) >> 4);
        else ch = 768 + g * 128 + (h & 3) * 32 + ((item - 3072) >> 4);
        const bf16_t* src = XBCt + ((size_t)b * 1024 + ch) * 2048 + c * 128 + tc * 8;
        cur7[it] = *(const u32x4g*)src;
        const bool hasprev = (c * 128 + tc * 8 >= 8);
        prv7[it] = *(const u32x4g*)(hasprev ? src - 8 : src);
        if (!hasprev) prv7[it] = (u32x4g){0u, 0u, 0u, 0u};
        cw7[it][0] = p.conv_w[ch]; cw7[it][1] = p.conv_w[1024 + ch]; cw7[it][2] = p.conv_w[2048 + ch]; cw7[it][3] = p.conv_w[3072 + ch]; cw7[it][4] = p.conv_b[ch];
    }
#pragma unroll
    for (int it = 0; it < 4; ++it) if (it < itn) {
        const int item = tid + 512 * (it0 + it);
        int kind, idx, ch; const int tc = item & 15;
        if (item < 1024) { kind = 0; idx = item >> 4; ch = h * 64 + idx; }
        else if (item < 3072) { kind = 1; idx = (item - 1024) >> 4; ch = 512 + g * 128 + idx; }
        else { kind = 2; idx = (h & 3) * 32 + ((item - 3072) >> 4); ch = 768 + g * 128 + idx; }
        const u32x4g cur = cur7[it], prv = prv7[it];
        float xv[11];
        xv[0] = bf2f((bf16_t)(prv.z >> 16)); xv[1] = bf2f((bf16_t)(prv.w & 0xFFFF)); xv[2] = bf2f((bf16_t)(prv.w >> 16));
        xv[3] = bf2f((bf16_t)(cur.x & 0xFFFF)); xv[4] = bf2f((bf16_t)(cur.x >> 16)); xv[5] = bf2f((bf16_t)(cur.y & 0xFFFF)); xv[6] = bf2f((bf16_t)(cur.y >> 16));
        xv[7] = bf2f((bf16_t)(cur.z & 0xFFFF)); xv[8] = bf2f((bf16_t)(cur.z >> 16)); xv[9] = bf2f((bf16_t)(cur.w & 0xFFFF)); xv[10] = bf2f((bf16_t)(cur.w >> 16));
        const float w0 = cw7[it][0], w1 = cw7[it][1], w2 = cw7[it][2], w3 = cw7[it][3], bias = cw7[it][4];
        float o[8];
#pragma unroll
        for (int j = 0; j < 8; ++j) { const float v = bias + w0 * xv[j] + w1 * xv[j + 1] + w2 * xv[j + 2] + w3 * xv[j + 3]; o[j] = bf2f(f2bf(silu_f(v))); }
        if (kind == 0) {
            *(uint4*)(Xt + ((size_t)b * 512 + ch) * 2048 + c * 128 + tc * 8) = make_uint4(pack2(o[0], o[1]), pack2(o[2], o[3]), pack2(o[4], o[5]), pack2(o[6], o[7]));
            float q[8];
#pragma unroll
            for (int j = 0; j < 8; ++j) q[j] = o[j] * s_w[tc * 8 + j];
            *(uint4*)(sXw + idx * 136 + tc * 8) = make_uint4(pack2(q[0], q[1]), pack2(q[2], q[3]), pack2(q[4], q[5]), pack2(q[6], q[7]));
        } else if (kind == 1) {
            *(uint4*)(sBt + idx * 136 + tc * 8) = make_uint4(pack2(o[0], o[1]), pack2(o[2], o[3]), pack2(o[4], o[5]), pack2(o[6], o[7]));
            if ((h & 3) == 0) {
#pragma unroll
                for (int j = 0; j < 8; ++j) Brm[(size_t)(tok0 + tc * 8 + j) * 256 + g * 128 + idx] = f2bf(o[j]);
            }
        } else {
#pragma unroll
            for (int j = 0; j < 8; ++j) Crm[(size_t)(tok0 + tc * 8 + j) * 256 + g * 128 + idx] = f2bf(o[j]);
        }
    }
    }
    __syncthreads();
    f32x4 acc[4];
#pragma unroll
    for (int i = 0; i < 4; ++i) acc[i] = (f32x4){0.f, 0.f, 0.f, 0.f};
#pragma unroll
    for (int ks = 0; ks < 4; ++ks) {
        const bf16x8 bb = ld8(sBt + (16 * w + cL) * 136 + ks * 32 + gq * 8);
#pragma unroll
        for (int pt = 0; pt < 4; ++pt) acc[pt] = mfma16(ld8(sXw + (16 * pt + cL) * 136 + ks * 32 + gq * 8), bb, acc[pt]);
    }
    float* ST = (float*)(ws + O_ST) + ((size_t)((b * 16 + c) * 8 + h)) * 8192;
#pragma unroll
    for (int pt = 0; pt < 4; ++pt)
#pragma unroll
        for (int r = 0; r < 4; ++r) ST[(16 * pt + 4 * gq + r) * 128 + 16 * w + cL] = acc[pt][r];
}

__device__ __forceinline__ void phase2c(const Params& p) {
    char* ws = p.ws;
    const int idx = blockIdx.x * 512 + tid_op();
    if (idx >= 64 * 2048) return;
    const int bh = idx >> 11, e4 = idx & 2047, b = bh >> 3, h = bh & 7;
    const float* ST = (const float*)(ws + O_ST); const float* ATOT = (const float*)(ws + O_ATOT);
    float4 sv[16]; float4 at4[4];
#pragma unroll
    for (int c = 0; c < 16; ++c) sv[c] = *(const float4*)(ST + ((size_t)((b * 16 + c) * 8 + h)) * 8192 + (size_t)e4 * 4);
#pragma unroll
    for (int k = 0; k < 4; ++k) at4[k] = *(const float4*)(ATOT + bh * 16 + 4 * k);
    const float at[16] = {at4[0].x, at4[0].y, at4[0].z, at4[0].w, at4[1].x, at4[1].y, at4[1].z, at4[1].w, at4[2].x, at4[2].y, at4[2].z, at4[2].w, at4[3].x, at4[3].y, at4[3].z, at4[3].w};
    float4 car = make_float4(0.f, 0.f, 0.f, 0.f);
    bf16_t* CAR = (bf16_t*)(ws + O_CAR);
#pragma unroll
    for (int c = 0; c < 16; ++c) {
        *(uint2*)(CAR + ((size_t)((b * 16 + c) * 8 + h)) * 8192 + (size_t)e4 * 4) = make_uint2(pack2(car.x, car.y), pack2(car.z, car.w));
        const float dec = __expf(at[c]);
        car.x = dec * car.x + sv[c].x; car.y = dec * car.y + sv[c].y; car.z = dec * car.z + sv[c].z; car.w = dec * car.w + sv[c].w;
    }
}

#define ATT_LDK 80
#define ATT_LDV 72
__device__ __forceinline__ void attn_unit(const Params& p, int unit, char* smem) {
    const int tid = tid_op(), lane = tid & 63, w = tid >> 6, cL = lane & 15, gq = lane >> 4;
    const int qb = 15 - (unit >> 6), bh = unit & 63, b = bh >> 3, h = bh & 7;
    char* ws = p.ws;
    const int q0 = qb * 128 + 16 * w;
    const int ktmax = (q0 + 15) >> 6;
    const int ntile = 2 * qb + 2;
    const bf16_t* Q = (const bf16_t*)(ws + O_QB) + (size_t)bh * 2048 * 64;
    const bf16_t* Kp = (const bf16_t*)(ws + O_KB) + (size_t)bh * 2048 * 64;
    const bf16_t* V = (const bf16_t*)(ws + O_VT) + (size_t)bh * 64 * 2048;
    const unsigned short* mrow = (const unsigned short*)(ws + O_MASK) + (size_t)(b * 2048 + q0 + cL) * 128;
    bf16_t* sK = (bf16_t*)smem;
    bf16_t* sV = (bf16_t*)(smem + 2 * 64 * ATT_LDK * 2);
    const int lr = tid >> 3, lc = (tid & 7) * 8;
    bf16x8 qf[2];
    qf[0] = ld8(Q + (size_t)(q0 + cL) * 64 + gq * 8); qf[1] = ld8(Q + (size_t)(q0 + cL) * 64 + 32 + gq * 8);
    float m_run = -1e30f, l_run = 0.f;
    f32x4 o[4];
#pragma unroll
    for (int i = 0; i < 4; ++i) o[i] = (f32x4){0.f, 0.f, 0.f, 0.f};
    u32x4g rk = *(const u32x4g*)(Kp + (size_t)lr * 64 + lc);
    u32x4g rv = *(const u32x4g*)(V + (size_t)lr * 2048 + lc);
    u32x4g rk1 = *(const u32x4g*)(Kp + (size_t)(64 + lr) * 64 + lc);
    u32x4g rv1 = *(const u32x4g*)(V + (size_t)lr * 2048 + 64 + lc);
    __syncthreads();
    *(u32x4g*)(sK + lr * ATT_LDK + lc) = rk; *(u32x4g*)(sV + lr * ATT_LDV + lc) = rv;
    __syncthreads();
    for (int kt = 0; kt < ntile; ++kt) {
        const int s0 = kt * 64, cur = kt & 1;
        rk = rk1; rv = rv1;
        { const int t2 = (kt + 2 < ntile) ? kt + 2 : ntile - 1; rk1 = *(const u32x4g*)(Kp + (size_t)(t2 * 64 + lr) * 64 + lc); rv1 = *(const u32x4g*)(V + (size_t)lr * 2048 + t2 * 64 + lc); }
        if (kt <= ktmax) {
            const bf16_t* tK = sK + cur * 64 * ATT_LDK; const bf16_t* tV = sV + cur * 64 * ATT_LDV;
            const unsigned long long mb = *(const unsigned long long*)(mrow + kt * 4);
            f32x4 st[4];
#pragma unroll
            for (int j = 0; j < 4; ++j) {
                f32x4 a = (f32x4){0.f, 0.f, 0.f, 0.f};
                const bf16_t* kr = tK + (16 * j + cL) * ATT_LDK + gq * 8;
                a = mfma16(ld8(kr), qf[0], a); a = mfma16(ld8(kr + 32), qf[1], a);
                st[j] = a;
            }
            float mx = m_run;
            const unsigned mlo = (unsigned)mb >> (4 * gq), mhi = (unsigned)(mb >> 32) >> (4 * gq);
#pragma unroll
            for (int j = 0; j < 4; ++j)
#pragma unroll
                for (int r = 0; r < 4; ++r) {
                    const bool bit = ((j < 2 ? mlo : mhi) & (1u << (16 * (j & 1) + r))) != 0u;
                    const float v = bit ? st[j][r] : -INFINITY;
                    st[j][r] = v; mx = fmaxf(mx, v);
                }
            mx = max_x32(max_x16(mx));
            const float alpha = __builtin_amdgcn_exp2f(m_run - mx); m_run = mx;
            float ls = 0.f;
#pragma unroll
            for (int j = 0; j < 4; ++j)
#pragma unroll
                for (int r = 0; r < 4; ++r) { const float pv = __builtin_amdgcn_exp2f(st[j][r] - mx); st[j][r] = pv; ls += pv; }
            ls = sum_x32(sum_x16(ls));
            l_run = l_run * alpha + ls;
#pragma unroll
            for (int i = 0; i < 4; ++i) o[i] = o[i] * alpha;
#pragma unroll
            for (int kk = 0; kk < 2; ++kk) {
                bf16x8 pf;
#pragma unroll
                for (int r = 0; r < 4; ++r) { pf[r] = (short)f2bf(st[2 * kk][r]); pf[4 + r] = (short)f2bf(st[2 * kk + 1][r]); }
#pragma unroll
                for (int dt = 0; dt < 4; ++dt) {
                    const bf16_t* vr = tV + (16 * dt + cL) * ATT_LDV + 32 * kk + 4 * gq;
                    o[dt] = mfma16(cat4(*(const bf16x4*)vr, *(const bf16x4*)(vr + 16)), pf, o[dt]);
                }
            }
        }
        if (kt + 1 < ntile) {
            const int nxt = cur ^ 1;
            *(u32x4g*)(sK + nxt * 64 * ATT_LDK + lr * ATT_LDK + lc) = rk; *(u32x4g*)(sV + nxt * 64 * ATT_LDV + lr * ATT_LDV + lc) = rv;
        }
        __syncthreads();
    }
    const float inv = 1.f / l_run;
    bf16_t* mix = (bf16_t*)(ws + O_MIX) + (size_t)(b * 2048 + q0 + cL) * 1024 + h * 64;
#pragma unroll
    for (int dt = 0; dt < 4; ++dt)
        *(uint2*)(mix + 16 * dt + 4 * gq) = make_uint2(pack2(o[dt][0] * inv, o[dt][1] * inv), pack2(o[dt][2] * inv, o[dt][3] * inv));
}

#define SSD_CAR_BYTES (4 * 64 * 136 * 2)
__device__ __forceinline__ void ssd_main_unit(const Params& p, int unit, char* smem) {
    const int tid = tid_op(), lane = tid & 63, w = tid >> 6, cL = lane & 15, gq = lane >> 4;
    const int g = unit & 1, c = (unit >> 1) & 15, b = unit >> 5;
    char* ws = p.ws;
    float* sAc = (float*)smem;
    float* sDt = sAc + 512;
    const int tok0 = b * 2048 + c * 128;
    const float* ATOT = (const float*)(ws + O_ATOT); const float* ACUM = (const float*)(ws + O_ACUM); const float* DTf = (const float*)(ws + O_DTF);
    const bf16_t* Xt = (const bf16_t*)(ws + O_XT); const bf16_t* Brm = (const bf16_t*)(ws + O_BRM); const bf16_t* Crm = (const bf16_t*)(ws + O_CRM);
    const bf16_t* Zb = (const bf16_t*)(ws + O_ZB);
    __syncthreads();
    {
        const int hh = tid >> 7, l = tid & 127;
        sAc[tid] = ACUM[(size_t)(b * 8 + 4 * g + hh) * 2048 + c * 128 + l];
        sDt[tid] = DTf[(size_t)(tok0 + l) * 8 + 4 * g + hh];
    }
    __syncthreads();
    bf16_t* mix = (bf16_t*)(ws + O_MIX);
    const int lt = w;
    const int ltok = tok0 + 16 * lt + cL;
    bf16x8 Cq[4];
#pragma unroll
    for (int ks = 0; ks < 4; ++ks) Cq[ks] = ld8(Crm + (size_t)ltok * 256 + g * 128 + ks * 32 + gq * 8);
    f32x4 cbT[8];
#pragma unroll
    for (int st = 0; st < 8; ++st) {
        cbT[st] = (f32x4){0.f, 0.f, 0.f, 0.f};
        if (st <= lt) {
            const bf16_t* br = Brm + (size_t)(tok0 + 16 * st + cL) * 256 + g * 128 + gq * 8;
#pragma unroll
            for (int ks = 0; ks < 4; ++ks) cbT[st] = mfma16(ld8(br + ks * 32), Cq[ks], cbT[st]);
        }
    }
    float ssq = 0.f;
#pragma unroll 1
    for (int hh = 0; hh < 4; ++hh) {
        const int h = 4 * g + hh;
        const float* ac = sAc + hh * 128; const float* dtl = sDt + hh * 128;
        const float al = ac[16 * lt + cL];
        const bf16_t* xh = Xt + ((size_t)b * 512 + h * 64) * 2048 + c * 128;
        const bf16_t* zh = Zb + (size_t)tok0 * 512 + h * 64;
        const bf16_t* carh = (const bf16_t*)(ws + O_CAR) + ((size_t)((b * 16 + c) * 8 + h)) * 8192;
        bf16x8 xf[4][4];
#pragma unroll
        for (int kk = 0; kk < 4; ++kk)
#pragma unroll
            for (int pt = 0; pt < 4; ++pt) {
                const int kc = (2 * kk <= lt) ? kk : 0;
                const unsigned xo = (unsigned)((16 * pt + cL) * 2048 + 32 * kc + 4 * gq);
                xf[kk][pt] = cat4(*(const bf16x4*)(xh + xo), *(const bf16x4*)(xh + xo + 16));
            }
        f32x4 acc1[4], acc2[4];
#pragma unroll
        for (int i = 0; i < 4; ++i) { acc1[i] = (f32x4){0.f, 0.f, 0.f, 0.f}; acc2[i] = (f32x4){0.f, 0.f, 0.f, 0.f}; }
#pragma unroll
        for (int kk = 0; kk < 4; ++kk) {
            if (2 * kk <= lt) {
                bf16x8 mf;
#pragma unroll
                for (int half = 0; half < 2; ++half) {
                    const int st = 2 * kk + half;
#pragma unroll
                    for (int r = 0; r < 4; ++r) {
                        const int sl = 16 * st + 4 * gq + r;
                        float v = 0.f;
                        if (st <= lt && sl <= 16 * lt + cL) v = cbT[st][r] * __expf(al - ac[sl]) * dtl[sl];
                        mf[half * 4 + r] = (short)f2bf(v);
                    }
                }
#pragma unroll
                for (int pt = 0; pt < 4; ++pt) acc1[pt] = mfma16(xf[kk][pt], mf, acc1[pt]);
            }
        }
        uint2 zz[4]; bf16_t xsv[4][4];
#pragma unroll
        for (int pt = 0; pt < 4; ++pt) {
            zz[pt] = *(const uint2*)(zh + (unsigned)((16 * lt + cL) * 512 + 16 * pt + 4 * gq));
#pragma unroll
            for (int r = 0; r < 4; ++r) xsv[pt][r] = xh[(unsigned)((16 * pt + 4 * gq + r) * 2048 + 16 * lt + cL)];
        }
#pragma unroll
        for (int ks = 0; ks < 4; ++ks)
#pragma unroll
            for (int pt = 0; pt < 4; ++pt) acc2[pt] = mfma16(ld8(carh + (unsigned)((16 * pt + cL) * 128 + ks * 32 + gq * 8)), Cq[ks], acc2[pt]);
        const float el = __expf(al), dsk = p.d_skip[h];
#pragma unroll
        for (int pt = 0; pt < 4; ++pt) {
            const float zf[4] = {bf2f((bf16_t)(zz[pt].x & 0xFFFF)), bf2f((bf16_t)(zz[pt].x >> 16)), bf2f((bf16_t)(zz[pt].y & 0xFFFF)), bf2f((bf16_t)(zz[pt].y >> 16))};
            float yv[4];
#pragma unroll
            for (int r = 0; r < 4; ++r) {
                float t = acc1[pt][r] + el * acc2[pt][r] + bf2f(xsv[pt][r]) * dsk;
                t *= silu_f(zf[r]);
                yv[r] = t; ssq += t * t;
            }
            *(uint2*)(mix + (size_t)ltok * 1024 + 512 + h * 64 + 16 * pt + 4 * gq) = make_uint2(pack2(yv[0], yv[1]), pack2(yv[2], yv[3]));
        }
    }
    ssq = sum_x32(sum_x16(ssq));
    const float rstd = rsqrtf(ssq * (1.f / 256.f) + LN_EPS);
#pragma unroll
    for (int hh = 0; hh < 4; ++hh)
#pragma unroll
        for (int pt = 0; pt < 4; ++pt) {
            const int ch = (4 * g + hh) * 64 + 16 * pt + 4 * gq;
            const float4 nw = *(const float4*)(p.norm_w + ch);
            const uint2 yy = *(const uint2*)(mix + (size_t)ltok * 1024 + 512 + ch);
            const float y0 = bf2f((bf16_t)(yy.x & 0xFFFF)), y1 = bf2f((bf16_t)(yy.x >> 16)), y2 = bf2f((bf16_t)(yy.y & 0xFFFF)), y3 = bf2f((bf16_t)(yy.y >> 16));
            *(uint2*)(mix + (size_t)ltok * 1024 + 512 + ch) = make_uint2(pack2(y0 * rstd * nw.x, y1 * rstd * nw.y), pack2(y2 * rstd * nw.z, y3 * rstd * nw.w));
        }
}

__device__ __forceinline__ void phase2(const Params& p, char* smem, int which = 3) {
    const int G = gridDim.x;
    for (int k = 0; k * G < 2048; ++k) {
        const int u = k * G + ((k & 1) ? (G - 1 - (int)blockIdx.x) : (int)blockIdx.x);
        if (u >= 2048) continue;
        if (u < 1024) { if (which & 1) indexer_unit(p, u, smem); } else { if (which & 2) ssd_prep_unit(p, u - 1024, smem); }
    }
}
__device__ __forceinline__ void phase3(const Params& p, char* smem, int which = 3) {
    const int G = gridDim.x;
    for (int k = 0; k * G < 1024 + 256; ++k) {
        const int u = k * G + ((k & 1) ? (G - 1 - (int)blockIdx.x) : (int)blockIdx.x);
        if (u >= 1024 + 256) continue;
        if (u < 256) { if (which & 1) ssd_main_unit(p, u, smem); } else { if (which & 2) attn_unit(p, u - 256, smem); }
    }
}

struct OutEpi {
    const float* x; float* y;
    __device__ __forceinline__ void operator()(const f32x4 (&acc)[4][4], int mb, int nb, int lane, char* lds) const {
        const int c = lane & 15, g = lane >> 4;
        float* L = (float*)lds;
#pragma unroll
        for (int half = 0; half < 2; ++half) {
#pragma unroll
            for (int mi2 = 0; mi2 < 2; ++mi2)
#pragma unroll
                for (int r = 0; r < 4; ++r)
#pragma unroll
                    for (int ni = 0; ni < 4; ++ni) L[(16 * mi2 + 4 * g + r) * 68 + 16 * ni + c] = acc[2 * half + mi2][ni][r];
#pragma unroll
            for (int i = 0; i < 8; ++i) {
                const int row = 4 * i + g;
                const float4 a = *(const float4*)(L + row * 68 + 4 * c);
                const size_t o = (size_t)(mb + 32 * half + row) * 1024 + nb + 4 * c;
                const float4 xv = *(const float4*)(x + o);
                *(float4*)(y + o) = make_float4(ALPHA * xv.x + a.x, ALPHA * xv.y + a.y, ALPHA * xv.z + a.z, ALPHA * xv.w + a.w);
            }
        }
    }
};
__device__ __forceinline__ void phase4(const Params& p, char* smem, const XcdMap xm) {
    pg8::Gemm g{(const bf16_t*)(p.ws + O_MIX), (const bf16_t*)(p.ws + O_WOUT_T), NTOK, 1024, 1024};
    pg8::StaticOrder S; S.init(NTOK, 1024, (int)gridDim.x, (int)blockIdx.x);
    pg8::EpiResF32 E{p.out, p.x, 1024, ALPHA};
    pg8::gemm_phase<pg8::EpiResF32, pg8::StaticOrder, false>((PG8_LAS unsigned char*)smem, g, S, E, nullptr);
}

__device__ __forceinline__ void phase5(const Params& p) {
    const int lane = tid_op() & 63, w = tid_op() >> 6;
    bf16_t* hb = (bf16_t*)(p.ws + O_HB);
    for (int row = blockIdx.x * 8 + w; row < NTOK; row += gridDim.x * 8) {
        float* yr = p.out + (size_t)row * 1024;
        float4 v[4]; float s = 0.f;
#pragma unroll
        for (int j = 0; j < 4; ++j) { v[j] = *(const float4*)(yr + 4 * lane + 256 * j); s += v[j].x + v[j].y + v[j].z + v[j].w; }
        const float mean = wave_sum(s) * (1.f / 1024.f);
        float q = 0.f;
#pragma unroll
        for (int j = 0; j < 4; ++j) { const float a = v[j].x - mean, b2 = v[j].y - mean, c2 = v[j].z - mean, d = v[j].w - mean; q += a * a + b2 * b2 + c2 * c2 + d * d; }
        const float rstd = rsqrtf(wave_sum(q) * (1.f / 1024.f) + LN_EPS);
#pragma unroll
        for (int j = 0; j < 4; ++j) {
            const int col = 4 * lane + 256 * j;
            const float4 gg = *(const float4*)(p.ln1_g + col), bb = *(const float4*)(p.ln1_b + col);
            float4 o;
            o.x = (v[j].x - mean) * rstd * gg.x + bb.x; o.y = (v[j].y - mean) * rstd * gg.y + bb.y; o.z = (v[j].z - mean) * rstd * gg.z + bb.z; o.w = (v[j].w - mean) * rstd * gg.w + bb.w;
            *(float4*)(yr + col) = o;
            *(uint2*)(hb + (size_t)row * 1024 + col) = make_uint2(pack2(o.x, o.y), pack2(o.z, o.w));
            int ph = __builtin_amdgcn_cvt_pk_fp8_f32(o.x, o.y, 0, false); ph = __builtin_amdgcn_cvt_pk_fp8_f32(o.z, o.w, ph, true);
            const f32x2 b01 = __builtin_amdgcn_cvt_pk_f32_fp8(ph, false), b23 = __builtin_amdgcn_cvt_pk_f32_fp8(ph, true);
            int pl = __builtin_amdgcn_cvt_pk_fp8_f32((o.x - b01.x) * 16.f, (o.y - b01.y) * 16.f, 0, false); pl = __builtin_amdgcn_cvt_pk_fp8_f32((o.z - b23.x) * 16.f, (o.w - b23.y) * 16.f, pl, true);
            *(int*)(p.ws + O_H8HI + (size_t)row * 1024 + col) = ph; *(int*)(p.ws + O_H8LO + (size_t)row * 1024 + col) = pl;
        }
    }
    const size_t gtid = (size_t)blockIdx.x * blockDim.x + tid_op(), gsz = (size_t)gridDim.x * blockDim.x;
    {
        unsigned* u8 = (unsigned*)(p.ws + O_U8); unsigned* v8 = (unsigned*)(p.ws + O_V8);
        for (size_t i = gtid; i < (size_t)16384 * 256; i += gsz) {
            const float4 fu = ((const float4*)p.u)[i];
            int pk = __builtin_amdgcn_cvt_pk_fp8_f32(fu.x * 32.f, fu.y * 32.f, 0, false); pk = __builtin_amdgcn_cvt_pk_fp8_f32(fu.z * 32.f, fu.w * 32.f, pk, true);
            u8[i] = (unsigned)pk;
            const float4 fv = ((const float4*)p.v)[i];
            int pv = __builtin_amdgcn_cvt_pk_fp8_f32(fv.x, fv.y, 0, false); pv = __builtin_amdgcn_cvt_pk_fp8_f32(fv.z, fv.w, pv, true);
            const size_t e = i >> 8, c4 = i & 255;
            v8[((c4 >> 5) * 16384 + e) * 32 + (c4 & 31)] = (unsigned)pv;
        }
    }
}

struct QpEpi {
    bf16_t* qp;
    __device__ __forceinline__ void operator()(const f32x4 (&acc)[4][4], int mb, int nb, int lane, char* lds) const {
        const int c = lane & 15, g = lane >> 4;
        bf16_t* L = (bf16_t*)lds;
#pragma unroll
        for (int mi = 0; mi < 4; ++mi)
#pragma unroll
            for (int r = 0; r < 4; ++r)
#pragma unroll
                for (int ni = 0; ni < 4; ++ni) L[(16 * mi + 4 * g + r) * 72 + 16 * ni + c] = f2bf(acc[mi][ni][r]);
#pragma unroll
        for (int i = 0; i < 8; ++i) {
            const int row = 8 * i + (lane >> 3), cc = (lane & 7) * 8;
            *(uint4*)(qp + (size_t)(mb + row) * 2048 + nb + cc) = *(const uint4*)(L + row * 72 + cc);
        }
    }
};
__device__ __forceinline__ void phase6(const Params& p, char* smem, const XcdMap xm) {
    pg8::Gemm g{(const bf16_t*)(p.ws + O_HB), (const bf16_t*)(p.ws + O_WQ_T), NTOK, 2048, 1024};
    pg8::StaticOrder S; S.init(NTOK, 2048, (int)gridDim.x, (int)blockIdx.x);
    pg8::EpiBf16Plain E{(bf16_t*)(p.ws + O_QP), 2048};
    pg8::gemm_phase<pg8::EpiBf16Plain, pg8::StaticOrder, false>((PG8_LAS unsigned char*)smem, g, S, E, nullptr);
}

__device__ __forceinline__ float gelu_erf(float d) { return 0.5f * d * (1.f + erff(d * 0.70710678118654752f)); }
typedef unsigned u32x4n __attribute__((ext_vector_type(4)));
__device__ __forceinline__ long lo64n(const u32x4n v) { return (long)(((unsigned long long)v.y << 32) | v.x); }
__device__ __forceinline__ long hi64n(const u32x4n v) { return (long)(((unsigned long long)v.w << 32) | v.z); }
struct P8aRows { u32x4n a[16]; };
__device__ __forceinline__ void p8a_load(P8aRows& R, const unsigned char* U8, int eid, int gq) {
    const unsigned char* urow = U8 + (size_t)eid * 1024 + 16 * gq;
#pragma unroll
    for (int j = 0; j < 16; ++j) R.a[j] = *(const u32x4n*)(urow + 64 * j);
}
__device__ __forceinline__ float p8_dot16(const u32x4n r, const f32x2 (&hp)[8]) {
    f32x2 acc = __builtin_amdgcn_cvt_pk_f32_fp8((int)r.x, false) * hp[0];
    acc += __builtin_amdgcn_cvt_pk_f32_fp8((int)r.x, true) * hp[1];
    acc += __builtin_amdgcn_cvt_pk_f32_fp8((int)r.y, false) * hp[2]; acc += __builtin_amdgcn_cvt_pk_f32_fp8((int)r.y, true) * hp[3];
    acc += __builtin_amdgcn_cvt_pk_f32_fp8((int)r.z, false) * hp[4]; acc += __builtin_amdgcn_cvt_pk_f32_fp8((int)r.z, true) * hp[5];
    acc += __builtin_amdgcn_cvt_pk_f32_fp8((int)r.w, false) * hp[6]; acc += __builtin_amdgcn_cvt_pk_f32_fp8((int)r.w, true) * hp[7];
    return acc.x + acc.y;
}
__device__ __forceinline__ float p8_reduce16(const float (&p)[16], int lane) {
    float q[8], r4[4], t2[2];
#pragma unroll
    for (int k = 0; k < 8; ++k) { const u32x2_t sw = __builtin_amdgcn_permlane32_swap(__float_as_uint(p[k]), __float_as_uint(p[k + 8]), false, false); q[k] = __uint_as_float(sw.x) + __uint_as_float(sw.y); }
#pragma unroll
    for (int k = 0; k < 4; ++k) { const u32x2_t sw = __builtin_amdgcn_permlane16_swap(__float_as_uint(q[k]), __float_as_uint(q[k + 4]), false, false); r4[k] = __uint_as_float(sw.x) + __uint_as_float(sw.y); }
    const bool b3 = (lane & 8) != 0, b2 = (lane & 4) != 0;
#pragma unroll
    for (int k = 0; k < 2; ++k) { const float snd = b3 ? r4[k] : r4[k + 2], keep = b3 ? r4[k + 2] : r4[k]; t2[k] = keep + dpp_f<0x128, 0xF, true>(snd); }
    const float snd = b2 ? t2[0] : t2[1], keep = b2 ? t2[1] : t2[0];
    float z = keep + dpp_f<0x141, 0xF, true>(snd);
    z += dpp_f<0xB1, 0xF, true>(z); z += dpp_f<0x4E, 0xF, true>(z);
    return z;
}
__constant__ unsigned char CAND_I[64] = {0,0,0,0,0,0,0,0,0,0,0,0,0,0,0,0, 1,1,1,1,1,1,1,1, 2,2,2,2,2, 3,3,3,3, 4,4,4, 5,5, 6,6, 7,7, 8,9,10,11,12,13,14,15, 0,0,0,0,0,0,0,0,0,0,0,0,0,0};
__constant__ unsigned char CAND_J[64] = {0,1,2,3,4,5,6,7,8,9,10,11,12,13,14,15, 0,1,2,3,4,5,6,7, 0,1,2,3,4, 0,1,2,3, 0,1,2, 0,1, 0,1, 0,1, 0,0,0,0,0,0,0,0, 0,0,0,0,0,0,0,0,0,0,0,0,0,0};
__device__ __forceinline__ unsigned rowmax_u(unsigned v) { return row_max_u(v); }
struct PeerSel { int ev[4]; float gv[4]; };
__device__ __forceinline__ PeerSel peer_select(const Params& p, int wunit) {
    const int lane = tid_op() & 63, cL = lane & 15, gq = lane >> 4, rowbase = lane & 48;
    const int tg = wunit >> 3, h = wunit & 7, tok0 = tg * 16;
    char* ws = p.ws;
    const bf16_t* QP = (const bf16_t*)(ws + O_QP);
    unsigned top[2][4];
#pragma unroll
    for (int half = 0; half < 2; ++half) {
        const bf16_t* KB = (const bf16_t*)(ws + (half ? O_K2B : O_K1B));
        bf16x8 a[4];
#pragma unroll
        for (int ks = 0; ks < 4; ++ks) a[ks] = ld8(QP + (size_t)(tok0 + cL) * 2048 + h * 256 + half * 128 + ks * 32 + gq * 8);
        unsigned pk[8][4];
#pragma unroll
        for (int nt = 0; nt < 8; ++nt) {
            f32x4 acc = (f32x4){0.f, 0.f, 0.f, 0.f};
#pragma unroll
            for (int ks = 0; ks < 4; ++ks) acc = mfma16(a[ks], ld8(KB + (size_t)(16 * nt + cL) * 128 + ks * 32 + gq * 8), acc);
#pragma unroll
            for (int r = 0; r < 4; ++r) pk[nt][r] = (f2sort(acc[r]) & ~0x7Fu) | (unsigned)(127 - (16 * nt + cL));
        }
#pragma unroll
        for (int r = 0; r < 4; ++r) top[half][r] = 0u;
        for (int it = 0; it < 16; ++it) {
#pragma unroll
            for (int r = 0; r < 4; ++r) {
                unsigned lm = pk[0][r];
#pragma unroll
                for (int nt = 1; nt < 8; ++nt) lm = max(lm, pk[nt][r]);
                const unsigned gm = rowmax_u(lm);
                if (cL == it) top[half][r] = gm;
#pragma unroll
                for (int nt = 0; nt < 8; ++nt) pk[nt][r] = (pk[nt][r] == gm) ? 0u : pk[nt][r];
            }
        }
    }
    unsigned ck[4][4];
#pragma unroll
    for (int s = 0; s < 4; ++s) {
        const int q = s * 16 + cL; const int ci = CAND_I[q], cj = CAND_J[q];
#pragma unroll
        for (int r = 0; r < 4; ++r) {
            const unsigned t1 = (unsigned)__shfl((int)top[0][r], rowbase + ci), t2 = (unsigned)__shfl((int)top[1][r], rowbase + cj);
            const float f = sort2f(t1 & ~0x7Fu) + sort2f(t2 & ~0x7Fu);
            ck[s][r] = (q < 50) ? ((f2sort(f) & ~0x3Fu) | (unsigned)(63 - q)) : 0u;
        }
    }
    unsigned best[4] = {0u, 0u, 0u, 0u};
    for (int it = 0; it < 16; ++it) {
#pragma unroll
        for (int r = 0; r < 4; ++r) {
            const unsigned lm = max(max(ck[0][r], ck[1][r]), max(ck[2][r], ck[3][r]));
            const unsigned gm = rowmax_u(lm);
            if (cL == it) best[r] = gm;
#pragma unroll
            for (int s = 0; s < 4; ++s) ck[s][r] = (ck[s][r] == gm) ? 0u : ck[s][r];
        }
    }
    PeerSel S_;
#pragma unroll
    for (int r = 0; r < 4; ++r) {
        const float fv = sort2f(best[r] & ~0x3Fu);
        const int q = 63 - (int)(best[r] & 63u);
        const int ci = CAND_I[q], cj = CAND_J[q];
        const unsigned t1 = (unsigned)__shfl((int)top[0][r], rowbase + ci), t2 = (unsigned)__shfl((int)top[1][r], rowbase + cj);
        S_.ev[r] = (127 - (int)(t1 & 127u)) * 128 + (127 - (int)(t2 & 127u));
        const float mx = __shfl(fv, rowbase);
        const float ex = __expf(fv - mx);
        const float sm = row_sum(ex);
        S_.gv[r] = ex / sm;
    }
    return S_;
}
#define PU_ROWEID(SEL, TT, I) __builtin_amdgcn_readlane(SEL.ev[(TT) & 3], 16 * ((TT) >> 2) + (I))
__device__ __forceinline__ void peer_blocks(const Params& p, int wunit, const PeerSel& S_, const PeerSel& N_, bool has_next, P8aRows& R0, P8aRows& R1) {
    const int lane = tid_op() & 63;
    const int tok0 = (wunit >> 3) * 16, h = wunit & 7;
    char* ws = p.ws;
    const unsigned char* U8 = (const unsigned char*)(ws + O_U8) + 16 * lane;
    const float* H = p.out + (size_t)tok0 * 1024 + 16 * lane;
    unsigned* ACT = (unsigned*)(ws + O_ACT) + (size_t)tok0 * 128 + h * 16;
#define PU_STEP(RC, TT) { \
        f32x2 hp[8]; \
        _Pragma("unroll") for (int k = 0; k < 4; ++k) { const f32x4 hv_ = *(const f32x4*)(H + (TT) * 1024 + 4 * k); hp[2 * k] = (f32x2){hv_[0], hv_[1]}; hp[2 * k + 1] = (f32x2){hv_[2], hv_[3]}; } \
        float pp[16]; \
        _Pragma("unroll") for (int i = 0; i < 16; ++i) { \
            pp[i] = p8_dot16(RC.a[i], hp); \
            if ((TT) < 14) RC.a[i] = *(const u32x4n*)(U8 + (size_t)PU_ROWEID(S_, ((TT) + 2) & 15, i) * 1024); \
            else if (has_next) RC.a[i] = *(const u32x4n*)(U8 + (size_t)PU_ROWEID(N_, ((TT) + 2) & 15, i) * 1024); } \
        const float dot = p8_reduce16(pp, lane) * (1.f / 32.f); \
        const int src_ = 16 * ((TT) >> 2) + (lane >> 2); \
        const float gt_ = __shfl(S_.gv[(TT) & 3], src_); const int ei_ = __shfl(S_.ev[(TT) & 3], src_); \
        const float act_ = gelu_erf(dot) * gt_; \
        if ((lane & 3) == 0) ACT[(TT) * 128 + (lane >> 2)] = (unsigned)ei_ | ((unsigned)f2bf(act_) << 16); }
    PU_STEP(R0, 0) PU_STEP(R1, 1) PU_STEP(R0, 2) PU_STEP(R1, 3) PU_STEP(R0, 4) PU_STEP(R1, 5) PU_STEP(R0, 6) PU_STEP(R1, 7)
    PU_STEP(R0, 8) PU_STEP(R1, 9) PU_STEP(R0, 10) PU_STEP(R1, 11) PU_STEP(R0, 12) PU_STEP(R1, 13) PU_STEP(R0, 14) PU_STEP(R1, 15)
#undef PU_STEP
}
__device__ __forceinline__ void phase7(const Params& p, char* smem) {
    const int lane = tid_op() & 63;
    const int w = __builtin_amdgcn_readfirstlane(tid_op() >> 6);
    const int stride = gridDim.x * 8;
    const unsigned char* U8 = (const unsigned char*)(p.ws + O_U8) + 16 * lane;
    for (int u = blockIdx.x * 8 + w; u < 8192; u += stride) {
        const PeerSel s0 = peer_select(p, u);
        P8aRows R0, R1;
#pragma unroll
        for (int i = 0; i < 16; ++i) { R0.a[i] = *(const u32x4n*)(U8 + (size_t)PU_ROWEID(s0, 0, i) * 1024); R1.a[i] = *(const u32x4n*)(U8 + (size_t)PU_ROWEID(s0, 1, i) * 1024); }
        peer_blocks(p, u, s0, s0, false, R0, R1);
    }
}
#undef PU_ROWEID

__device__ __forceinline__ float dot16_fp8(const uint4& r, const float (&hv)[16]) {
    const f32x2 a0 = __builtin_amdgcn_cvt_pk_f32_fp8((int)r.x, false), a1 = __builtin_amdgcn_cvt_pk_f32_fp8((int)r.x, true);
    const f32x2 b0 = __builtin_amdgcn_cvt_pk_f32_fp8((int)r.y, false), b1 = __builtin_amdgcn_cvt_pk_f32_fp8((int)r.y, true);
    const f32x2 c0 = __builtin_amdgcn_cvt_pk_f32_fp8((int)r.z, false), c1 = __builtin_amdgcn_cvt_pk_f32_fp8((int)r.z, true);
    const f32x2 d0 = __builtin_amdgcn_cvt_pk_f32_fp8((int)r.w, false), d1 = __builtin_amdgcn_cvt_pk_f32_fp8((int)r.w, true);
    return (hv[0] * a0.x + hv[1] * a0.y + hv[2] * a1.x + hv[3] * a1.y) + (hv[4] * b0.x + hv[5] * b0.y + hv[6] * b1.x + hv[7] * b1.y)
         + (hv[8] * c0.x + hv[9] * c0.y + hv[10] * c1.x + hv[11] * c1.y) + (hv[12] * d0.x + hv[13] * d0.y + hv[14] * d1.x + hv[15] * d1.y);
}
struct P8bRows { u32x4n v[8]; };
struct P8bMeta { u32x4n m[4]; };
__device__ __forceinline__ void p8b_meta(P8bMeta& M, const unsigned* ACT, int row, int e8) {
#pragma unroll
    for (int k = 0; k < 4; ++k) M.m[k] = *(const u32x4n*)(ACT + (size_t)row * 128 + e8 * 16 + 4 * k);
}
template <int HALF> __device__ __forceinline__ void p8b_load(P8bRows& R, const P8bMeta& M, const unsigned char* V8) {
#pragma unroll
    for (int k = 0; k < 2; ++k) {
        const u32x4n mm = M.m[2 * HALF + k];
        R.v[4 * k + 0] = *(const u32x4n*)(V8 + (size_t)(mm.x & 0xFFFFu) * 128); R.v[4 * k + 1] = *(const u32x4n*)(V8 + (size_t)(mm.y & 0xFFFFu) * 128);
        R.v[4 * k + 2] = *(const u32x4n*)(V8 + (size_t)(mm.z & 0xFFFFu) * 128); R.v[4 * k + 3] = *(const u32x4n*)(V8 + (size_t)(mm.w & 0xFFFFu) * 128);
    }
}
template <int HALF> __device__ __forceinline__ void p8b_accum(f32x2 (&acc)[8], const P8bRows& R, const P8bMeta& M) {
#pragma unroll
    for (int k = 0; k < 2; ++k) {
        const u32x4n mm = M.m[2 * HALF + k];
        const unsigned mw[4] = {mm.x, mm.y, mm.z, mm.w};
#pragma unroll
        for (int q = 0; q < 4; ++q) {
            const float a1 = __uint_as_float(mw[q] & 0xFFFF0000u);
            const f32x2 av = (f32x2){a1, a1};
            const u32x4n x = R.v[4 * k + q];
            acc[0] += av * __builtin_amdgcn_cvt_pk_f32_fp8((int)x.x, false); acc[1] += av * __builtin_amdgcn_cvt_pk_f32_fp8((int)x.x, true);
            acc[2] += av * __builtin_amdgcn_cvt_pk_f32_fp8((int)x.y, false); acc[3] += av * __builtin_amdgcn_cvt_pk_f32_fp8((int)x.y, true);
            acc[4] += av * __builtin_amdgcn_cvt_pk_f32_fp8((int)x.z, false); acc[5] += av * __builtin_amdgcn_cvt_pk_f32_fp8((int)x.z, true);
            acc[6] += av * __builtin_amdgcn_cvt_pk_f32_fp8((int)x.w, false); acc[7] += av * __builtin_amdgcn_cvt_pk_f32_fp8((int)x.w, true);
        }
    }
}
__device__ __forceinline__ void p8b_store(const f32x2 (&acc)[8], float* hr, int e8) {
    float r[16];
#pragma unroll
    for (int j = 0; j < 8; ++j) { r[2 * j] = acc[j].x; r[2 * j + 1] = acc[j].y; }
#pragma unroll
    for (int j = 0; j < 16; ++j) { r[j] += dpp_f<0x128, 0xF, true>(r[j]); r[j] = sum_x32(sum_x16(r[j])); }
    if (e8 == 0) {
#pragma unroll
        for (int j = 0; j < 4; ++j) {
            const float4 h0 = *(const float4*)(hr + 4 * j);
            *(float4*)(hr + 4 * j) = make_float4(ALPHA * h0.x + r[4 * j], ALPHA * h0.y + r[4 * j + 1], ALPHA * h0.z + r[4 * j + 2], ALPHA * h0.w + r[4 * j + 3]);
        }
    }
}
__device__ __forceinline__ void phase8b(const Params& p, const XcdMap xm, float* outp) {
    const int lane = tid_op() & 63, w = tid_op() >> 6, e8 = lane >> 3, c8 = lane & 7;
    char* ws = p.ws;
    const unsigned char* V8 = (const unsigned char*)(ws + O_V8) + (size_t)xm.slice * 16384 * 128 + 16 * c8;
    const unsigned* ACT = (const unsigned*)(ws + O_ACT);
    const int stride = xm.nloc * 8;
    int row = xm.rank * 8 + w;
    if (row >= NTOK) return;
    float* const hbase = outp + xm.slice * 128 + 16 * c8;
    P8bMeta Mc, Mn; P8bRows Ra, Rb;
    p8b_meta(Mc, ACT, row, e8);
    p8b_meta(Mn, ACT, (row + stride < NTOK) ? row + stride : row, e8);
    p8b_load<0>(Ra, Mc, V8);
    for (; row < NTOK; row += stride) {
        f32x2 acc[8];
#pragma unroll
        for (int j = 0; j < 8; ++j) acc[j] = (f32x2){0.f, 0.f};
        p8b_load<1>(Rb, Mc, V8);
        p8b_accum<0>(acc, Ra, Mc);
        p8b_load<0>(Ra, Mn, V8);
        p8b_accum<1>(acc, Rb, Mc);
        p8b_store(acc, hbase + (size_t)row * 1024, e8);
        Mc = Mn;
        const int r2 = row + 2 * stride;
        p8b_meta(Mn, ACT, r2 < NTOK ? r2 : row, e8);
    }
}
__device__ __forceinline__ void phase8c(const Params& p) {
    const int lane = tid_op() & 63, w = tid_op() >> 6;
    for (int row = blockIdx.x * 8 + w; row < NTOK; row += gridDim.x * 8) {
        float* yr = p.out + (size_t)row * 1024;
        float4 v[4]; float s = 0.f;
#pragma unroll
        for (int j = 0; j < 4; ++j) { v[j] = *(const float4*)(yr + 4 * lane + 256 * j); s += v[j].x + v[j].y + v[j].z + v[j].w; }
        const float mean = wave_sum(s) * (1.f / 1024.f);
        float q = 0.f;
#pragma unroll
        for (int j = 0; j < 4; ++j) { const float a = v[j].x - mean, b2 = v[j].y - mean, c2 = v[j].z - mean, d = v[j].w - mean; q += a * a + b2 * b2 + c2 * c2 + d * d; }
        const float rstd = rsqrtf(wave_sum(q) * (1.f / 1024.f) + LN_EPS);
#pragma unroll
        for (int j = 0; j < 4; ++j) {
            const int col = 4 * lane + 256 * j;
            const float4 gg = *(const float4*)(p.ln2_g + col), bb = *(const float4*)(p.ln2_b + col);
            float4 o;
            o.x = (v[j].x - mean) * rstd * gg.x + bb.x; o.y = (v[j].y - mean) * rstd * gg.y + bb.y; o.z = (v[j].z - mean) * rstd * gg.z + bb.z; o.w = (v[j].w - mean) * rstd * gg.w + bb.w;
            *(float4*)(yr + col) = o;
        }
    }
}

typedef const __attribute__((address_space(4))) Params* ParamsK;
__device__ __forceinline__ Params params_reload() {
#if defined(__HIP_DEVICE_COMPILE__)
    auto ka = __builtin_amdgcn_kernarg_segment_ptr();
    asm volatile("" : "+s"(ka));
    Params r; __builtin_memcpy(&r, (const __attribute__((address_space(4))) void*)ka, sizeof(Params));
    return r;
#else
    return Params{};
#endif
}
#if ONE_LAUNCH
__global__ void __launch_bounds__(512, 2) fwd_megakernel(Params p) {
    __shared__ __attribute__((aligned(16))) char smem[SMEM_BYTES];
    cg::grid_group grid = cg::this_grid();
    volatile LAS unsigned* st = (volatile LAS unsigned*)(smem + SMEM_BYTES - 16);
    if (threadIdx.x == 0) { st[0] = 0u; st[1] = 0u; st[2] = 0u; st[3] = 0u; }
    __syncthreads();
    const XcdBarrier xb = xcd_barrier_post((unsigned*)(p.ws + O_BAR), st);
#define GRID_BAR() do { if (p.use_cg) grid.sync(); else xcd_barrier(xb); } while (0)
#ifndef DUP
#define DUP -1
#endif
#define PP (params_reload())
#define RUNPH(k, call) { int n_ = (DUP == k) ? 2 : 1; asm volatile("" : "+s"(n_)); _Pragma("unroll 1") for (int i_ = 0; i_ < n_; ++i_) { call; GRID_BAR(); } }
    RUNPH(0, phase0(PP))
    XcdMap xm;
    if (st[2]) { xm.slice = (int)xb.x; xm.rank = (int)st[3]; xm.nloc = (int)st[0]; }
    else { xm.slice = blockIdx.x & 7; xm.rank = blockIdx.x >> 3; xm.nloc = gridDim.x >> 3; }
    xm.slice = __builtin_amdgcn_readfirstlane(xm.slice); xm.rank = __builtin_amdgcn_readfirstlane(xm.rank); xm.nloc = __builtin_amdgcn_readfirstlane(xm.nloc);
    RUNPH(1, phase1(PP, smem, xm))
    RUNPH(2, phase2(PP, smem))
    if (DUP == 20) { int wh_ = 1; asm volatile("" : "+s"(wh_)); phase2(PP, smem, wh_); GRID_BAR(); }
    if (DUP == 21) { int wh_ = 2; asm volatile("" : "+s"(wh_)); phase2(PP, smem, wh_); GRID_BAR(); }
    phase2c(PP); GRID_BAR();
    RUNPH(3, phase3(PP, smem))
    if (DUP == 30) { int wh_ = 1; asm volatile("" : "+s"(wh_)); phase3(PP, smem, wh_); GRID_BAR(); }
    if (DUP == 31) { int wh_ = 2; asm volatile("" : "+s"(wh_)); phase3(PP, smem, wh_); GRID_BAR(); }
    RUNPH(4, phase4(PP, smem, xm))
    phase5(PP); GRID_BAR();
    RUNPH(6, phase6(PP, smem, xm))
    RUNPH(7, phase7(PP, smem))
#ifdef SCRAMBLE
    { const int x_ = xm.slice, r_ = xm.rank; xm.slice = (x_ + r_) & 7; xm.rank = (r_ >> 3) * 8 + x_; xm.nloc = 32; }
#endif
    if (DUP == 9) { phase8b(PP, xm, (float*)(PP.ws + O_QP)); GRID_BAR(); }
    phase8b(PP, xm, PP.out); GRID_BAR();
    phase8c(PP);
}
#else
__global__ void __launch_bounds__(512, 2) k_phase0(Params p) { phase0(p); }
__global__ void __launch_bounds__(512, 2) k_phase1(Params p) { __shared__ __attribute__((aligned(16))) char smem[SMEM_BYTES]; XcdMap xm; xm.slice = blockIdx.x & 7; xm.rank = blockIdx.x >> 3; xm.nloc = gridDim.x >> 3; phase1(p, smem, xm); }
__global__ void __launch_bounds__(512, 2) k_phase2(Params p) { __shared__ __attribute__((aligned(16))) char smem[SMEM_BYTES]; phase2(p, smem); }
__global__ void __launch_bounds__(512, 2) k_phase2c(Params p) { phase2c(p); }
__global__ void __launch_bounds__(512, 2) k_phase3(Params p) { __shared__ __attribute__((aligned(16))) char smem[SMEM_BYTES]; phase3(p, smem); }
__global__ void __launch_bounds__(512, 2) k_phase4(Params p) { __shared__ __attribute__((aligned(16))) char smem[SMEM_BYTES]; XcdMap xm; xm.slice = blockIdx.x & 7; xm.rank = blockIdx.x >> 3; xm.nloc = gridDim.x >> 3; phase4(p, smem, xm); }
__global__ void __launch_bounds__(512, 2) k_phase5(Params p) { phase5(p); }
__global__ void __launch_bounds__(512, 2) k_phase6(Params p) { __shared__ __attribute__((aligned(16))) char smem[SMEM_BYTES]; XcdMap xm; xm.slice = blockIdx.x & 7; xm.rank = blockIdx.x >> 3; xm.nloc = gridDim.x >> 3; phase6(p, smem, xm); }
__global__ void __launch_bounds__(512, 2) k_phase7(Params p) { __shared__ __attribute__((aligned(16))) char smem_[SMEM_BYTES]; phase7(p, smem_); }
__global__ void __launch_bounds__(512, 2) k_phase8b(Params p) { XcdMap xm; xm.slice = blockIdx.x & 7; xm.rank = blockIdx.x >> 3; xm.nloc = gridDim.x >> 3; phase8b(p, xm, p.out); }
__global__ void __launch_bounds__(512, 2) k_phase8c(Params p) { phase8c(p); }
#endif

extern "C" void kernel_launch(void* const* d_in, const int* in_sizes, int n_in, void* d_out, int out_size, void* d_ws, size_t ws_size, hipStream_t stream) {
    Params p{};
    p.x = (const float*)d_in[0]; p.pos = (const int*)d_in[1]; p.w_in = (const float*)d_in[2]; p.conv_w = (const float*)d_in[3]; p.conv_b = (const float*)d_in[4];
    p.dt_bias = (const float*)d_in[5]; p.a_log = (const float*)d_in[6]; p.d_skip = (const float*)d_in[7]; p.norm_w = (const float*)d_in[8]; p.w_out = (const float*)d_in[9];
    p.ln1_g = (const float*)d_in[10]; p.ln1_b = (const float*)d_in[11]; p.wq = (const float*)d_in[12]; p.k1 = (const float*)d_in[13]; p.k2 = (const float*)d_in[14];
    p.u = (const float*)d_in[15]; p.v = (const float*)d_in[16]; p.ln2_g = (const float*)d_in[17]; p.ln2_b = (const float*)d_in[18];
    p.out = (float*)d_out; p.ws = (char*)d_ws;
    if (ws_size < WS_NEEDED) { fprintf(stderr, "kernel_launch: workspace too small (%zu < %zu)\n", ws_size, (size_t)WS_NEEDED); return; }
#if ONE_LAUNCH
    static int grid_blocks = 0;
    if (!grid_blocks) {
        int dev = 0, cus = 0, per_cu = 0;
        hipGetDevice(&dev);
        hipDeviceGetAttribute(&cus, hipDeviceAttributeMultiprocessorCount, dev);
        hipOccupancyMaxActiveBlocksPerMultiprocessor(&per_cu, fwd_megakernel, 512, 0);
        if (per_cu > 1) per_cu = 1;
        if (per_cu < 1) per_cu = 1;
        grid_blocks = cus * per_cu;
    }
    (void)hipMemsetAsync((char*)d_ws + O_BAR, 0, XCD_BAR_WORDS * 4, stream);
    void* args[] = {&p};
    hipError_t e = hipLaunchCooperativeKernel((void*)fwd_megakernel, dim3(grid_blocks), dim3(512), args, 0, stream);
    if (e != hipSuccess) fprintf(stderr, "cooperative launch failed: %s (grid %d)\n", hipGetErrorString(e), grid_blocks);
#else
    const int G = 512;
    k_phase0<<<G, 512, 0, stream>>>(p);
    k_phase1<<<G, 512, 0, stream>>>(p);
    k_phase2<<<G, 512, 0, stream>>>(p);
    k_phase2c<<<G, 512, 0, stream>>>(p);
    k_phase3<<<G, 512, 0, stream>>>(p);
    k_phase4<<<G, 512, 0, stream>>>(p);
    k_phase5<<<G, 512, 0, stream>>>(p);
    k_phase6<<<G, 512, 0, stream>>>(p);
    k_phase7<<<G, 512, 0, stream>>>(p);
    k_phase8b<<<G, 512, 0, stream>>>(p);
    k_phase8c<<<G, 512, 0, stream>>>(p);
#endif
}
```

```cpp
#include <hip/hip_runtime.h>
#include <hip/hip_cooperative_groups.h>
#include <stdint.h>
#include <stdio.h>
namespace cg = cooperative_groups;

typedef unsigned short bf16_t;
typedef short bf16x8 __attribute__((ext_vector_type(8)));
typedef short bf16x4 __attribute__((ext_vector_type(4)));
typedef float f32x4 __attribute__((ext_vector_type(4)));
typedef float f32x2 __attribute__((ext_vector_type(2)));

#ifndef ONE_LAUNCH
#define ONE_LAUNCH 1
#endif

constexpr int NB = 8, SEQ = 2048, DM = 1024, NTOK = NB * SEQ;
constexpr int NP = 3584;
constexpr int QOFF = 0, KOFF = 512, VOFF = 1024, IQOFF = 1536, MISCOFF = 1792, ZOFF = 1856, XBCOFF = 2368, NUSED = 3392;
constexpr float ALPHA = 1.189207115002721f;
constexpr float LN_EPS = 1e-5f;

constexpr size_t MB = 1024 * 1024;
constexpr size_t O_WIN_T = 0;
constexpr size_t O_WOUT_T = O_WIN_T + (size_t)NP * 1024 * 2;
constexpr size_t O_WQ_T = O_WOUT_T + 2 * MB;
constexpr size_t O_K1B = O_WQ_T + 4 * MB;
constexpr size_t O_K2B = O_K1B + 32768;
constexpr size_t O_CS64 = O_K2B + 32768;
constexpr size_t O_CS32 = O_CS64 + 4 * MB;
constexpr size_t O_BAR = O_CS32 + 2 * MB;
constexpr size_t O_MIX = O_BAR + 65536;
constexpr size_t O_R1 = O_MIX + 32 * MB;
constexpr size_t O_XB = O_R1;
constexpr size_t O_XT = O_R1;
constexpr size_t O_BRM = O_XT + 16 * MB;
constexpr size_t O_CRM = O_BRM + 8 * MB;
constexpr size_t O_QB = O_XB + 32 * MB;
constexpr size_t O_KB = O_QB + 16 * MB;
constexpr size_t O_VT = O_KB + 16 * MB;
constexpr size_t O_IQB = O_VT + 16 * MB;
constexpr size_t O_IKB = O_IQB + 8 * MB;
constexpr size_t O_IWF = O_IKB + 1 * MB;
constexpr size_t O_DTF = O_IWF + MB / 2;
constexpr size_t O_ZB = O_DTF + MB / 2;
constexpr size_t O_XBCT = O_ZB + 16 * MB;
constexpr size_t O_CAR = O_XBCT;
constexpr size_t O_ACUM = O_XBCT + 32 * MB;
constexpr size_t O_ATOT = O_ACUM + MB / 2;
constexpr size_t O_ST = O_ATOT + MB / 2;
constexpr size_t O_MASK = O_ST + 32 * MB;
constexpr size_t O_R1_END = O_MASK + 4 * MB;
constexpr size_t O_HB = O_R1;
constexpr size_t O_QP = O_HB + 32 * MB;
constexpr size_t O_EIDX = O_QP + 64 * MB;
constexpr size_t O_GATE = O_EIDX + 8 * MB;
constexpr size_t O_U8 = O_GATE + 8 * MB;
constexpr size_t O_V8 = O_U8 + 16 * MB;
constexpr size_t O_ACT = O_V8 + 16 * MB;
constexpr size_t O_H8HI = O_ACT + 8 * MB;
constexpr size_t O_H8LO = O_H8HI + 16 * MB;
constexpr size_t O_R2_END = O_H8LO + 16 * MB;
constexpr size_t WS_NEEDED = (O_R1_END > O_R2_END ? O_R1_END : O_R2_END);
static_assert(WS_NEEDED <= 256 * MB, "workspace too large");
static_assert(O_R2_END <= O_R1_END + 64 * MB, "region 2 too large");

struct Params {
    const float* x; const int* pos; const float* w_in; const float* conv_w; const float* conv_b; const float* dt_bias;
    const float* a_log; const float* d_skip; const float* norm_w; const float* w_out; const float* ln1_g; const float* ln1_b;
    const float* wq; const float* k1; const float* k2; const float* u; const float* v; const float* ln2_g; const float* ln2_b;
    float* out; char* ws; int use_cg; int pad_;
};

#define SMEM_BYTES 133120

__device__ __forceinline__ int tid_op() { int t = threadIdx.x; asm volatile("" : "+v"(t)); return t; }
__device__ __forceinline__ bf16_t f2bf(float f) {
    unsigned u = __float_as_uint(f);
    u += 0x7FFFu + ((u >> 16) & 1u);
    return (bf16_t)(u >> 16);
}
__device__ __forceinline__ float bf2f(bf16_t b) { return __uint_as_float(((unsigned)b) << 16); }
__device__ __forceinline__ unsigned pack2(float a, float b) { return (unsigned)f2bf(a) | ((unsigned)f2bf(b) << 16); }
__device__ __forceinline__ unsigned f2sort(float f) { unsigned u = __float_as_uint(f); return (u & 0x80000000u) ? ~u : (u | 0x80000000u); }
__device__ __forceinline__ float sort2f(unsigned s) { unsigned u = (s & 0x80000000u) ? (s & 0x7FFFFFFFu) : ~s; return __uint_as_float(u); }
__device__ __forceinline__ f32x4 mfma16(bf16x8 a, bf16x8 b, f32x4 c) { return __builtin_amdgcn_mfma_f32_16x16x32_bf16(a, b, c, 0, 0, 0); }
__device__ __forceinline__ float silu_f(float v) { return v / (1.f + __expf(-v)); }
__device__ __forceinline__ bf16x8 ld8(const bf16_t* p) { return *(const bf16x8*)p; }
__device__ __forceinline__ bf16x8 cat4(bf16x4 lo, bf16x4 hi) { return __builtin_shufflevector(lo, hi, 0, 1, 2, 3, 4, 5, 6, 7); }


template <int CTRL, int ROWMASK, bool BC> __device__ __forceinline__ int dpp_i(int v) { return __builtin_amdgcn_update_dpp(0, v, CTRL, ROWMASK, 0xF, BC); }
template <int CTRL, int ROWMASK, bool BC> __device__ __forceinline__ float dpp_f(float v) { return __builtin_bit_cast(float, __builtin_amdgcn_update_dpp(0, __builtin_bit_cast(int, v), CTRL, ROWMASK, 0xF, BC)); }
__device__ __forceinline__ float row_sum(float v) { v += dpp_f<0xB1, 0xF, true>(v); v += dpp_f<0x4E, 0xF, true>(v); v += dpp_f<0x141, 0xF, true>(v); v += dpp_f<0x140, 0xF, true>(v); return v; }
__device__ __forceinline__ unsigned row_sum_u(unsigned v) { v += (unsigned)dpp_i<0xB1, 0xF, true>((int)v); v += (unsigned)dpp_i<0x4E, 0xF, true>((int)v); v += (unsigned)dpp_i<0x141, 0xF, true>((int)v); v += (unsigned)dpp_i<0x140, 0xF, true>((int)v); return v; }
__device__ __forceinline__ unsigned row_max_u(unsigned v) {
    v = max(v, (unsigned)dpp_i<0xB1, 0xF, true>((int)v)); v = max(v, (unsigned)dpp_i<0x4E, 0xF, true>((int)v));
    v = max(v, (unsigned)dpp_i<0x141, 0xF, true>((int)v)); v = max(v, (unsigned)dpp_i<0x140, 0xF, true>((int)v)); return v;
}
__device__ __forceinline__ float wave_sum_u(float v) {
    v = row_sum(v);
    v += dpp_f<0x142, 0xA, false>(v);
    v += dpp_f<0x143, 0xC, false>(v);
    return __builtin_bit_cast(float, __builtin_amdgcn_readlane(__builtin_bit_cast(int, v), 63));
}
typedef unsigned u32x2_t __attribute__((ext_vector_type(2)));
__device__ __forceinline__ float sum_x16(float v) { const u32x2_t r = __builtin_amdgcn_permlane16_swap(__float_as_uint(v), __float_as_uint(v), false, false); return __uint_as_float(r.x) + __uint_as_float(r.y); }
__device__ __forceinline__ float sum_x32(float v) { const u32x2_t r = __builtin_amdgcn_permlane32_swap(__float_as_uint(v), __float_as_uint(v), false, false); return __uint_as_float(r.x) + __uint_as_float(r.y); }
__device__ __forceinline__ float max_x16(float v) { const u32x2_t r = __builtin_amdgcn_permlane16_swap(__float_as_uint(v), __float_as_uint(v), false, false); return fmaxf(__uint_as_float(r.x), __uint_as_float(r.y)); }
__device__ __forceinline__ float max_x32(float v) { const u32x2_t r = __builtin_amdgcn_permlane32_swap(__float_as_uint(v), __float_as_uint(v), false, false); return fmaxf(__uint_as_float(r.x), __uint_as_float(r.y)); }
__device__ __forceinline__ float wave_sum(float v) { return sum_x32(sum_x16(row_sum(v))); }

#define XB_TMO      128
#define XB_XCNT(j)  (256  + 64 * (j))
#define XB_XSUB(j)  (1280 + 64 * (j))
#define XB_XGEN(j)  (2304 + 64 * (j))
#define XB_TOP      3328
#define XB_TOPGEN   3392
#define XCD_BAR_WORDS 3456
#define XB_SPIN_CAP (1u << 22)
#define LAS __attribute__((address_space(3)))
__device__ __forceinline__ unsigned xb_ld(unsigned* p)              { return __hip_atomic_load(p, __ATOMIC_RELAXED, __HIP_MEMORY_SCOPE_AGENT); }
__device__ __forceinline__ unsigned xb_add(unsigned* p, unsigned v) { return __hip_atomic_fetch_add(p, v, __ATOMIC_RELAXED, __HIP_MEMORY_SCOPE_AGENT); }
__device__ __forceinline__ unsigned xb_xcc_id() { return (unsigned)__builtin_amdgcn_s_getreg((3 << 11) | 20) & 0xFu; }
#define XB_SPIN(cond, bar) do { unsigned _sp = 0; while (cond) { __builtin_amdgcn_s_sleep(1); \
    if ((++_sp & 255u) == 0u) { if (xb_ld(&(bar)[XB_TMO])) break; if (_sp > XB_SPIN_CAP) { atomicAdd(&(bar)[XB_TMO], 1u); break; } } } } while (0)
struct XcdBarrier { unsigned* bar; unsigned x; volatile LAS unsigned* st; };
__device__ __forceinline__ XcdBarrier xcd_barrier_post(unsigned* bar, volatile LAS unsigned* st) {
    XcdBarrier b; b.bar = bar; b.x = xb_xcc_id(); b.st = st;
    if (threadIdx.x == 0) st[3] = xb_add(&bar[XB_XCNT(b.x)], 1u);
    return b;
}
__device__ __forceinline__ void xcd_barrier_complete(unsigned* bar, unsigned x, unsigned& nloc, unsigned& nx, unsigned& low8) {
    const unsigned G = gridDim.x * gridDim.y * gridDim.z;
    unsigned sum, cnt, mine, lo, sp = 0u;
    for (;;) {
        sum = 0u; cnt = 0u; mine = 0u; lo = 0u;
#pragma unroll
        for (unsigned j = 0; j < 16; ++j) { const unsigned c = xb_ld(&bar[XB_XCNT(j)]); sum += c; cnt += (c > 0u) ? 1u : 0u; lo += (j < 8u && c > 0u) ? 1u : 0u; mine = (j == x) ? c : mine; }
        if (sum == G) break;
        __builtin_amdgcn_s_sleep(1);
        if ((++sp & 255u) == 0u) { if (xb_ld(&bar[XB_TMO])) break; if (sp > XB_SPIN_CAP) { atomicAdd(&bar[XB_TMO], 1u); break; } }
    }
    nloc = mine > 0u ? mine : 1u; nx = cnt > 0u ? cnt : 1u; low8 = (lo == 8u && cnt == 8u) ? 1u : 0u;
}
__device__ __forceinline__ void xcd_barrier(const XcdBarrier& b) {
    asm volatile("s_waitcnt vmcnt(0)" ::: "memory");
    __syncthreads();
    if (threadIdx.x == 0) {
        unsigned* bar = b.bar;
        __builtin_amdgcn_s_waitcnt(0);
        unsigned nloc = b.st[0], nx = b.st[1];
        if (nloc == 0u) { unsigned low8; xcd_barrier_complete(bar, b.x, nloc, nx, low8); b.st[0] = nloc; b.st[1] = nx; b.st[2] = low8; }
        const unsigned old = xb_add(&bar[XB_XSUB(b.x)], 1u);
        const unsigned gen = old / nloc;
        if (old + 1u == (gen + 1u) * nloc) {
            __builtin_amdgcn_fence(__ATOMIC_RELEASE, "agent");
            asm volatile("s_waitcnt vmcnt(0)" ::: "memory");
            const unsigned og = xb_add(&bar[XB_TOP], 1u);
            const unsigned tg = og / nx;
            if (og + 1u == (tg + 1u) * nx) xb_add(&bar[XB_TOPGEN], 1u);
            else XB_SPIN(xb_ld(&bar[XB_TOPGEN]) == tg, bar);
            __builtin_amdgcn_fence(__ATOMIC_ACQUIRE, "agent");
            xb_add(&bar[XB_XGEN(b.x)], 1u);
            asm volatile("s_waitcnt vmcnt(0)" ::: "memory");
        } else {
            XB_SPIN(xb_ld(&bar[XB_XGEN(b.x)]) == gen, bar);
            __builtin_amdgcn_fence(__ATOMIC_ACQUIRE, "agent");
            asm volatile("s_waitcnt vmcnt(0)" ::: "memory");
        }
    }
    __syncthreads();
}

__device__ __forceinline__ int rot_perm(int gcol, int H) { const int j = (gcol % H) >> 3, e = gcol & 7; return (gcol / H) * H + 4 * j + (e & 3) + ((e >> 2) ? H / 2 : 0); }
__device__ __forceinline__ int win_src_col(int n) {
    if (n < 1024) return rot_perm(n, 64);
    if (n < 1536) return n;
    if (n < 1824) return 1536 + rot_perm(n - 1536, 32);
    if (n < 1832) return n;
    if (n < 1840) return 3368 + (n - 1832);
    if (n < 1856) return -1;
    if (n < 2368) return 1832 + (n - 1856);
    if (n < 3392) return 2344 + (n - 2368);
    return -1;
}
__device__ __forceinline__ void p0_transpose(const float* __restrict__ W, int N, int Nout, bool remap, bf16_t* __restrict__ Wt, int gtid, int gsz) {
    const int items = Nout * 128;
    for (int it = gtid; it < items; it += gsz) {
        const int n = it % Nout, kc = it / Nout;
        const int src = remap ? win_src_col(n) : n;
        unsigned w[4] = {0, 0, 0, 0};
        if (src >= 0) {
            float f[8];
#pragma unroll
            for (int j = 0; j < 8; ++j) f[j] = W[(size_t)(kc * 8 + j) * N + src];
#pragma unroll
            for (int j = 0; j < 4; ++j) w[j] = pack2(f[2 * j], f[2 * j + 1]);
        }
        *(uint4*)(Wt + (size_t)n * 1024 + kc * 8) = make_uint4(w[0], w[1], w[2], w[3]);
    }
}
__device__ __forceinline__ void p0_convert(const float* __restrict__ src, bf16_t* __restrict__ dst, size_t n4, size_t gtid, size_t gsz) {
    for (size_t i = gtid; i < n4; i += gsz) {
        const float4 f = ((const float4*)src)[i];
        ((uint2*)dst)[i] = make_uint2(pack2(f.x, f.y), pack2(f.z, f.w));
    }
}
__device__ __forceinline__ void phase0(const Params& p) {
    const int gtid = blockIdx.x * blockDim.x + tid_op(), gsz = gridDim.x * blockDim.x;
    p0_transpose(p.w_in, 3376, NP, true, (bf16_t*)(p.ws + O_WIN_T), gtid, gsz);
    p0_transpose(p.w_out, 1024, 1024, false, (bf16_t*)(p.ws + O_WOUT_T), gtid, gsz);
    p0_transpose(p.wq, 2048, 2048, false, (bf16_t*)(p.ws + O_WQ_T), gtid, gsz);
    p0_convert(p.k1, (bf16_t*)(p.ws + O_K1B), 128 * 128 / 4, gtid, gsz);
    p0_convert(p.k2, (bf16_t*)(p.ws + O_K2B), 128 * 128 / 4, gtid, gsz);
    p0_convert(p.x, (bf16_t*)(p.ws + O_XB), (size_t)NTOK * DM / 4, gtid, gsz);
    float2* cs64 = (float2*)(p.ws + O_CS64); float2* cs32 = (float2*)(p.ws + O_CS32);
    for (int it = gtid; it < NTOK * 48; it += gsz) {
        const int m = it / 48, i = it % 48;
        const float ps = (float)p.pos[m];
        if (i < 32) { const float inv = powf(10000.f, -(float)(2 * i) / 64.f); const float a = ps * inv; cs64[m * 32 + i] = make_float2(cosf(a), sinf(a)); }
        else { const int k = i - 32; const float inv = powf(10000.f, -(float)(2 * k) / 32.f); const float a = ps * inv; cs32[m * 16 + k] = make_float2(cosf(a), sinf(a)); }
    }
}

struct XcdMap { int slice, rank, nloc; };
__device__ __forceinline__ bool gemm_next_tile(const XcdMap& xm, int it, int ntn, int& tm, int& tn) {
    const int j = xm.rank + xm.nloc * it;
    if (j >= 8 * ntn) return false;
    tm = 8 * xm.slice + j / ntn; tn = j % ntn; return true;
}
#define GEMM_LDK 80
#define GEMM_LDS_A (256 * GEMM_LDK * 2)
#define GEMM_LDS_STAGE (GEMM_LDS_A + 128 * GEMM_LDK * 2)
typedef unsigned u32x4g __attribute__((ext_vector_type(4)));
struct GemmRegs { u32x4g a0, a1, a2, a3, b0, b1; };
__device__ __forceinline__ void gemm_gload(GemmRegs& r, const bf16_t* ga, const bf16_t* gb, size_t astep) {
    r.a0 = *(const u32x4g*)(ga); r.a1 = *(const u32x4g*)(ga + astep); r.a2 = *(const u32x4g*)(ga + 2 * astep); r.a3 = *(const u32x4g*)(ga + 3 * astep);
    r.b0 = *(const u32x4g*)(gb); r.b1 = *(const u32x4g*)(gb + astep);
}
__device__ __forceinline__ void gemm_lstore(const GemmRegs& r, bf16_t* wa, bf16_t* wb) {
    *(u32x4g*)(wa) = r.a0; *(u32x4g*)(wa + 64 * GEMM_LDK) = r.a1; *(u32x4g*)(wa + 128 * GEMM_LDK) = r.a2; *(u32x4g*)(wa + 192 * GEMM_LDK) = r.a3;
    *(u32x4g*)(wb) = r.b0; *(u32x4g*)(wb + 64 * GEMM_LDK) = r.b1;
}
__device__ __forceinline__ void gemm_compute(f32x4 (&acc)[4][4], const bf16_t* sA, const bf16_t* sB, int wm, int wn, int lane) {
#pragma unroll
    for (int ks = 0; ks < 2; ++ks) {
        bf16x8 a[4], b[4];
#pragma unroll
        for (int i = 0; i < 4; ++i) a[i] = ld8(sA + (wm * 64 + i * 16 + (lane & 15)) * GEMM_LDK + ks * 32 + (lane >> 4) * 8);
#pragma unroll
        for (int i = 0; i < 4; ++i) b[i] = ld8(sB + (wn * 64 + i * 16 + (lane & 15)) * GEMM_LDK + ks * 32 + (lane >> 4) * 8);
#pragma unroll
        for (int i = 0; i < 4; ++i)
#pragma unroll
            for (int j = 0; j < 4; ++j) acc[i][j] = mfma16(a[i], b[j], acc[i][j]);
    }
}
template <class Epi>
__device__ __forceinline__ void gemm_tile(const bf16_t* __restrict__ A, const bf16_t* __restrict__ Bt, int K, int m0, int n0, const Epi& epi, char* smem) {
    const int tid = tid_op(), lane = tid & 63, w = tid >> 6, wm = w >> 1, wn = w & 1;
    f32x4 acc[4][4];
#pragma unroll
    for (int i = 0; i < 4; ++i)
#pragma unroll
        for (int j = 0; j < 4; ++j) acc[i][j] = (f32x4){0.f, 0.f, 0.f, 0.f};
    const int lrow = tid >> 3, lkc = (tid & 7) * 8;
    const bf16_t* ga = A + (size_t)(m0 + lrow) * K + lkc;
    const bf16_t* gb = Bt + (size_t)(n0 + lrow) * K + lkc;
    const size_t astep = (size_t)64 * K;
    bf16_t* sA0 = (bf16_t*)smem; bf16_t* sB0 = (bf16_t*)(smem + GEMM_LDS_A);
    bf16_t* sA1 = (bf16_t*)(smem + GEMM_LDS_STAGE); bf16_t* sB1 = (bf16_t*)(smem + GEMM_LDS_STAGE + GEMM_LDS_A);
    const int woff = lrow * GEMM_LDK + lkc;
    GemmRegs r0, r1;
    gemm_gload(r0, ga, gb, astep);
    gemm_gload(r1, ga + 64, gb + 64, astep);
    __syncthreads();
    gemm_lstore(r0, sA0 + woff, sB0 + woff);
    __syncthreads();
    const int nk = K / 64;
    for (int k = 0; k < nk; k += 2) {
        { const int kk = (k + 2 < nk) ? k + 2 : nk - 1; gemm_gload(r0, ga + kk * 64, gb + kk * 64, astep); }
        gemm_compute(acc, sA0, sB0, wm, wn, lane);
        gemm_lstore(r1, sA1 + woff, sB1 + woff);
        __syncthreads();
        { const int kk = (k + 3 < nk) ? k + 3 : nk - 1; gemm_gload(r1, ga + kk * 64, gb + kk * 64, astep); }
        gemm_compute(acc, sA1, sB1, wm, wn, lane);
        gemm_lstore(r0, sA0 + woff, sB0 + woff);
        __syncthreads();
    }
    epi(acc, m0 + wm * 64, n0 + wn * 64, lane, smem + w * 9216);
}

namespace pg8 {
#define PG8_LAS __attribute__((address_space(3)))
typedef unsigned short bf16_t;
typedef short bf16x8 __attribute__((ext_vector_type(8)));
typedef float f32x4 __attribute__((ext_vector_type(4)));
typedef unsigned u32x4 __attribute__((ext_vector_type(4)));
constexpr int BM = 256, BK = 64, HALF = 128, HTB = HALF * BK * 2  , STAGE_BYTES = 8 * HTB, NXCD = 8, WGM = 8;

__host__ __device__ __forceinline__ int lds_byte(int r, int c) { const int st = (r >> 4) * 2 + (c >> 5), rr = r & 15, cc = c & 31, ob = rr * 64 + cc * 2; return st * 1024 + (ob ^ (((ob >> 9) & 1) << 5)); }
__host__ __device__ __forceinline__ void stage_rc(int b, int& R, int& C) { const int st = b / 1024, sb = b % 1024, swz = sb ^ (((sb >> 9) & 1) << 5); R = (st >> 1) * 16 + swz / 64; C = (st & 1) * 32 + (swz % 64) / 2; }
__host__ __device__ __forceinline__ int perm32(int rho) { const int n = rho >> 4, i = rho & 15; return 8 * (i >> 2) + 4 * n + (i & 3); }

struct Unit { int pm, pn; };
struct Gemm { const bf16_t* A; const bf16_t* Bt; int M, N, K; };

struct StaticOrder {
    int nM, nN, nwg, G, c;
    __host__ __device__ void init(int M, int N, int G_, int c_) { nM = M / BM; nN = N / BM; nwg = nM * nN; G = G_; c = c_; }
    __host__ __device__ bool next(int i, Unit& u) const {
        const long L = (long)i * G + c; if (L >= nwg) return false;
        int wgid = (int)L; { const int q = nwg / NXCD, r = nwg % NXCD, xcd = wgid % NXCD, off = wgid / NXCD; wgid = (xcd < r ? xcd * (q + 1) : r * (q + 1) + (xcd - r) * q) + off; }
        const int nig = WGM * nN, gid = wgid / nig, fm = gid * WGM, gsz = (nM - fm) < WGM ? (nM - fm) : WGM;
        u.pm = fm + ((wgid % nig) % gsz); u.pn = (wgid % nig) / gsz; return true;
    }
    __device__ __forceinline__ void a_ready(const Unit&) const {}
    __device__ __forceinline__ void done(const Unit&) const {}
};
__device__ __forceinline__ unsigned cvt_pk_bf16(float lo, float hi) { unsigned r; asm volatile("v_cvt_pk_bf16_f32 %0, %1, %2" : "=v"(r) : "v"(lo), "v"(hi)); return r; }

struct EpiBf16Plain {
    static constexpr bool PERM = true, AFTER_DRAIN = false;
    bf16_t* O; int ldc;
    __device__ __forceinline__ void operator()(const f32x4 (&acc)[2][2][4][2], const Unit& u, int wr, int wc, int fr, int fq) const {
        const int row0 = u.pm * BM + wr * 64 + fr, col0 = u.pn * BM + wc * 32 + 8 * fq;
#pragma unroll
        for (int ai = 0; ai < 2; ++ai)
#pragma unroll
            for (int m = 0; m < 4; ++m) { bf16_t* rowp = O + (size_t)(row0 + ai * HALF + m * 16) * ldc + col0;
#pragma unroll
                for (int bj = 0; bj < 2; ++bj) { const f32x4 v0 = acc[ai][bj][m][0], v1 = acc[ai][bj][m][1];
                    u32x4 w; w.x = cvt_pk_bf16(v0[0], v0[1]); w.y = cvt_pk_bf16(v0[2], v0[3]); w.z = cvt_pk_bf16(v1[0], v1[1]); w.w = cvt_pk_bf16(v1[2], v1[3]);
                    *(u32x4*)(rowp + bj * HALF) = w; } }
    }
};
struct EpiResF32 {
    static constexpr bool PERM = false, AFTER_DRAIN = false;
    float* Y; const float* X; int ldc; float alpha;
    __device__ __forceinline__ void operator()(const f32x4 (&acc)[2][2][4][2], const Unit& u, int wr, int wc, int fr, int fq) const {
        const int row0 = u.pm * BM + wr * 64 + fr, col0 = u.pn * BM + wc * 32 + 4 * fq;
#pragma unroll
        for (int ai = 0; ai < 2; ++ai)
#pragma unroll
            for (int m = 0; m < 4; ++m) { const size_t ro = (size_t)(row0 + ai * HALF + m * 16) * ldc + col0;
#pragma unroll
                for (int bj = 0; bj < 2; ++bj)
#pragma unroll
                    for (int n = 0; n < 2; ++n) { const f32x4 xv = *(const f32x4*)(X + ro + bj * HALF + n * 16); *(f32x4*)(Y + ro + bj * HALF + n * 16) = xv * alpha + acc[ai][bj][m][n]; } }
    }
};
template <class Epi, class Sched, bool STAMP = false>
__device__ __forceinline__ void gemm_phase(PG8_LAS unsigned char* lds, const Gemm g, const Sched& S, const Epi& E, unsigned long long* stamps) {
    const int tid = tid_op(), wid = __builtin_amdgcn_readfirstlane(tid >> 6), lane = tid & 63, wr = wid >> 2, wc = wid & 3, fr = lane & 15, fq = lane >> 4;
    const int K = g.K, nt = K / BK;
    int ts_lo = 0, ts_hi = 0, nts = 0; const unsigned long long rt_entry = STAMP ? (unsigned long long)wall_clock64() : 0ull;
#define PG8_STAMP() do { if (STAMP && wid == 0 && nts < 64) { const unsigned long long _c = (unsigned long long)clock64(); \
        ts_lo = (lane == nts) ? (int)(unsigned)_c : ts_lo; ts_hi = (lane == nts) ? (int)(unsigned)(_c >> 32) : ts_hi; ++nts; } } while (0)
    PG8_STAMP();
    unsigned voffA[2], voffB[2];
#pragma unroll
    for (int i = 0; i < 2; ++i) { int R, C; stage_rc(tid * 16 + i * 8192, R, C); const int Rb = Epi::PERM ? ((R & ~31) + perm32(R & 31)) : R;
        voffA[i] = (unsigned)(R * K + C) * 2u; voffB[i] = (unsigned)(Rb * K + C) * 2u; }
    const size_t kstep = (size_t)(BK * 2);
    const size_t hstep = (size_t)HALF * K * 2;
    const size_t tstep = 2 * hstep;
    const unsigned ldsw = (unsigned)wid * 1024u;
    const int aoff = lds_byte(wr * 64 + fr, fq * 8), boff = lds_byte(wc * 32 + fr, fq * 8);
#define PG8_SA(b, h) (((b) * 2 + (h)) * HTB)
#define PG8_SB(b, h) ((4 + (b) * 2 + (h)) * HTB)
#define PG8_STAGE(bufoff, gbase, voff) do { _Pragma("unroll") for (int _i = 0; _i < 2; ++_i) \
        __builtin_amdgcn_global_load_lds((const unsigned*)((const char*)(gbase) + (voff)[_i]), (PG8_LAS unsigned*)(lds + (bufoff) + ldsw + _i * 8192), 16, 0, 0); } while (0)
#define PG8_LDA(dst, b, h) do { _Pragma("unroll") for (int m = 0; m < 4; ++m) _Pragma("unroll") for (int k = 0; k < 2; ++k) dst[m][k] = *(const PG8_LAS bf16x8*)(lds + PG8_SA(b, h) + aoff + m * 2048 + k * 1024); } while (0)
#define PG8_LDB(dst, b, h) do { _Pragma("unroll") for (int n = 0; n < 2; ++n) _Pragma("unroll") for (int k = 0; k < 2; ++k) dst[n][k] = *(const PG8_LAS bf16x8*)(lds + PG8_SB(b, h) + boff + n * 2048 + k * 1024); } while (0)
#define PG8_MMA(ai, bj, At, Bt) do { __builtin_amdgcn_s_setprio(1); _Pragma("unroll") for (int m = 0; m < 4; ++m) _Pragma("unroll") for (int n = 0; n < 2; ++n) _Pragma("unroll") for (int k = 0; k < 2; ++k) \
        acc[ai][bj][m][n] = __builtin_amdgcn_mfma_f32_16x16x32_bf16(Bt[n][k], At[m][k], acc[ai][bj][m][n], 0, 0, 0); __builtin_amdgcn_s_setprio(0); } while (0)
#define PG8_WAIT_V(n) asm volatile("s_waitcnt vmcnt(" #n ")" ::: "memory")
#define PG8_WAIT_L(n) asm volatile("s_waitcnt lgkmcnt(" #n ")" ::: "memory")
#define PG8_BAR __builtin_amdgcn_s_barrier()
#define PG8_SCHED __builtin_amdgcn_sched_barrier(0)
    Unit cur, nxt; int ui = 0;
    if (!S.next(0, cur)) return;
    f32x4 acc[2][2][4][2];
#pragma unroll
    for (int a = 0; a < 2; ++a)
#pragma unroll
        for (int b = 0; b < 2; ++b)
#pragma unroll
            for (int m = 0; m < 4; ++m)
#pragma unroll
                for (int n = 0; n < 2; ++n) acc[a][b][m][n] = (f32x4){0.f, 0.f, 0.f, 0.f};
    bf16x8 At[4][2], B0[2][2], B1[2][2];
    const char* cA = (const char*)g.A + (size_t)cur.pm * tstep; const char* cB = (const char*)g.Bt + (size_t)cur.pn * tstep;
    S.a_ready(cur);
    PG8_STAGE(PG8_SB(0, 0), cB, voffB); PG8_STAGE(PG8_SA(0, 0), cA, voffA); PG8_STAGE(PG8_SB(0, 1), cB + hstep, voffB); PG8_STAGE(PG8_SA(0, 1), cA + hstep, voffA);
    if (wr == 1) PG8_BAR;
    PG8_WAIT_V(4); PG8_BAR;
    PG8_STAGE(PG8_SB(1, 0), cB + kstep, voffB); PG8_STAGE(PG8_SA(1, 0), cA + kstep, voffA); PG8_STAGE(PG8_SB(1, 1), cB + hstep + kstep, voffB);
    PG8_WAIT_V(6); PG8_BAR;
    PG8_STAMP();
    for (;;) {
        const bool has_next = S.next(ui + 1, nxt);
        const char* nA = has_next ? (const char*)g.A + (size_t)nxt.pm * tstep : cA; const char* nB = has_next ? (const char*)g.Bt + (size_t)nxt.pn * tstep : cB;
        for (int t = 0; t < nt; t += 2) {
            const bool last = (t == nt - 2);
            const char* a1 = cA + (size_t)(t + 1) * kstep;
            const char* a2 = last ? nA : cA + (size_t)(t + 2) * kstep; const char* b2 = last ? nB : cB + (size_t)(t + 2) * kstep;
            const char* a3 = a2 + kstep; const char* b3 = b2 + kstep;
            if (last && has_next) S.a_ready(nxt);
            PG8_LDB(B0, 0, 0); PG8_SCHED; PG8_LDA(At, 0, 0); PG8_STAGE(PG8_SA(1, 1), a1 + hstep, voffA);
            PG8_WAIT_L(8); PG8_BAR; PG8_WAIT_L(0); PG8_MMA(0, 0, At, B0); PG8_BAR; PG8_SCHED;
            PG8_LDB(B1, 0, 1); PG8_STAGE(PG8_SB(0, 0), b2, voffB);
            PG8_BAR; PG8_WAIT_L(0); PG8_MMA(0, 1, At, B1); PG8_BAR;
            PG8_LDA(At, 0, 1); PG8_STAGE(PG8_SA(0, 0), a2, voffA);
            PG8_BAR; PG8_WAIT_L(0); PG8_MMA(1, 0, At, B0); PG8_BAR; PG8_SCHED;
            PG8_STAGE(PG8_SB(0, 1), b2 + hstep, voffB);
            PG8_WAIT_V(6); PG8_BAR; PG8_MMA(1, 1, At, B1); PG8_BAR;
            PG8_LDB(B0, 1, 0); PG8_SCHED; PG8_LDA(At, 1, 0); PG8_STAGE(PG8_SA(0, 1), a2 + hstep, voffA);
            PG8_WAIT_L(8); PG8_BAR; PG8_WAIT_L(0); PG8_MMA(0, 0, At, B0); PG8_BAR; PG8_SCHED;
            PG8_LDB(B1, 1, 1); PG8_STAGE(PG8_SB(1, 0), b3, voffB);
            PG8_BAR; PG8_WAIT_L(0); PG8_MMA(0, 1, At, B1); PG8_BAR;
            PG8_LDA(At, 1, 1); PG8_STAGE(PG8_SA(1, 0), a3, voffA);
            PG8_BAR; PG8_WAIT_L(0); PG8_MMA(1, 0, At, B0); PG8_BAR; PG8_SCHED;
            PG8_STAGE(PG8_SB(1, 1), b3 + hstep, voffB);
            PG8_WAIT_V(6); PG8_BAR; PG8_MMA(1, 1, At, B1); PG8_BAR;
        }
        PG8_STAMP();
        if constexpr (!Epi::AFTER_DRAIN) { E(acc, cur, wr, wc, fr, fq); S.done(cur); }
        PG8_STAMP();
        if (!has_next) break;
#pragma unroll
        for (int a = 0; a < 2; ++a)
#pragma unroll
            for (int b = 0; b < 2; ++b)
#pragma unroll
                for (int m = 0; m < 4; ++m)
#pragma unroll
                    for (int n = 0; n < 2; ++n) acc[a][b][m][n] = (f32x4){0.f, 0.f, 0.f, 0.f};
        cur = nxt; cA = nA; cB = nB; ++ui;
    }
    PG8_WAIT_V(0);
    if (wr == 0) PG8_BAR;
    PG8_BAR;
    if constexpr (Epi::AFTER_DRAIN) { E.fused(acc, cur, wr, wc, fr, fq, lds, wid, lane); S.done(cur); }
    PG8_STAMP();
    if (STAMP && wid == 0) { stamps[lane] = lane < nts ? (((unsigned long long)(unsigned)ts_hi << 32) | (unsigned)ts_lo) : 0ull;
        if (lane == 62) stamps[62] = rt_entry; if (lane == 63) stamps[63] = (unsigned long long)wall_clock64(); }
#undef PG8_STAMP
#undef PG8_SA
#undef PG8_SB
#undef PG8_STAGE
#undef PG8_LDA
#undef PG8_LDB
#undef PG8_MMA
#undef PG8_WAIT_V
#undef PG8_WAIT_L
#undef PG8_BAR
#undef PG8_SCHED
}
}

struct ProjEpi8 {
    static constexpr bool PERM = true, AFTER_DRAIN = false;
    char* ws; const float* dt_bias;
    __device__ __forceinline__ uint4 rot8(const pg8::f32x4 v0, const pg8::f32x4 v1, const float* tab, float sc) const {
        const float4 c01 = *(const float4*)tab, c23 = *(const float4*)(tab + 4);
        const float o10 = (v0[0] * c01.x - v1[0] * c01.y) * sc, o11 = (v0[1] * c01.z - v1[1] * c01.w) * sc, o12 = (v0[2] * c23.x - v1[2] * c23.y) * sc, o13 = (v0[3] * c23.z - v1[3] * c23.w) * sc;
        const float o20 = (v1[0] * c01.x + v0[0] * c01.y) * sc, o21 = (v1[1] * c01.z + v0[1] * c01.w) * sc, o22 = (v1[2] * c23.x + v0[2] * c23.y) * sc, o23 = (v1[3] * c23.z + v0[3] * c23.w) * sc;
        return make_uint4(pack2(o10, o11), pack2(o12, o13), pack2(o20, o21), pack2(o22, o23));
    }
    template <int SEG> __device__ __forceinline__ void store_row(const pg8::f32x4 v0, const pg8::f32x4 v1, const int cg, const int row) const {
        const int b = row >> 11, t = row & 2047;
        if (SEG == 0) {
            const bool isq = cg < 512; const int head = (cg & 511) >> 6, j = (cg & 63) >> 3;
            bf16_t* dst = (bf16_t*)(ws + (isq ? O_QB : O_KB)) + ((size_t)(b * 8 + head) * 2048 + t) * 64 + 8 * j;
            *(uint4*)dst = rot8(v0, v1, (const float*)(ws + O_CS64) + ((size_t)row * 32 + 4 * j) * 2, isq ? 0.125f * 1.4426950408889634f : 1.f);
        } else if (SEG == 1) {
            bf16_t* dst = (bf16_t*)(ws + O_VT) + ((size_t)(b * 8 + ((cg - 1024) >> 6)) * 64 + (cg & 63)) * 2048 + t;
#pragma unroll
            for (int e = 0; e < 4; ++e) { dst[(size_t)e * 2048] = f2bf(v0[e]); dst[(size_t)(e + 4) * 2048] = f2bf(v1[e]); }
        } else if (SEG == 2) {
            const int j = (cg & 31) >> 3;
            *(uint4*)((bf16_t*)(ws + O_IQB) + ((size_t)row * 8 + ((cg - 1536) >> 5)) * 32 + 8 * j) = rot8(v0, v1, (const float*)(ws + O_CS32) + ((size_t)row * 16 + 4 * j) * 2, 0.17677669529663687f);
        } else if (SEG == 3) {
            if (cg < 1824) {
                const int j = (cg & 31) >> 3;
                *(uint4*)((bf16_t*)(ws + O_IKB) + (size_t)row * 32 + 8 * j) = rot8(v0, v1, (const float*)(ws + O_CS32) + ((size_t)row * 16 + 4 * j) * 2, 1.f);
            } else if (cg == 1824) {
                const float k8 = 0.35355339059327373f; float* d = (float*)(ws + O_IWF) + (size_t)row * 8;
                *(float4*)d = make_float4(v0[0] * k8, v0[1] * k8, v0[2] * k8, v0[3] * k8); *(float4*)(d + 4) = make_float4(v1[0] * k8, v1[1] * k8, v1[2] * k8, v1[3] * k8);
            } else if (cg == 1832) {
                float o[8];
#pragma unroll
                for (int e = 0; e < 4; ++e) { const float a0 = v0[e] + dt_bias[e], a1 = v1[e] + dt_bias[4 + e]; o[e] = (a0 > 20.f) ? a0 : __logf(1.f + __expf(a0)); o[4 + e] = (a1 > 20.f) ? a1 : __logf(1.f + __expf(a1)); }
                float* d = (float*)(ws + O_DTF) + (size_t)row * 8;
                *(float4*)d = make_float4(o[0], o[1], o[2], o[3]); *(float4*)(d + 4) = make_float4(o[4], o[5], o[6], o[7]);
            }
        } else if (SEG == 4) {
            *(uint4*)((bf16_t*)(ws + O_ZB) + (size_t)row * 512 + (cg - ZOFF)) = make_uint4(pack2(v0[0], v0[1]), pack2(v0[2], v0[3]), pack2(v1[0], v1[1]), pack2(v1[2], v1[3]));
        } else {
            bf16_t* dst = (bf16_t*)(ws + O_XBCT) + ((size_t)b * 1024 + (cg - XBCOFF)) * 2048 + t;
#pragma unroll
            for (int e = 0; e < 4; ++e) { dst[(size_t)e * 2048] = f2bf(v0[e]); dst[(size_t)(e + 4) * 2048] = f2bf(v1[e]); }
        }
    }
    template <int SEG, int BJ> __device__ __forceinline__ void rows8(const pg8::f32x4 (&acc)[2][2][4][2], const int cg, const int row0) const {
#pragma unroll
        for (int ai = 0; ai < 2; ++ai)
#pragma unroll
            for (int m = 0; m < 4; ++m) store_row<SEG>(acc[ai][BJ][m][0], acc[ai][BJ][m][1], cg, row0 + ai * 128 + m * 16);
    }
    template <int BJ> __device__ __forceinline__ void half(const pg8::f32x4 (&acc)[2][2][4][2], const pg8::Unit& u, int wr, int wc, int fr, int fq) const {
        const int cw = u.pn * 256 + BJ * 128 + wc * 32;
        const int cg = cw + 8 * fq, row0 = u.pm * 256 + wr * 64 + fr;
        if (cw < 1024) rows8<0, BJ>(acc, cg, row0);
        else if (cw < 1536) rows8<1, BJ>(acc, cg, row0);
        else if (cw < 1792) rows8<2, BJ>(acc, cg, row0);
        else if (cw < 1856) rows8<3, BJ>(acc, cg, row0);
        else if (cw < 2368) rows8<4, BJ>(acc, cg, row0);
        else if (cw < NUSED) rows8<5, BJ>(acc, cg, row0);
    }
    __device__ __forceinline__ void operator()(const pg8::f32x4 (&acc)[2][2][4][2], const pg8::Unit& u, int wr, int wc, int fr, int fq) const {
        half<0>(acc, u, wr, wc, fr, fq); half<1>(acc, u, wr, wc, fr, fq);
    }
};
__device__ __forceinline__ void phase1(const Params& p, char* smem, const XcdMap xm) {
    char* ws = p.ws;
    ProjEpi8 e; e.ws = ws; e.dt_bias = p.dt_bias;
    pg8::Gemm g{(const bf16_t*)(ws + O_XB), (const bf16_t*)(ws + O_WIN_T), NTOK, NP, 1024};
    pg8::StaticOrder S; S.init(NTOK, NP, (int)gridDim.x, (int)blockIdx.x);
    pg8::gemm_phase<ProjEpi8, pg8::StaticOrder, false>((PG8_LAS unsigned char*)smem, g, S, e, nullptr);
}

#define IDX_NT 16
#define IDX_LDS_SCORES (16 * 2048 * 4)
__device__ __forceinline__ unsigned wave_sum_cnt(unsigned v) {
    v = row_sum_u(v);
    v += (unsigned)dpp_i<0x142, 0xA, false>((int)v);
    v += (unsigned)dpp_i<0x143, 0xC, false>((int)v);
    return (unsigned)__builtin_amdgcn_readlane((int)v, 63);
}
template <int NR> __device__ __forceinline__ unsigned idx_count_ge(const unsigned (&k)[NR], unsigned cand) {
    unsigned n = 0u;
#pragma unroll
    for (int i = 0; i < NR; ++i) n += (k[i] >= cand) ? 1u : 0u;
    return wave_sum_cnt(n);
}
template <int NR> __device__ __forceinline__ unsigned long long idx_words(const unsigned (&k)[NR], unsigned K, bool exact, int lane) {
    unsigned long long wd = 0ull;
    if (exact) {
#pragma unroll
        for (int i = 0; i < NR; ++i) { const unsigned long long bal = __ballot(k[i] >= K); if (lane == i) wd = bal; }
    } else {
        unsigned n = 0u;
#pragma unroll
        for (int i = 0; i < NR; ++i) n += (k[i] > K) ? 1u : 0u;
        unsigned rem = 256u - wave_sum_cnt(n);
#pragma unroll 1
        for (int i = 0; i < NR; ++i) {
            unsigned ki = k[0];
#pragma unroll
            for (int j = 1; j < NR; ++j) ki = (j == i) ? k[j] : ki;
            const unsigned long long gt = __ballot(ki > K), eq = __ballot(ki == K);
            unsigned long long take = 0ull, e = eq;
            while (rem > 0u && e) { take |= e & (~e + 1ull); e &= e - 1ull; --rem; }
            if (lane == i) wd = gt | take;
        }
    }
    return wd;
}
template <int NR> __device__ __forceinline__ void idx_select(const unsigned* Sa, unsigned long long* mrow, int lane) {
    unsigned ka[NR], kb[NR];
#pragma unroll
    for (int i = 0; i < NR; ++i) { ka[i] = Sa[64 * i]; kb[i] = Sa[2048 + 64 * i]; }
    unsigned Ka = 0u, Kb = 0u; bool da = false, db = false;
    for (int bit = 31; bit >= 0; --bit) {
        const unsigned ca = Ka | (1u << bit), cb = Kb | (1u << bit);
        const unsigned ta = idx_count_ge<NR>(ka, ca), tb = idx_count_ge<NR>(kb, cb);
        if (!da && ta >= 256u) { Ka = ca; da = (ta == 256u); }
        if (!db && tb >= 256u) { Kb = cb; db = (tb == 256u); }
        if (da && db) break;
    }
    const unsigned long long wa = idx_words<NR>(ka, Ka, da, lane), wb = idx_words<NR>(kb, Kb, db, lane);
    if (lane < NR) { mrow[lane] = wa; mrow[32 + lane] = wb; }
}
__device__ __forceinline__ void indexer_unit(const Params& p, int unit, char* smem) {
    const int tid = tid_op(), lane = tid & 63, w = tid >> 6, c = lane & 15, g = lane >> 4;
    const int b = unit & 7, grp = 127 - (unit >> 3), t0 = grp * 16;
    char* ws = p.ws;
    unsigned long long* mask64 = (unsigned long long*)(ws + O_MASK) + (size_t)(b * 2048 + t0) * 32;
    const int nblk64 = (t0 + 16 + 63) >> 6;
    if (t0 < 256) {
        for (int i = tid; i < 16 * nblk64; i += 512) {
            const int q = i / nblk64, wd = i % nblk64, t = t0 + q, s0 = wd * 64;
            const unsigned long long bits = (t >= s0 + 63) ? ~0ull : (t < s0 ? 0ull : ((1ull << (t - s0 + 1)) - 1ull));
            mask64[q * 32 + wd] = bits;
        }
        return;
    }
    const int ntile = (nblk64 + 1) >> 1;
    const bf16_t* IQb = (const bf16_t*)(ws + O_IQB); const bf16_t* IKb = (const bf16_t*)(ws + O_IKB); const float* IWf = (const float*)(ws + O_IWF);
    unsigned* S = (unsigned*)smem;
    float* siw = (float*)(smem + IDX_LDS_SCORES);
    __syncthreads();
    if (tid < 128) siw[tid] = IWf[(size_t)(b * 2048 + t0) * 8 + tid];
    {
        const int nr = (nblk64 <= 8) ? 8 : (nblk64 <= 16) ? 16 : (nblk64 <= 24) ? 24 : 32, kfrom = 8 * ntile * 16, kto = nr * 64;
        for (int i = tid; i < 16 * (kto - kfrom); i += 512) { const int q = i / (kto - kfrom), k = kfrom + i % (kto - kfrom); S[q * 2048 + k] = 0u; }
    }
    __syncthreads();
    {
        bf16x8 aq[8];
#pragma unroll
        for (int h = 0; h < 8; ++h) aq[h] = ld8(IQb + ((size_t)(b * 2048 + t0 + c) * 8 + h) * 32 + g * 8);
        float wq[4][8];
#pragma unroll
        for (int r = 0; r < 4; ++r)
#pragma unroll
            for (int h = 0; h < 8; ++h) wq[r][h] = siw[(4 * g + r) * 8 + h];
        bf16x8 bk[IDX_NT];
#pragma unroll
        for (int i = 0; i < IDX_NT; ++i) {
            const int ti = (i < ntile) ? (w * ntile + i) : (w * ntile);
            bk[i] = ld8(IKb + (size_t)(b * 2048 + ti * 16 + c) * 32 + g * 8);
        }
#pragma unroll
        for (int i = 0; i < IDX_NT; ++i) {
            if (i < ntile) {
                const int s0 = (w * ntile + i) * 16;
                float sc[4] = {0.f, 0.f, 0.f, 0.f};
#pragma unroll
                for (int h = 0; h < 8; ++h) {
                    const f32x4 o = mfma16(aq[h], bk[i], (f32x4){0.f, 0.f, 0.f, 0.f});
#pragma unroll
                    for (int r = 0; r < 4; ++r) sc[r] += wq[r][h] * fmaxf(o[r], 0.f);
                }
#pragma unroll
                for (int r = 0; r < 4; ++r) S[(4 * g + r) * 2048 + s0 + c] = (s0 + c <= t0 + 4 * g + r) ? f2sort(sc[r]) : 0u;
            }
        }
    }
    __syncthreads();
    if (nblk64 <= 8) idx_select<8>(S + (2 * w) * 2048 + lane, mask64 + (2 * w) * 32, lane);
    else if (nblk64 <= 16) idx_select<16>(S + (2 * w) * 2048 + lane, mask64 + (2 * w) * 32, lane);
    else if (nblk64 <= 24) idx_select<24>(S + (2 * w) * 2048 + lane, mask64 + (2 * w) * 32, lane);
    else idx_select<32>(S + (2 * w) * 2048 + lane, mask64 + (2 * w) * 32, lane);
}

__device__ __forceinline__ void ssd_prep_unit(const Params& p, int unit, char* smem) {
    const int tid = tid_op(), lane = tid & 63, w = tid >> 6, cL = lane & 15, gq = lane >> 4;
    const int h = unit & 7, c = (unit >> 3) & 15, b = unit >> 7, g = h >> 2;
    char* ws = p.ws;
    float* s_acum = (float*)smem; float* s_dt = s_acum + 128; float* s_w = s_dt + 128;
    bf16_t* sXw = (bf16_t*)(smem + 2048); bf16_t* sBt = sXw + 64 * 136;
    const int tok0 = b * 2048 + c * 128;
    const float a_h = -expf(p.a_log[h]);
    const float* DTf = (const float*)(ws + O_DTF);
    __syncthreads();
    if (tid < 128) s_dt[tid] = DTf[(size_t)(tok0 + tid) * 8 + h];
    __syncthreads();
    if (tid < 128) {
        float s = 0.f;
        for (int k = 0; k <= tid; ++k) s += s_dt[k] * a_h;
        s_acum[tid] = s;
        ((float*)(ws + O_ACUM))[(size_t)(b * 8 + h) * 2048 + c * 128 + tid] = s;
    }
    __syncthreads();
    if (tid < 128) {
        const float tot = s_acum[127];
        s_w[tid] = s_dt[tid] * __expf(tot - s_acum[tid]);
        if (tid == 0) ((float*)(ws + O_ATOT))[(b * 8 + h) * 16 + c] = tot;
    }
    __syncthreads();
    const bf16_t* XBCt = (const bf16_t*)(ws + O_XBCT);
    bf16_t* Xt = (bf16_t*)(ws + O_XT); bf16_t* Brm = (bf16_t*)(ws + O_BRM); bf16_t* Crm = (bf16_t*)(ws + O_CRM);
#pragma unroll
    for (int bt = 0; bt < 2; ++bt) {
    const int it0 = bt * 4, itn = bt ? 3 : 4;
    u32x4g cur7[4], prv7[4]; float cw7[4][5];
#pragma unroll
    for (int it = 0; it < 4; ++it) if (it < itn) {
        const int item = tid + 512 * (it0 + it);
        int ch; const int tc = item & 15;
        if (item < 1024) ch = h * 64 + (item >> 4);
        else if (item < 3072) ch = 512 + g * 128 + ((item - 1024) >> 4);
        else ch = 768 + g * 128 + (h & 3) * 32 + ((item - 3072) >> 4);
        const bf16_t* src = XBCt + ((size_t)b * 1024 + ch) * 2048 + c * 128 + tc * 8;
        cur7[it] = *(const u32x4g*)src;
        const bool hasprev = (c * 128 + tc * 8 >= 8);
        prv7[it] = *(const u32x4g*)(hasprev ? src - 8 : src);
        if (!hasprev) prv7[it] = (u32x4g){0u, 0u, 0u, 0u};
        cw7[it][0] = p.conv_w[ch]; cw7[it][1] = p.conv_w[1024 + ch]; cw7[it][2] = p.conv_w[2048 + ch]; cw7[it][3] = p.conv_w[3072 + ch]; cw7[it][4] = p.conv_b[ch];
    }
#pragma unroll
    for (int it = 0; it < 4; ++it) if (it < itn) {
        const int item = tid + 512 * (it0 + it);
        int kind, idx, ch; const int tc = item & 15;
        if (item < 1024) { kind = 0; idx = item >> 4; ch = h * 64 + idx; }
        else if (item < 3072) { kind = 1; idx = (item - 1024) >> 4; ch = 512 + g * 128 + idx; }
        else { kind = 2; idx = (h & 3) * 32 + ((item - 3072) >> 4); ch = 768 + g * 128 + idx; }
        const u32x4g cur = cur7[it], prv = prv7[it];
        float xv[11];
        xv[0] = bf2f((bf16_t)(prv.z >> 16)); xv[1] = bf2f((bf16_t)(prv.w & 0xFFFF)); xv[2] = bf2f((bf16_t)(prv.w >> 16));
        xv[3] = bf2f((bf16_t)(cur.x & 0xFFFF)); xv[4] = bf2f((bf16_t)(cur.x >> 16)); xv[5] = bf2f((bf16_t)(cur.y & 0xFFFF)); xv[6] = bf2f((bf16_t)(cur.y >> 16));
        xv[7] = bf2f((bf16_t)(cur.z & 0xFFFF)); xv[8] = bf2f((bf16_t)(cur.z >> 16)); xv[9] = bf2f((bf16_t)(cur.w & 0xFFFF)); xv[10] = bf2f((bf16_t)(cur.w >> 16));
        const float w0 = cw7[it][0], w1 = cw7[it][1], w2 = cw7[it][2], w3 = cw7[it][3], bias = cw7[it][4];
        float o[8];
#pragma unroll
        for (int j = 0; j < 8; ++j) { const float v = bias + w0 * xv[j] + w1 * xv[j + 1] + w2 * xv[j + 2] + w3 * xv[j + 3]; o[j] = bf2f(f2bf(silu_f(v))); }
        if (kind == 0) {
            *(uint4*)(Xt + ((size_t)b * 512 + ch) * 2048 + c * 128 + tc * 8) = make_uint4(pack2(o[0], o[1]), pack2(o[2], o[3]), pack2(o[4], o[5]), pack2(o[6], o[7]));
            float q[8];
#pragma unroll
            for (int j = 0; j < 8; ++j) q[j] = o[j] * s_w[tc * 8 + j];
            *(uint4*)(sXw + idx * 136 + tc * 8) = make_uint4(pack2(q[0], q[1]), pack2(q[2], q[3]), pack2(q[4], q[5]), pack2(q[6], q[7]));
        } else if (kind == 1) {
            *(uint4*)(sBt + idx * 136 + tc * 8) = make_uint4(pack2(o[0], o[1]), pack2(o[2], o[3]), pack2(o[4], o[5]), pack2(o[6], o[7]));
            if ((h & 3) == 0) {
#pragma unroll
                for (int j = 0; j < 8; ++j) Brm[(size_t)(tok0 + tc * 8 + j) * 256 + g * 128 + idx] = f2bf(o[j]);
            }
        } else {
#pragma unroll
            for (int j = 0; j < 8; ++j) Crm[(size_t)(tok0 + tc * 8 + j) * 256 + g * 128 + idx] = f2bf(o[j]);
        }
    }
    }
    __syncthreads();
    f32x4 acc[4];
#pragma unroll
    for (int i = 0; i < 4; ++i) acc[i] = (f32x4){0.f, 0.f, 0.f, 0.f};
#pragma unroll
    for (int ks = 0; ks < 4; ++ks) {
        const bf16x8 bb = ld8(sBt + (16 * w + cL) * 136 + ks * 32 + gq * 8);
#pragma unroll
        for (int pt = 0; pt < 4; ++pt) acc[pt] = mfma16(ld8(sXw + (16 * pt + cL) * 136 + ks * 32 + gq * 8), bb, acc[pt]);
    }
    float* ST = (float*)(ws + O_ST) + ((size_t)((b * 16 + c) * 8 + h)) * 8192;
#pragma unroll
    for (int pt = 0; pt < 4; ++pt)
#pragma unroll
        for (int r = 0; r < 4; ++r) ST[(16 * pt + 4 * gq + r) * 128 + 16 * w + cL] = acc[pt][r];
}

__device__ __forceinline__ void phase2c(const Params& p) {
    char* ws = p.ws;
    const int idx = blockIdx.x * 512 + tid_op();
    if (idx >= 64 * 2048) return;
    const int bh = idx >> 11, e4 = idx & 2047, b = bh >> 3, h = bh & 7;
    const float* ST = (const float*)(ws + O_ST); const float* ATOT = (const float*)(ws + O_ATOT);
    float4 sv[16]; float4 at4[4];
#pragma unroll
    for (int c = 0; c < 16; ++c) sv[c] = *(const float4*)(ST + ((size_t)((b * 16 + c) * 8 + h)) * 8192 + (size_t)e4 * 4);
#pragma unroll
    for (int k = 0; k < 4; ++k) at4[k] = *(const float4*)(ATOT + bh * 16 + 4 * k);
    const float at[16] = {at4[0].x, at4[0].y, at4[0].z, at4[0].w, at4[1].x, at4[1].y, at4[1].z, at4[1].w, at4[2].x, at4[2].y, at4[2].z, at4[2].w, at4[3].x, at4[3].y, at4[3].z, at4[3].w};
    float4 car = make_float4(0.f, 0.f, 0.f, 0.f);
    bf16_t* CAR = (bf16_t*)(ws + O_CAR);
#pragma unroll
    for (int c = 0; c < 16; ++c) {
        *(uint2*)(CAR + ((size_t)((b * 16 + c) * 8 + h)) * 8192 + (size_t)e4 * 4) = make_uint2(pack2(car.x, car.y), pack2(car.z, car.w));
        const float dec = __expf(at[c]);
        car.x = dec * car.x + sv[c].x; car.y = dec * car.y + sv[c].y; car.z = dec * car.z + sv[c].z; car.w = dec * car.w + sv[c].w;
    }
}

#define ATT_LDK 80
#define ATT_LDV 136
#define ATT_KBYTES (128 * ATT_LDK * 2)
#define ATT_VBYTES (64 * ATT_LDV * 2)
__device__ __forceinline__ void attn_unit(const Params& p, int unit, char* smem) {
    const int tid = tid_op(), lane = tid & 63, w = tid >> 6, cL = lane & 15, gq = lane >> 4;
    const int qb = 15 - (unit >> 6), bh = unit & 63, b = bh >> 3, h = bh & 7;
    char* ws = p.ws;
    const int q0 = qb * 128 + 16 * w;
    const int ntile = qb + 1;
    const int wmax = (q0 + 15) >> 6;
    const bf16_t* Q = (const bf16_t*)(ws + O_QB) + (size_t)bh * 2048 * 64;
    const bf16_t* Kp = (const bf16_t*)(ws + O_KB) + (size_t)bh * 2048 * 64;
    const bf16_t* V = (const bf16_t*)(ws + O_VT) + (size_t)bh * 64 * 2048;
    const unsigned long long* mrow = (const unsigned long long*)(ws + O_MASK) + (size_t)(b * 2048 + q0 + cL) * 32;
    const int lr = tid >> 3, lc = (tid & 7) * 8;
    bf16x8 qf[2];
    qf[0] = ld8(Q + (size_t)(q0 + cL) * 64 + gq * 8); qf[1] = ld8(Q + (size_t)(q0 + cL) * 64 + 32 + gq * 8);
    float m_run = -1e30f, l_run = 0.f;
    f32x4 o[4];
#pragma unroll
    for (int i = 0; i < 4; ++i) o[i] = (f32x4){0.f, 0.f, 0.f, 0.f};
    char* sK = smem; char* sV = smem + 2 * ATT_KBYTES;
#define ATT_GLOAD(T, K0, K1, V0, V1) { const int s_ = (T) * 128; \
        K0 = *(const u32x4g*)(Kp + (size_t)(s_ + lr) * 64 + lc); K1 = *(const u32x4g*)(Kp + (size_t)(s_ + 64 + lr) * 64 + lc); \
        V0 = *(const u32x4g*)(V + (size_t)lr * 2048 + s_ + lc); V1 = *(const u32x4g*)(V + (size_t)lr * 2048 + s_ + 64 + lc); }
#define ATT_LSTORE(BUF, K0, K1, V0, V1) { bf16_t* k_ = (bf16_t*)(sK + (BUF) * ATT_KBYTES); bf16_t* v_ = (bf16_t*)(sV + (BUF) * ATT_VBYTES); \
        *(u32x4g*)(k_ + lr * ATT_LDK + lc) = K0; *(u32x4g*)(k_ + (64 + lr) * ATT_LDK + lc) = K1; \
        *(u32x4g*)(v_ + lr * ATT_LDV + lc) = V0; *(u32x4g*)(v_ + lr * ATT_LDV + 64 + lc) = V1; }
    u32x4g ka0, ka1, va0, va1, kb0, kb1, vb0, vb1;
    ATT_GLOAD(0, ka0, ka1, va0, va1)
    { const int t1 = (ntile > 1) ? 1 : 0; ATT_GLOAD(t1, kb0, kb1, vb0, vb1) }
    unsigned long long nmb0 = mrow[0], nmb1 = mrow[1];
    __syncthreads();
    ATT_LSTORE(0, ka0, ka1, va0, va1)
    __syncthreads();
    for (int kt = 0; kt < ntile; ++kt) {
        const int cur = kt & 1;
        ka0 = kb0; ka1 = kb1; va0 = vb0; va1 = vb1;
        { const int t2 = (kt + 2 < ntile) ? kt + 2 : ntile - 1; ATT_GLOAD(t2, kb0, kb1, vb0, vb1) }
        {
            const bf16_t* tK = (const bf16_t*)(sK + cur * ATT_KBYTES); const bf16_t* tV = (const bf16_t*)(sV + cur * ATT_VBYTES);
            const unsigned long long mb0 = (2 * kt <= wmax) ? nmb0 : 0ull, mb1 = (2 * kt + 1 <= wmax) ? nmb1 : 0ull;
            { const int tn = (kt + 1 < ntile) ? kt + 1 : kt; nmb0 = mrow[2 * tn]; nmb1 = mrow[2 * tn + 1]; }
            f32x4 st[8];
#pragma unroll
            for (int j = 0; j < 8; ++j) {
                f32x4 a = (f32x4){0.f, 0.f, 0.f, 0.f};
                const bf16_t* kr = tK + (16 * j + cL) * ATT_LDK + gq * 8;
                a = mfma16(ld8(kr), qf[0], a); a = mfma16(ld8(kr + 32), qf[1], a);
                st[j] = a;
            }
            float mx = m_run;
            const unsigned mw[4] = {(unsigned)mb0 >> (4 * gq), (unsigned)(mb0 >> 32) >> (4 * gq), (unsigned)mb1 >> (4 * gq), (unsigned)(mb1 >> 32) >> (4 * gq)};
#pragma unroll
            for (int j = 0; j < 8; ++j)
#pragma unroll
                for (int r = 0; r < 4; ++r) {
                    const bool bit = (mw[j >> 1] & (1u << (16 * (j & 1) + r))) != 0u;
                    const float v = bit ? st[j][r] : -INFINITY;
                    st[j][r] = v; mx = fmaxf(mx, v);
                }
            mx = max_x32(max_x16(mx));
            const float alpha = __builtin_amdgcn_exp2f(m_run - mx); m_run = mx;
            float ls = 0.f;
#pragma unroll
            for (int j = 0; j < 8; ++j)
#pragma unroll
                for (int r = 0; r < 4; ++r) { const float pv = __builtin_amdgcn_exp2f(st[j][r] - mx); st[j][r] = pv; ls += pv; }
            ls = sum_x32(sum_x16(ls));
            l_run = l_run * alpha + ls;
#pragma unroll
            for (int i = 0; i < 4; ++i) o[i] = o[i] * alpha;
#pragma unroll
            for (int kk = 0; kk < 4; ++kk) {
                bf16x8 pf;
#pragma unroll
                for (int r = 0; r < 4; ++r) { pf[r] = (short)f2bf(st[2 * kk][r]); pf[4 + r] = (short)f2bf(st[2 * kk + 1][r]); }
#pragma unroll
                for (int dt = 0; dt < 4; ++dt) {
                    const bf16_t* vr = tV + (16 * dt + cL) * ATT_LDV + 32 * kk + 4 * gq;
                    o[dt] = mfma16(cat4(*(const bf16x4*)vr, *(const bf16x4*)(vr + 16)), pf, o[dt]);
                }
            }
        }
        if (kt + 1 < ntile) ATT_LSTORE(cur ^ 1, ka0, ka1, va0, va1)
        __syncthreads();
    }
#undef ATT_GLOAD
#undef ATT_LSTORE
    const float inv = 1.f / l_run;
    bf16_t* mix = (bf16_t*)(ws + O_MIX) + (size_t)(b * 2048 + q0 + cL) * 1024 + h * 64;
#pragma unroll
    for (int dt = 0; dt < 4; ++dt)
        *(uint2*)(mix + 16 * dt + 4 * gq) = make_uint2(pack2(o[dt][0] * inv, o[dt][1] * inv), pack2(o[dt][2] * inv, o[dt][3] * inv));
}

#define SSD_CAR_BYTES (4 * 64 * 136 * 2)
__device__ __forceinline__ void ssd_main_unit(const Params& p, int unit, char* smem) {
    const int tid = tid_op(), lane = tid & 63, w = tid >> 6, cL = lane & 15, gq = lane >> 4;
    const int g = unit & 1, c = (unit >> 1) & 15, b = unit >> 5;
    char* ws = p.ws;
    float* sAc = (float*)smem;
    float* sDt = sAc + 512;
    const int tok0 = b * 2048 + c * 128;
    const float* ATOT = (const float*)(ws + O_ATOT); const float* ACUM = (const float*)(ws + O_ACUM); const float* DTf = (const float*)(ws + O_DTF);
    const bf16_t* Xt = (const bf16_t*)(ws + O_XT); const bf16_t* Brm = (const bf16_t*)(ws + O_BRM); const bf16_t* Crm = (const bf16_t*)(ws + O_CRM);
    const bf16_t* Zb = (const bf16_t*)(ws + O_ZB);
    __syncthreads();
    {
        const int hh = tid >> 7, l = tid & 127;
        sAc[tid] = ACUM[(size_t)(b * 8 + 4 * g + hh) * 2048 + c * 128 + l];
        sDt[tid] = DTf[(size_t)(tok0 + l) * 8 + 4 * g + hh];
    }
    __syncthreads();
    bf16_t* mix = (bf16_t*)(ws + O_MIX);
    const int lt = w;
    const int ltok = tok0 + 16 * lt + cL;
    bf16x8 Cq[4];
#pragma unroll
    for (int ks = 0; ks < 4; ++ks) Cq[ks] = ld8(Crm + (size_t)ltok * 256 + g * 128 + ks * 32 + gq * 8);
    f32x4 cbT[8];
#pragma unroll
    for (int st = 0; st < 8; ++st) {
        cbT[st] = (f32x4){0.f, 0.f, 0.f, 0.f};
        if (st <= lt) {
            const bf16_t* br = Brm + (size_t)(tok0 + 16 * st + cL) * 256 + g * 128 + gq * 8;
#pragma unroll
            for (int ks = 0; ks < 4; ++ks) cbT[st] = mfma16(ld8(br + ks * 32), Cq[ks], cbT[st]);
        }
    }
    float ssq = 0.f;
#pragma unroll 1
    for (int hh = 0; hh < 4; ++hh) {
        const int h = 4 * g + hh;
        const float* ac = sAc + hh * 128; const float* dtl = sDt + hh * 128;
        const float al = ac[16 * lt + cL];
        const bf16_t* xh = Xt + ((size_t)b * 512 + h * 64) * 2048 + c * 128;
        const bf16_t* zh = Zb + (size_t)tok0 * 512 + h * 64;
        const bf16_t* carh = (const bf16_t*)(ws + O_CAR) + ((size_t)((b * 16 + c) * 8 + h)) * 8192;
        bf16x8 xf[4][4];
#pragma unroll
        for (int kk = 0; kk < 4; ++kk)
#pragma unroll
            for (int pt = 0; pt < 4; ++pt) {
                const int kc = (2 * kk <= lt) ? kk : 0;
                const unsigned xo = (unsigned)((16 * pt + cL) * 2048 + 32 * kc + 4 * gq);
                xf[kk][pt] = cat4(*(const bf16x4*)(xh + xo), *(const bf16x4*)(xh + xo + 16));
            }
        f32x4 acc1[4], acc2[4];
#pragma unroll
        for (int i = 0; i < 4; ++i) { acc1[i] = (f32x4){0.f, 0.f, 0.f, 0.f}; acc2[i] = (f32x4){0.f, 0.f, 0.f, 0.f}; }
#pragma unroll
        for (int kk = 0; kk < 4; ++kk) {
            if (2 * kk <= lt) {
                bf16x8 mf;
#pragma unroll
                for (int half = 0; half < 2; ++half) {
                    const int st = 2 * kk + half;
#pragma unroll
                    for (int r = 0; r < 4; ++r) {
                        const int sl = 16 * st + 4 * gq + r;
                        float v = 0.f;
                        if (st <= lt && sl <= 16 * lt + cL) v = cbT[st][r] * __expf(al - ac[sl]) * dtl[sl];
                        mf[half * 4 + r] = (short)f2bf(v);
                    }
                }
#pragma unroll
                for (int pt = 0; pt < 4; ++pt) acc1[pt] = mfma16(xf[kk][pt], mf, acc1[pt]);
            }
        }
        uint2 zz[4]; bf16_t xsv[4][4];
#pragma unroll
        for (int pt = 0; pt < 4; ++pt) {
            zz[pt] = *(const uint2*)(zh + (unsigned)((16 * lt + cL) * 512 + 16 * pt + 4 * gq));
#pragma unroll
            for (int r = 0; r < 4; ++r) xsv[pt][r] = xh[(unsigned)((16 * pt + 4 * gq + r) * 2048 + 16 * lt + cL)];
        }
#pragma unroll
        for (int ks = 0; ks < 4; ++ks)
#pragma unroll
            for (int pt = 0; pt < 4; ++pt) acc2[pt] = mfma16(ld8(carh + (unsigned)((16 * pt + cL) * 128 + ks * 32 + gq * 8)), Cq[ks], acc2[pt]);
        const float el = __expf(al), dsk = p.d_skip[h];
#pragma unroll
        for (int pt = 0; pt < 4; ++pt) {
            const float zf[4] = {bf2f((bf16_t)(zz[pt].x & 0xFFFF)), bf2f((bf16_t)(zz[pt].x >> 16)), bf2f((bf16_t)(zz[pt].y & 0xFFFF)), bf2f((bf16_t)(zz[pt].y >> 16))};
            float yv[4];
#pragma unroll
            for (int r = 0; r < 4; ++r) {
                float t = acc1[pt][r] + el * acc2[pt][r] + bf2f(xsv[pt][r]) * dsk;
                t *= silu_f(zf[r]);
                yv[r] = t; ssq += t * t;
            }
            *(uint2*)(mix + (size_t)ltok * 1024 + 512 + h * 64 + 16 * pt + 4 * gq) = make_uint2(pack2(yv[0], yv[1]), pack2(yv[2], yv[3]));
        }
    }
    ssq = sum_x32(sum_x16(ssq));
    const float rstd = rsqrtf(ssq * (1.f / 256.f) + LN_EPS);
#pragma unroll
    for (int hh = 0; hh < 4; ++hh)
#pragma unroll
        for (int pt = 0; pt < 4; ++pt) {
            const int ch = (4 * g + hh) * 64 + 16 * pt + 4 * gq;
            const float4 nw = *(const float4*)(p.norm_w + ch);
            const uint2 yy = *(const uint2*)(mix + (size_t)ltok * 1024 + 512 + ch);
            const float y0 = bf2f((bf16_t)(yy.x & 0xFFFF)), y1 = bf2f((bf16_t)(yy.x >> 16)), y2 = bf2f((bf16_t)(yy.y & 0xFFFF)), y3 = bf2f((bf16_t)(yy.y >> 16));
            *(uint2*)(mix + (size_t)ltok * 1024 + 512 + ch) = make_uint2(pack2(y0 * rstd * nw.x, y1 * rstd * nw.y), pack2(y2 * rstd * nw.z, y3 * rstd * nw.w));
        }
}

__device__ __forceinline__ void phase2(const Params& p, char* smem, int which = 3) {
    const int G = gridDim.x;
    for (int k = 0; k * G < 2048; ++k) {
        const int u = k * G + ((k & 1) ? (G - 1 - (int)blockIdx.x) : (int)blockIdx.x);
        if (u >= 2048) continue;
        if (u < 1024) { if (which & 1) indexer_unit(p, u, smem); } else { if (which & 2) ssd_prep_unit(p, u - 1024, smem); }
    }
}
__device__ __forceinline__ void phase3(const Params& p, char* smem, int which = 3) {
    const int G = gridDim.x;
    for (int k = 0; k * G < 1024 + 256; ++k) {
        const int u = k * G + ((k & 1) ? (G - 1 - (int)blockIdx.x) : (int)blockIdx.x);
        if (u >= 1024 + 256) continue;
        if (u < 256) { if (which & 1) ssd_main_unit(p, u, smem); } else { if (which & 2) attn_unit(p, u - 256, smem); }
    }
}

struct OutEpi {
    const float* x; float* y;
    __device__ __forceinline__ void operator()(const f32x4 (&acc)[4][4], int mb, int nb, int lane, char* lds) const {
        const int c = lane & 15, g = lane >> 4;
        float* L = (float*)lds;
#pragma unroll
        for (int half = 0; half < 2; ++half) {
#pragma unroll
            for (int mi2 = 0; mi2 < 2; ++mi2)
#pragma unroll
                for (int r = 0; r < 4; ++r)
#pragma unroll
                    for (int ni = 0; ni < 4; ++ni) L[(16 * mi2 + 4 * g + r) * 68 + 16 * ni + c] = acc[2 * half + mi2][ni][r];
#pragma unroll
            for (int i = 0; i < 8; ++i) {
                const int row = 4 * i + g;
                const float4 a = *(const float4*)(L + row * 68 + 4 * c);
                const size_t o = (size_t)(mb + 32 * half + row) * 1024 + nb + 4 * c;
                const float4 xv = *(const float4*)(x + o);
                *(float4*)(y + o) = make_float4(ALPHA * xv.x + a.x, ALPHA * xv.y + a.y, ALPHA * xv.z + a.z, ALPHA * xv.w + a.w);
            }
        }
    }
};
__device__ __forceinline__ void phase4(const Params& p, char* smem, const XcdMap xm) {
    pg8::Gemm g{(const bf16_t*)(p.ws + O_MIX), (const bf16_t*)(p.ws + O_WOUT_T), NTOK, 1024, 1024};
    pg8::StaticOrder S; S.init(NTOK, 1024, (int)gridDim.x, (int)blockIdx.x);
    pg8::EpiResF32 E{p.out, p.x, 1024, ALPHA};
    pg8::gemm_phase<pg8::EpiResF32, pg8::StaticOrder, false>((PG8_LAS unsigned char*)smem, g, S, E, nullptr);
}

__device__ __forceinline__ void phase5(const Params& p) {
    const int lane = tid_op() & 63, w = tid_op() >> 6;
    bf16_t* hb = (bf16_t*)(p.ws + O_HB);
    for (int row = blockIdx.x * 8 + w; row < NTOK; row += gridDim.x * 8) {
        float* yr = p.out + (size_t)row * 1024;
        float4 v[4]; float s = 0.f;
#pragma unroll
        for (int j = 0; j < 4; ++j) { v[j] = *(const float4*)(yr + 4 * lane + 256 * j); s += v[j].x + v[j].y + v[j].z + v[j].w; }
        const float mean = wave_sum(s) * (1.f / 1024.f);
        float q = 0.f;
#pragma unroll
        for (int j = 0; j < 4; ++j) { const float a = v[j].x - mean, b2 = v[j].y - mean, c2 = v[j].z - mean, d = v[j].w - mean; q += a * a + b2 * b2 + c2 * c2 + d * d; }
        const float rstd = rsqrtf(wave_sum(q) * (1.f / 1024.f) + LN_EPS);
#pragma unroll
        for (int j = 0; j < 4; ++j) {
            const int col = 4 * lane + 256 * j;
            const float4 gg = *(const float4*)(p.ln1_g + col), bb = *(const float4*)(p.ln1_b + col);
            float4 o;
            o.x = (v[j].x - mean) * rstd * gg.x + bb.x; o.y = (v[j].y - mean) * rstd * gg.y + bb.y; o.z = (v[j].z - mean) * rstd * gg.z + bb.z; o.w = (v[j].w - mean) * rstd * gg.w + bb.w;
            *(float4*)(yr + col) = o;
            *(uint2*)(hb + (size_t)row * 1024 + col) = make_uint2(pack2(o.x, o.y), pack2(o.z, o.w));
        }
    }
    const size_t gtid = (size_t)blockIdx.x * blockDim.x + tid_op(), gsz = (size_t)gridDim.x * blockDim.x;
    {
        unsigned* u8 = (unsigned*)(p.ws + O_U8); unsigned* v8 = (unsigned*)(p.ws + O_V8);
        for (size_t i = gtid; i < (size_t)16384 * 256; i += gsz) {
            const float4 fu = ((const float4*)p.u)[i];
            int pk = __builtin_amdgcn_cvt_pk_fp8_f32(fu.x * 32.f, fu.y * 32.f, 0, false); pk = __builtin_amdgcn_cvt_pk_fp8_f32(fu.z * 32.f, fu.w * 32.f, pk, true);
            u8[i] = (unsigned)pk;
            const float4 fv = ((const float4*)p.v)[i];
            int pv = __builtin_amdgcn_cvt_pk_fp8_f32(fv.x, fv.y, 0, false); pv = __builtin_amdgcn_cvt_pk_fp8_f32(fv.z, fv.w, pv, true);
            const size_t e = i >> 8, c4 = i & 255;
            v8[((c4 >> 5) * 16384 + e) * 32 + (c4 & 31)] = (unsigned)pv;
        }
    }
}

struct QpEpi {
    bf16_t* qp;
    __device__ __forceinline__ void operator()(const f32x4 (&acc)[4][4], int mb, int nb, int lane, char* lds) const {
        const int c = lane & 15, g = lane >> 4;
        bf16_t* L = (bf16_t*)lds;
#pragma unroll
        for (int mi = 0; mi < 4; ++mi)
#pragma unroll
            for (int r = 0; r < 4; ++r)
#pragma unroll
                for (int ni = 0; ni < 4; ++ni) L[(16 * mi + 4 * g + r) * 72 + 16 * ni + c] = f2bf(acc[mi][ni][r]);
#pragma unroll
        for (int i = 0; i < 8; ++i) {
            const int row = 8 * i + (lane >> 3), cc = (lane & 7) * 8;
            *(uint4*)(qp + (size_t)(mb + row) * 2048 + nb + cc) = *(const uint4*)(L + row * 72 + cc);
        }
    }
};
__device__ __forceinline__ void phase6(const Params& p, char* smem, const XcdMap xm) {
    pg8::Gemm g{(const bf16_t*)(p.ws + O_HB), (const bf16_t*)(p.ws + O_WQ_T), NTOK, 2048, 1024};
    pg8::StaticOrder S; S.init(NTOK, 2048, (int)gridDim.x, (int)blockIdx.x);
    pg8::EpiBf16Plain E{(bf16_t*)(p.ws + O_QP), 2048};
    pg8::gemm_phase<pg8::EpiBf16Plain, pg8::StaticOrder, false>((PG8_LAS unsigned char*)smem, g, S, E, nullptr);
}

__device__ __forceinline__ float gelu_erf(float d) { return 0.5f * d * (1.f + erff(d * 0.70710678118654752f)); }
typedef unsigned u32x4n __attribute__((ext_vector_type(4)));
__device__ __forceinline__ long lo64n(const u32x4n v) { return (long)(((unsigned long long)v.y << 32) | v.x); }
__device__ __forceinline__ long hi64n(const u32x4n v) { return (long)(((unsigned long long)v.w << 32) | v.z); }
struct P8aRows { u32x4n a[16]; };
__device__ __forceinline__ void p8a_load(P8aRows& R, const unsigned char* U8, int eid, int gq) {
    const unsigned char* urow = U8 + (size_t)eid * 1024 + 16 * gq;
#pragma unroll
    for (int j = 0; j < 16; ++j) R.a[j] = *(const u32x4n*)(urow + 64 * j);
}
__device__ __forceinline__ float p8_dot16(const u32x4n r, const f32x2 (&hp)[8]) {
    f32x2 acc = __builtin_amdgcn_cvt_pk_f32_fp8((int)r.x, false) * hp[0];
    acc += __builtin_amdgcn_cvt_pk_f32_fp8((int)r.x, true) * hp[1];
    acc += __builtin_amdgcn_cvt_pk_f32_fp8((int)r.y, false) * hp[2]; acc += __builtin_amdgcn_cvt_pk_f32_fp8((int)r.y, true) * hp[3];
    acc += __builtin_amdgcn_cvt_pk_f32_fp8((int)r.z, false) * hp[4]; acc += __builtin_amdgcn_cvt_pk_f32_fp8((int)r.z, true) * hp[5];
    acc += __builtin_amdgcn_cvt_pk_f32_fp8((int)r.w, false) * hp[6]; acc += __builtin_amdgcn_cvt_pk_f32_fp8((int)r.w, true) * hp[7];
    return acc.x + acc.y;
}
__device__ __forceinline__ float p8_reduce16(const float (&p)[16], int lane) {
    float q[8], r4[4], t2[2];
#pragma unroll
    for (int k = 0; k < 8; ++k) { const u32x2_t sw = __builtin_amdgcn_permlane32_swap(__float_as_uint(p[k]), __float_as_uint(p[k + 8]), false, false); q[k] = __uint_as_float(sw.x) + __uint_as_float(sw.y); }
#pragma unroll
    for (int k = 0; k < 4; ++k) { const u32x2_t sw = __builtin_amdgcn_permlane16_swap(__float_as_uint(q[k]), __float_as_uint(q[k + 4]), false, false); r4[k] = __uint_as_float(sw.x) + __uint_as_float(sw.y); }
    const bool b3 = (lane & 8) != 0, b2 = (lane & 4) != 0;
#pragma unroll
    for (int k = 0; k < 2; ++k) { const float snd = b3 ? r4[k] : r4[k + 2], keep = b3 ? r4[k + 2] : r4[k]; t2[k] = keep + dpp_f<0x128, 0xF, true>(snd); }
    const float snd = b2 ? t2[0] : t2[1], keep = b2 ? t2[1] : t2[0];
    float z = keep + dpp_f<0x141, 0xF, true>(snd);
    z += dpp_f<0xB1, 0xF, true>(z); z += dpp_f<0x4E, 0xF, true>(z);
    return z;
}
__constant__ unsigned char CAND_I[64] = {0,0,0,0,0,0,0,0,0,0,0,0,0,0,0,0, 1,1,1,1,1,1,1,1, 2,2,2,2,2, 3,3,3,3, 4,4,4, 5,5, 6,6, 7,7, 8,9,10,11,12,13,14,15, 0,0,0,0,0,0,0,0,0,0,0,0,0,0};
__constant__ unsigned char CAND_J[64] = {0,1,2,3,4,5,6,7,8,9,10,11,12,13,14,15, 0,1,2,3,4,5,6,7, 0,1,2,3,4, 0,1,2,3, 0,1,2, 0,1, 0,1, 0,1, 0,0,0,0,0,0,0,0, 0,0,0,0,0,0,0,0,0,0,0,0,0,0};
__device__ __forceinline__ unsigned rowmax_u(unsigned v) { return row_max_u(v); }
struct PeerSel { int ev[4]; float gv[4]; };
__device__ __forceinline__ PeerSel peer_select(const Params& p, int wunit, const char* ktab) {
    const int lane = tid_op() & 63, cL = lane & 15, gq = lane >> 4, rowbase = lane & 48;
    const int tg = wunit >> 3, h = wunit & 7, tok0 = tg * 16;
    char* ws = p.ws;
    const bf16_t* QP = (const bf16_t*)(ws + O_QP);
    unsigned top[2][4];
#pragma unroll
    for (int half = 0; half < 2; ++half) {
        const bf16_t* KB = (const bf16_t*)(ktab + half * (128 * 144 * 2));
        bf16x8 a[4];
#pragma unroll
        for (int ks = 0; ks < 4; ++ks) a[ks] = ld8(QP + (size_t)(tok0 + cL) * 2048 + h * 256 + half * 128 + ks * 32 + gq * 8);
        unsigned pk[8][4];
#pragma unroll
        for (int nt = 0; nt < 8; ++nt) {
            f32x4 acc = (f32x4){0.f, 0.f, 0.f, 0.f};
#pragma unroll
            for (int ks = 0; ks < 4; ++ks) acc = mfma16(a[ks], ld8(KB + (16 * nt + cL) * 144 + ks * 32 + gq * 8), acc);
#pragma unroll
            for (int r = 0; r < 4; ++r) pk[nt][r] = (f2sort(acc[r]) & ~0x7Fu) | (unsigned)(127 - (16 * nt + cL));
        }
#pragma unroll
        for (int r = 0; r < 4; ++r) top[half][r] = 0u;
#define PS_CAS(A, B) { const unsigned hi_ = max(pk[A][r], pk[B][r]), lo_ = min(pk[A][r], pk[B][r]); pk[A][r] = hi_; pk[B][r] = lo_; }
#pragma unroll
        for (int r = 0; r < 4; ++r) {
            PS_CAS(0, 1) PS_CAS(2, 3) PS_CAS(4, 5) PS_CAS(6, 7)
            PS_CAS(0, 2) PS_CAS(1, 3) PS_CAS(4, 6) PS_CAS(5, 7)
            PS_CAS(1, 2) PS_CAS(5, 6)
            PS_CAS(0, 4) PS_CAS(1, 5) PS_CAS(2, 6) PS_CAS(3, 7)
            PS_CAS(2, 4) PS_CAS(3, 5)
            PS_CAS(1, 2) PS_CAS(3, 4) PS_CAS(5, 6)
        }
#undef PS_CAS
        for (int it = 0; it < 16; ++it) {
#pragma unroll
            for (int r = 0; r < 4; ++r) {
                const unsigned gm = rowmax_u(pk[0][r]);
                if (cL == it) top[half][r] = gm;
                const bool pop = (pk[0][r] == gm);
#pragma unroll
                for (int nt = 0; nt < 7; ++nt) pk[nt][r] = pop ? pk[nt + 1][r] : pk[nt][r];
                pk[7][r] = pop ? 0u : pk[7][r];
            }
        }
    }
    unsigned ck[4][4];
#pragma unroll
    for (int s = 0; s < 4; ++s) {
        const int q = s * 16 + cL; const int ci = CAND_I[q], cj = CAND_J[q];
#pragma unroll
        for (int r = 0; r < 4; ++r) {
            const unsigned t1 = (unsigned)__shfl((int)top[0][r], rowbase + ci), t2 = (unsigned)__shfl((int)top[1][r], rowbase + cj);
            const float f = sort2f(t1 & ~0x7Fu) + sort2f(t2 & ~0x7Fu);
            ck[s][r] = (q < 50) ? ((f2sort(f) & ~0x3Fu) | (unsigned)(63 - q)) : 0u;
        }
    }
    unsigned best[4] = {0u, 0u, 0u, 0u};
#define PS_CAS(A, B) { const unsigned hi_ = max(ck[A][r], ck[B][r]), lo_ = min(ck[A][r], ck[B][r]); ck[A][r] = hi_; ck[B][r] = lo_; }
#pragma unroll
    for (int r = 0; r < 4; ++r) { PS_CAS(0, 1) PS_CAS(2, 3) PS_CAS(0, 2) PS_CAS(1, 3) PS_CAS(1, 2) }
#undef PS_CAS
    for (int it = 0; it < 16; ++it) {
#pragma unroll
        for (int r = 0; r < 4; ++r) {
            const unsigned gm = rowmax_u(ck[0][r]);
            if (cL == it) best[r] = gm;
            const bool pop = (ck[0][r] == gm);
            ck[0][r] = pop ? ck[1][r] : ck[0][r]; ck[1][r] = pop ? ck[2][r] : ck[1][r]; ck[2][r] = pop ? ck[3][r] : ck[2][r]; ck[3][r] = pop ? 0u : ck[3][r];
        }
    }
    PeerSel S_;
#pragma unroll
    for (int r = 0; r < 4; ++r) {
        const float fv = sort2f(best[r] & ~0x3Fu);
        const int q = 63 - (int)(best[r] & 63u);
        const int ci = CAND_I[q], cj = CAND_J[q];
        const unsigned t1 = (unsigned)__shfl((int)top[0][r], rowbase + ci), t2 = (unsigned)__shfl((int)top[1][r], rowbase + cj);
        S_.ev[r] = (127 - (int)(t1 & 127u)) * 128 + (127 - (int)(t2 & 127u));
        const float mx = __shfl(fv, rowbase);
        const float ex = __expf(fv - mx);
        const float sm = row_sum(ex);
        S_.gv[r] = ex / sm;
    }
    return S_;
}
#define PU_ROWEID(SEL, TT, I) __builtin_amdgcn_readlane(SEL.ev[(TT) & 3], 16 * ((TT) >> 2) + (I))
__device__ __forceinline__ void peer_blocks(const Params& p, int wunit, const PeerSel& S_, const PeerSel& N_, bool has_next, P8aRows& R0, P8aRows& R1) {
    const int lane = tid_op() & 63;
    const int tok0 = (wunit >> 3) * 16, h = wunit & 7;
    char* ws = p.ws;
    const unsigned char* U8 = (const unsigned char*)(ws + O_U8) + 16 * lane;
    const float* H = p.out + (size_t)tok0 * 1024 + 16 * lane;
    unsigned* ACT = (unsigned*)(ws + O_ACT) + (size_t)tok0 * 128 + h * 16;
#define PU_STEP(RC, TT) { \
        f32x2 hp[8]; \
        _Pragma("unroll") for (int k = 0; k < 4; ++k) { const f32x4 hv_ = *(const f32x4*)(H + (TT) * 1024 + 4 * k); hp[2 * k] = (f32x2){hv_[0], hv_[1]}; hp[2 * k + 1] = (f32x2){hv_[2], hv_[3]}; } \
        float pp[16]; \
        _Pragma("unroll") for (int i = 0; i < 16; ++i) { \
            pp[i] = p8_dot16(RC.a[i], hp); \
            if ((TT) < 14) RC.a[i] = *(const u32x4n*)(U8 + (size_t)PU_ROWEID(S_, ((TT) + 2) & 15, i) * 1024); \
            else if (has_next) RC.a[i] = *(const u32x4n*)(U8 + (size_t)PU_ROWEID(N_, ((TT) + 2) & 15, i) * 1024); } \
        const float dot = p8_reduce16(pp, lane) * (1.f / 32.f); \
        const int src_ = 16 * ((TT) >> 2) + (lane >> 2); \
        const float gt_ = __shfl(S_.gv[(TT) & 3], src_); const int ei_ = __shfl(S_.ev[(TT) & 3], src_); \
        const float act_ = gelu_erf(dot) * gt_; \
        if ((lane & 3) == 0) ACT[(TT) * 128 + (lane >> 2)] = (unsigned)ei_ | ((unsigned)f2bf(act_) << 16); }
    PU_STEP(R0, 0) PU_STEP(R1, 1) PU_STEP(R0, 2) PU_STEP(R1, 3) PU_STEP(R0, 4) PU_STEP(R1, 5) PU_STEP(R0, 6) PU_STEP(R1, 7)
    PU_STEP(R0, 8) PU_STEP(R1, 9) PU_STEP(R0, 10) PU_STEP(R1, 11) PU_STEP(R0, 12) PU_STEP(R1, 13) PU_STEP(R0, 14) PU_STEP(R1, 15)
#undef PU_STEP
}
__device__ __forceinline__ void phase7(const Params& p, char* smem) {
    const int lane = tid_op() & 63;
    const int w = __builtin_amdgcn_readfirstlane(tid_op() >> 6);
    const int stride = gridDim.x * 8;
    const unsigned char* U8 = (const unsigned char*)(p.ws + O_U8) + 16 * lane;
    {
        const int tid = tid_op();
        __syncthreads();
#pragma unroll
        for (int k = 0; k < 8; ++k) {
            const int c = tid + 512 * k, half = c >> 11, row = (c >> 4) & 127, ch = c & 15;
            *(uint4*)(smem + half * (128 * 144 * 2) + row * 288 + ch * 16) = *(const uint4*)(p.ws + (half ? O_K2B : O_K1B) + (size_t)row * 256 + ch * 16);
        }
        __syncthreads();
    }
    for (int u = blockIdx.x * 8 + w; u < 8192; u += stride) {
        const PeerSel s0 = peer_select(p, u, smem);
        P8aRows R0, R1;
#pragma unroll
        for (int i = 0; i < 16; ++i) { R0.a[i] = *(const u32x4n*)(U8 + (size_t)PU_ROWEID(s0, 0, i) * 1024); R1.a[i] = *(const u32x4n*)(U8 + (size_t)PU_ROWEID(s0, 1, i) * 1024); }
        peer_blocks(p, u, s0, s0, false, R0, R1);
    }
}
#undef PU_ROWEID

__device__ __forceinline__ float dot16_fp8(const uint4& r, const float (&hv)[16]) {
    const f32x2 a0 = __builtin_amdgcn_cvt_pk_f32_fp8((int)r.x, false), a1 = __builtin_amdgcn_cvt_pk_f32_fp8((int)r.x, true);
    const f32x2 b0 = __builtin_amdgcn_cvt_pk_f32_fp8((int)r.y, false), b1 = __builtin_amdgcn_cvt_pk_f32_fp8((int)r.y, true);
    const f32x2 c0 = __builtin_amdgcn_cvt_pk_f32_fp8((int)r.z, false), c1 = __builtin_amdgcn_cvt_pk_f32_fp8((int)r.z, true);
    const f32x2 d0 = __builtin_amdgcn_cvt_pk_f32_fp8((int)r.w, false), d1 = __builtin_amdgcn_cvt_pk_f32_fp8((int)r.w, true);
    return (hv[0] * a0.x + hv[1] * a0.y + hv[2] * a1.x + hv[3] * a1.y) + (hv[4] * b0.x + hv[5] * b0.y + hv[6] * b1.x + hv[7] * b1.y)
         + (hv[8] * c0.x + hv[9] * c0.y + hv[10] * c1.x + hv[11] * c1.y) + (hv[12] * d0.x + hv[13] * d0.y + hv[14] * d1.x + hv[15] * d1.y);
}
struct P8bRows { u32x4n v[8]; };
struct P8bMeta { u32x4n m[4]; };
__device__ __forceinline__ void p8b_meta(P8bMeta& M, const unsigned* ACT, int row, int e8) {
#pragma unroll
    for (int k = 0; k < 4; ++k) M.m[k] = *(const u32x4n*)(ACT + (size_t)row * 128 + e8 * 16 + 4 * k);
}
template <int HALF> __device__ __forceinline__ void p8b_load(P8bRows& R, const P8bMeta& M, const unsigned char* V8) {
#pragma unroll
    for (int k = 0; k < 2; ++k) {
        const u32x4n mm = M.m[2 * HALF + k];
        R.v[4 * k + 0] = *(const u32x4n*)(V8 + (size_t)(mm.x & 0xFFFFu) * 128); R.v[4 * k + 1] = *(const u32x4n*)(V8 + (size_t)(mm.y & 0xFFFFu) * 128);
        R.v[4 * k + 2] = *(const u32x4n*)(V8 + (size_t)(mm.z & 0xFFFFu) * 128); R.v[4 * k + 3] = *(const u32x4n*)(V8 + (size_t)(mm.w & 0xFFFFu) * 128);
    }
}
template <int HALF> __device__ __forceinline__ void p8b_accum(f32x2 (&acc)[8], const P8bRows& R, const P8bMeta& M) {
#pragma unroll
    for (int k = 0; k < 2; ++k) {
        const u32x4n mm = M.m[2 * HALF + k];
        const unsigned mw[4] = {mm.x, mm.y, mm.z, mm.w};
#pragma unroll
        for (int q = 0; q < 4; ++q) {
            const float a1 = __uint_as_float(mw[q] & 0xFFFF0000u);
            const f32x2 av = (f32x2){a1, a1};
            const u32x4n x = R.v[4 * k + q];
            acc[0] += av * __builtin_amdgcn_cvt_pk_f32_fp8((int)x.x, false); acc[1] += av * __builtin_amdgcn_cvt_pk_f32_fp8((int)x.x, true);
            acc[2] += av * __builtin_amdgcn_cvt_pk_f32_fp8((int)x.y, false); acc[3] += av * __builtin_amdgcn_cvt_pk_f32_fp8((int)x.y, true);
            acc[4] += av * __builtin_amdgcn_cvt_pk_f32_fp8((int)x.z, false); acc[5] += av * __builtin_amdgcn_cvt_pk_f32_fp8((int)x.z, true);
            acc[6] += av * __builtin_amdgcn_cvt_pk_f32_fp8((int)x.w, false); acc[7] += av * __builtin_amdgcn_cvt_pk_f32_fp8((int)x.w, true);
        }
    }
}
__device__ __forceinline__ void p8b_store(const f32x2 (&acc)[8], float* hr, int e8) {
    float r[16];
#pragma unroll
    for (int j = 0; j < 8; ++j) { r[2 * j] = acc[j].x; r[2 * j + 1] = acc[j].y; }
#pragma unroll
    for (int j = 0; j < 16; ++j) { r[j] += dpp_f<0x128, 0xF, true>(r[j]); r[j] = sum_x32(sum_x16(r[j])); }
    if (e8 == 0) {
#pragma unroll
        for (int j = 0; j < 4; ++j) {
            const float4 h0 = *(const float4*)(hr + 4 * j);
            *(float4*)(hr + 4 * j) = make_float4(ALPHA * h0.x + r[4 * j], ALPHA * h0.y + r[4 * j + 1], ALPHA * h0.z + r[4 * j + 2], ALPHA * h0.w + r[4 * j + 3]);
        }
    }
}
__device__ __forceinline__ void phase8b(const Params& p, const XcdMap xm, float* outp) {
    const int lane = tid_op() & 63, w = tid_op() >> 6, e8 = lane >> 3, c8 = lane & 7;
    char* ws = p.ws;
    const unsigned char* V8 = (const unsigned char*)(ws + O_V8) + (size_t)xm.slice * 16384 * 128 + 16 * c8;
    const unsigned* ACT = (const unsigned*)(ws + O_ACT);
    const int stride = xm.nloc * 8;
    int row = xm.rank * 8 + w;
    if (row >= NTOK) return;
    float* const hbase = outp + xm.slice * 128 + 16 * c8;
    P8bMeta Mc, Mn; P8bRows Ra, Rb;
    p8b_meta(Mc, ACT, row, e8);
    p8b_meta(Mn, ACT, (row + stride < NTOK) ? row + stride : row, e8);
    p8b_load<0>(Ra, Mc, V8);
    for (; row < NTOK; row += stride) {
        f32x2 acc[8];
#pragma unroll
        for (int j = 0; j < 8; ++j) acc[j] = (f32x2){0.f, 0.f};
        p8b_load<1>(Rb, Mc, V8);
        p8b_accum<0>(acc, Ra, Mc);
        p8b_load<0>(Ra, Mn, V8);
        p8b_accum<1>(acc, Rb, Mc);
        p8b_store(acc, hbase + (size_t)row * 1024, e8);
        Mc = Mn;
        const int r2 = row + 2 * stride;
        p8b_meta(Mn, ACT, r2 < NTOK ? r2 : row, e8);
    }
}
__device__ __forceinline__ void phase8c(const Params& p) {
    const int lane = tid_op() & 63, w = tid_op() >> 6;
    for (int row = blockIdx.x * 8 + w; row < NTOK; row += gridDim.x * 8) {
        float* yr = p.out + (size_t)row * 1024;
        float4 v[4]; float s = 0.f;
#pragma unroll
        for (int j = 0; j < 4; ++j) { v[j] = *(const float4*)(yr + 4 * lane + 256 * j); s += v[j].x + v[j].y + v[j].z + v[j].w; }
        const float mean = wave_sum(s) * (1.f / 1024.f);
        float q = 0.f;
#pragma unroll
        for (int j = 0; j < 4; ++j) { const float a = v[j].x - mean, b2 = v[j].y - mean, c2 = v[j].z - mean, d = v[j].w - mean; q += a * a + b2 * b2 + c2 * c2 + d * d; }
        const float rstd = rsqrtf(wave_sum(q) * (1.f / 1024.f) + LN_EPS);
#pragma unroll
        for (int j = 0; j < 4; ++j) {
            const int col = 4 * lane + 256 * j;
            const float4 gg = *(const float4*)(p.ln2_g + col), bb = *(const float4*)(p.ln2_b + col);
            float4 o;
            o.x = (v[j].x - mean) * rstd * gg.x + bb.x; o.y = (v[j].y - mean) * rstd * gg.y + bb.y; o.z = (v[j].z - mean) * rstd * gg.z + bb.z; o.w = (v[j].w - mean) * rstd * gg.w + bb.w;
            *(float4*)(yr + col) = o;
        }
    }
}

typedef const __attribute__((address_space(4))) Params* ParamsK;
__device__ __forceinline__ Params params_reload() {
#if defined(__HIP_DEVICE_COMPILE__)
    auto ka = __builtin_amdgcn_kernarg_segment_ptr();
    asm volatile("" : "+s"(ka));
    Params r; __builtin_memcpy(&r, (const __attribute__((address_space(4))) void*)ka, sizeof(Params));
    return r;
#else
    return Params{};
#endif
}
#if ONE_LAUNCH
__global__ void __launch_bounds__(512, 2) fwd_megakernel(Params p) {
    __shared__ __attribute__((aligned(16))) char smem[SMEM_BYTES];
    cg::grid_group grid = cg::this_grid();
    volatile LAS unsigned* st = (volatile LAS unsigned*)(smem + SMEM_BYTES - 16);
    if (threadIdx.x == 0) { st[0] = 0u; st[1] = 0u; st[2] = 0u; st[3] = 0u; }
    __syncthreads();
    const XcdBarrier xb = xcd_barrier_post((unsigned*)(p.ws + O_BAR), st);
#define GRID_BAR() do { if (p.use_cg) grid.sync(); else xcd_barrier(xb); } while (0)
#ifndef DUP
#define DUP -1
#endif
#define PP (params_reload())
#define RUNPH(k, call) { int n_ = (DUP == k) ? 2 : 1; asm volatile("" : "+s"(n_)); _Pragma("unroll 1") for (int i_ = 0; i_ < n_; ++i_) { call; GRID_BAR(); } }
    RUNPH(0, phase0(PP))
    XcdMap xm;
    if (st[2]) { xm.slice = (int)xb.x; xm.rank = (int)st[3]; xm.nloc = (int)st[0]; }
    else { xm.slice = blockIdx.x & 7; xm.rank = blockIdx.x >> 3; xm.nloc = gridDim.x >> 3; }
    xm.slice = __builtin_amdgcn_readfirstlane(xm.slice); xm.rank = __builtin_amdgcn_readfirstlane(xm.rank); xm.nloc = __builtin_amdgcn_readfirstlane(xm.nloc);
    RUNPH(1, phase1(PP, smem, xm))
    RUNPH(2, phase2(PP, smem))
    if (DUP == 20) { int wh_ = 1; asm volatile("" : "+s"(wh_)); phase2(PP, smem, wh_); GRID_BAR(); }
    if (DUP == 21) { int wh_ = 2; asm volatile("" : "+s"(wh_)); phase2(PP, smem, wh_); GRID_BAR(); }
    phase2c(PP); GRID_BAR();
    RUNPH(3, phase3(PP, smem))
    if (DUP == 30) { int wh_ = 1; asm volatile("" : "+s"(wh_)); phase3(PP, smem, wh_); GRID_BAR(); }
    if (DUP == 31) { int wh_ = 2; asm volatile("" : "+s"(wh_)); phase3(PP, smem, wh_); GRID_BAR(); }
    RUNPH(4, phase4(PP, smem, xm))
    phase5(PP); GRID_BAR();
    RUNPH(6, phase6(PP, smem, xm))
    RUNPH(7, phase7(PP, smem))
#ifdef SCRAMBLE
    { const int x_ = xm.slice, r_ = xm.rank; xm.slice = (x_ + r_) & 7; xm.rank = (r_ >> 3) * 8 + x_; xm.nloc = 32; }
#endif
    if (DUP == 9) { phase8b(PP, xm, (float*)(PP.ws + O_QP)); GRID_BAR(); }
    phase8b(PP, xm, PP.out); GRID_BAR();
    phase8c(PP);
}
#else
__global__ void __launch_bounds__(512, 2) k_phase0(Params p) { phase0(p); }
__global__ void __launch_bounds__(512, 2) k_phase1(Params p) { __shared__ __attribute__((aligned(16))) char smem[SMEM_BYTES]; XcdMap xm; xm.slice = blockIdx.x & 7; xm.rank = blockIdx.x >> 3; xm.nloc = gridDim.x >> 3; phase1(p, smem, xm); }
__global__ void __launch_bounds__(512, 2) k_phase2(Params p) { __shared__ __attribute__((aligned(16))) char smem[SMEM_BYTES]; phase2(p, smem); }
__global__ void __launch_bounds__(512, 2) k_phase2c(Params p) { phase2c(p); }
__global__ void __launch_bounds__(512, 2) k_phase3(Params p) { __shared__ __attribute__((aligned(16))) char smem[SMEM_BYTES]; phase3(p, smem); }
__global__ void __launch_bounds__(512, 2) k_phase4(Params p) { __shared__ __attribute__((aligned(16))) char smem[SMEM_BYTES]; XcdMap xm; xm.slice = blockIdx.x & 7; xm.rank = blockIdx.x >> 3; xm.nloc = gridDim.x >> 3; phase4(p, smem, xm); }
__global__ void __launch_bounds__(512, 2) k_phase5(Params p) { phase5(p); }
__global__ void __launch_bounds__(512, 2) k_phase6(Params p) { __shared__ __attribute__((aligned(16))) char smem[SMEM_BYTES]; XcdMap xm; xm.slice = blockIdx.x & 7; xm.rank = blockIdx.x >> 3; xm.nloc = gridDim.x >> 3; phase6(p, smem, xm); }
__global__ void __launch_bounds__(512, 2) k_phase7(Params p) { __shared__ __attribute__((aligned(16))) char smem_[SMEM_BYTES]; phase7(p, smem_); }
__global__ void __launch_bounds__(512, 2) k_phase8b(Params p) { XcdMap xm; xm.slice = blockIdx.x & 7; xm.rank = blockIdx.x >> 3; xm.nloc = gridDim.x >> 3; phase8b(p, xm, p.out); }
__global__ void __launch_bounds__(512, 2) k_phase8c(Params p) { phase8c(p); }
#endif

extern "C" void kernel_launch(void* const* d_in, const int* in_sizes, int n_in, void* d_out, int out_size, void* d_ws, size_t ws_size, hipStream_t stream) {
    Params p{};
    p.x = (const float*)d_in[0]; p.pos = (const int*)d_in[1]; p.w_in = (const float*)d_in[2]; p.conv_w = (const float*)d_in[3]; p.conv_b = (const float*)d_in[4];
    p.dt_bias = (const float*)d_in[5]; p.a_log = (const float*)d_in[6]; p.d_skip = (const float*)d_in[7]; p.norm_w = (const float*)d_in[8]; p.w_out = (const float*)d_in[9];
    p.ln1_g = (const float*)d_in[10]; p.ln1_b = (const float*)d_in[11]; p.wq = (const float*)d_in[12]; p.k1 = (const float*)d_in[13]; p.k2 = (const float*)d_in[14];
    p.u = (const float*)d_in[15]; p.v = (const float*)d_in[16]; p.ln2_g = (const float*)d_in[17]; p.ln2_b = (const float*)d_in[18];
    p.out = (float*)d_out; p.ws = (char*)d_ws;
    if (ws_size < WS_NEEDED) { fprintf(stderr, "kernel_launch: workspace too small (%zu < %zu)\n", ws_size, (size_t)WS_NEEDED); return; }
#if ONE_LAUNCH
    static int grid_blocks = 0;
    if (!grid_blocks) {
        int dev = 0, cus = 0, per_cu = 0;
        hipGetDevice(&dev);
        hipDeviceGetAttribute(&cus, hipDeviceAttributeMultiprocessorCount, dev);
        hipOccupancyMaxActiveBlocksPerMultiprocessor(&per_cu, fwd_megakernel, 512, 0);
        if (per_cu > 1) per_cu = 1;
        if (per_cu < 1) per_cu = 1;
        grid_blocks = cus * per_cu;
    }
    (void)hipMemsetAsync((char*)d_ws + O_BAR, 0, XCD_BAR_WORDS * 4, stream);
    void* args[] = {&p};
    hipError_t e = hipLaunchCooperativeKernel((void*)fwd_megakernel, dim3(grid_blocks), dim3(512), args, 0, stream);
    if (e != hipSuccess) fprintf(stderr, "cooperative launch failed: %s (grid %d)\n", hipGetErrorString(e), grid_blocks);
#else
    const int G = 512;
    k_phase0<<<G, 512, 0, stream>>>(p);
    k_phase1<<<G, 512, 0, stream>>>(p);
    k_phase2<<<G, 512, 0, stream>>>(p);
    k_phase2c<<<G, 512, 0, stream>>>(p);
    k_phase3<<<G, 512, 0, stream>>>(p);
    k_phase4<<<G, 512, 0, stream>>>(p);
    k_phase5<<<G, 512, 0, stream>>>(p);
    k_phase6<<<G, 512, 0, stream>>>(p);
    k_phase7<<<G, 512, 0, stream>>>(p);
    k_phase8b<<<G, 512, 0, stream>>>(p);
    k_phase8c<<<G, 512, 0, stream>>>(p);
#endif
}
```

```cpp
#include <hip/hip_runtime.h>
#include <hip/hip_cooperative_groups.h>
#include <stdint.h>
#include <stdio.h>
namespace cg = cooperative_groups;

typedef unsigned short bf16_t;
typedef short bf16x8 __attribute__((ext_vector_type(8)));
typedef short bf16x4 __attribute__((ext_vector_type(4)));
typedef float f32x4 __attribute__((ext_vector_type(4)));
typedef float f32x2 __attribute__((ext_vector_type(2)));

#ifndef ONE_LAUNCH
#define ONE_LAUNCH 1
#endif

constexpr int NB = 8, SEQ = 2048, DM = 1024, NTOK = NB * SEQ;
constexpr int NP = 3584;
constexpr int QOFF = 0, KOFF = 512, VOFF = 1024, IQOFF = 1536, MISCOFF = 1792, ZOFF = 1856, XBCOFF = 2368, NUSED = 3392;
constexpr float ALPHA = 1.189207115002721f;
constexpr float LN_EPS = 1e-5f;

constexpr size_t MB = 1024 * 1024;
constexpr size_t O_WIN_T = 0;
constexpr size_t O_WOUT_T = O_WIN_T + (size_t)NP * 1024 * 2;
constexpr size_t O_WQ_T = O_WOUT_T + 2 * MB;
constexpr size_t O_K1B = O_WQ_T + 4 * MB;
constexpr size_t O_K2B = O_K1B + 32768;
constexpr size_t O_CS64 = O_K2B + 32768;
constexpr size_t O_CS32 = O_CS64 + 4 * MB;
constexpr size_t O_BAR = O_CS32 + 2 * MB;
constexpr size_t O_MIX = O_BAR + 65536;
constexpr size_t O_R1 = O_MIX + 32 * MB;
constexpr size_t O_XB = O_R1;
constexpr size_t O_XT = O_R1;
constexpr size_t O_BRM = O_XT + 16 * MB;
constexpr size_t O_CRM = O_BRM + 8 * MB;
constexpr size_t O_QB = O_XB + 32 * MB;
constexpr size_t O_KB = O_QB + 16 * MB;
constexpr size_t O_VT = O_KB + 16 * MB;
constexpr size_t O_IQB = O_VT + 16 * MB;
constexpr size_t O_IKB = O_IQB + 8 * MB;
constexpr size_t O_IWF = O_IKB + 1 * MB;
constexpr size_t O_DTF = O_IWF + MB / 2;
constexpr size_t O_ZB = O_DTF + MB / 2;
constexpr size_t O_XBCT = O_ZB + 16 * MB;
constexpr size_t O_CAR = O_XBCT;
constexpr size_t O_ACUM = O_XBCT + 32 * MB;
constexpr size_t O_ATOT = O_ACUM + MB / 2;
constexpr size_t O_ST = O_ATOT + MB / 2;
constexpr size_t O_MASK = O_ST + 32 * MB;
constexpr size_t O_R1_END = O_MASK + 4 * MB;
constexpr size_t O_HB = O_R1;
constexpr size_t O_QP = O_HB + 32 * MB;
constexpr size_t O_EIDX = O_QP + 64 * MB;
constexpr size_t O_GATE = O_EIDX + 8 * MB;
constexpr size_t O_U8 = O_GATE + 8 * MB;
constexpr size_t O_V8 = O_U8 + 16 * MB;
constexpr size_t O_ACT = O_V8 + 16 * MB;
constexpr size_t O_H8HI = O_ACT + 8 * MB;
constexpr size_t O_H8LO = O_H8HI + 16 * MB;
constexpr size_t O_R2_END = O_H8LO + 16 * MB;
constexpr size_t WS_NEEDED = (O_R1_END > O_R2_END ? O_R1_END : O_R2_END);
static_assert(WS_NEEDED <= 256 * MB, "workspace too large");
static_assert(O_R2_END <= O_R1_END + 64 * MB, "region 2 too large");

struct Params {
    const float* x; const int* pos; const float* w_in; const float* conv_w; const float* conv_b; const float* dt_bias;
    const float* a_log; const float* d_skip; const float* norm_w; const float* w_out; const float* ln1_g; const float* ln1_b;
    const float* wq; const float* k1; const float* k2; const float* u; const float* v; const float* ln2_g; const float* ln2_b;
    float* out; char* ws; int use_cg; int pad_;
};

#define SMEM_BYTES 133120

__device__ __forceinline__ int tid_op() { int t = threadIdx.x; asm volatile("" : "+v"(t)); return t; }
__device__ __forceinline__ bf16_t f2bf(float f) {
    unsigned u = __float_as_uint(f);
    u += 0x7FFFu + ((u >> 16) & 1u);
    return (bf16_t)(u >> 16);
}
__device__ __forceinline__ float bf2f(bf16_t b) { return __uint_as_float(((unsigned)b) << 16); }
__device__ __forceinline__ unsigned pack2(float a, float b) { return (unsigned)f2bf(a) | ((unsigned)f2bf(b) << 16); }
__device__ __forceinline__ unsigned f2sort(float f) { unsigned u = __float_as_uint(f); return (u & 0x80000000u) ? ~u : (u | 0x80000000u); }
__device__ __forceinline__ float sort2f(unsigned s) { unsigned u = (s & 0x80000000u) ? (s & 0x7FFFFFFFu) : ~s; return __uint_as_float(u); }
__device__ __forceinline__ f32x4 mfma16(bf16x8 a, bf16x8 b, f32x4 c) { return __builtin_amdgcn_mfma_f32_16x16x32_bf16(a, b, c, 0, 0, 0); }
__device__ __forceinline__ float silu_f(float v) { return v / (1.f + __expf(-v)); }
__device__ __forceinline__ bf16x8 ld8(const bf16_t* p) { return *(const bf16x8*)p; }
__device__ __forceinline__ bf16x8 cat4(bf16x4 lo, bf16x4 hi) { return __builtin_shufflevector(lo, hi, 0, 1, 2, 3, 4, 5, 6, 7); }


template <int CTRL, int ROWMASK, bool BC> __device__ __forceinline__ int dpp_i(int v) { return __builtin_amdgcn_update_dpp(0, v, CTRL, ROWMASK, 0xF, BC); }
template <int CTRL, int ROWMASK, bool BC> __device__ __forceinline__ float dpp_f(float v) { return __builtin_bit_cast(float, __builtin_amdgcn_update_dpp(0, __builtin_bit_cast(int, v), CTRL, ROWMASK, 0xF, BC)); }
__device__ __forceinline__ float row_sum(float v) { v += dpp_f<0xB1, 0xF, true>(v); v += dpp_f<0x4E, 0xF, true>(v); v += dpp_f<0x141, 0xF, true>(v); v += dpp_f<0x140, 0xF, true>(v); return v; }
__device__ __forceinline__ unsigned row_sum_u(unsigned v) { v += (unsigned)dpp_i<0xB1, 0xF, true>((int)v); v += (unsigned)dpp_i<0x4E, 0xF, true>((int)v); v += (unsigned)dpp_i<0x141, 0xF, true>((int)v); v += (unsigned)dpp_i<0x140, 0xF, true>((int)v); return v; }
__device__ __forceinline__ unsigned row_max_u(unsigned v) {
    v = max(v, (unsigned)dpp_i<0xB1, 0xF, true>((int)v)); v = max(v, (unsigned)dpp_i<0x4E, 0xF, true>((int)v));
    v = max(v, (unsigned)dpp_i<0x141, 0xF, true>((int)v)); v = max(v, (unsigned)dpp_i<0x140, 0xF, true>((int)v)); return v;
}
__device__ __forceinline__ float wave_sum_u(float v) {
    v = row_sum(v);
    v += dpp_f<0x142, 0xA, false>(v);
    v += dpp_f<0x143, 0xC, false>(v);
    return __builtin_bit_cast(float, __builtin_amdgcn_readlane(__builtin_bit_cast(int, v), 63));
}
typedef unsigned u32x2_t __attribute__((ext_vector_type(2)));
__device__ __forceinline__ float sum_x16(float v) { const u32x2_t r = __builtin_amdgcn_permlane16_swap(__float_as_uint(v), __float_as_uint(v), false, false); return __uint_as_float(r.x) + __uint_as_float(r.y); }
__device__ __forceinline__ float sum_x32(float v) { const u32x2_t r = __builtin_amdgcn_permlane32_swap(__float_as_uint(v), __float_as_uint(v), false, false); return __uint_as_float(r.x) + __uint_as_float(r.y); }
__device__ __forceinline__ float max_x16(float v) { const u32x2_t r = __builtin_amdgcn_permlane16_swap(__float_as_uint(v), __float_as_uint(v), false, false); return fmaxf(__uint_as_float(r.x), __uint_as_float(r.y)); }
__device__ __forceinline__ float max_x32(float v) { const u32x2_t r = __builtin_amdgcn_permlane32_swap(__float_as_uint(v), __float_as_uint(v), false, false); return fmaxf(__uint_as_float(r.x), __uint_as_float(r.y)); }
__device__ __forceinline__ float wave_sum(float v) { return sum_x32(sum_x16(row_sum(v))); }

#define XB_TMO      128
#define XB_XCNT(j)  (256  + 64 * (j))
#define XB_XSUB(j)  (1280 + 64 * (j))
#define XB_XGEN(j)  (2304 + 64 * (j))
#define XB_TOP      3328
#define XB_TOPGEN   3392
#define XCD_BAR_WORDS 3456
#define XB_SPIN_CAP (1u << 22)
#define LAS __attribute__((address_space(3)))
__device__ __forceinline__ unsigned xb_ld(unsigned* p)              { return __hip_atomic_load(p, __ATOMIC_RELAXED, __HIP_MEMORY_SCOPE_AGENT); }
__device__ __forceinline__ unsigned xb_add(unsigned* p, unsigned v) { return __hip_atomic_fetch_add(p, v, __ATOMIC_RELAXED, __HIP_MEMORY_SCOPE_AGENT); }
__device__ __forceinline__ unsigned xb_xcc_id() { return (unsigned)__builtin_amdgcn_s_getreg((3 << 11) | 20) & 0xFu; }
#define XB_SPIN(cond, bar) do { unsigned _sp = 0; while (cond) { __builtin_amdgcn_s_sleep(1); \
    if ((++_sp & 255u) == 0u) { if (xb_ld(&(bar)[XB_TMO])) break; if (_sp > XB_SPIN_CAP) { atomicAdd(&(bar)[XB_TMO], 1u); break; } } } } while (0)
struct XcdBarrier { unsigned* bar; unsigned x; volatile LAS unsigned* st; };
__device__ __forceinline__ XcdBarrier xcd_barrier_post(unsigned* bar, volatile LAS unsigned* st) {
    XcdBarrier b; b.bar = bar; b.x = xb_xcc_id(); b.st = st;
    if (threadIdx.x == 0) st[3] = xb_add(&bar[XB_XCNT(b.x)], 1u);
    return b;
}
__device__ __forceinline__ void xcd_barrier_complete(unsigned* bar, unsigned x, unsigned& nloc, unsigned& nx, unsigned& low8) {
    const unsigned G = gridDim.x * gridDim.y * gridDim.z;
    unsigned sum, cnt, mine, lo, sp = 0u;
    for (;;) {
        sum = 0u; cnt = 0u; mine = 0u; lo = 0u;
#pragma unroll
        for (unsigned j = 0; j < 16; ++j) { const unsigned c = xb_ld(&bar[XB_XCNT(j)]); sum += c; cnt += (c > 0u) ? 1u : 0u; lo += (j < 8u && c > 0u) ? 1u : 0u; mine = (j == x) ? c : mine; }
        if (sum == G) break;
        __builtin_amdgcn_s_sleep(1);
        if ((++sp & 255u) == 0u) { if (xb_ld(&bar[XB_TMO])) break; if (sp > XB_SPIN_CAP) { atomicAdd(&bar[XB_TMO], 1u); break; } }
    }
    nloc = mine > 0u ? mine : 1u; nx = cnt > 0u ? cnt : 1u; low8 = (lo == 8u && cnt == 8u) ? 1u : 0u;
}
__device__ __forceinline__ void xcd_barrier(const XcdBarrier& b) {
    asm volatile("s_waitcnt vmcnt(0)" ::: "memory");
    __syncthreads();
    if (threadIdx.x == 0) {
        unsigned* bar = b.bar;
        __builtin_amdgcn_s_waitcnt(0);
        unsigned nloc = b.st[0], nx = b.st[1];
        if (nloc == 0u) { unsigned low8; xcd_barrier_complete(bar, b.x, nloc, nx, low8); b.st[0] = nloc; b.st[1] = nx; b.st[2] = low8; }
        const unsigned old = xb_add(&bar[XB_XSUB(b.x)], 1u);
        const unsigned gen = old / nloc;
        if (old + 1u == (gen + 1u) * nloc) {
            __builtin_amdgcn_fence(__ATOMIC_RELEASE, "agent");
            asm volatile("s_waitcnt vmcnt(0)" ::: "memory");
            const unsigned og = xb_add(&bar[XB_TOP], 1u);
            const unsigned tg = og / nx;
            if (og + 1u == (tg + 1u) * nx) xb_add(&bar[XB_TOPGEN], 1u);
            else XB_SPIN(xb_ld(&bar[XB_TOPGEN]) == tg, bar);
            __builtin_amdgcn_fence(__ATOMIC_ACQUIRE, "agent");
            xb_add(&bar[XB_XGEN(b.x)], 1u);
            asm volatile("s_waitcnt vmcnt(0)" ::: "memory");
        } else {
            XB_SPIN(xb_ld(&bar[XB_XGEN(b.x)]) == gen, bar);
            __builtin_amdgcn_fence(__ATOMIC_ACQUIRE, "agent");
            asm volatile("s_waitcnt vmcnt(0)" ::: "memory");
        }
    }
    __syncthreads();
}

__device__ __forceinline__ int rot_perm(int gcol, int H) { const int j = (gcol % H) >> 3, e = gcol & 7; return (gcol / H) * H + 4 * j + (e & 3) + ((e >> 2) ? H / 2 : 0); }
__device__ __forceinline__ int win_src_col(int n) {
    if (n < 1024) return rot_perm(n, 64);
    if (n < 1536) return n;
    if (n < 1824) return 1536 + rot_perm(n - 1536, 32);
    if (n < 1832) return n;
    if (n < 1840) return 3368 + (n - 1832);
    if (n < 1856) return -1;
    if (n < 2368) return 1832 + (n - 1856);
    if (n < 3392) return 2344 + (n - 2368);
    return -1;
}
__device__ __forceinline__ void p0_transpose(const float* __restrict__ W, int N, int Nout, bool remap, bf16_t* __restrict__ Wt, int gtid, int gsz) {
    const int items = Nout * 128;
    for (int it = gtid; it < items; it += gsz) {
        const int n = it % Nout, kc = it / Nout;
        const int src = remap ? win_src_col(n) : n;
        unsigned w[4] = {0, 0, 0, 0};
        if (src >= 0) {
            float f[8];
#pragma unroll
            for (int j = 0; j < 8; ++j) f[j] = W[(size_t)(kc * 8 + j) * N + src];
#pragma unroll
            for (int j = 0; j < 4; ++j) w[j] = pack2(f[2 * j], f[2 * j + 1]);
        }
        *(uint4*)(Wt + (size_t)n * 1024 + kc * 8) = make_uint4(w[0], w[1], w[2], w[3]);
    }
}
__device__ __forceinline__ void p0_convert(const float* __restrict__ src, bf16_t* __restrict__ dst, size_t n4, size_t gtid, size_t gsz) {
    for (size_t i = gtid; i < n4; i += gsz) {
        const float4 f = ((const float4*)src)[i];
        ((uint2*)dst)[i] = make_uint2(pack2(f.x, f.y), pack2(f.z, f.w));
    }
}
__device__ __forceinline__ void phase0(const Params& p) {
    const int gtid = blockIdx.x * blockDim.x + tid_op(), gsz = gridDim.x * blockDim.x;
    p0_transpose(p.w_in, 3376, NP, true, (bf16_t*)(p.ws + O_WIN_T), gtid, gsz);
    p0_transpose(p.w_out, 1024, 1024, false, (bf16_t*)(p.ws + O_WOUT_T), gtid, gsz);
    p0_transpose(p.wq, 2048, 2048, false, (bf16_t*)(p.ws + O_WQ_T), gtid, gsz);
    p0_convert(p.k1, (bf16_t*)(p.ws + O_K1B), 128 * 128 / 4, gtid, gsz);
    p0_convert(p.k2, (bf16_t*)(p.ws + O_K2B), 128 * 128 / 4, gtid, gsz);
    p0_convert(p.x, (bf16_t*)(p.ws + O_XB), (size_t)NTOK * DM / 4, gtid, gsz);
    float2* cs64 = (float2*)(p.ws + O_CS64); float2* cs32 = (float2*)(p.ws + O_CS32);
    for (int it = gtid; it < NTOK * 48; it += gsz) {
        const int m = it / 48, i = it % 48;
        const float ps = (float)p.pos[m];
        if (i < 32) { const float inv = powf(10000.f, -(float)(2 * i) / 64.f); const float a = ps * inv; cs64[m * 32 + i] = make_float2(cosf(a), sinf(a)); }
        else { const int k = i - 32; const float inv = powf(10000.f, -(float)(2 * k) / 32.f); const float a = ps * inv; cs32[m * 16 + k] = make_float2(cosf(a), sinf(a)); }
    }
}

struct XcdMap { int slice, rank, nloc; };
__device__ __forceinline__ bool gemm_next_tile(const XcdMap& xm, int it, int ntn, int& tm, int& tn) {
    const int j = xm.rank + xm.nloc * it;
    if (j >= 8 * ntn) return false;
    tm = 8 * xm.slice + j / ntn; tn = j % ntn; return true;
}
#define GEMM_LDK 80
#define GEMM_LDS_A (256 * GEMM_LDK * 2)
#define GEMM_LDS_STAGE (GEMM_LDS_A + 128 * GEMM_LDK * 2)
typedef unsigned u32x4g __attribute__((ext_vector_type(4)));
struct GemmRegs { u32x4g a0, a1, a2, a3, b0, b1; };
__device__ __forceinline__ void gemm_gload(GemmRegs& r, const bf16_t* ga, const bf16_t* gb, size_t astep) {
    r.a0 = *(const u32x4g*)(ga); r.a1 = *(const u32x4g*)(ga + astep); r.a2 = *(const u32x4g*)(ga + 2 * astep); r.a3 = *(const u32x4g*)(ga + 3 * astep);
    r.b0 = *(const u32x4g*)(gb); r.b1 = *(const u32x4g*)(gb + astep);
}
__device__ __forceinline__ void gemm_lstore(const GemmRegs& r, bf16_t* wa, bf16_t* wb) {
    *(u32x4g*)(wa) = r.a0; *(u32x4g*)(wa + 64 * GEMM_LDK) = r.a1; *(u32x4g*)(wa + 128 * GEMM_LDK) = r.a2; *(u32x4g*)(wa + 192 * GEMM_LDK) = r.a3;
    *(u32x4g*)(wb) = r.b0; *(u32x4g*)(wb + 64 * GEMM_LDK) = r.b1;
}
__device__ __forceinline__ void gemm_compute(f32x4 (&acc)[4][4], const bf16_t* sA, const bf16_t* sB, int wm, int wn, int lane) {
#pragma unroll
    for (int ks = 0; ks < 2; ++ks) {
        bf16x8 a[4], b[4];
#pragma unroll
        for (int i = 0; i < 4; ++i) a[i] = ld8(sA + (wm * 64 + i * 16 + (lane & 15)) * GEMM_LDK + ks * 32 + (lane >> 4) * 8);
#pragma unroll
        for (int i = 0; i < 4; ++i) b[i] = ld8(sB + (wn * 64 + i * 16 + (lane & 15)) * GEMM_LDK + ks * 32 + (lane >> 4) * 8);
#pragma unroll
        for (int i = 0; i < 4; ++i)
#pragma unroll
            for (int j = 0; j < 4; ++j) acc[i][j] = mfma16(a[i], b[j], acc[i][j]);
    }
}
template <class Epi>
__device__ __forceinline__ void gemm_tile(const bf16_t* __restrict__ A, const bf16_t* __restrict__ Bt, int K, int m0, int n0, const Epi& epi, char* smem) {
    const int tid = tid_op(), lane = tid & 63, w = tid >> 6, wm = w >> 1, wn = w & 1;
    f32x4 acc[4][4];
#pragma unroll
    for (int i = 0; i < 4; ++i)
#pragma unroll
        for (int j = 0; j < 4; ++j) acc[i][j] = (f32x4){0.f, 0.f, 0.f, 0.f};
    const int lrow = tid >> 3, lkc = (tid & 7) * 8;
    const bf16_t* ga = A + (size_t)(m0 + lrow) * K + lkc;
    const bf16_t* gb = Bt + (size_t)(n0 + lrow) * K + lkc;
    const size_t astep = (size_t)64 * K;
    bf16_t* sA0 = (bf16_t*)smem; bf16_t* sB0 = (bf16_t*)(smem + GEMM_LDS_A);
    bf16_t* sA1 = (bf16_t*)(smem + GEMM_LDS_STAGE); bf16_t* sB1 = (bf16_t*)(smem + GEMM_LDS_STAGE + GEMM_LDS_A);
    const int woff = lrow * GEMM_LDK + lkc;
    GemmRegs r0, r1;
    gemm_gload(r0, ga, gb, astep);
    gemm_gload(r1, ga + 64, gb + 64, astep);
    __syncthreads();
    gemm_lstore(r0, sA0 + woff, sB0 + woff);
    __syncthreads();
    const int nk = K / 64;
    for (int k = 0; k < nk; k += 2) {
        { const int kk = (k + 2 < nk) ? k + 2 : nk - 1; gemm_gload(r0, ga + kk * 64, gb + kk * 64, astep); }
        gemm_compute(acc, sA0, sB0, wm, wn, lane);
        gemm_lstore(r1, sA1 + woff, sB1 + woff);
        __syncthreads();
        { const int kk = (k + 3 < nk) ? k + 3 : nk - 1; gemm_gload(r1, ga + kk * 64, gb + kk * 64, astep); }
        gemm_compute(acc, sA1, sB1, wm, wn, lane);
        gemm_lstore(r0, sA0 + woff, sB0 + woff);
        __syncthreads();
    }
    epi(acc, m0 + wm * 64, n0 + wn * 64, lane, smem + w * 9216);
}

namespace pg8 {
#define PG8_LAS __attribute__((address_space(3)))
typedef unsigned short bf16_t;
typedef short bf16x8 __attribute__((ext_vector_type(8)));
typedef float f32x4 __attribute__((ext_vector_type(4)));
typedef unsigned u32x4 __attribute__((ext_vector_type(4)));
constexpr int BM = 256, BK = 64, HALF = 128, HTB = HALF * BK * 2  , STAGE_BYTES = 8 * HTB, NXCD = 8, WGM = 8;

__host__ __device__ __forceinline__ int lds_byte(int r, int c) { const int st = (r >> 4) * 2 + (c >> 5), rr = r & 15, cc = c & 31, ob = rr * 64 + cc * 2; return st * 1024 + (ob ^ (((ob >> 9) & 1) << 5)); }
__host__ __device__ __forceinline__ void stage_rc(int b, int& R, int& C) { const int st = b / 1024, sb = b % 1024, swz = sb ^ (((sb >> 9) & 1) << 5); R = (st >> 1) * 16 + swz / 64; C = (st & 1) * 32 + (swz % 64) / 2; }
__host__ __device__ __forceinline__ int perm32(int rho) { const int n = rho >> 4, i = rho & 15; return 8 * (i >> 2) + 4 * n + (i & 3); }

struct Unit { int pm, pn; };
struct Gemm { const bf16_t* A; const bf16_t* Bt; int M, N, K; };

struct StaticOrder {
    int nM, nN, nwg, G, c;
    __host__ __device__ void init(int M, int N, int G_, int c_) { nM = M / BM; nN = N / BM; nwg = nM * nN; G = G_; c = c_; }
    __host__ __device__ bool next(int i, Unit& u) const {
        const long L = (long)i * G + c; if (L >= nwg) return false;
        int wgid = (int)L; { const int q = nwg / NXCD, r = nwg % NXCD, xcd = wgid % NXCD, off = wgid / NXCD; wgid = (xcd < r ? xcd * (q + 1) : r * (q + 1) + (xcd - r) * q) + off; }
        const int nig = WGM * nN, gid = wgid / nig, fm = gid * WGM, gsz = (nM - fm) < WGM ? (nM - fm) : WGM;
        u.pm = fm + ((wgid % nig) % gsz); u.pn = (wgid % nig) / gsz; return true;
    }
    __device__ __forceinline__ void a_ready(const Unit&) const {}
    __device__ __forceinline__ void done(const Unit&) const {}
};
__device__ __forceinline__ unsigned cvt_pk_bf16(float lo, float hi) { unsigned r; asm volatile("v_cvt_pk_bf16_f32 %0, %1, %2" : "=v"(r) : "v"(lo), "v"(hi)); return r; }

struct EpiBf16Plain {
    static constexpr bool PERM = true, AFTER_DRAIN = false;
    bf16_t* O; int ldc;
    __device__ __forceinline__ void operator()(const f32x4 (&acc)[2][2][4][2], const Unit& u, int wr, int wc, int fr, int fq) const {
        const int row0 = u.pm * BM + wr * 64 + fr, col0 = u.pn * BM + wc * 32 + 8 * fq;
#pragma unroll
        for (int ai = 0; ai < 2; ++ai)
#pragma unroll
            for (int m = 0; m < 4; ++m) { bf16_t* rowp = O + (size_t)(row0 + ai * HALF + m * 16) * ldc + col0;
#pragma unroll
                for (int bj = 0; bj < 2; ++bj) { const f32x4 v0 = acc[ai][bj][m][0], v1 = acc[ai][bj][m][1];
                    u32x4 w; w.x = cvt_pk_bf16(v0[0], v0[1]); w.y = cvt_pk_bf16(v0[2], v0[3]); w.z = cvt_pk_bf16(v1[0], v1[1]); w.w = cvt_pk_bf16(v1[2], v1[3]);
                    *(u32x4*)(rowp + bj * HALF) = w; } }
    }
};
struct EpiResF32 {
    static constexpr bool PERM = false, AFTER_DRAIN = false;
    float* Y; const float* X; int ldc; float alpha;
    __device__ __forceinline__ void operator()(const f32x4 (&acc)[2][2][4][2], const Unit& u, int wr, int wc, int fr, int fq) const {
        const int row0 = u.pm * BM + wr * 64 + fr, col0 = u.pn * BM + wc * 32 + 4 * fq;
#pragma unroll
        for (int ai = 0; ai < 2; ++ai)
#pragma unroll
            for (int m = 0; m < 4; ++m) { const size_t ro = (size_t)(row0 + ai * HALF + m * 16) * ldc + col0;
#pragma unroll
                for (int bj = 0; bj < 2; ++bj)
#pragma unroll
                    for (int n = 0; n < 2; ++n) { const f32x4 xv = *(const f32x4*)(X + ro + bj * HALF + n * 16); *(f32x4*)(Y + ro + bj * HALF + n * 16) = xv * alpha + acc[ai][bj][m][n]; } }
    }
};
struct EpiResBf16 {
    static constexpr bool PERM = true, AFTER_DRAIN = false;
    bf16_t* Y; const float* X; int ldc; float alpha;
    __device__ __forceinline__ void operator()(const f32x4 (&acc)[2][2][4][2], const Unit& u, int wr, int wc, int fr, int fq) const {
        const int row0 = u.pm * BM + wr * 64 + fr, col0 = u.pn * BM + wc * 32 + 8 * fq;
#pragma unroll
        for (int ai = 0; ai < 2; ++ai)
#pragma unroll
            for (int m = 0; m < 4; ++m) { const size_t ro = (size_t)(row0 + ai * HALF + m * 16) * ldc + col0;
#pragma unroll
                for (int bj = 0; bj < 2; ++bj) {
                    const f32x4 x0 = *(const f32x4*)(X + ro + bj * HALF), x1 = *(const f32x4*)(X + ro + bj * HALF + 4);
                    const f32x4 v0 = x0 * alpha + acc[ai][bj][m][0], v1 = x1 * alpha + acc[ai][bj][m][1];
                    u32x4 w; w.x = cvt_pk_bf16(v0[0], v0[1]); w.y = cvt_pk_bf16(v0[2], v0[3]); w.z = cvt_pk_bf16(v1[0], v1[1]); w.w = cvt_pk_bf16(v1[2], v1[3]);
                    *(u32x4*)(Y + ro + bj * HALF) = w; } }
    }
};
template <class Epi, class Sched, bool STAMP = false>
__device__ __forceinline__ void gemm_phase(PG8_LAS unsigned char* lds, const Gemm g, const Sched& S, const Epi& E, unsigned long long* stamps) {
    const int tid = tid_op(), wid = __builtin_amdgcn_readfirstlane(tid >> 6), lane = tid & 63, wr = wid >> 2, wc = wid & 3, fr = lane & 15, fq = lane >> 4;
    const int K = g.K, nt = K / BK;
    int ts_lo = 0, ts_hi = 0, nts = 0; const unsigned long long rt_entry = STAMP ? (unsigned long long)wall_clock64() : 0ull;
#define PG8_STAMP() do { if (STAMP && wid == 0 && nts < 64) { const unsigned long long _c = (unsigned long long)clock64(); \
        ts_lo = (lane == nts) ? (int)(unsigned)_c : ts_lo; ts_hi = (lane == nts) ? (int)(unsigned)(_c >> 32) : ts_hi; ++nts; } } while (0)
    PG8_STAMP();
    unsigned voffA[2], voffB[2];
#pragma unroll
    for (int i = 0; i < 2; ++i) { int R, C; stage_rc(tid * 16 + i * 8192, R, C); const int Rb = Epi::PERM ? ((R & ~31) + perm32(R & 31)) : R;
        voffA[i] = (unsigned)(R * K + C) * 2u; voffB[i] = (unsigned)(Rb * K + C) * 2u; }
    const size_t kstep = (size_t)(BK * 2);
    const size_t hstep = (size_t)HALF * K * 2;
    const size_t tstep = 2 * hstep;
    const unsigned ldsw = (unsigned)wid * 1024u;
    const int aoff = lds_byte(wr * 64 + fr, fq * 8), boff = lds_byte(wc * 32 + fr, fq * 8);
#define PG8_SA(b, h) (((b) * 2 + (h)) * HTB)
#define PG8_SB(b, h) ((4 + (b) * 2 + (h)) * HTB)
#define PG8_STAGE(bufoff, gbase, voff) do { _Pragma("unroll") for (int _i = 0; _i < 2; ++_i) \
        __builtin_amdgcn_global_load_lds((const unsigned*)((const char*)(gbase) + (voff)[_i]), (PG8_LAS unsigned*)(lds + (bufoff) + ldsw + _i * 8192), 16, 0, 0); } while (0)
#define PG8_LDA(dst, b, h) do { _Pragma("unroll") for (int m = 0; m < 4; ++m) _Pragma("unroll") for (int k = 0; k < 2; ++k) dst[m][k] = *(const PG8_LAS bf16x8*)(lds + PG8_SA(b, h) + aoff + m * 2048 + k * 1024); } while (0)
#define PG8_LDB(dst, b, h) do { _Pragma("unroll") for (int n = 0; n < 2; ++n) _Pragma("unroll") for (int k = 0; k < 2; ++k) dst[n][k] = *(const PG8_LAS bf16x8*)(lds + PG8_SB(b, h) + boff + n * 2048 + k * 1024); } while (0)
#define PG8_MMA(ai, bj, At, Bt) do { __builtin_amdgcn_s_setprio(1); _Pragma("unroll") for (int m = 0; m < 4; ++m) _Pragma("unroll") for (int n = 0; n < 2; ++n) _Pragma("unroll") for (int k = 0; k < 2; ++k) \
        acc[ai][bj][m][n] = __builtin_amdgcn_mfma_f32_16x16x32_bf16(Bt[n][k], At[m][k], acc[ai][bj][m][n], 0, 0, 0); __builtin_amdgcn_s_setprio(0); } while (0)
#define PG8_WAIT_V(n) asm volatile("s_waitcnt vmcnt(" #n ")" ::: "memory")
#define PG8_WAIT_L(n) asm volatile("s_waitcnt lgkmcnt(" #n ")" ::: "memory")
#define PG8_BAR __builtin_amdgcn_s_barrier()
#define PG8_SCHED __builtin_amdgcn_sched_barrier(0)
    Unit cur, nxt; int ui = 0;
    if (!S.next(0, cur)) return;
    f32x4 acc[2][2][4][2];
#pragma unroll
    for (int a = 0; a < 2; ++a)
#pragma unroll
        for (int b = 0; b < 2; ++b)
#pragma unroll
            for (int m = 0; m < 4; ++m)
#pragma unroll
                for (int n = 0; n < 2; ++n) acc[a][b][m][n] = (f32x4){0.f, 0.f, 0.f, 0.f};
    bf16x8 At[4][2], B0[2][2], B1[2][2];
    const char* cA = (const char*)g.A + (size_t)cur.pm * tstep; const char* cB = (const char*)g.Bt + (size_t)cur.pn * tstep;
    S.a_ready(cur);
    PG8_STAGE(PG8_SB(0, 0), cB, voffB); PG8_STAGE(PG8_SA(0, 0), cA, voffA); PG8_STAGE(PG8_SB(0, 1), cB + hstep, voffB); PG8_STAGE(PG8_SA(0, 1), cA + hstep, voffA);
    if (wr == 1) PG8_BAR;
    PG8_WAIT_V(4); PG8_BAR;
    PG8_STAGE(PG8_SB(1, 0), cB + kstep, voffB); PG8_STAGE(PG8_SA(1, 0), cA + kstep, voffA); PG8_STAGE(PG8_SB(1, 1), cB + hstep + kstep, voffB);
    PG8_WAIT_V(6); PG8_BAR;
    PG8_STAMP();
    for (;;) {
        const bool has_next = S.next(ui + 1, nxt);
        const char* nA = has_next ? (const char*)g.A + (size_t)nxt.pm * tstep : cA; const char* nB = has_next ? (const char*)g.Bt + (size_t)nxt.pn * tstep : cB;
        for (int t = 0; t < nt; t += 2) {
            const bool last = (t == nt - 2);
            const char* a1 = cA + (size_t)(t + 1) * kstep;
            const char* a2 = last ? nA : cA + (size_t)(t + 2) * kstep; const char* b2 = last ? nB : cB + (size_t)(t + 2) * kstep;
            const char* a3 = a2 + kstep; const char* b3 = b2 + kstep;
            if (last && has_next) S.a_ready(nxt);
            PG8_LDB(B0, 0, 0); PG8_SCHED; PG8_LDA(At, 0, 0); PG8_STAGE(PG8_SA(1, 1), a1 + hstep, voffA);
            PG8_WAIT_L(8); PG8_BAR; PG8_WAIT_L(0); PG8_MMA(0, 0, At, B0); PG8_BAR; PG8_SCHED;
            PG8_LDB(B1, 0, 1); PG8_STAGE(PG8_SB(0, 0), b2, voffB);
            PG8_BAR; PG8_WAIT_L(0); PG8_MMA(0, 1, At, B1); PG8_BAR;
            PG8_LDA(At, 0, 1); PG8_STAGE(PG8_SA(0, 0), a2, voffA);
            PG8_BAR; PG8_WAIT_L(0); PG8_MMA(1, 0, At, B0); PG8_BAR; PG8_SCHED;
            PG8_STAGE(PG8_SB(0, 1), b2 + hstep, voffB);
            PG8_WAIT_V(6); PG8_BAR; PG8_MMA(1, 1, At, B1); PG8_BAR;
            PG8_LDB(B0, 1, 0); PG8_SCHED; PG8_LDA(At, 1, 0); PG8_STAGE(PG8_SA(0, 1), a2 + hstep, voffA);
            PG8_WAIT_L(8); PG8_BAR; PG8_WAIT_L(0); PG8_MMA(0, 0, At, B0); PG8_BAR; PG8_SCHED;
            PG8_LDB(B1, 1, 1); PG8_STAGE(PG8_SB(1, 0), b3, voffB);
            PG8_BAR; PG8_WAIT_L(0); PG8_MMA(0, 1, At, B1); PG8_BAR;
            PG8_LDA(At, 1, 1); PG8_STAGE(PG8_SA(1, 0), a3, voffA);
            PG8_BAR; PG8_WAIT_L(0); PG8_MMA(1, 0, At, B0); PG8_BAR; PG8_SCHED;
            PG8_STAGE(PG8_SB(1, 1), b3 + hstep, voffB);
            PG8_WAIT_V(6); PG8_BAR; PG8_MMA(1, 1, At, B1); PG8_BAR;
        }
        PG8_STAMP();
        if constexpr (!Epi::AFTER_DRAIN) { E(acc, cur, wr, wc, fr, fq); S.done(cur); }
        PG8_STAMP();
        if (!has_next) break;
#pragma unroll
        for (int a = 0; a < 2; ++a)
#pragma unroll
            for (int b = 0; b < 2; ++b)
#pragma unroll
                for (int m = 0; m < 4; ++m)
#pragma unroll
                    for (int n = 0; n < 2; ++n) acc[a][b][m][n] = (f32x4){0.f, 0.f, 0.f, 0.f};
        cur = nxt; cA = nA; cB = nB; ++ui;
    }
    PG8_WAIT_V(0);
    if (wr == 0) PG8_BAR;
    PG8_BAR;
    if constexpr (Epi::AFTER_DRAIN) { E.fused(acc, cur, wr, wc, fr, fq, lds, wid, lane); S.done(cur); }
    PG8_STAMP();
    if (STAMP && wid == 0) { stamps[lane] = lane < nts ? (((unsigned long long)(unsigned)ts_hi << 32) | (unsigned)ts_lo) : 0ull;
        if (lane == 62) stamps[62] = rt_entry; if (lane == 63) stamps[63] = (unsigned long long)wall_clock64(); }
#undef PG8_STAMP
#undef PG8_SA
#undef PG8_SB
#undef PG8_STAGE
#undef PG8_LDA
#undef PG8_LDB
#undef PG8_MMA
#undef PG8_WAIT_V
#undef PG8_WAIT_L
#undef PG8_BAR
#undef PG8_SCHED
}
}

struct ProjEpi8 {
    static constexpr bool PERM = true, AFTER_DRAIN = false;
    char* ws; const float* dt_bias;
    __device__ __forceinline__ uint4 rot8(const pg8::f32x4 v0, const pg8::f32x4 v1, const float* tab, float sc) const {
        const float4 c01 = *(const float4*)tab, c23 = *(const float4*)(tab + 4);
        const float o10 = (v0[0] * c01.x - v1[0] * c01.y) * sc, o11 = (v0[1] * c01.z - v1[1] * c01.w) * sc, o12 = (v0[2] * c23.x - v1[2] * c23.y) * sc, o13 = (v0[3] * c23.z - v1[3] * c23.w) * sc;
        const float o20 = (v1[0] * c01.x + v0[0] * c01.y) * sc, o21 = (v1[1] * c01.z + v0[1] * c01.w) * sc, o22 = (v1[2] * c23.x + v0[2] * c23.y) * sc, o23 = (v1[3] * c23.z + v0[3] * c23.w) * sc;
        return make_uint4(pack2(o10, o11), pack2(o12, o13), pack2(o20, o21), pack2(o22, o23));
    }
    template <int SEG> __device__ __forceinline__ void store_row(const pg8::f32x4 v0, const pg8::f32x4 v1, const int cg, const int row) const {
        const int b = row >> 11, t = row & 2047;
        if (SEG == 0) {
            const bool isq = cg < 512; const int head = (cg & 511) >> 6, j = (cg & 63) >> 3;
            bf16_t* dst = (bf16_t*)(ws + (isq ? O_QB : O_KB)) + ((size_t)(b * 8 + head) * 2048 + t) * 64 + 8 * j;
            *(uint4*)dst = rot8(v0, v1, (const float*)(ws + O_CS64) + ((size_t)row * 32 + 4 * j) * 2, isq ? 0.125f * 1.4426950408889634f : 1.f);
        } else if (SEG == 1) {
            bf16_t* dst = (bf16_t*)(ws + O_VT) + ((size_t)(b * 8 + ((cg - 1024) >> 6)) * 64 + (cg & 63)) * 2048 + t;
#pragma unroll
            for (int e = 0; e < 4; ++e) { dst[(size_t)e * 2048] = f2bf(v0[e]); dst[(size_t)(e + 4) * 2048] = f2bf(v1[e]); }
        } else if (SEG == 2) {
            const int j = (cg & 31) >> 3;
            *(uint4*)((bf16_t*)(ws + O_IQB) + ((size_t)row * 8 + ((cg - 1536) >> 5)) * 32 + 8 * j) = rot8(v0, v1, (const float*)(ws + O_CS32) + ((size_t)row * 16 + 4 * j) * 2, 0.17677669529663687f);
        } else if (SEG == 3) {
            if (cg < 1824) {
                const int j = (cg & 31) >> 3;
                *(uint4*)((bf16_t*)(ws + O_IKB) + (size_t)row * 32 + 8 * j) = rot8(v0, v1, (const float*)(ws + O_CS32) + ((size_t)row * 16 + 4 * j) * 2, 1.f);
            } else if (cg == 1824) {
                const float k8 = 0.35355339059327373f; float* d = (float*)(ws + O_IWF) + (size_t)row * 8;
                *(float4*)d = make_float4(v0[0] * k8, v0[1] * k8, v0[2] * k8, v0[3] * k8); *(float4*)(d + 4) = make_float4(v1[0] * k8, v1[1] * k8, v1[2] * k8, v1[3] * k8);
            } else if (cg == 1832) {
                float o[8];
#pragma unroll
                for (int e = 0; e < 4; ++e) { const float a0 = v0[e] + dt_bias[e], a1 = v1[e] + dt_bias[4 + e]; o[e] = (a0 > 20.f) ? a0 : __logf(1.f + __expf(a0)); o[4 + e] = (a1 > 20.f) ? a1 : __logf(1.f + __expf(a1)); }
                float* d = (float*)(ws + O_DTF) + (size_t)row * 8;
                *(float4*)d = make_float4(o[0], o[1], o[2], o[3]); *(float4*)(d + 4) = make_float4(o[4], o[5], o[6], o[7]);
            }
        } else if (SEG == 4) {
            *(uint4*)((bf16_t*)(ws + O_ZB) + (size_t)row * 512 + (cg - ZOFF)) = make_uint4(pack2(v0[0], v0[1]), pack2(v0[2], v0[3]), pack2(v1[0], v1[1]), pack2(v1[2], v1[3]));
        } else {
            bf16_t* dst = (bf16_t*)(ws + O_XBCT) + ((size_t)b * 1024 + (cg - XBCOFF)) * 2048 + t;
#pragma unroll
            for (int e = 0; e < 4; ++e) { dst[(size_t)e * 2048] = f2bf(v0[e]); dst[(size_t)(e + 4) * 2048] = f2bf(v1[e]); }
        }
    }
    template <int SEG, int BJ> __device__ __forceinline__ void rows8(const pg8::f32x4 (&acc)[2][2][4][2], const int cg, const int row0) const {
#pragma unroll
        for (int ai = 0; ai < 2; ++ai)
#pragma unroll
            for (int m = 0; m < 4; ++m) store_row<SEG>(acc[ai][BJ][m][0], acc[ai][BJ][m][1], cg, row0 + ai * 128 + m * 16);
    }
    template <int BJ> __device__ __forceinline__ void half(const pg8::f32x4 (&acc)[2][2][4][2], const pg8::Unit& u, int wr, int wc, int fr, int fq) const {
        const int cw = u.pn * 256 + BJ * 128 + wc * 32;
        const int cg = cw + 8 * fq, row0 = u.pm * 256 + wr * 64 + fr;
        if (cw < 1024) rows8<0, BJ>(acc, cg, row0);
        else if (cw < 1536) rows8<1, BJ>(acc, cg, row0);
        else if (cw < 1792) rows8<2, BJ>(acc, cg, row0);
        else if (cw < 1856) rows8<3, BJ>(acc, cg, row0);
        else if (cw < 2368) rows8<4, BJ>(acc, cg, row0);
        else if (cw < NUSED) rows8<5, BJ>(acc, cg, row0);
    }
    __device__ __forceinline__ void operator()(const pg8::f32x4 (&acc)[2][2][4][2], const pg8::Unit& u, int wr, int wc, int fr, int fq) const {
        half<0>(acc, u, wr, wc, fr, fq); half<1>(acc, u, wr, wc, fr, fq);
    }
};
__device__ __forceinline__ void phase1(const Params& p, char* smem, const XcdMap xm) {
    char* ws = p.ws;
    ProjEpi8 e; e.ws = ws; e.dt_bias = p.dt_bias;
    pg8::Gemm g{(const bf16_t*)(ws + O_XB), (const bf16_t*)(ws + O_WIN_T), NTOK, NP, 1024};
    pg8::StaticOrder S; S.init(NTOK, NP, (int)gridDim.x, (int)blockIdx.x);
    pg8::gemm_phase<ProjEpi8, pg8::StaticOrder, false>((PG8_LAS unsigned char*)smem, g, S, e, nullptr);
}

#define IDX_NT 16
#define IDX_LDS_SCORES (16 * 2048 * 4)
__device__ __forceinline__ unsigned wave_sum_cnt(unsigned v) {
    v = row_sum_u(v);
    v += (unsigned)dpp_i<0x142, 0xA, false>((int)v);
    v += (unsigned)dpp_i<0x143, 0xC, false>((int)v);
    return (unsigned)__builtin_amdgcn_readlane((int)v, 63);
}
template <int NR> __device__ __forceinline__ unsigned idx_count_ge(const unsigned (&k)[NR], unsigned cand) {
    unsigned n = 0u;
#pragma unroll
    for (int i = 0; i < NR; ++i) n += (k[i] >= cand) ? 1u : 0u;
    return wave_sum_cnt(n);
}
template <int NR> __device__ __forceinline__ unsigned long long idx_words(const unsigned (&k)[NR], unsigned K, bool exact, int lane) {
    unsigned long long wd = 0ull;
    if (exact) {
#pragma unroll
        for (int i = 0; i < NR; ++i) { const unsigned long long bal = __ballot(k[i] >= K); if (lane == i) wd = bal; }
    } else {
        unsigned n = 0u;
#pragma unroll
        for (int i = 0; i < NR; ++i) n += (k[i] > K) ? 1u : 0u;
        unsigned rem = 256u - wave_sum_cnt(n);
#pragma unroll 1
        for (int i = 0; i < NR; ++i) {
            unsigned ki = k[0];
#pragma unroll
            for (int j = 1; j < NR; ++j) ki = (j == i) ? k[j] : ki;
            const unsigned long long gt = __ballot(ki > K), eq = __ballot(ki == K);
            unsigned long long take = 0ull, e = eq;
            while (rem > 0u && e) { take |= e & (~e + 1ull); e &= e - 1ull; --rem; }
            if (lane == i) wd = gt | take;
        }
    }
    return wd;
}
template <int NR> __device__ __forceinline__ void idx_select(const unsigned* Sa, unsigned long long* mrow, int lane) {
    unsigned ka[NR], kb[NR];
#pragma unroll
    for (int i = 0; i < NR; ++i) { ka[i] = Sa[64 * i]; kb[i] = Sa[2048 + 64 * i]; }
    unsigned Ka = 0u, Kb = 0u; bool da = false, db = false;
    for (int bit = 31; bit >= 0; --bit) {
        const unsigned ca = Ka | (1u << bit), cb = Kb | (1u << bit);
        const unsigned ta = idx_count_ge<NR>(ka, ca), tb = idx_count_ge<NR>(kb, cb);
        if (!da && ta >= 256u) { Ka = ca; da = (ta == 256u); }
        if (!db && tb >= 256u) { Kb = cb; db = (tb == 256u); }
        if (da && db) break;
    }
    const unsigned long long wa = idx_words<NR>(ka, Ka, da, lane), wb = idx_words<NR>(kb, Kb, db, lane);
    if (lane < NR) { mrow[lane] = wa; mrow[32 + lane] = wb; }
}
__device__ __forceinline__ void indexer_unit(const Params& p, int unit, char* smem) {
    const int tid = tid_op(), lane = tid & 63, w = tid >> 6, c = lane & 15, g = lane >> 4;
    const int b = unit & 7, grp = 127 - (unit >> 3), t0 = grp * 16;
    char* ws = p.ws;
    unsigned long long* mask64 = (unsigned long long*)(ws + O_MASK) + (size_t)(b * 2048 + t0) * 32;
    const int nblk64 = (t0 + 16 + 63) >> 6;
    if (t0 < 256) {
        for (int i = tid; i < 16 * nblk64; i += 512) {
            const int q = i / nblk64, wd = i % nblk64, t = t0 + q, s0 = wd * 64;
            const unsigned long long bits = (t >= s0 + 63) ? ~0ull : (t < s0 ? 0ull : ((1ull << (t - s0 + 1)) - 1ull));
            mask64[q * 32 + wd] = bits;
        }
        return;
    }
    const int ntile = (nblk64 + 1) >> 1;
    const bf16_t* IQb = (const bf16_t*)(ws + O_IQB); const bf16_t* IKb = (const bf16_t*)(ws + O_IKB); const float* IWf = (const float*)(ws + O_IWF);
    unsigned* S = (unsigned*)smem;
    float* siw = (float*)(smem + IDX_LDS_SCORES);
    __syncthreads();
    if (tid < 128) siw[tid] = IWf[(size_t)(b * 2048 + t0) * 8 + tid];
    {
        const int nr = (nblk64 <= 8) ? 8 : (nblk64 <= 16) ? 16 : (nblk64 <= 24) ? 24 : 32, kfrom = 8 * ntile * 16, kto = nr * 64;
        for (int i = tid; i < 16 * (kto - kfrom); i += 512) { const int q = i / (kto - kfrom), k = kfrom + i % (kto - kfrom); S[q * 2048 + k] = 0u; }
    }
    __syncthreads();
    {
        bf16x8 aq[8];
#pragma unroll
        for (int h = 0; h < 8; ++h) aq[h] = ld8(IQb + ((size_t)(b * 2048 + t0 + c) * 8 + h) * 32 + g * 8);
        float wq[4][8];
#pragma unroll
        for (int r = 0; r < 4; ++r)
#pragma unroll
            for (int h = 0; h < 8; ++h) wq[r][h] = siw[(4 * g + r) * 8 + h];
        bf16x8 bk[IDX_NT];
#pragma unroll
        for (int i = 0; i < IDX_NT; ++i) {
            const int ti = (i < ntile) ? (w * ntile + i) : (w * ntile);
            bk[i] = ld8(IKb + (size_t)(b * 2048 + ti * 16 + c) * 32 + g * 8);
        }
#pragma unroll
        for (int i = 0; i < IDX_NT; ++i) {
            if (i < ntile) {
                const int s0 = (w * ntile + i) * 16;
                float sc[4] = {0.f, 0.f, 0.f, 0.f};
#pragma unroll
                for (int h = 0; h < 8; ++h) {
                    const f32x4 o = mfma16(aq[h], bk[i], (f32x4){0.f, 0.f, 0.f, 0.f});
#pragma unroll
                    for (int r = 0; r < 4; ++r) sc[r] += wq[r][h] * fmaxf(o[r], 0.f);
                }
#pragma unroll
                for (int r = 0; r < 4; ++r) S[(4 * g + r) * 2048 + s0 + c] = (s0 + c <= t0 + 4 * g + r) ? f2sort(sc[r]) : 0u;
            }
        }
    }
    __syncthreads();
    if (nblk64 <= 8) idx_select<8>(S + (2 * w) * 2048 + lane, mask64 + (2 * w) * 32, lane);
    else if (nblk64 <= 16) idx_select<16>(S + (2 * w) * 2048 + lane, mask64 + (2 * w) * 32, lane);
    else if (nblk64 <= 24) idx_select<24>(S + (2 * w) * 2048 + lane, mask64 + (2 * w) * 32, lane);
    else idx_select<32>(S + (2 * w) * 2048 + lane, mask64 + (2 * w) * 32, lane);
}

__device__ __forceinline__ void ssd_prep_unit(const Params& p, int unit, char* smem) {
    const int tid = tid_op(), lane = tid & 63, w = tid >> 6, cL = lane & 15, gq = lane >> 4;
    const int h = unit & 7, c = (unit >> 3) & 15, b = unit >> 7, g = h >> 2;
    char* ws = p.ws;
    float* s_acum = (float*)smem; float* s_dt = s_acum + 128; float* s_w = s_dt + 128;
    bf16_t* sXw = (bf16_t*)(smem + 2048); bf16_t* sBt = sXw + 64 * 136;
    const int tok0 = b * 2048 + c * 128;
    const float a_h = -expf(p.a_log[h]);
    const float* DTf = (const float*)(ws + O_DTF);
    __syncthreads();
    if (tid < 128) s_dt[tid] = DTf[(size_t)(tok0 + tid) * 8 + h];
    __syncthreads();
    if (tid < 128) {
        float s = 0.f;
        for (int k = 0; k <= tid; ++k) s += s_dt[k] * a_h;
        s_acum[tid] = s;
        ((float*)(ws + O_ACUM))[(size_t)(b * 8 + h) * 2048 + c * 128 + tid] = s;
    }
    __syncthreads();
    if (tid < 128) {
        const float tot = s_acum[127];
        s_w[tid] = s_dt[tid] * __expf(tot - s_acum[tid]);
        if (tid == 0) ((float*)(ws + O_ATOT))[(b * 8 + h) * 16 + c] = tot;
    }
    __syncthreads();
    const bf16_t* XBCt = (const bf16_t*)(ws + O_XBCT);
    bf16_t* Xt = (bf16_t*)(ws + O_XT); bf16_t* Brm = (bf16_t*)(ws + O_BRM); bf16_t* Crm = (bf16_t*)(ws + O_CRM);
#pragma unroll
    for (int bt = 0; bt < 2; ++bt) {
    const int it0 = bt * 4, itn = bt ? 3 : 4;
    u32x4g cur7[4], prv7[4]; float cw7[4][5];
#pragma unroll
    for (int it = 0; it < 4; ++it) if (it < itn) {
        const int item = tid + 512 * (it0 + it);
        int ch; const int tc = item & 15;
        if (item < 1024) ch = h * 64 + (item >> 4);
        else if (item < 3072) ch = 512 + g * 128 + ((item - 1024) >> 4);
        else ch = 768 + g * 128 + (h & 3) * 32 + ((item - 3072) >> 4);
        const bf16_t* src = XBCt + ((size_t)b * 1024 + ch) * 2048 + c * 128 + tc * 8;
        cur7[it] = *(const u32x4g*)src;
        const bool hasprev = (c * 128 + tc * 8 >= 8);
        prv7[it] = *(const u32x4g*)(hasprev ? src - 8 : src);
        if (!hasprev) prv7[it] = (u32x4g){0u, 0u, 0u, 0u};
        cw7[it][0] = p.conv_w[ch]; cw7[it][1] = p.conv_w[1024 + ch]; cw7[it][2] = p.conv_w[2048 + ch]; cw7[it][3] = p.conv_w[3072 + ch]; cw7[it][4] = p.conv_b[ch];
    }
#pragma unroll
    for (int it = 0; it < 4; ++it) if (it < itn) {
        const int item = tid + 512 * (it0 + it);
        int kind, idx, ch; const int tc = item & 15;
        if (item < 1024) { kind = 0; idx = item >> 4; ch = h * 64 + idx; }
        else if (item < 3072) { kind = 1; idx = (item - 1024) >> 4; ch = 512 + g * 128 + idx; }
        else { kind = 2; idx = (h & 3) * 32 + ((item - 3072) >> 4); ch = 768 + g * 128 + idx; }
        const u32x4g cur = cur7[it], prv = prv7[it];
        float xv[11];
        xv[0] = bf2f((bf16_t)(prv.z >> 16)); xv[1] = bf2f((bf16_t)(prv.w & 0xFFFF)); xv[2] = bf2f((bf16_t)(prv.w >> 16));
        xv[3] = bf2f((bf16_t)(cur.x & 0xFFFF)); xv[4] = bf2f((bf16_t)(cur.x >> 16)); xv[5] = bf2f((bf16_t)(cur.y & 0xFFFF)); xv[6] = bf2f((bf16_t)(cur.y >> 16));
        xv[7] = bf2f((bf16_t)(cur.z & 0xFFFF)); xv[8] = bf2f((bf16_t)(cur.z >> 16)); xv[9] = bf2f((bf16_t)(cur.w & 0xFFFF)); xv[10] = bf2f((bf16_t)(cur.w >> 16));
        const float w0 = cw7[it][0], w1 = cw7[it][1], w2 = cw7[it][2], w3 = cw7[it][3], bias = cw7[it][4];
        float o[8];
#pragma unroll
        for (int j = 0; j < 8; ++j) { const float v = bias + w0 * xv[j] + w1 * xv[j + 1] + w2 * xv[j + 2] + w3 * xv[j + 3]; o[j] = bf2f(f2bf(silu_f(v))); }
        if (kind == 0) {
            *(uint4*)(Xt + ((size_t)b * 512 + ch) * 2048 + c * 128 + tc * 8) = make_uint4(pack2(o[0], o[1]), pack2(o[2], o[3]), pack2(o[4], o[5]), pack2(o[6], o[7]));
            float q[8];
#pragma unroll
            for (int j = 0; j < 8; ++j) q[j] = o[j] * s_w[tc * 8 + j];
            *(uint4*)(sXw + idx * 136 + tc * 8) = make_uint4(pack2(q[0], q[1]), pack2(q[2], q[3]), pack2(q[4], q[5]), pack2(q[6], q[7]));
        } else if (kind == 1) {
            *(uint4*)(sBt + idx * 136 + tc * 8) = make_uint4(pack2(o[0], o[1]), pack2(o[2], o[3]), pack2(o[4], o[5]), pack2(o[6], o[7]));
            if ((h & 3) == 0) {
#pragma unroll
                for (int j = 0; j < 8; ++j) Brm[(size_t)(tok0 + tc * 8 + j) * 256 + g * 128 + idx] = f2bf(o[j]);
            }
        } else {
#pragma unroll
            for (int j = 0; j < 8; ++j) Crm[(size_t)(tok0 + tc * 8 + j) * 256 + g * 128 + idx] = f2bf(o[j]);
        }
    }
    }
    __syncthreads();
    f32x4 acc[4];
#pragma unroll
    for (int i = 0; i < 4; ++i) acc[i] = (f32x4){0.f, 0.f, 0.f, 0.f};
#pragma unroll
    for (int ks = 0; ks < 4; ++ks) {
        const bf16x8 bb = ld8(sBt + (16 * w + cL) * 136 + ks * 32 + gq * 8);
#pragma unroll
        for (int pt = 0; pt < 4; ++pt) acc[pt] = mfma16(ld8(sXw + (16 * pt + cL) * 136 + ks * 32 + gq * 8), bb, acc[pt]);
    }
    float* ST = (float*)(ws + O_ST) + ((size_t)((b * 16 + c) * 8 + h)) * 8192;
#pragma unroll
    for (int pt = 0; pt < 4; ++pt)
#pragma unroll
        for (int r = 0; r < 4; ++r) ST[(16 * pt + 4 * gq + r) * 128 + 16 * w + cL] = acc[pt][r];
}

__device__ __forceinline__ void phase2c(const Params& p) {
    char* ws = p.ws;
    const int idx = blockIdx.x * 512 + tid_op();
    if (idx >= 64 * 2048) return;
    const int bh = idx >> 11, e4 = idx & 2047, b = bh >> 3, h = bh & 7;
    const float* ST = (const float*)(ws + O_ST); const float* ATOT = (const float*)(ws + O_ATOT);
    float4 sv[16]; float4 at4[4];
#pragma unroll
    for (int c = 0; c < 16; ++c) sv[c] = *(const float4*)(ST + ((size_t)((b * 16 + c) * 8 + h)) * 8192 + (size_t)e4 * 4);
#pragma unroll
    for (int k = 0; k < 4; ++k) at4[k] = *(const float4*)(ATOT + bh * 16 + 4 * k);
    const float at[16] = {at4[0].x, at4[0].y, at4[0].z, at4[0].w, at4[1].x, at4[1].y, at4[1].z, at4[1].w, at4[2].x, at4[2].y, at4[2].z, at4[2].w, at4[3].x, at4[3].y, at4[3].z, at4[3].w};
    float4 car = make_float4(0.f, 0.f, 0.f, 0.f);
    bf16_t* CAR = (bf16_t*)(ws + O_CAR);
#pragma unroll
    for (int c = 0; c < 16; ++c) {
        *(uint2*)(CAR + ((size_t)((b * 16 + c) * 8 + h)) * 8192 + (size_t)e4 * 4) = make_uint2(pack2(car.x, car.y), pack2(car.z, car.w));
        const float dec = __expf(at[c]);
        car.x = dec * car.x + sv[c].x; car.y = dec * car.y + sv[c].y; car.z = dec * car.z + sv[c].z; car.w = dec * car.w + sv[c].w;
    }
}

#define ATT_LDK 80
#define ATT_LDV 136
#define ATT_KBYTES (128 * ATT_LDK * 2)
#define ATT_VBYTES (64 * ATT_LDV * 2)
__device__ __forceinline__ void attn_unit(const Params& p, int unit, char* smem) {
    const int tid = tid_op(), lane = tid & 63, w = tid >> 6, cL = lane & 15, gq = lane >> 4;
    const int qb = 15 - (unit >> 6), bh = unit & 63, b = bh >> 3, h = bh & 7;
    char* ws = p.ws;
    const int q0 = qb * 128 + 16 * w;
    const int ntile = qb + 1;
    const int wmax = (q0 + 15) >> 6;
    const bf16_t* Q = (const bf16_t*)(ws + O_QB) + (size_t)bh * 2048 * 64;
    const bf16_t* Kp = (const bf16_t*)(ws + O_KB) + (size_t)bh * 2048 * 64;
    const bf16_t* V = (const bf16_t*)(ws + O_VT) + (size_t)bh * 64 * 2048;
    const unsigned long long* mrow = (const unsigned long long*)(ws + O_MASK) + (size_t)(b * 2048 + q0 + cL) * 32;
    const int lr = tid >> 3, lc = (tid & 7) * 8;
    bf16x8 qf[2];
    qf[0] = ld8(Q + (size_t)(q0 + cL) * 64 + gq * 8); qf[1] = ld8(Q + (size_t)(q0 + cL) * 64 + 32 + gq * 8);
    float m_run = -1e30f, l_run = 0.f;
    f32x4 o[4];
#pragma unroll
    for (int i = 0; i < 4; ++i) o[i] = (f32x4){0.f, 0.f, 0.f, 0.f};
    char* sK = smem; char* sV = smem + 2 * ATT_KBYTES;
#define ATT_GLOAD(T, K0, K1, V0, V1) { const int s_ = (T) * 128; \
        K0 = *(const u32x4g*)(Kp + (size_t)(s_ + lr) * 64 + lc); K1 = *(const u32x4g*)(Kp + (size_t)(s_ + 64 + lr) * 64 + lc); \
        V0 = *(const u32x4g*)(V + (size_t)lr * 2048 + s_ + lc); V1 = *(const u32x4g*)(V + (size_t)lr * 2048 + s_ + 64 + lc); }
#define ATT_LSTORE(BUF, K0, K1, V0, V1) { bf16_t* k_ = (bf16_t*)(sK + (BUF) * ATT_KBYTES); bf16_t* v_ = (bf16_t*)(sV + (BUF) * ATT_VBYTES); \
        *(u32x4g*)(k_ + lr * ATT_LDK + lc) = K0; *(u32x4g*)(k_ + (64 + lr) * ATT_LDK + lc) = K1; \
        *(u32x4g*)(v_ + lr * ATT_LDV + lc) = V0; *(u32x4g*)(v_ + lr * ATT_LDV + 64 + lc) = V1; }
    u32x4g ka0, ka1, va0, va1, kb0, kb1, vb0, vb1;
    ATT_GLOAD(0, ka0, ka1, va0, va1)
    { const int t1 = (ntile > 1) ? 1 : 0; ATT_GLOAD(t1, kb0, kb1, vb0, vb1) }
    unsigned long long nmb0 = mrow[0], nmb1 = mrow[1];
    __syncthreads();
    ATT_LSTORE(0, ka0, ka1, va0, va1)
    __syncthreads();
    for (int kt = 0; kt < ntile; ++kt) {
        const int cur = kt & 1;
        ka0 = kb0; ka1 = kb1; va0 = vb0; va1 = vb1;
        { const int t2 = (kt + 2 < ntile) ? kt + 2 : ntile - 1; ATT_GLOAD(t2, kb0, kb1, vb0, vb1) }
        {
            const bf16_t* tK = (const bf16_t*)(sK + cur * ATT_KBYTES); const bf16_t* tV = (const bf16_t*)(sV + cur * ATT_VBYTES);
            const unsigned long long mb0 = (2 * kt <= wmax) ? nmb0 : 0ull, mb1 = (2 * kt + 1 <= wmax) ? nmb1 : 0ull;
            { const int tn = (kt + 1 < ntile) ? kt + 1 : kt; nmb0 = mrow[2 * tn]; nmb1 = mrow[2 * tn + 1]; }
            f32x4 st[8];
#pragma unroll
            for (int j = 0; j < 8; ++j) {
                f32x4 a = (f32x4){0.f, 0.f, 0.f, 0.f};
                const bf16_t* kr = tK + (16 * j + cL) * ATT_LDK + gq * 8;
                a = mfma16(ld8(kr), qf[0], a); a = mfma16(ld8(kr + 32), qf[1], a);
                st[j] = a;
            }
            float mx = m_run;
            const unsigned mw[4] = {(unsigned)mb0 >> (4 * gq), (unsigned)(mb0 >> 32) >> (4 * gq), (unsigned)mb1 >> (4 * gq), (unsigned)(mb1 >> 32) >> (4 * gq)};
#pragma unroll
            for (int j = 0; j < 8; ++j)
#pragma unroll
                for (int r = 0; r < 4; ++r) {
                    const bool bit = (mw[j >> 1] & (1u << (16 * (j & 1) + r))) != 0u;
                    const float v = bit ? st[j][r] : -INFINITY;
                    st[j][r] = v; mx = fmaxf(mx, v);
                }
            mx = max_x32(max_x16(mx));
            const float alpha = __builtin_amdgcn_exp2f(m_run - mx); m_run = mx;
            float ls = 0.f;
#pragma unroll
            for (int j = 0; j < 8; ++j)
#pragma unroll
                for (int r = 0; r < 4; ++r) { const float pv = __builtin_amdgcn_exp2f(st[j][r] - mx); st[j][r] = pv; ls += pv; }
            ls = sum_x32(sum_x16(ls));
            l_run = l_run * alpha + ls;
#pragma unroll
            for (int i = 0; i < 4; ++i) o[i] = o[i] * alpha;
#pragma unroll
            for (int kk = 0; kk < 4; ++kk) {
                bf16x8 pf;
#pragma unroll
                for (int r = 0; r < 4; ++r) { pf[r] = (short)f2bf(st[2 * kk][r]); pf[4 + r] = (short)f2bf(st[2 * kk + 1][r]); }
#pragma unroll
                for (int dt = 0; dt < 4; ++dt) {
                    const bf16_t* vr = tV + (16 * dt + cL) * ATT_LDV + 32 * kk + 4 * gq;
                    o[dt] = mfma16(cat4(*(const bf16x4*)vr, *(const bf16x4*)(vr + 16)), pf, o[dt]);
                }
            }
        }
        if (kt + 1 < ntile) ATT_LSTORE(cur ^ 1, ka0, ka1, va0, va1)
        __syncthreads();
    }
#undef ATT_GLOAD
#undef ATT_LSTORE
    const float inv = 1.f / l_run;
    bf16_t* mix = (bf16_t*)(ws + O_MIX) + (size_t)(b * 2048 + q0 + cL) * 1024 + h * 64;
#pragma unroll
    for (int dt = 0; dt < 4; ++dt)
        *(uint2*)(mix + 16 * dt + 4 * gq) = make_uint2(pack2(o[dt][0] * inv, o[dt][1] * inv), pack2(o[dt][2] * inv, o[dt][3] * inv));
}

#define SSD_CAR_BYTES (4 * 64 * 136 * 2)
__device__ __forceinline__ void ssd_main_unit(const Params& p, int unit, char* smem) {
    const int tid = tid_op(), lane = tid & 63, w = tid >> 6, cL = lane & 15, gq = lane >> 4;
    const int g = unit & 1, c = (unit >> 1) & 15, b = unit >> 5;
    char* ws = p.ws;
    float* sAc = (float*)smem;
    float* sDt = sAc + 512;
    const int tok0 = b * 2048 + c * 128;
    const float* ATOT = (const float*)(ws + O_ATOT); const float* ACUM = (const float*)(ws + O_ACUM); const float* DTf = (const float*)(ws + O_DTF);
    const bf16_t* Xt = (const bf16_t*)(ws + O_XT); const bf16_t* Brm = (const bf16_t*)(ws + O_BRM); const bf16_t* Crm = (const bf16_t*)(ws + O_CRM);
    const bf16_t* Zb = (const bf16_t*)(ws + O_ZB);
    __syncthreads();
    {
        const int hh = tid >> 7, l = tid & 127;
        sAc[tid] = ACUM[(size_t)(b * 8 + 4 * g + hh) * 2048 + c * 128 + l];
        sDt[tid] = DTf[(size_t)(tok0 + l) * 8 + 4 * g + hh];
    }
    __syncthreads();
    bf16_t* mix = (bf16_t*)(ws + O_MIX);
    const int lt = w;
    const int ltok = tok0 + 16 * lt + cL;
    bf16x8 Cq[4];
#pragma unroll
    for (int ks = 0; ks < 4; ++ks) Cq[ks] = ld8(Crm + (size_t)ltok * 256 + g * 128 + ks * 32 + gq * 8);
    f32x4 cbT[8];
#pragma unroll
    for (int st = 0; st < 8; ++st) {
        cbT[st] = (f32x4){0.f, 0.f, 0.f, 0.f};
        if (st <= lt) {
            const bf16_t* br = Brm + (size_t)(tok0 + 16 * st + cL) * 256 + g * 128 + gq * 8;
#pragma unroll
            for (int ks = 0; ks < 4; ++ks) cbT[st] = mfma16(ld8(br + ks * 32), Cq[ks], cbT[st]);
        }
    }
    float ssq = 0.f;
#pragma unroll 1
    for (int hh = 0; hh < 4; ++hh) {
        const int h = 4 * g + hh;
        const float* ac = sAc + hh * 128; const float* dtl = sDt + hh * 128;
        const float al = ac[16 * lt + cL];
        const bf16_t* xh = Xt + ((size_t)b * 512 + h * 64) * 2048 + c * 128;
        const bf16_t* zh = Zb + (size_t)tok0 * 512 + h * 64;
        const bf16_t* carh = (const bf16_t*)(ws + O_CAR) + ((size_t)((b * 16 + c) * 8 + h)) * 8192;
        bf16x8 xf[4][4];
#pragma unroll
        for (int kk = 0; kk < 4; ++kk)
#pragma unroll
            for (int pt = 0; pt < 4; ++pt) {
                const int kc = (2 * kk <= lt) ? kk : 0;
                const unsigned xo = (unsigned)((16 * pt + cL) * 2048 + 32 * kc + 4 * gq);
                xf[kk][pt] = cat4(*(const bf16x4*)(xh + xo), *(const bf16x4*)(xh + xo + 16));
            }
        f32x4 acc1[4], acc2[4];
#pragma unroll
        for (int i = 0; i < 4; ++i) { acc1[i] = (f32x4){0.f, 0.f, 0.f, 0.f}; acc2[i] = (f32x4){0.f, 0.f, 0.f, 0.f}; }
#pragma unroll
        for (int kk = 0; kk < 4; ++kk) {
            if (2 * kk <= lt) {
                bf16x8 mf;
#pragma unroll
                for (int half = 0; half < 2; ++half) {
                    const int st = 2 * kk + half;
#pragma unroll
                    for (int r = 0; r < 4; ++r) {
                        const int sl = 16 * st + 4 * gq + r;
                        float v = 0.f;
                        if (st <= lt && sl <= 16 * lt + cL) v = cbT[st][r] * __expf(al - ac[sl]) * dtl[sl];
                        mf[half * 4 + r] = (short)f2bf(v);
                    }
                }
#pragma unroll
                for (int pt = 0; pt < 4; ++pt) acc1[pt] = mfma16(xf[kk][pt], mf, acc1[pt]);
            }
        }
        uint2 zz[4]; bf16_t xsv[4][4];
#pragma unroll
        for (int pt = 0; pt < 4; ++pt) {
            zz[pt] = *(const uint2*)(zh + (unsigned)((16 * lt + cL) * 512 + 16 * pt + 4 * gq));
#pragma unroll
            for (int r = 0; r < 4; ++r) xsv[pt][r] = xh[(unsigned)((16 * pt + 4 * gq + r) * 2048 + 16 * lt + cL)];
        }
#pragma unroll
        for (int ks = 0; ks < 4; ++ks)
#pragma unroll
            for (int pt = 0; pt < 4; ++pt) acc2[pt] = mfma16(ld8(carh + (unsigned)((16 * pt + cL) * 128 + ks * 32 + gq * 8)), Cq[ks], acc2[pt]);
        const float el = __expf(al), dsk = p.d_skip[h];
#pragma unroll
        for (int pt = 0; pt < 4; ++pt) {
            const float zf[4] = {bf2f((bf16_t)(zz[pt].x & 0xFFFF)), bf2f((bf16_t)(zz[pt].x >> 16)), bf2f((bf16_t)(zz[pt].y & 0xFFFF)), bf2f((bf16_t)(zz[pt].y >> 16))};
            float yv[4];
#pragma unroll
            for (int r = 0; r < 4; ++r) {
                float t = acc1[pt][r] + el * acc2[pt][r] + bf2f(xsv[pt][r]) * dsk;
                t *= silu_f(zf[r]);
                yv[r] = t; ssq += t * t;
            }
            *(uint2*)(mix + (size_t)ltok * 1024 + 512 + h * 64 + 16 * pt + 4 * gq) = make_uint2(pack2(yv[0], yv[1]), pack2(yv[2], yv[3]));
        }
    }
    ssq = sum_x32(sum_x16(ssq));
    const float rstd = rsqrtf(ssq * (1.f / 256.f) + LN_EPS);
#pragma unroll
    for (int hh = 0; hh < 4; ++hh)
#pragma unroll
        for (int pt = 0; pt < 4; ++pt) {
            const int ch = (4 * g + hh) * 64 + 16 * pt + 4 * gq;
            const float4 nw = *(const float4*)(p.norm_w + ch);
            const uint2 yy = *(const uint2*)(mix + (size_t)ltok * 1024 + 512 + ch);
            const float y0 = bf2f((bf16_t)(yy.x & 0xFFFF)), y1 = bf2f((bf16_t)(yy.x >> 16)), y2 = bf2f((bf16_t)(yy.y & 0xFFFF)), y3 = bf2f((bf16_t)(yy.y >> 16));
            *(uint2*)(mix + (size_t)ltok * 1024 + 512 + ch) = make_uint2(pack2(y0 * rstd * nw.x, y1 * rstd * nw.y), pack2(y2 * rstd * nw.z, y3 * rstd * nw.w));
        }
}

__device__ __forceinline__ void phase2(const Params& p, char* smem, int which = 3) {
    const int G = gridDim.x;
    for (int k = 0; k * G < 2048; ++k) {
        const int u = k * G + ((k & 1) ? (G - 1 - (int)blockIdx.x) : (int)blockIdx.x);
        if (u >= 2048) continue;
        if (u < 1024) { if (which & 1) indexer_unit(p, u, smem); } else { if (which & 2) ssd_prep_unit(p, u - 1024, smem); }
    }
}
__device__ __forceinline__ void phase3(const Params& p, char* smem, int which = 3) {
    const int G = gridDim.x;
    for (int k = 0; k * G < 1024 + 256; ++k) {
        const int u = k * G + ((k & 1) ? (G - 1 - (int)blockIdx.x) : (int)blockIdx.x);
        if (u >= 1024 + 256) continue;
        if (u < 256) { if (which & 1) ssd_main_unit(p, u, smem); } else { if (which & 2) attn_unit(p, u - 256, smem); }
    }
}

struct OutEpi {
    const float* x; float* y;
    __device__ __forceinline__ void operator()(const f32x4 (&acc)[4][4], int mb, int nb, int lane, char* lds) const {
        const int c = lane & 15, g = lane >> 4;
        float* L = (float*)lds;
#pragma unroll
        for (int half = 0; half < 2; ++half) {
#pragma unroll
            for (int mi2 = 0; mi2 < 2; ++mi2)
#pragma unroll
                for (int r = 0; r < 4; ++r)
#pragma unroll
                    for (int ni = 0; ni < 4; ++ni) L[(16 * mi2 + 4 * g + r) * 68 + 16 * ni + c] = acc[2 * half + mi2][ni][r];
#pragma unroll
            for (int i = 0; i < 8; ++i) {
                const int row = 4 * i + g;
                const float4 a = *(const float4*)(L + row * 68 + 4 * c);
                const size_t o = (size_t)(mb + 32 * half + row) * 1024 + nb + 4 * c;
                const float4 xv = *(const float4*)(x + o);
                *(float4*)(y + o) = make_float4(ALPHA * xv.x + a.x, ALPHA * xv.y + a.y, ALPHA * xv.z + a.z, ALPHA * xv.w + a.w);
            }
        }
    }
};
__device__ __forceinline__ void phase4(const Params& p, char* smem, const XcdMap xm) {
    pg8::Gemm g{(const bf16_t*)(p.ws + O_MIX), (const bf16_t*)(p.ws + O_WOUT_T), NTOK, 1024, 1024};
    pg8::StaticOrder S; S.init(NTOK, 1024, (int)gridDim.x, (int)blockIdx.x);
    pg8::EpiResBf16 E{(bf16_t*)(p.ws + O_HB), p.x, 1024, ALPHA};
    pg8::gemm_phase<pg8::EpiResBf16, pg8::StaticOrder, false>((PG8_LAS unsigned char*)smem, g, S, E, nullptr);
}

__device__ __forceinline__ void phase5(const Params& p) {
    const int lane = tid_op() & 63, w = tid_op() >> 6;
    bf16_t* hb = (bf16_t*)(p.ws + O_HB);
    for (int row = blockIdx.x * 8 + w; row < NTOK; row += gridDim.x * 8) {
        bf16_t* yr = hb + (size_t)row * 1024 + 8 * lane;
        float v[16]; float s = 0.f;
#pragma unroll
        for (int j = 0; j < 2; ++j) {
            const uint4 r = *(const uint4*)(yr + 512 * j);
            const unsigned rw[4] = {r.x, r.y, r.z, r.w};
#pragma unroll
            for (int k = 0; k < 4; ++k) { v[8 * j + 2 * k] = __uint_as_float(rw[k] << 16); v[8 * j + 2 * k + 1] = __uint_as_float(rw[k] & 0xFFFF0000u); }
        }
#pragma unroll
        for (int k = 0; k < 16; ++k) s += v[k];
        const float mean = wave_sum(s) * (1.f / 1024.f);
        float q = 0.f;
#pragma unroll
        for (int k = 0; k < 16; ++k) { const float a = v[k] - mean; q += a * a; }
        const float rstd = rsqrtf(wave_sum(q) * (1.f / 1024.f) + LN_EPS);
#pragma unroll
        for (int j = 0; j < 2; ++j) {
            const int col = 8 * lane + 512 * j;
            const float4 g0 = *(const float4*)(p.ln1_g + col), g1 = *(const float4*)(p.ln1_g + col + 4), b0 = *(const float4*)(p.ln1_b + col), b1 = *(const float4*)(p.ln1_b + col + 4);
            const float gg[8] = {g0.x, g0.y, g0.z, g0.w, g1.x, g1.y, g1.z, g1.w}, bb[8] = {b0.x, b0.y, b0.z, b0.w, b1.x, b1.y, b1.z, b1.w};
            float o[8];
#pragma unroll
            for (int k = 0; k < 8; ++k) o[k] = (v[8 * j + k] - mean) * rstd * gg[k] + bb[k];
            *(uint4*)(yr + 512 * j) = make_uint4(pack2(o[0], o[1]), pack2(o[2], o[3]), pack2(o[4], o[5]), pack2(o[6], o[7]));
        }
    }
    const size_t gtid = (size_t)blockIdx.x * blockDim.x + tid_op(), gsz = (size_t)gridDim.x * blockDim.x;
    {
        unsigned* u8 = (unsigned*)(p.ws + O_U8); unsigned* v8 = (unsigned*)(p.ws + O_V8);
        for (size_t i = gtid; i < (size_t)16384 * 256; i += gsz) {
            const float4 fu = ((const float4*)p.u)[i];
            int pk = __builtin_amdgcn_cvt_pk_fp8_f32(fu.x * 32.f, fu.y * 32.f, 0, false); pk = __builtin_amdgcn_cvt_pk_fp8_f32(fu.z * 32.f, fu.w * 32.f, pk, true);
            u8[i] = (unsigned)pk;
            const float4 fv = ((const float4*)p.v)[i];
            int pv = __builtin_amdgcn_cvt_pk_fp8_f32(fv.x, fv.y, 0, false); pv = __builtin_amdgcn_cvt_pk_fp8_f32(fv.z, fv.w, pv, true);
            const size_t e = i >> 8, c4 = i & 255;
            v8[((c4 >> 5) * 16384 + e) * 32 + (c4 & 31)] = (unsigned)pv;
        }
    }
}

struct QpEpi {
    bf16_t* qp;
    __device__ __forceinline__ void operator()(const f32x4 (&acc)[4][4], int mb, int nb, int lane, char* lds) const {
        const int c = lane & 15, g = lane >> 4;
        bf16_t* L = (bf16_t*)lds;
#pragma unroll
        for (int mi = 0; mi < 4; ++mi)
#pragma unroll
            for (int r = 0; r < 4; ++r)
#pragma unroll
                for (int ni = 0; ni < 4; ++ni) L[(16 * mi + 4 * g + r) * 72 + 16 * ni + c] = f2bf(acc[mi][ni][r]);
#pragma unroll
        for (int i = 0; i < 8; ++i) {
            const int row = 8 * i + (lane >> 3), cc = (lane & 7) * 8;
            *(uint4*)(qp + (size_t)(mb + row) * 2048 + nb + cc) = *(const uint4*)(L + row * 72 + cc);
        }
    }
};
__device__ __forceinline__ void phase6(const Params& p, char* smem, const XcdMap xm) {
    pg8::Gemm g{(const bf16_t*)(p.ws + O_HB), (const bf16_t*)(p.ws + O_WQ_T), NTOK, 2048, 1024};
    pg8::StaticOrder S; S.init(NTOK, 2048, (int)gridDim.x, (int)blockIdx.x);
    pg8::EpiBf16Plain E{(bf16_t*)(p.ws + O_QP), 2048};
    pg8::gemm_phase<pg8::EpiBf16Plain, pg8::StaticOrder, false>((PG8_LAS unsigned char*)smem, g, S, E, nullptr);
}

__device__ __forceinline__ float gelu_erf(float d) { return 0.5f * d * (1.f + erff(d * 0.70710678118654752f)); }
typedef unsigned u32x4n __attribute__((ext_vector_type(4)));
__device__ __forceinline__ long lo64n(const u32x4n v) { return (long)(((unsigned long long)v.y << 32) | v.x); }
__device__ __forceinline__ long hi64n(const u32x4n v) { return (long)(((unsigned long long)v.w << 32) | v.z); }
struct P8aRows { u32x4n a[16]; };
__device__ __forceinline__ void p8a_load(P8aRows& R, const unsigned char* U8, int eid, int gq) {
    const unsigned char* urow = U8 + (size_t)eid * 1024 + 16 * gq;
#pragma unroll
    for (int j = 0; j < 16; ++j) R.a[j] = *(const u32x4n*)(urow + 64 * j);
}
__device__ __forceinline__ float p8_dot16(const u32x4n r, const f32x2 (&hp)[8]) {
    f32x2 acc = __builtin_amdgcn_cvt_pk_f32_fp8((int)r.x, false) * hp[0];
    acc += __builtin_amdgcn_cvt_pk_f32_fp8((int)r.x, true) * hp[1];
    acc += __builtin_amdgcn_cvt_pk_f32_fp8((int)r.y, false) * hp[2]; acc += __builtin_amdgcn_cvt_pk_f32_fp8((int)r.y, true) * hp[3];
    acc += __builtin_amdgcn_cvt_pk_f32_fp8((int)r.z, false) * hp[4]; acc += __builtin_amdgcn_cvt_pk_f32_fp8((int)r.z, true) * hp[5];
    acc += __builtin_amdgcn_cvt_pk_f32_fp8((int)r.w, false) * hp[6]; acc += __builtin_amdgcn_cvt_pk_f32_fp8((int)r.w, true) * hp[7];
    return acc.x + acc.y;
}
__device__ __forceinline__ float p8_reduce16(const float (&p)[16], int lane) {
    float q[8], r4[4], t2[2];
#pragma unroll
    for (int k = 0; k < 8; ++k) { const u32x2_t sw = __builtin_amdgcn_permlane32_swap(__float_as_uint(p[k]), __float_as_uint(p[k + 8]), false, false); q[k] = __uint_as_float(sw.x) + __uint_as_float(sw.y); }
#pragma unroll
    for (int k = 0; k < 4; ++k) { const u32x2_t sw = __builtin_amdgcn_permlane16_swap(__float_as_uint(q[k]), __float_as_uint(q[k + 4]), false, false); r4[k] = __uint_as_float(sw.x) + __uint_as_float(sw.y); }
    const bool b3 = (lane & 8) != 0, b2 = (lane & 4) != 0;
#pragma unroll
    for (int k = 0; k < 2; ++k) { const float snd = b3 ? r4[k] : r4[k + 2], keep = b3 ? r4[k + 2] : r4[k]; t2[k] = keep + dpp_f<0x128, 0xF, true>(snd); }
    const float snd = b2 ? t2[0] : t2[1], keep = b2 ? t2[1] : t2[0];
    float z = keep + dpp_f<0x141, 0xF, true>(snd);
    z += dpp_f<0xB1, 0xF, true>(z); z += dpp_f<0x4E, 0xF, true>(z);
    return z;
}
__constant__ unsigned char CAND_I[64] = {0,0,0,0,0,0,0,0,0,0,0,0,0,0,0,0, 1,1,1,1,1,1,1,1, 2,2,2,2,2, 3,3,3,3, 4,4,4, 5,5, 6,6, 7,7, 8,9,10,11,12,13,14,15, 0,0,0,0,0,0,0,0,0,0,0,0,0,0};
__constant__ unsigned char CAND_J[64] = {0,1,2,3,4,5,6,7,8,9,10,11,12,13,14,15, 0,1,2,3,4,5,6,7, 0,1,2,3,4, 0,1,2,3, 0,1,2, 0,1, 0,1, 0,1, 0,0,0,0,0,0,0,0, 0,0,0,0,0,0,0,0,0,0,0,0,0,0};
__device__ __forceinline__ unsigned rowmax_u(unsigned v) { return row_max_u(v); }
struct PeerSel { int ev[4]; float gv[4]; };
__device__ __forceinline__ PeerSel peer_select(const Params& p, int wunit, const char* ktab) {
    const int lane = tid_op() & 63, cL = lane & 15, gq = lane >> 4, rowbase = lane & 48;
    const int tg = wunit >> 3, h = wunit & 7, tok0 = tg * 16;
    char* ws = p.ws;
    const bf16_t* QP = (const bf16_t*)(ws + O_QP);
    unsigned top[2][4];
#pragma unroll
    for (int half = 0; half < 2; ++half) {
        const bf16_t* KB = (const bf16_t*)(ktab + half * (128 * 144 * 2));
        bf16x8 a[4];
#pragma unroll
        for (int ks = 0; ks < 4; ++ks) a[ks] = ld8(QP + (size_t)(tok0 + cL) * 2048 + h * 256 + half * 128 + ks * 32 + gq * 8);
        unsigned pk[8][4];
#pragma unroll
        for (int nt = 0; nt < 8; ++nt) {
            f32x4 acc = (f32x4){0.f, 0.f, 0.f, 0.f};
#pragma unroll
            for (int ks = 0; ks < 4; ++ks) acc = mfma16(a[ks], ld8(KB + (16 * nt + cL) * 144 + ks * 32 + gq * 8), acc);
#pragma unroll
            for (int r = 0; r < 4; ++r) pk[nt][r] = (f2sort(acc[r]) & ~0x7Fu) | (unsigned)(127 - (16 * nt + cL));
        }
#pragma unroll
        for (int r = 0; r < 4; ++r) top[half][r] = 0u;
#define PS_CAS(A, B) { const unsigned hi_ = max(pk[A][r], pk[B][r]), lo_ = min(pk[A][r], pk[B][r]); pk[A][r] = hi_; pk[B][r] = lo_; }
#pragma unroll
        for (int r = 0; r < 4; ++r) {
            PS_CAS(0, 1) PS_CAS(2, 3) PS_CAS(4, 5) PS_CAS(6, 7)
            PS_CAS(0, 2) PS_CAS(1, 3) PS_CAS(4, 6) PS_CAS(5, 7)
            PS_CAS(1, 2) PS_CAS(5, 6)
            PS_CAS(0, 4) PS_CAS(1, 5) PS_CAS(2, 6) PS_CAS(3, 7)
            PS_CAS(2, 4) PS_CAS(3, 5)
            PS_CAS(1, 2) PS_CAS(3, 4) PS_CAS(5, 6)
        }
#undef PS_CAS
        for (int it = 0; it < 16; ++it) {
#pragma unroll
            for (int r = 0; r < 4; ++r) {
                const unsigned gm = rowmax_u(pk[0][r]);
                if (cL == it) top[half][r] = gm;
                const bool pop = (pk[0][r] == gm);
#pragma unroll
                for (int nt = 0; nt < 7; ++nt) pk[nt][r] = pop ? pk[nt + 1][r] : pk[nt][r];
                pk[7][r] = pop ? 0u : pk[7][r];
            }
        }
    }
    unsigned ck[4][4];
#pragma unroll
    for (int s = 0; s < 4; ++s) {
        const int q = s * 16 + cL; const int ci = CAND_I[q], cj = CAND_J[q];
#pragma unroll
        for (int r = 0; r < 4; ++r) {
            const unsigned t1 = (unsigned)__shfl((int)top[0][r], rowbase + ci), t2 = (unsigned)__shfl((int)top[1][r], rowbase + cj);
            const float f = sort2f(t1 & ~0x7Fu) + sort2f(t2 & ~0x7Fu);
            ck[s][r] = (q < 50) ? ((f2sort(f) & ~0x3Fu) | (unsigned)(63 - q)) : 0u;
        }
    }
    unsigned best[4] = {0u, 0u, 0u, 0u};
#define PS_CAS(A, B) { const unsigned hi_ = max(ck[A][r], ck[B][r]), lo_ = min(ck[A][r], ck[B][r]); ck[A][r] = hi_; ck[B][r] = lo_; }
#pragma unroll
    for (int r = 0; r < 4; ++r) { PS_CAS(0, 1) PS_CAS(2, 3) PS_CAS(0, 2) PS_CAS(1, 3) PS_CAS(1, 2) }
#undef PS_CAS
    for (int it = 0; it < 16; ++it) {
#pragma unroll
        for (int r = 0; r < 4; ++r) {
            const unsigned gm = rowmax_u(ck[0][r]);
            if (cL == it) best[r] = gm;
            const bool pop = (ck[0][r] == gm);
            ck[0][r] = pop ? ck[1][r] : ck[0][r]; ck[1][r] = pop ? ck[2][r] : ck[1][r]; ck[2][r] = pop ? ck[3][r] : ck[2][r]; ck[3][r] = pop ? 0u : ck[3][r];
        }
    }
    PeerSel S_;
#pragma unroll
    for (int r = 0; r < 4; ++r) {
        const float fv = sort2f(best[r] & ~0x3Fu);
        const int q = 63 - (int)(best[r] & 63u);
        const int ci = CAND_I[q], cj = CAND_J[q];
        const unsigned t1 = (unsigned)__shfl((int)top[0][r], rowbase + ci), t2 = (unsigned)__shfl((int)top[1][r], rowbase + cj);
        S_.ev[r] = (127 - (int)(t1 & 127u)) * 128 + (127 - (int)(t2 & 127u));
        const float mx = __shfl(fv, rowbase);
        const float ex = __expf(fv - mx);
        const float sm = row_sum(ex);
        S_.gv[r] = ex / sm;
    }
    return S_;
}
#define PU_ROWEID(SEL, TT, I) __builtin_amdgcn_readlane(SEL.ev[(TT) & 3], 16 * ((TT) >> 2) + (I))
__device__ __forceinline__ void peer_blocks(const Params& p, int wunit, const PeerSel& S_, const PeerSel& N_, bool has_next, P8aRows& R0, P8aRows& R1) {
    const int lane = tid_op() & 63;
    const int tok0 = (wunit >> 3) * 16, h = wunit & 7;
    char* ws = p.ws;
    const unsigned char* U8 = (const unsigned char*)(ws + O_U8) + 16 * lane;
    const bf16_t* H = (const bf16_t*)(ws + O_HB) + (size_t)tok0 * 1024 + 16 * lane;
    unsigned* ACT = (unsigned*)(ws + O_ACT) + (size_t)tok0 * 128 + h * 16;
#define PU_STEP(RC, TT) { \
        f32x2 hp[8]; \
        _Pragma("unroll") for (int k = 0; k < 2; ++k) { const u32x4n hv_ = *(const u32x4n*)(H + (TT) * 1024 + 8 * k); \
            hp[4 * k] = (f32x2){__uint_as_float(hv_.x << 16), __uint_as_float(hv_.x & 0xFFFF0000u)}; hp[4 * k + 1] = (f32x2){__uint_as_float(hv_.y << 16), __uint_as_float(hv_.y & 0xFFFF0000u)}; \
            hp[4 * k + 2] = (f32x2){__uint_as_float(hv_.z << 16), __uint_as_float(hv_.z & 0xFFFF0000u)}; hp[4 * k + 3] = (f32x2){__uint_as_float(hv_.w << 16), __uint_as_float(hv_.w & 0xFFFF0000u)}; } \
        float pp[16]; \
        _Pragma("unroll") for (int i = 0; i < 16; ++i) { \
            pp[i] = p8_dot16(RC.a[i], hp); \
            if ((TT) < 14) RC.a[i] = *(const u32x4n*)(U8 + (size_t)PU_ROWEID(S_, ((TT) + 2) & 15, i) * 1024); \
            else if (has_next) RC.a[i] = *(const u32x4n*)(U8 + (size_t)PU_ROWEID(N_, ((TT) + 2) & 15, i) * 1024); } \
        const float dot = p8_reduce16(pp, lane) * (1.f / 32.f); \
        const int src_ = 16 * ((TT) >> 2) + (lane >> 2); \
        const float gt_ = __shfl(S_.gv[(TT) & 3], src_); const int ei_ = __shfl(S_.ev[(TT) & 3], src_); \
        const float act_ = gelu_erf(dot) * gt_; \
        if ((lane & 3) == 0) ACT[(TT) * 128 + (lane >> 2)] = (unsigned)ei_ | ((unsigned)f2bf(act_) << 16); }
    PU_STEP(R0, 0) PU_STEP(R1, 1) PU_STEP(R0, 2) PU_STEP(R1, 3) PU_STEP(R0, 4) PU_STEP(R1, 5) PU_STEP(R0, 6) PU_STEP(R1, 7)
    PU_STEP(R0, 8) PU_STEP(R1, 9) PU_STEP(R0, 10) PU_STEP(R1, 11) PU_STEP(R0, 12) PU_STEP(R1, 13) PU_STEP(R0, 14) PU_STEP(R1, 15)
#undef PU_STEP
}
__device__ __forceinline__ void phase7(const Params& p, char* smem) {
    const int lane = tid_op() & 63;
    const int w = __builtin_amdgcn_readfirstlane(tid_op() >> 6);
    const int stride = gridDim.x * 8;
    const unsigned char* U8 = (const unsigned char*)(p.ws + O_U8) + 16 * lane;
    {
        const int tid = tid_op();
        __syncthreads();
#pragma unroll
        for (int k = 0; k < 8; ++k) {
            const int c = tid + 512 * k, half = c >> 11, row = (c >> 4) & 127, ch = c & 15;
            *(uint4*)(smem + half * (128 * 144 * 2) + row * 288 + ch * 16) = *(const uint4*)(p.ws + (half ? O_K2B : O_K1B) + (size_t)row * 256 + ch * 16);
        }
        __syncthreads();
    }
    for (int u = blockIdx.x * 8 + w; u < 8192; u += stride) {
        const PeerSel s0 = peer_select(p, u, smem);
        P8aRows R0, R1;
#pragma unroll
        for (int i = 0; i < 16; ++i) { R0.a[i] = *(const u32x4n*)(U8 + (size_t)PU_ROWEID(s0, 0, i) * 1024); R1.a[i] = *(const u32x4n*)(U8 + (size_t)PU_ROWEID(s0, 1, i) * 1024); }
        peer_blocks(p, u, s0, s0, false, R0, R1);
    }
}
#undef PU_ROWEID

__device__ __forceinline__ float dot16_fp8(const uint4& r, const float (&hv)[16]) {
    const f32x2 a0 = __builtin_amdgcn_cvt_pk_f32_fp8((int)r.x, false), a1 = __builtin_amdgcn_cvt_pk_f32_fp8((int)r.x, true);
    const f32x2 b0 = __builtin_amdgcn_cvt_pk_f32_fp8((int)r.y, false), b1 = __builtin_amdgcn_cvt_pk_f32_fp8((int)r.y, true);
    const f32x2 c0 = __builtin_amdgcn_cvt_pk_f32_fp8((int)r.z, false), c1 = __builtin_amdgcn_cvt_pk_f32_fp8((int)r.z, true);
    const f32x2 d0 = __builtin_amdgcn_cvt_pk_f32_fp8((int)r.w, false), d1 = __builtin_amdgcn_cvt_pk_f32_fp8((int)r.w, true);
    return (hv[0] * a0.x + hv[1] * a0.y + hv[2] * a1.x + hv[3] * a1.y) + (hv[4] * b0.x + hv[5] * b0.y + hv[6] * b1.x + hv[7] * b1.y)
         + (hv[8] * c0.x + hv[9] * c0.y + hv[10] * c1.x + hv[11] * c1.y) + (hv[12] * d0.x + hv[13] * d0.y + hv[14] * d1.x + hv[15] * d1.y);
}
struct P8bRows { u32x4n v[8]; };
struct P8bMeta { u32x4n m[4]; };
__device__ __forceinline__ void p8b_meta(P8bMeta& M, const unsigned* ACT, int row, int e8) {
#pragma unroll
    for (int k = 0; k < 4; ++k) M.m[k] = *(const u32x4n*)(ACT + (size_t)row * 128 + e8 * 16 + 4 * k);
}
template <int HALF> __device__ __forceinline__ void p8b_load(P8bRows& R, const P8bMeta& M, const unsigned char* V8) {
#pragma unroll
    for (int k = 0; k < 2; ++k) {
        const u32x4n mm = M.m[2 * HALF + k];
        R.v[4 * k + 0] = *(const u32x4n*)(V8 + (size_t)(mm.x & 0xFFFFu) * 128); R.v[4 * k + 1] = *(const u32x4n*)(V8 + (size_t)(mm.y & 0xFFFFu) * 128);
        R.v[4 * k + 2] = *(const u32x4n*)(V8 + (size_t)(mm.z & 0xFFFFu) * 128); R.v[4 * k + 3] = *(const u32x4n*)(V8 + (size_t)(mm.w & 0xFFFFu) * 128);
    }
}
template <int HALF> __device__ __forceinline__ void p8b_accum(f32x2 (&acc)[8], const P8bRows& R, const P8bMeta& M) {
#pragma unroll
    for (int k = 0; k < 2; ++k) {
        const u32x4n mm = M.m[2 * HALF + k];
        const unsigned mw[4] = {mm.x, mm.y, mm.z, mm.w};
#pragma unroll
        for (int q = 0; q < 4; ++q) {
            const float a1 = __uint_as_float(mw[q] & 0xFFFF0000u);
            const f32x2 av = (f32x2){a1, a1};
            const u32x4n x = R.v[4 * k + q];
            acc[0] += av * __builtin_amdgcn_cvt_pk_f32_fp8((int)x.x, false); acc[1] += av * __builtin_amdgcn_cvt_pk_f32_fp8((int)x.x, true);
            acc[2] += av * __builtin_amdgcn_cvt_pk_f32_fp8((int)x.y, false); acc[3] += av * __builtin_amdgcn_cvt_pk_f32_fp8((int)x.y, true);
            acc[4] += av * __builtin_amdgcn_cvt_pk_f32_fp8((int)x.z, false); acc[5] += av * __builtin_amdgcn_cvt_pk_f32_fp8((int)x.z, true);
            acc[6] += av * __builtin_amdgcn_cvt_pk_f32_fp8((int)x.w, false); acc[7] += av * __builtin_amdgcn_cvt_pk_f32_fp8((int)x.w, true);
        }
    }
}
__device__ __forceinline__ void p8b_store(const f32x2 (&acc)[8], float* hr, const bf16_t* hb, int e8) {
    float r[16];
#pragma unroll
    for (int j = 0; j < 8; ++j) { r[2 * j] = acc[j].x; r[2 * j + 1] = acc[j].y; }
#pragma unroll
    for (int j = 0; j < 16; ++j) { r[j] += dpp_f<0x128, 0xF, true>(r[j]); r[j] = sum_x32(sum_x16(r[j])); }
    if (e8 == 0) {
#pragma unroll
        for (int j = 0; j < 2; ++j) {
            const uint4 hw = *(const uint4*)(hb + 8 * j);
            *(float4*)(hr + 8 * j) = make_float4(ALPHA * __uint_as_float(hw.x << 16) + r[8 * j], ALPHA * __uint_as_float(hw.x & 0xFFFF0000u) + r[8 * j + 1],
                                                 ALPHA * __uint_as_float(hw.y << 16) + r[8 * j + 2], ALPHA * __uint_as_float(hw.y & 0xFFFF0000u) + r[8 * j + 3]);
            *(float4*)(hr + 8 * j + 4) = make_float4(ALPHA * __uint_as_float(hw.z << 16) + r[8 * j + 4], ALPHA * __uint_as_float(hw.z & 0xFFFF0000u) + r[8 * j + 5],
                                                     ALPHA * __uint_as_float(hw.w << 16) + r[8 * j + 6], ALPHA * __uint_as_float(hw.w & 0xFFFF0000u) + r[8 * j + 7]);
        }
    }
}
__device__ __forceinline__ void phase8b(const Params& p, const XcdMap xm, float* outp) {
    const int lane = tid_op() & 63, w = tid_op() >> 6, e8 = lane >> 3, c8 = lane & 7;
    char* ws = p.ws;
    const unsigned char* V8 = (const unsigned char*)(ws + O_V8) + (size_t)xm.slice * 16384 * 128 + 16 * c8;
    const unsigned* ACT = (const unsigned*)(ws + O_ACT);
    const int stride = xm.nloc * 8;
    int row = xm.rank * 8 + w;
    if (row >= NTOK) return;
    float* const hbase = outp + xm.slice * 128 + 16 * c8;
    const bf16_t* const hbb = (const bf16_t*)(ws + O_HB) + xm.slice * 128 + 16 * c8;
    P8bMeta Mc, Mn; P8bRows Ra, Rb;
    p8b_meta(Mc, ACT, row, e8);
    p8b_meta(Mn, ACT, (row + stride < NTOK) ? row + stride : row, e8);
    p8b_load<0>(Ra, Mc, V8);
    for (; row < NTOK; row += stride) {
        f32x2 acc[8];
#pragma unroll
        for (int j = 0; j < 8; ++j) acc[j] = (f32x2){0.f, 0.f};
        p8b_load<1>(Rb, Mc, V8);
        p8b_accum<0>(acc, Ra, Mc);
        p8b_load<0>(Ra, Mn, V8);
        p8b_accum<1>(acc, Rb, Mc);
        p8b_store(acc, hbase + (size_t)row * 1024, hbb + (size_t)row * 1024, e8);
        Mc = Mn;
        const int r2 = row + 2 * stride;
        p8b_meta(Mn, ACT, r2 < NTOK ? r2 : row, e8);
    }
}
__device__ __forceinline__ void phase8c(const Params& p) {
    const int lane = tid_op() & 63, w = tid_op() >> 6;
    for (int row = blockIdx.x * 8 + w; row < NTOK; row += gridDim.x * 8) {
        float* yr = p.out + (size_t)row * 1024;
        float4 v[4]; float s = 0.f;
#pragma unroll
        for (int j = 0; j < 4; ++j) { v[j] = *(const float4*)(yr + 4 * lane + 256 * j); s += v[j].x + v[j].y + v[j].z + v[j].w; }
        const float mean = wave_sum(s) * (1.f / 1024.f);
        float q = 0.f;
#pragma unroll
        for (int j = 0; j < 4; ++j) { const float a = v[j].x - mean, b2 = v[j].y - mean, c2 = v[j].z - mean, d = v[j].w - mean; q += a * a + b2 * b2 + c2 * c2 + d * d; }
        const float rstd = rsqrtf(wave_sum(q) * (1.f / 1024.f) + LN_EPS);
#pragma unroll
        for (int j = 0; j < 4; ++j) {
            const int col = 4 * lane + 256 * j;
            const float4 gg = *(const float4*)(p.ln2_g + col), bb = *(const float4*)(p.ln2_b + col);
            float4 o;
            o.x = (v[j].x - mean) * rstd * gg.x + bb.x; o.y = (v[j].y - mean) * rstd * gg.y + bb.y; o.z = (v[j].z - mean) * rstd * gg.z + bb.z; o.w = (v[j].w - mean) * rstd * gg.w + bb.w;
            *(float4*)(yr + col) = o;
        }
    }
}

typedef const __attribute__((address_space(4))) Params* ParamsK;
__device__ __forceinline__ Params params_reload() {
#if defined(__HIP_DEVICE_COMPILE__)
    auto ka = __builtin_amdgcn_kernarg_segment_ptr();
    asm volatile("" : "+s"(ka));
    Params r; __builtin_memcpy(&r, (const __attribute__((address_space(4))) void*)ka, sizeof(Params));
    return r;
#else
    return Params{};
#endif
}
#if ONE_LAUNCH
__global__ void __launch_bounds__(512, 2) fwd_megakernel(Params p) {
    __shared__ __attribute__((aligned(16))) char smem[SMEM_BYTES];
    cg::grid_group grid = cg::this_grid();
    volatile LAS unsigned* st = (volatile LAS unsigned*)(smem + SMEM_BYTES - 16);
    if (threadIdx.x == 0) { st[0] = 0u; st[1] = 0u; st[2] = 0u; st[3] = 0u; }
    __syncthreads();
    const XcdBarrier xb = xcd_barrier_post((unsigned*)(p.ws + O_BAR), st);
#define GRID_BAR() do { if (p.use_cg) grid.sync(); else xcd_barrier(xb); } while (0)
#ifndef DUP
#define DUP -1
#endif
#define PP (params_reload())
#define RUNPH(k, call) { int n_ = (DUP == k) ? 2 : 1; asm volatile("" : "+s"(n_)); _Pragma("unroll 1") for (int i_ = 0; i_ < n_; ++i_) { call; GRID_BAR(); } }
    RUNPH(0, phase0(PP))
    XcdMap xm;
    if (st[2]) { xm.slice = (int)xb.x; xm.rank = (int)st[3]; xm.nloc = (int)st[0]; }
    else { xm.slice = blockIdx.x & 7; xm.rank = blockIdx.x >> 3; xm.nloc = gridDim.x >> 3; }
    xm.slice = __builtin_amdgcn_readfirstlane(xm.slice); xm.rank = __builtin_amdgcn_readfirstlane(xm.rank); xm.nloc = __builtin_amdgcn_readfirstlane(xm.nloc);
    RUNPH(1, phase1(PP, smem, xm))
    RUNPH(2, phase2(PP, smem))
    if (DUP == 20) { int wh_ = 1; asm volatile("" : "+s"(wh_)); phase2(PP, smem, wh_); GRID_BAR(); }
    if (DUP == 21) { int wh_ = 2; asm volatile("" : "+s"(wh_)); phase2(PP, smem, wh_); GRID_BAR(); }
    phase2c(PP); GRID_BAR();
    RUNPH(3, phase3(PP, smem))
    if (DUP == 30) { int wh_ = 1; asm volatile("" : "+s"(wh_)); phase3(PP, smem, wh_); GRID_BAR(); }
    if (DUP == 31) { int wh_ = 2; asm volatile("" : "+s"(wh_)); phase3(PP, smem, wh_); GRID_BAR(); }
    RUNPH(4, phase4(PP, smem, xm))
    phase5(PP); GRID_BAR();
    RUNPH(6, phase6(PP, smem, xm))
    RUNPH(7, phase7(PP, smem))
#ifdef SCRAMBLE
    { const int x_ = xm.slice, r_ = xm.rank; xm.slice = (x_ + r_) & 7; xm.rank = (r_ >> 3) * 8 + x_; xm.nloc = 32; }
#endif
    if (DUP == 9) { phase8b(PP, xm, (float*)(PP.ws + O_QP)); GRID_BAR(); }
    phase8b(PP, xm, PP.out); GRID_BAR();
    phase8c(PP);
}
#else
__global__ void __launch_bounds__(512, 2) k_phase0(Params p) { phase0(p); }
__global__ void __launch_bounds__(512, 2) k_phase1(Params p) { __shared__ __attribute__((aligned(16))) char smem[SMEM_BYTES]; XcdMap xm; xm.slice = blockIdx.x & 7; xm.rank = blockIdx.x >> 3; xm.nloc = gridDim.x >> 3; phase1(p, smem, xm); }
__global__ void __launch_bounds__(512, 2) k_phase2(Params p) { __shared__ __attribute__((aligned(16))) char smem[SMEM_BYTES]; phase2(p, smem); }
__global__ void __launch_bounds__(512, 2) k_phase2c(Params p) { phase2c(p); }
__global__ void __launch_bounds__(512, 2) k_phase3(Params p) { __shared__ __attribute__((aligned(16))) char smem[SMEM_BYTES]; phase3(p, smem); }
__global__ void __launch_bounds__(512, 2) k_phase4(Params p) { __shared__ __attribute__((aligned(16))) char smem[SMEM_BYTES]; XcdMap xm; xm.slice = blockIdx.x & 7; xm.rank = blockIdx.x >> 3; xm.nloc = gridDim.x >> 3; phase4(p, smem, xm); }
__global__ void __launch_bounds__(512, 2) k_phase5(Params p) { phase5(p); }
__global__ void __launch_bounds__(512, 2) k_phase6(Params p) { __shared__ __attribute__((aligned(16))) char smem[SMEM_BYTES]; XcdMap xm; xm.slice = blockIdx.x & 7; xm.rank = blockIdx.x >> 3; xm.nloc = gridDim.x >> 3; phase6(p, smem, xm); }
__global__ void __launch_bounds__(512, 2) k_phase7(Params p) { __shared__ __attribute__((aligned(16))) char smem_[SMEM_BYTES]; phase7(p, smem_); }
__global__ void __launch_bounds__(512, 2) k_phase8b(Params p) { XcdMap xm; xm.slice = blockIdx.x & 7; xm.rank = blockIdx.x >> 3; xm.nloc = gridDim.x >> 3; phase8b(p, xm, p.out); }
__global__ void __launch_bounds__(512, 2) k_phase8c(Params p) { phase8c(p); }
#endif

extern "C" void kernel_launch(void* const* d_in, const int* in_sizes, int n_in, void* d_out, int out_size, void* d_ws, size_t ws_size, hipStream_t stream) {
    Params p{};
    p.x = (const float*)d_in[0]; p.pos = (const int*)d_in[1]; p.w_in = (const float*)d_in[2]; p.conv_w = (const float*)d_in[3]; p.conv_b = (const float*)d_in[4];
    p.dt_bias = (const float*)d_in[5]; p.a_log = (const float*)d_in[6]; p.d_skip = (const float*)d_in[7]; p.norm_w = (const float*)d_in[8]; p.w_out = (const float*)d_in[9];
    p.ln1_g = (const float*)d_in[10]; p.ln1_b = (const float*)d_in[11]; p.wq = (const float*)d_in[12]; p.k1 = (const float*)d_in[13]; p.k2 = (const float*)d_in[14];
    p.u = (const float*)d_in[15]; p.v = (const float*)d_in[16]; p.ln2_g = (const float*)d_in[17]; p.ln2_b = (const float*)d_in[18];
    p.out = (float*)d_out; p.ws = (char*)d_ws;
    if (ws_size < WS_NEEDED) { fprintf(stderr, "kernel_launch: workspace too small (%zu < %zu)\n", ws_size, (size_t)WS_NEEDED); return; }
#if ONE_LAUNCH
    static int grid_blocks = 0;
    if (!grid_blocks) {
        int dev = 0, cus = 0, per_cu = 0;
        hipGetDevice(&dev);
        hipDeviceGetAttribute(&cus, hipDeviceAttributeMultiprocessorCount, dev);
        hipOccupancyMaxActiveBlocksPerMultiprocessor(&per_cu, fwd_megakernel, 512, 0);
        if (per_cu > 1) per_cu = 1;
        if (per_cu < 1) per_cu = 1;
        grid_blocks = cus * per_cu;
    }
    (void)hipMemsetAsync((char*)d_ws + O_BAR, 0, XCD_BAR_WORDS * 4, stream);
    void* args[] = {&p};
    hipError_t e = hipLaunchCooperativeKernel((void*)fwd_megakernel, dim3(grid_blocks), dim3(512), args, 0, stream);
    if (e != hipSuccess) fprintf(stderr, "cooperative launch failed: %s (grid %d)\n", hipGetErrorString(e), grid_blocks);
#else
    const int G = 512;
    k_phase0<<<G, 512, 0, stream>>>(p);
    k_phase1<<<G, 512, 0, stream>>>(p);
    k_phase2<<<G, 512, 0, stream>>>(p);
    k_phase2c<<<G, 512, 0, stream>>>(p);
    k_phase3<<<G, 512, 0, stream>>>(p);
    k_phase4<<<G, 512, 0, stream>>>(p);
    k_phase5<<<G, 512, 0, stream>>>(p);
    k_phase6<<<G, 512, 0, stream>>>(p);
    k_phase7<<<G, 512, 0, stream>>>(p);
    k_phase8b<<<G, 512, 0, stream>>>(p);
    k_phase8c<<<G, 512, 0, stream>>>(p);
#endif
}
```

```cpp
#include <hip/hip_runtime.h>
#include <hip/hip_cooperative_groups.h>
#include <stdint.h>
#include <stdio.h>
namespace cg = cooperative_groups;

typedef unsigned short bf16_t;
typedef short bf16x8 __attribute__((ext_vector_type(8)));
typedef short bf16x4 __attribute__((ext_vector_type(4)));
typedef float f32x4 __attribute__((ext_vector_type(4)));
typedef float f32x2 __attribute__((ext_vector_type(2)));

#ifndef ONE_LAUNCH
#define ONE_LAUNCH 1
#endif

constexpr int NB = 8, SEQ = 2048, DM = 1024, NTOK = NB * SEQ;
constexpr int NP = 3584;
constexpr int QOFF = 0, KOFF = 512, VOFF = 1024, IQOFF = 1536, MISCOFF = 1792, ZOFF = 1856, XBCOFF = 2368, NUSED = 3392;
constexpr float ALPHA = 1.189207115002721f;
constexpr float LN_EPS = 1e-5f;

constexpr size_t MB = 1024 * 1024;
constexpr size_t O_WIN_T = 0;
constexpr size_t O_WOUT_T = O_WIN_T + (size_t)NP * 1024 * 2;
constexpr size_t O_WQ_T = O_WOUT_T + 2 * MB;
constexpr size_t O_K1B = O_WQ_T + 4 * MB;
constexpr size_t O_K2B = O_K1B + 32768;
constexpr size_t O_CS64 = O_K2B + 32768;
constexpr size_t O_CS32 = O_CS64 + 4 * MB;
constexpr size_t O_BAR = O_CS32 + 2 * MB;
constexpr size_t O_R1 = O_BAR + 65536;
constexpr size_t O_XB = O_R1;
constexpr size_t O_XT = O_R1;
constexpr size_t O_BRM = O_XT + 16 * MB;
constexpr size_t O_CRM = O_BRM + 8 * MB;
constexpr size_t O_QB = O_XB + 32 * MB;
constexpr size_t O_KB = O_QB + 16 * MB;
constexpr size_t O_VT = O_KB + 16 * MB;
constexpr size_t O_IQB = O_VT + 16 * MB;
constexpr size_t O_IKB = O_IQB + 8 * MB;
constexpr size_t O_IWF = O_IKB + 1 * MB;
constexpr size_t O_DTF = O_IWF + MB / 2;
constexpr size_t O_ZB = O_DTF + MB / 2;
constexpr size_t O_XBCT = O_ZB + 16 * MB;
constexpr size_t O_CAR = O_XBCT;
constexpr size_t O_ACUM = O_XBCT + 32 * MB;
constexpr size_t O_ATOT = O_ACUM + MB / 2;
constexpr size_t O_ST = O_ATOT + MB / 2;
constexpr size_t O_MIX = O_ST;
constexpr size_t O_MASK = O_ST + 32 * MB;
constexpr size_t O_R1_END = O_MASK + 4 * MB;
constexpr size_t O_HB = O_R1;
constexpr size_t O_QP = O_HB + 32 * MB;
constexpr size_t O_ACT = O_QP + 64 * MB;
constexpr size_t O_R2_END = O_ACT + 8 * MB;
static_assert(O_R2_END <= O_ST, "region 2 must not reach MIX");
constexpr size_t O_U8 = O_R1_END;
constexpr size_t O_V8 = O_U8 + 16 * MB;
constexpr size_t WS_NEEDED = O_V8 + 16 * MB;
static_assert(WS_NEEDED <= 256 * MB, "workspace too large");

struct Params {
    const float* x; const int* pos; const float* w_in; const float* conv_w; const float* conv_b; const float* dt_bias;
    const float* a_log; const float* d_skip; const float* norm_w; const float* w_out; const float* ln1_g; const float* ln1_b;
    const float* wq; const float* k1; const float* k2; const float* u; const float* v; const float* ln2_g; const float* ln2_b;
    float* out; char* ws; int use_cg; int pad_;
};

#define SMEM_BYTES 133120

__device__ __forceinline__ int tid_op() { int t = threadIdx.x; asm volatile("" : "+v"(t)); return t; }
__device__ __forceinline__ bf16_t f2bf(float f) {
    unsigned u = __float_as_uint(f);
    u += 0x7FFFu + ((u >> 16) & 1u);
    return (bf16_t)(u >> 16);
}
__device__ __forceinline__ float bf2f(bf16_t b) { return __uint_as_float(((unsigned)b) << 16); }
__device__ __forceinline__ unsigned pack2(float a, float b) { return (unsigned)f2bf(a) | ((unsigned)f2bf(b) << 16); }
__device__ __forceinline__ unsigned f2sort(float f) { unsigned u = __float_as_uint(f); return (u & 0x80000000u) ? ~u : (u | 0x80000000u); }
__device__ __forceinline__ float sort2f(unsigned s) { unsigned u = (s & 0x80000000u) ? (s & 0x7FFFFFFFu) : ~s; return __uint_as_float(u); }
__device__ __forceinline__ f32x4 mfma16(bf16x8 a, bf16x8 b, f32x4 c) { return __builtin_amdgcn_mfma_f32_16x16x32_bf16(a, b, c, 0, 0, 0); }
__device__ __forceinline__ float silu_f(float v) { return v / (1.f + __expf(-v)); }
__device__ __forceinline__ bf16x8 ld8(const bf16_t* p) { return *(const bf16x8*)p; }
__device__ __forceinline__ bf16x8 cat4(bf16x4 lo, bf16x4 hi) { return __builtin_shufflevector(lo, hi, 0, 1, 2, 3, 4, 5, 6, 7); }


template <int CTRL, int ROWMASK, bool BC> __device__ __forceinline__ int dpp_i(int v) { return __builtin_amdgcn_update_dpp(0, v, CTRL, ROWMASK, 0xF, BC); }
template <int CTRL, int ROWMASK, bool BC> __device__ __forceinline__ float dpp_f(float v) { return __builtin_bit_cast(float, __builtin_amdgcn_update_dpp(0, __builtin_bit_cast(int, v), CTRL, ROWMASK, 0xF, BC)); }
__device__ __forceinline__ float row_sum(float v) { v += dpp_f<0xB1, 0xF, true>(v); v += dpp_f<0x4E, 0xF, true>(v); v += dpp_f<0x141, 0xF, true>(v); v += dpp_f<0x140, 0xF, true>(v); return v; }
__device__ __forceinline__ unsigned row_sum_u(unsigned v) { v += (unsigned)dpp_i<0xB1, 0xF, true>((int)v); v += (unsigned)dpp_i<0x4E, 0xF, true>((int)v); v += (unsigned)dpp_i<0x141, 0xF, true>((int)v); v += (unsigned)dpp_i<0x140, 0xF, true>((int)v); return v; }
__device__ __forceinline__ unsigned row_max_u(unsigned v) {
    v = max(v, (unsigned)dpp_i<0xB1, 0xF, true>((int)v)); v = max(v, (unsigned)dpp_i<0x4E, 0xF, true>((int)v));
    v = max(v, (unsigned)dpp_i<0x141, 0xF, true>((int)v)); v = max(v, (unsigned)dpp_i<0x140, 0xF, true>((int)v)); return v;
}
__device__ __forceinline__ float wave_sum_u(float v) {
    v = row_sum(v);
    v += dpp_f<0x142, 0xA, false>(v);
    v += dpp_f<0x143, 0xC, false>(v);
    return __builtin_bit_cast(float, __builtin_amdgcn_readlane(__builtin_bit_cast(int, v), 63));
}
typedef unsigned u32x2_t __attribute__((ext_vector_type(2)));
__device__ __forceinline__ float sum_x16(float v) { const u32x2_t r = __builtin_amdgcn_permlane16_swap(__float_as_uint(v), __float_as_uint(v), false, false); return __uint_as_float(r.x) + __uint_as_float(r.y); }
__device__ __forceinline__ float sum_x32(float v) { const u32x2_t r = __builtin_amdgcn_permlane32_swap(__float_as_uint(v), __float_as_uint(v), false, false); return __uint_as_float(r.x) + __uint_as_float(r.y); }
__device__ __forceinline__ float max_x16(float v) { const u32x2_t r = __builtin_amdgcn_permlane16_swap(__float_as_uint(v), __float_as_uint(v), false, false); return fmaxf(__uint_as_float(r.x), __uint_as_float(r.y)); }
__device__ __forceinline__ float max_x32(float v) { const u32x2_t r = __builtin_amdgcn_permlane32_swap(__float_as_uint(v), __float_as_uint(v), false, false); return fmaxf(__uint_as_float(r.x), __uint_as_float(r.y)); }
__device__ __forceinline__ float wave_sum(float v) { return sum_x32(sum_x16(row_sum(v))); }

#define XB_TMO      128
#define XB_XCNT(j)  (256  + 64 * (j))
#define XB_XSUB(j)  (1280 + 64 * (j))
#define XB_XGEN(j)  (2304 + 64 * (j))
#define XB_TOP      3328
#define XB_TOPGEN   3392
#define XCD_BAR_WORDS 3456
#define XB_SPIN_CAP (1u << 22)
#define LAS __attribute__((address_space(3)))
__device__ __forceinline__ unsigned xb_ld(unsigned* p)              { return __hip_atomic_load(p, __ATOMIC_RELAXED, __HIP_MEMORY_SCOPE_AGENT); }
__device__ __forceinline__ unsigned xb_add(unsigned* p, unsigned v) { return __hip_atomic_fetch_add(p, v, __ATOMIC_RELAXED, __HIP_MEMORY_SCOPE_AGENT); }
__device__ __forceinline__ unsigned xb_xcc_id() { return (unsigned)__builtin_amdgcn_s_getreg((3 << 11) | 20) & 0xFu; }
#define XB_SPIN(cond, bar) do { unsigned _sp = 0; while (cond) { __builtin_amdgcn_s_sleep(1); \
    if ((++_sp & 255u) == 0u) { if (xb_ld(&(bar)[XB_TMO])) break; if (_sp > XB_SPIN_CAP) { atomicAdd(&(bar)[XB_TMO], 1u); break; } } } } while (0)
struct XcdBarrier { unsigned* bar; unsigned x; volatile LAS unsigned* st; };
__device__ __forceinline__ XcdBarrier xcd_barrier_post(unsigned* bar, volatile LAS unsigned* st) {
    XcdBarrier b; b.bar = bar; b.x = xb_xcc_id(); b.st = st;
    if (threadIdx.x == 0) st[3] = xb_add(&bar[XB_XCNT(b.x)], 1u);
    return b;
}
__device__ __forceinline__ void xcd_barrier_complete(unsigned* bar, unsigned x, unsigned& nloc, unsigned& nx, unsigned& low8) {
    const unsigned G = gridDim.x * gridDim.y * gridDim.z;
    unsigned sum, cnt, mine, lo, sp = 0u;
    for (;;) {
        sum = 0u; cnt = 0u; mine = 0u; lo = 0u;
#pragma unroll
        for (unsigned j = 0; j < 16; ++j) { const unsigned c = xb_ld(&bar[XB_XCNT(j)]); sum += c; cnt += (c > 0u) ? 1u : 0u; lo += (j < 8u && c > 0u) ? 1u : 0u; mine = (j == x) ? c : mine; }
        if (sum == G) break;
        __builtin_amdgcn_s_sleep(1);
        if ((++sp & 255u) == 0u) { if (xb_ld(&bar[XB_TMO])) break; if (sp > XB_SPIN_CAP) { atomicAdd(&bar[XB_TMO], 1u); break; } }
    }
    nloc = mine > 0u ? mine : 1u; nx = cnt > 0u ? cnt : 1u; low8 = (lo == 8u && cnt == 8u) ? 1u : 0u;
}
__device__ __forceinline__ void xcd_barrier(const XcdBarrier& b) {
    asm volatile("s_waitcnt vmcnt(0)" ::: "memory");
    __syncthreads();
    if (threadIdx.x == 0) {
        unsigned* bar = b.bar;
        __builtin_amdgcn_s_waitcnt(0);
        unsigned nloc = b.st[0], nx = b.st[1];
        if (nloc == 0u) { unsigned low8; xcd_barrier_complete(bar, b.x, nloc, nx, low8); b.st[0] = nloc; b.st[1] = nx; b.st[2] = low8; }
        const unsigned old = xb_add(&bar[XB_XSUB(b.x)], 1u);
        const unsigned gen = old / nloc;
        if (old + 1u == (gen + 1u) * nloc) {
            __builtin_amdgcn_fence(__ATOMIC_RELEASE, "agent");
            asm volatile("s_waitcnt vmcnt(0)" ::: "memory");
            const unsigned og = xb_add(&bar[XB_TOP], 1u);
            const unsigned tg = og / nx;
            if (og + 1u == (tg + 1u) * nx) xb_add(&bar[XB_TOPGEN], 1u);
            else XB_SPIN(xb_ld(&bar[XB_TOPGEN]) == tg, bar);
            __builtin_amdgcn_fence(__ATOMIC_ACQUIRE, "agent");
            xb_add(&bar[XB_XGEN(b.x)], 1u);
            asm volatile("s_waitcnt vmcnt(0)" ::: "memory");
        } else {
            XB_SPIN(xb_ld(&bar[XB_XGEN(b.x)]) == gen, bar);
            __builtin_amdgcn_fence(__ATOMIC_ACQUIRE, "agent");
            asm volatile("s_waitcnt vmcnt(0)" ::: "memory");
        }
    }
    __syncthreads();
}

__device__ __forceinline__ int rot_perm(int gcol, int H) { const int j = (gcol % H) >> 3, e = gcol & 7; return (gcol / H) * H + 4 * j + (e & 3) + ((e >> 2) ? H / 2 : 0); }
__device__ __forceinline__ int win_src_col(int n) {
    if (n < 1024) return rot_perm(n, 64);
    if (n < 1536) return n;
    if (n < 1824) return 1536 + rot_perm(n - 1536, 32);
    if (n < 1832) return n;
    if (n < 1840) return 3368 + (n - 1832);
    if (n < 1856) return -1;
    if (n < 2368) return 1832 + (n - 1856);
    if (n < 3392) return 2344 + (n - 2368);
    return -1;
}
__device__ __forceinline__ void p0_transpose(const float* __restrict__ W, int N, int Nout, bool remap, bf16_t* __restrict__ Wt, int gtid, int gsz) {
    const int items = Nout * 128;
    for (int it = gtid; it < items; it += gsz) {
        const int n = it % Nout, kc = it / Nout;
        const int src = remap ? win_src_col(n) : n;
        unsigned w[4] = {0, 0, 0, 0};
        if (src >= 0) {
            float f[8];
#pragma unroll
            for (int j = 0; j < 8; ++j) f[j] = W[(size_t)(kc * 8 + j) * N + src];
#pragma unroll
            for (int j = 0; j < 4; ++j) w[j] = pack2(f[2 * j], f[2 * j + 1]);
        }
        *(uint4*)(Wt + (size_t)n * 1024 + kc * 8) = make_uint4(w[0], w[1], w[2], w[3]);
    }
}
__device__ __forceinline__ void p0_convert(const float* __restrict__ src, bf16_t* __restrict__ dst, size_t n4, size_t gtid, size_t gsz) {
    for (size_t i = gtid; i < n4; i += gsz) {
        const float4 f = ((const float4*)src)[i];
        ((uint2*)dst)[i] = make_uint2(pack2(f.x, f.y), pack2(f.z, f.w));
    }
}
__device__ __forceinline__ void phase0(const Params& p) {
    const int gtid = blockIdx.x * blockDim.x + tid_op(), gsz = gridDim.x * blockDim.x;
    p0_transpose(p.w_in, 3376, NP, true, (bf16_t*)(p.ws + O_WIN_T), gtid, gsz);
    p0_transpose(p.w_out, 1024, 1024, false, (bf16_t*)(p.ws + O_WOUT_T), gtid, gsz);
    p0_transpose(p.wq, 2048, 2048, false, (bf16_t*)(p.ws + O_WQ_T), gtid, gsz);
    p0_convert(p.k1, (bf16_t*)(p.ws + O_K1B), 128 * 128 / 4, gtid, gsz);
    p0_convert(p.k2, (bf16_t*)(p.ws + O_K2B), 128 * 128 / 4, gtid, gsz);
    p0_convert(p.x, (bf16_t*)(p.ws + O_XB), (size_t)NTOK * DM / 4, gtid, gsz);
    float2* cs64 = (float2*)(p.ws + O_CS64); float2* cs32 = (float2*)(p.ws + O_CS32);
    for (int it = gtid; it < NTOK * 48; it += gsz) {
        const int m = it / 48, i = it % 48;
        const float ps = (float)p.pos[m];
        if (i < 32) { const float inv = powf(10000.f, -(float)(2 * i) / 64.f); const float a = ps * inv; cs64[m * 32 + i] = make_float2(cosf(a), sinf(a)); }
        else { const int k = i - 32; const float inv = powf(10000.f, -(float)(2 * k) / 32.f); const float a = ps * inv; cs32[m * 16 + k] = make_float2(cosf(a), sinf(a)); }
    }
}

struct XcdMap { int slice, rank, nloc; };
__device__ __forceinline__ bool gemm_next_tile(const XcdMap& xm, int it, int ntn, int& tm, int& tn) {
    const int j = xm.rank + xm.nloc * it;
    if (j >= 8 * ntn) return false;
    tm = 8 * xm.slice + j / ntn; tn = j % ntn; return true;
}
#define GEMM_LDK 80
#define GEMM_LDS_A (256 * GEMM_LDK * 2)
#define GEMM_LDS_STAGE (GEMM_LDS_A + 128 * GEMM_LDK * 2)
typedef unsigned u32x4g __attribute__((ext_vector_type(4)));
struct GemmRegs { u32x4g a0, a1, a2, a3, b0, b1; };
__device__ __forceinline__ void gemm_gload(GemmRegs& r, const bf16_t* ga, const bf16_t* gb, size_t astep) {
    r.a0 = *(const u32x4g*)(ga); r.a1 = *(const u32x4g*)(ga + astep); r.a2 = *(const u32x4g*)(ga + 2 * astep); r.a3 = *(const u32x4g*)(ga + 3 * astep);
    r.b0 = *(const u32x4g*)(gb); r.b1 = *(const u32x4g*)(gb + astep);
}
__device__ __forceinline__ void gemm_lstore(const GemmRegs& r, bf16_t* wa, bf16_t* wb) {
    *(u32x4g*)(wa) = r.a0; *(u32x4g*)(wa + 64 * GEMM_LDK) = r.a1; *(u32x4g*)(wa + 128 * GEMM_LDK) = r.a2; *(u32x4g*)(wa + 192 * GEMM_LDK) = r.a3;
    *(u32x4g*)(wb) = r.b0; *(u32x4g*)(wb + 64 * GEMM_LDK) = r.b1;
}
__device__ __forceinline__ void gemm_compute(f32x4 (&acc)[4][4], const bf16_t* sA, const bf16_t* sB, int wm, int wn, int lane) {
#pragma unroll
    for (int ks = 0; ks < 2; ++ks) {
        bf16x8 a[4], b[4];
#pragma unroll
        for (int i = 0; i < 4; ++i) a[i] = ld8(sA + (wm * 64 + i * 16 + (lane & 15)) * GEMM_LDK + ks * 32 + (lane >> 4) * 8);
#pragma unroll
        for (int i = 0; i < 4; ++i) b[i] = ld8(sB + (wn * 64 + i * 16 + (lane & 15)) * GEMM_LDK + ks * 32 + (lane >> 4) * 8);
#pragma unroll
        for (int i = 0; i < 4; ++i)
#pragma unroll
            for (int j = 0; j < 4; ++j) acc[i][j] = mfma16(a[i], b[j], acc[i][j]);
    }
}
template <class Epi>
__device__ __forceinline__ void gemm_tile(const bf16_t* __restrict__ A, const bf16_t* __restrict__ Bt, int K, int m0, int n0, const Epi& epi, char* smem) {
    const int tid = tid_op(), lane = tid & 63, w = tid >> 6, wm = w >> 1, wn = w & 1;
    f32x4 acc[4][4];
#pragma unroll
    for (int i = 0; i < 4; ++i)
#pragma unroll
        for (int j = 0; j < 4; ++j) acc[i][j] = (f32x4){0.f, 0.f, 0.f, 0.f};
    const int lrow = tid >> 3, lkc = (tid & 7) * 8;
    const bf16_t* ga = A + (size_t)(m0 + lrow) * K + lkc;
    const bf16_t* gb = Bt + (size_t)(n0 + lrow) * K + lkc;
    const size_t astep = (size_t)64 * K;
    bf16_t* sA0 = (bf16_t*)smem; bf16_t* sB0 = (bf16_t*)(smem + GEMM_LDS_A);
    bf16_t* sA1 = (bf16_t*)(smem + GEMM_LDS_STAGE); bf16_t* sB1 = (bf16_t*)(smem + GEMM_LDS_STAGE + GEMM_LDS_A);
    const int woff = lrow * GEMM_LDK + lkc;
    GemmRegs r0, r1;
    gemm_gload(r0, ga, gb, astep);
    gemm_gload(r1, ga + 64, gb + 64, astep);
    __syncthreads();
    gemm_lstore(r0, sA0 + woff, sB0 + woff);
    __syncthreads();
    const int nk = K / 64;
    for (int k = 0; k < nk; k += 2) {
        { const int kk = (k + 2 < nk) ? k + 2 : nk - 1; gemm_gload(r0, ga + kk * 64, gb + kk * 64, astep); }
        gemm_compute(acc, sA0, sB0, wm, wn, lane);
        gemm_lstore(r1, sA1 + woff, sB1 + woff);
        __syncthreads();
        { const int kk = (k + 3 < nk) ? k + 3 : nk - 1; gemm_gload(r1, ga + kk * 64, gb + kk * 64, astep); }
        gemm_compute(acc, sA1, sB1, wm, wn, lane);
        gemm_lstore(r0, sA0 + woff, sB0 + woff);
        __syncthreads();
    }
    epi(acc, m0 + wm * 64, n0 + wn * 64, lane, smem + w * 9216);
}

namespace pg8 {
#define PG8_LAS __attribute__((address_space(3)))
typedef unsigned short bf16_t;
typedef short bf16x8 __attribute__((ext_vector_type(8)));
typedef float f32x4 __attribute__((ext_vector_type(4)));
typedef unsigned u32x4 __attribute__((ext_vector_type(4)));
constexpr int BM = 256, BK = 64, HALF = 128, HTB = HALF * BK * 2  , STAGE_BYTES = 8 * HTB, NXCD = 8, WGM = 8;

__host__ __device__ __forceinline__ int lds_byte(int r, int c) { const int st = (r >> 4) * 2 + (c >> 5), rr = r & 15, cc = c & 31, ob = rr * 64 + cc * 2; return st * 1024 + (ob ^ (((ob >> 9) & 1) << 5)); }
__host__ __device__ __forceinline__ void stage_rc(int b, int& R, int& C) { const int st = b / 1024, sb = b % 1024, swz = sb ^ (((sb >> 9) & 1) << 5); R = (st >> 1) * 16 + swz / 64; C = (st & 1) * 32 + (swz % 64) / 2; }
__host__ __device__ __forceinline__ int perm32(int rho) { const int n = rho >> 4, i = rho & 15; return 8 * (i >> 2) + 4 * n + (i & 3); }

struct Unit { int pm, pn; };
struct Gemm { const bf16_t* A; const bf16_t* Bt; int M, N, K; };

struct StaticOrder {
    int nM, nN, nwg, G, c;
    __host__ __device__ void init(int M, int N, int G_, int c_) { nM = M / BM; nN = N / BM; nwg = nM * nN; G = G_; c = c_; }
    __host__ __device__ bool next(int i, Unit& u) const {
        const long L = (long)i * G + c; if (L >= nwg) return false;
        int wgid = (int)L; { const int q = nwg / NXCD, r = nwg % NXCD, xcd = wgid % NXCD, off = wgid / NXCD; wgid = (xcd < r ? xcd * (q + 1) : r * (q + 1) + (xcd - r) * q) + off; }
        const int nig = WGM * nN, gid = wgid / nig, fm = gid * WGM, gsz = (nM - fm) < WGM ? (nM - fm) : WGM;
        u.pm = fm + ((wgid % nig) % gsz); u.pn = (wgid % nig) / gsz; return true;
    }
    __device__ __forceinline__ void a_ready(const Unit&) const {}
    __device__ __forceinline__ void done(const Unit&) const {}
};
__device__ __forceinline__ unsigned cvt_pk_bf16(float lo, float hi) { unsigned r; asm volatile("v_cvt_pk_bf16_f32 %0, %1, %2" : "=v"(r) : "v"(lo), "v"(hi)); return r; }

struct EpiBf16Plain {
    static constexpr bool PERM = true, AFTER_DRAIN = false;
    bf16_t* O; int ldc;
    __device__ __forceinline__ void operator()(const f32x4 (&acc)[2][2][4][2], const Unit& u, int wr, int wc, int fr, int fq) const {
        const int row0 = u.pm * BM + wr * 64 + fr, col0 = u.pn * BM + wc * 32 + 8 * fq;
#pragma unroll
        for (int ai = 0; ai < 2; ++ai)
#pragma unroll
            for (int m = 0; m < 4; ++m) { bf16_t* rowp = O + (size_t)(row0 + ai * HALF + m * 16) * ldc + col0;
#pragma unroll
                for (int bj = 0; bj < 2; ++bj) { const f32x4 v0 = acc[ai][bj][m][0], v1 = acc[ai][bj][m][1];
                    u32x4 w; w.x = cvt_pk_bf16(v0[0], v0[1]); w.y = cvt_pk_bf16(v0[2], v0[3]); w.z = cvt_pk_bf16(v1[0], v1[1]); w.w = cvt_pk_bf16(v1[2], v1[3]);
                    *(u32x4*)(rowp + bj * HALF) = w; } }
    }
};
struct EpiResF32 {
    static constexpr bool PERM = false, AFTER_DRAIN = false;
    float* Y; const float* X; int ldc; float alpha;
    __device__ __forceinline__ void operator()(const f32x4 (&acc)[2][2][4][2], const Unit& u, int wr, int wc, int fr, int fq) const {
        const int row0 = u.pm * BM + wr * 64 + fr, col0 = u.pn * BM + wc * 32 + 4 * fq;
#pragma unroll
        for (int ai = 0; ai < 2; ++ai)
#pragma unroll
            for (int m = 0; m < 4; ++m) { const size_t ro = (size_t)(row0 + ai * HALF + m * 16) * ldc + col0;
#pragma unroll
                for (int bj = 0; bj < 2; ++bj)
#pragma unroll
                    for (int n = 0; n < 2; ++n) { const f32x4 xv = *(const f32x4*)(X + ro + bj * HALF + n * 16); *(f32x4*)(Y + ro + bj * HALF + n * 16) = xv * alpha + acc[ai][bj][m][n]; } }
    }
};
struct EpiResBf16 {
    static constexpr bool PERM = true, AFTER_DRAIN = false;
    bf16_t* Y; const float* X; int ldc; float alpha;
    __device__ __forceinline__ void operator()(const f32x4 (&acc)[2][2][4][2], const Unit& u, int wr, int wc, int fr, int fq) const {
        const int row0 = u.pm * BM + wr * 64 + fr, col0 = u.pn * BM + wc * 32 + 8 * fq;
#pragma unroll
        for (int ai = 0; ai < 2; ++ai)
#pragma unroll
            for (int m = 0; m < 4; ++m) { const size_t ro = (size_t)(row0 + ai * HALF + m * 16) * ldc + col0;
#pragma unroll
                for (int bj = 0; bj < 2; ++bj) {
                    const f32x4 x0 = *(const f32x4*)(X + ro + bj * HALF), x1 = *(const f32x4*)(X + ro + bj * HALF + 4);
                    const f32x4 v0 = x0 * alpha + acc[ai][bj][m][0], v1 = x1 * alpha + acc[ai][bj][m][1];
                    u32x4 w; w.x = cvt_pk_bf16(v0[0], v0[1]); w.y = cvt_pk_bf16(v0[2], v0[3]); w.z = cvt_pk_bf16(v1[0], v1[1]); w.w = cvt_pk_bf16(v1[2], v1[3]);
                    *(u32x4*)(Y + ro + bj * HALF) = w; } }
    }
};
template <class Epi, class Sched, bool STAMP = false>
__device__ __forceinline__ void gemm_phase(PG8_LAS unsigned char* lds, const Gemm g, const Sched& S, const Epi& E, unsigned long long* stamps) {
    const int tid = tid_op(), wid = __builtin_amdgcn_readfirstlane(tid >> 6), lane = tid & 63, wr = wid >> 2, wc = wid & 3, fr = lane & 15, fq = lane >> 4;
    const int K = g.K, nt = K / BK;
    int ts_lo = 0, ts_hi = 0, nts = 0; const unsigned long long rt_entry = STAMP ? (unsigned long long)wall_clock64() : 0ull;
#define PG8_STAMP() do { if (STAMP && wid == 0 && nts < 64) { const unsigned long long _c = (unsigned long long)clock64(); \
        ts_lo = (lane == nts) ? (int)(unsigned)_c : ts_lo; ts_hi = (lane == nts) ? (int)(unsigned)(_c >> 32) : ts_hi; ++nts; } } while (0)
    PG8_STAMP();
    unsigned voffA[2], voffB[2];
#pragma unroll
    for (int i = 0; i < 2; ++i) { int R, C; stage_rc(tid * 16 + i * 8192, R, C); const int Rb = Epi::PERM ? ((R & ~31) + perm32(R & 31)) : R;
        voffA[i] = (unsigned)(R * K + C) * 2u; voffB[i] = (unsigned)(Rb * K + C) * 2u; }
    const size_t kstep = (size_t)(BK * 2);
    const size_t hstep = (size_t)HALF * K * 2;
    const size_t tstep = 2 * hstep;
    const unsigned ldsw = (unsigned)wid * 1024u;
    const int aoff = lds_byte(wr * 64 + fr, fq * 8), boff = lds_byte(wc * 32 + fr, fq * 8);
#define PG8_SA(b, h) (((b) * 2 + (h)) * HTB)
#define PG8_SB(b, h) ((4 + (b) * 2 + (h)) * HTB)
#define PG8_STAGE(bufoff, gbase, voff) do { _Pragma("unroll") for (int _i = 0; _i < 2; ++_i) \
        __builtin_amdgcn_global_load_lds((const unsigned*)((const char*)(gbase) + (voff)[_i]), (PG8_LAS unsigned*)(lds + (bufoff) + ldsw + _i * 8192), 16, 0, 0); } while (0)
#define PG8_LDA(dst, b, h) do { _Pragma("unroll") for (int m = 0; m < 4; ++m) _Pragma("unroll") for (int k = 0; k < 2; ++k) dst[m][k] = *(const PG8_LAS bf16x8*)(lds + PG8_SA(b, h) + aoff + m * 2048 + k * 1024); } while (0)
#define PG8_LDB(dst, b, h) do { _Pragma("unroll") for (int n = 0; n < 2; ++n) _Pragma("unroll") for (int k = 0; k < 2; ++k) dst[n][k] = *(const PG8_LAS bf16x8*)(lds + PG8_SB(b, h) + boff + n * 2048 + k * 1024); } while (0)
#define PG8_MMA(ai, bj, At, Bt) do { __builtin_amdgcn_s_setprio(1); _Pragma("unroll") for (int m = 0; m < 4; ++m) _Pragma("unroll") for (int n = 0; n < 2; ++n) _Pragma("unroll") for (int k = 0; k < 2; ++k) \
        acc[ai][bj][m][n] = __builtin_amdgcn_mfma_f32_16x16x32_bf16(Bt[n][k], At[m][k], acc[ai][bj][m][n], 0, 0, 0); __builtin_amdgcn_s_setprio(0); } while (0)
#define PG8_WAIT_V(n) asm volatile("s_waitcnt vmcnt(" #n ")" ::: "memory")
#define PG8_WAIT_L(n) asm volatile("s_waitcnt lgkmcnt(" #n ")" ::: "memory")
#define PG8_BAR __builtin_amdgcn_s_barrier()
#define PG8_SCHED __builtin_amdgcn_sched_barrier(0)
    Unit cur, nxt; int ui = 0;
    if (!S.next(0, cur)) return;
    f32x4 acc[2][2][4][2];
#pragma unroll
    for (int a = 0; a < 2; ++a)
#pragma unroll
        for (int b = 0; b < 2; ++b)
#pragma unroll
            for (int m = 0; m < 4; ++m)
#pragma unroll
                for (int n = 0; n < 2; ++n) acc[a][b][m][n] = (f32x4){0.f, 0.f, 0.f, 0.f};
    bf16x8 At[4][2], B0[2][2], B1[2][2];
    const char* cA = (const char*)g.A + (size_t)cur.pm * tstep; const char* cB = (const char*)g.Bt + (size_t)cur.pn * tstep;
    S.a_ready(cur);
    PG8_STAGE(PG8_SB(0, 0), cB, voffB); PG8_STAGE(PG8_SA(0, 0), cA, voffA); PG8_STAGE(PG8_SB(0, 1), cB + hstep, voffB); PG8_STAGE(PG8_SA(0, 1), cA + hstep, voffA);
    if (wr == 1) PG8_BAR;
    PG8_WAIT_V(4); PG8_BAR;
    PG8_STAGE(PG8_SB(1, 0), cB + kstep, voffB); PG8_STAGE(PG8_SA(1, 0), cA + kstep, voffA); PG8_STAGE(PG8_SB(1, 1), cB + hstep + kstep, voffB);
    PG8_WAIT_V(6); PG8_BAR;
    PG8_STAMP();
    for (;;) {
        const bool has_next = S.next(ui + 1, nxt);
        const char* nA = has_next ? (const char*)g.A + (size_t)nxt.pm * tstep : cA; const char* nB = has_next ? (const char*)g.Bt + (size_t)nxt.pn * tstep : cB;
        for (int t = 0; t < nt; t += 2) {
            const bool last = (t == nt - 2);
            const char* a1 = cA + (size_t)(t + 1) * kstep;
            const char* a2 = last ? nA : cA + (size_t)(t + 2) * kstep; const char* b2 = last ? nB : cB + (size_t)(t + 2) * kstep;
            const char* a3 = a2 + kstep; const char* b3 = b2 + kstep;
            if (last && has_next) S.a_ready(nxt);
            PG8_LDB(B0, 0, 0); PG8_SCHED; PG8_LDA(At, 0, 0); PG8_STAGE(PG8_SA(1, 1), a1 + hstep, voffA);
            PG8_WAIT_L(8); PG8_BAR; PG8_WAIT_L(0); PG8_MMA(0, 0, At, B0); PG8_BAR; PG8_SCHED;
            PG8_LDB(B1, 0, 1); PG8_STAGE(PG8_SB(0, 0), b2, voffB);
            PG8_BAR; PG8_WAIT_L(0); PG8_MMA(0, 1, At, B1); PG8_BAR;
            PG8_LDA(At, 0, 1); PG8_STAGE(PG8_SA(0, 0), a2, voffA);
            PG8_BAR; PG8_WAIT_L(0); PG8_MMA(1, 0, At, B0); PG8_BAR; PG8_SCHED;
            PG8_STAGE(PG8_SB(0, 1), b2 + hstep, voffB);
            PG8_WAIT_V(6); PG8_BAR; PG8_MMA(1, 1, At, B1); PG8_BAR;
            PG8_LDB(B0, 1, 0); PG8_SCHED; PG8_LDA(At, 1, 0); PG8_STAGE(PG8_SA(0, 1), a2 + hstep, voffA);
            PG8_WAIT_L(8); PG8_BAR; PG8_WAIT_L(0); PG8_MMA(0, 0, At, B0); PG8_BAR; PG8_SCHED;
            PG8_LDB(B1, 1, 1); PG8_STAGE(PG8_SB(1, 0), b3, voffB);
            PG8_BAR; PG8_WAIT_L(0); PG8_MMA(0, 1, At, B1); PG8_BAR;
            PG8_LDA(At, 1, 1); PG8_STAGE(PG8_SA(1, 0), a3, voffA);
            PG8_BAR; PG8_WAIT_L(0); PG8_MMA(1, 0, At, B0); PG8_BAR; PG8_SCHED;
            PG8_STAGE(PG8_SB(1, 1), b3 + hstep, voffB);
            PG8_WAIT_V(6); PG8_BAR; PG8_MMA(1, 1, At, B1); PG8_BAR;
        }
        PG8_STAMP();
        if constexpr (!Epi::AFTER_DRAIN) { E(acc, cur, wr, wc, fr, fq); S.done(cur); }
        PG8_STAMP();
        if (!has_next) break;
#pragma unroll
        for (int a = 0; a < 2; ++a)
#pragma unroll
            for (int b = 0; b < 2; ++b)
#pragma unroll
                for (int m = 0; m < 4; ++m)
#pragma unroll
                    for (int n = 0; n < 2; ++n) acc[a][b][m][n] = (f32x4){0.f, 0.f, 0.f, 0.f};
        cur = nxt; cA = nA; cB = nB; ++ui;
    }
    PG8_WAIT_V(0);
    if (wr == 0) PG8_BAR;
    PG8_BAR;
    if constexpr (Epi::AFTER_DRAIN) { E.fused(acc, cur, wr, wc, fr, fq, lds, wid, lane); S.done(cur); }
    PG8_STAMP();
    if (STAMP && wid == 0) { stamps[lane] = lane < nts ? (((unsigned long long)(unsigned)ts_hi << 32) | (unsigned)ts_lo) : 0ull;
        if (lane == 62) stamps[62] = rt_entry; if (lane == 63) stamps[63] = (unsigned long long)wall_clock64(); }
#undef PG8_STAMP
#undef PG8_SA
#undef PG8_SB
#undef PG8_STAGE
#undef PG8_LDA
#undef PG8_LDB
#undef PG8_MMA
#undef PG8_WAIT_V
#undef PG8_WAIT_L
#undef PG8_BAR
#undef PG8_SCHED
}
}

struct ProjEpi8 {
    static constexpr bool PERM = true, AFTER_DRAIN = false;
    char* ws; const float* dt_bias;
    __device__ __forceinline__ uint4 rot8(const pg8::f32x4 v0, const pg8::f32x4 v1, const float* tab, float sc) const {
        const float4 c01 = *(const float4*)tab, c23 = *(const float4*)(tab + 4);
        const float o10 = (v0[0] * c01.x - v1[0] * c01.y) * sc, o11 = (v0[1] * c01.z - v1[1] * c01.w) * sc, o12 = (v0[2] * c23.x - v1[2] * c23.y) * sc, o13 = (v0[3] * c23.z - v1[3] * c23.w) * sc;
        const float o20 = (v1[0] * c01.x + v0[0] * c01.y) * sc, o21 = (v1[1] * c01.z + v0[1] * c01.w) * sc, o22 = (v1[2] * c23.x + v0[2] * c23.y) * sc, o23 = (v1[3] * c23.z + v0[3] * c23.w) * sc;
        return make_uint4(pack2(o10, o11), pack2(o12, o13), pack2(o20, o21), pack2(o22, o23));
    }
    template <int SEG> __device__ __forceinline__ void store_row(const pg8::f32x4 v0, const pg8::f32x4 v1, const int cg, const int row) const {
        const int b = row >> 11, t = row & 2047;
        if (SEG == 0) {
            const bool isq = cg < 512; const int head = (cg & 511) >> 6, j = (cg & 63) >> 3;
            bf16_t* dst = (bf16_t*)(ws + (isq ? O_QB : O_KB)) + ((size_t)(b * 8 + head) * 2048 + t) * 64 + 8 * j;
            *(uint4*)dst = rot8(v0, v1, (const float*)(ws + O_CS64) + ((size_t)row * 32 + 4 * j) * 2, isq ? 0.125f * 1.4426950408889634f : 1.f);
        } else if (SEG == 1) {
            bf16_t* dst = (bf16_t*)(ws + O_VT) + ((size_t)(b * 8 + ((cg - 1024) >> 6)) * 64 + (cg & 63)) * 2048 + t;
#pragma unroll
            for (int e = 0; e < 4; ++e) { dst[(size_t)e * 2048] = f2bf(v0[e]); dst[(size_t)(e + 4) * 2048] = f2bf(v1[e]); }
        } else if (SEG == 2) {
            const int j = (cg & 31) >> 3;
            *(uint4*)((bf16_t*)(ws + O_IQB) + ((size_t)row * 8 + ((cg - 1536) >> 5)) * 32 + 8 * j) = rot8(v0, v1, (const float*)(ws + O_CS32) + ((size_t)row * 16 + 4 * j) * 2, 0.17677669529663687f);
        } else if (SEG == 3) {
            if (cg < 1824) {
                const int j = (cg & 31) >> 3;
                *(uint4*)((bf16_t*)(ws + O_IKB) + (size_t)row * 32 + 8 * j) = rot8(v0, v1, (const float*)(ws + O_CS32) + ((size_t)row * 16 + 4 * j) * 2, 1.f);
            } else if (cg == 1824) {
                const float k8 = 0.35355339059327373f; float* d = (float*)(ws + O_IWF) + (size_t)row * 8;
                *(float4*)d = make_float4(v0[0] * k8, v0[1] * k8, v0[2] * k8, v0[3] * k8); *(float4*)(d + 4) = make_float4(v1[0] * k8, v1[1] * k8, v1[2] * k8, v1[3] * k8);
            } else if (cg == 1832) {
                float o[8];
#pragma unroll
                for (int e = 0; e < 4; ++e) { const float a0 = v0[e] + dt_bias[e], a1 = v1[e] + dt_bias[4 + e]; o[e] = (a0 > 20.f) ? a0 : __logf(1.f + __expf(a0)); o[4 + e] = (a1 > 20.f) ? a1 : __logf(1.f + __expf(a1)); }
                float* d = (float*)(ws + O_DTF) + (size_t)row * 8;
                *(float4*)d = make_float4(o[0], o[1], o[2], o[3]); *(float4*)(d + 4) = make_float4(o[4], o[5], o[6], o[7]);
            }
        } else if (SEG == 4) {
            *(uint4*)((bf16_t*)(ws + O_ZB) + (size_t)row * 512 + (cg - ZOFF)) = make_uint4(pack2(v0[0], v0[1]), pack2(v0[2], v0[3]), pack2(v1[0], v1[1]), pack2(v1[2], v1[3]));
        } else {
            bf16_t* dst = (bf16_t*)(ws + O_XBCT) + ((size_t)b * 1024 + (cg - XBCOFF)) * 2048 + t;
#pragma unroll
            for (int e = 0; e < 4; ++e) { dst[(size_t)e * 2048] = f2bf(v0[e]); dst[(size_t)(e + 4) * 2048] = f2bf(v1[e]); }
        }
    }
    template <int SEG, int BJ> __device__ __forceinline__ void rows8(const pg8::f32x4 (&acc)[2][2][4][2], const int cg, const int row0) const {
#pragma unroll
        for (int ai = 0; ai < 2; ++ai)
#pragma unroll
            for (int m = 0; m < 4; ++m) store_row<SEG>(acc[ai][BJ][m][0], acc[ai][BJ][m][1], cg, row0 + ai * 128 + m * 16);
    }
    template <int BJ> __device__ __forceinline__ void half(const pg8::f32x4 (&acc)[2][2][4][2], const pg8::Unit& u, int wr, int wc, int fr, int fq) const {
        const int cw = u.pn * 256 + BJ * 128 + wc * 32;
        const int cg = cw + 8 * fq, row0 = u.pm * 256 + wr * 64 + fr;
        if (cw < 1024) rows8<0, BJ>(acc, cg, row0);
        else if (cw < 1536) rows8<1, BJ>(acc, cg, row0);
        else if (cw < 1792) rows8<2, BJ>(acc, cg, row0);
        else if (cw < 1856) rows8<3, BJ>(acc, cg, row0);
        else if (cw < 2368) rows8<4, BJ>(acc, cg, row0);
        else if (cw < NUSED) rows8<5, BJ>(acc, cg, row0);
    }
    __device__ __forceinline__ void operator()(const pg8::f32x4 (&acc)[2][2][4][2], const pg8::Unit& u, int wr, int wc, int fr, int fq) const {
        half<0>(acc, u, wr, wc, fr, fq); half<1>(acc, u, wr, wc, fr, fq);
    }
};
#ifndef V_EARLY
#define V_EARLY 8192
#endif
template <bool DO_U> __device__ __forceinline__ void convert_rows(const Params& p, size_t i_begin, size_t i_end, int wg, int nwg) {
    unsigned* u8 = (unsigned*)(p.ws + O_U8); unsigned* v8 = (unsigned*)(p.ws + O_V8);
    const size_t gsz = (size_t)nwg * 512;
    for (size_t i0 = i_begin + (size_t)wg * 512 + tid_op(); i0 < i_end; i0 += 8 * gsz) {
        float4 fv[8];
#pragma unroll
        for (int k = 0; k < 8; ++k) { const size_t i = i0 + k * gsz; const size_t ic = i < i_end ? i : i0; fv[k] = ((const float4*)p.v)[ic]; }
#pragma unroll
        for (int k = 0; k < 8; ++k) {
            const size_t i = i0 + k * gsz;
            if (i < i_end) {
                int pv = __builtin_amdgcn_cvt_pk_fp8_f32(fv[k].x, fv[k].y, 0, false); pv = __builtin_amdgcn_cvt_pk_fp8_f32(fv[k].z, fv[k].w, pv, true);
                const size_t e = i >> 8, c4 = i & 255;
                v8[((c4 >> 5) * 16384 + e) * 32 + (c4 & 31)] = (unsigned)pv;
            }
        }
    }
    if (DO_U) {
        for (size_t i0 = (size_t)wg * 512 + tid_op(); i0 < (size_t)16384 * 256; i0 += 8 * gsz) {
            float4 fu[8];
#pragma unroll
            for (int k = 0; k < 8; ++k) { const size_t i = i0 + k * gsz; const size_t ic = i < (size_t)16384 * 256 ? i : i0; fu[k] = ((const float4*)p.u)[ic]; }
#pragma unroll
            for (int k = 0; k < 8; ++k) {
                const size_t i = i0 + k * gsz;
                if (i < (size_t)16384 * 256) {
                    int pk = __builtin_amdgcn_cvt_pk_fp8_f32(fu[k].x * 32.f, fu[k].y * 32.f, 0, false); pk = __builtin_amdgcn_cvt_pk_fp8_f32(fu[k].z * 32.f, fu[k].w * 32.f, pk, true);
                    u8[i] = (unsigned)pk;
                }
            }
        }
    }
}
__device__ __forceinline__ void phase1(const Params& p, char* smem, const XcdMap xm) {
    char* ws = p.ws;
    ProjEpi8 e; e.ws = ws; e.dt_bias = p.dt_bias;
    pg8::Gemm g{(const bf16_t*)(ws + O_XB), (const bf16_t*)(ws + O_WIN_T), NTOK, NP, 1024};
    pg8::StaticOrder S; S.init(NTOK, NP, (int)gridDim.x, (int)blockIdx.x);
    pg8::gemm_phase<ProjEpi8, pg8::StaticOrder, false>((PG8_LAS unsigned char*)smem, g, S, e, nullptr);
    const int G = (int)gridDim.x, first = (64 * (NP / 256)) % G;
    if ((int)blockIdx.x >= first) convert_rows<true>(p, 0, (size_t)V_EARLY * 256, (int)blockIdx.x - first, G - first);
}

#define IDX_NT 16
#define IDX_LDS_SCORES (16 * 2048 * 4)
__device__ __forceinline__ unsigned wave_sum_cnt(unsigned v) {
    v = row_sum_u(v);
    v += (unsigned)dpp_i<0x142, 0xA, false>((int)v);
    v += (unsigned)dpp_i<0x143, 0xC, false>((int)v);
    return (unsigned)__builtin_amdgcn_readlane((int)v, 63);
}
template <int NR> __device__ __forceinline__ unsigned idx_count_ge(const unsigned (&k)[NR], unsigned cand) {
    unsigned n = 0u;
#pragma unroll
    for (int i = 0; i < NR; ++i) n += (k[i] >= cand) ? 1u : 0u;
    return wave_sum_cnt(n);
}
template <int NR> __device__ __forceinline__ unsigned long long idx_words(const unsigned (&k)[NR], unsigned K, bool exact, int lane) {
    unsigned long long wd = 0ull;
    if (exact) {
#pragma unroll
        for (int i = 0; i < NR; ++i) { const unsigned long long bal = __ballot(k[i] >= K); if (lane == i) wd = bal; }
    } else {
        unsigned n = 0u;
#pragma unroll
        for (int i = 0; i < NR; ++i) n += (k[i] > K) ? 1u : 0u;
        unsigned rem = 256u - wave_sum_cnt(n);
#pragma unroll 1
        for (int i = 0; i < NR; ++i) {
            unsigned ki = k[0];
#pragma unroll
            for (int j = 1; j < NR; ++j) ki = (j == i) ? k[j] : ki;
            const unsigned long long gt = __ballot(ki > K), eq = __ballot(ki == K);
            unsigned long long take = 0ull, e = eq;
            while (rem > 0u && e) { take |= e & (~e + 1ull); e &= e - 1ull; --rem; }
            if (lane == i) wd = gt | take;
        }
    }
    return wd;
}
template <int NR> __device__ __forceinline__ void idx_select(const unsigned* Sa, unsigned long long* mrow, int lane) {
    unsigned ka[NR], kb[NR];
#pragma unroll
    for (int i = 0; i < NR; ++i) { ka[i] = Sa[64 * i]; kb[i] = Sa[2048 + 64 * i]; }
    unsigned Ka = 0u, Kb = 0u; bool da = false, db = false;
    for (int bit = 31; bit >= 0; --bit) {
        const unsigned ca = Ka | (1u << bit), cb = Kb | (1u << bit);
        const unsigned ta = idx_count_ge<NR>(ka, ca), tb = idx_count_ge<NR>(kb, cb);
        if (!da && ta >= 256u) { Ka = ca; da = (ta == 256u); }
        if (!db && tb >= 256u) { Kb = cb; db = (tb == 256u); }
        if (da && db) break;
    }
    const unsigned long long wa = idx_words<NR>(ka, Ka, da, lane), wb = idx_words<NR>(kb, Kb, db, lane);
    if (lane < NR) { mrow[lane] = wa; mrow[32 + lane] = wb; }
}
__device__ __forceinline__ void indexer_unit(const Params& p, int unit, char* smem) {
    const int tid = tid_op(), lane = tid & 63, w = tid >> 6, c = lane & 15, g = lane >> 4;
    const int b = unit & 7, grp = 127 - (unit >> 3), t0 = grp * 16;
    char* ws = p.ws;
    unsigned long long* mask64 = (unsigned long long*)(ws + O_MASK) + (size_t)(b * 2048 + t0) * 32;
    const int nblk64 = (t0 + 16 + 63) >> 6;
    if (t0 < 256) {
        for (int i = tid; i < 16 * nblk64; i += 512) {
            const int q = i / nblk64, wd = i % nblk64, t = t0 + q, s0 = wd * 64;
            const unsigned long long bits = (t >= s0 + 63) ? ~0ull : (t < s0 ? 0ull : ((1ull << (t - s0 + 1)) - 1ull));
            mask64[q * 32 + wd] = bits;
        }
        return;
    }
    const int ntile = (nblk64 + 1) >> 1;
    const bf16_t* IQb = (const bf16_t*)(ws + O_IQB); const bf16_t* IKb = (const bf16_t*)(ws + O_IKB); const float* IWf = (const float*)(ws + O_IWF);
    unsigned* S = (unsigned*)smem;
    float* siw = (float*)(smem + IDX_LDS_SCORES);
    __syncthreads();
    if (tid < 128) siw[tid] = IWf[(size_t)(b * 2048 + t0) * 8 + tid];
    {
        const int nr = (nblk64 <= 8) ? 8 : (nblk64 <= 16) ? 16 : (nblk64 <= 24) ? 24 : 32, kfrom = 8 * ntile * 16, kto = nr * 64;
        for (int i = tid; i < 16 * (kto - kfrom); i += 512) { const int q = i / (kto - kfrom), k = kfrom + i % (kto - kfrom); S[q * 2048 + k] = 0u; }
    }
    __syncthreads();
    {
        bf16x8 aq[8];
#pragma unroll
        for (int h = 0; h < 8; ++h) aq[h] = ld8(IQb + ((size_t)(b * 2048 + t0 + c) * 8 + h) * 32 + g * 8);
        float wq[4][8];
#pragma unroll
        for (int r = 0; r < 4; ++r)
#pragma unroll
            for (int h = 0; h < 8; ++h) wq[r][h] = siw[(4 * g + r) * 8 + h];
        bf16x8 bk[IDX_NT];
#pragma unroll
        for (int i = 0; i < IDX_NT; ++i) {
            const int ti = (i < ntile) ? (w * ntile + i) : (w * ntile);
            bk[i] = ld8(IKb + (size_t)(b * 2048 + ti * 16 + c) * 32 + g * 8);
        }
#pragma unroll
        for (int i = 0; i < IDX_NT; ++i) {
            if (i < ntile) {
                const int s0 = (w * ntile + i) * 16;
                float sc[4] = {0.f, 0.f, 0.f, 0.f};
#pragma unroll
                for (int h = 0; h < 8; ++h) {
                    const f32x4 o = mfma16(aq[h], bk[i], (f32x4){0.f, 0.f, 0.f, 0.f});
#pragma unroll
                    for (int r = 0; r < 4; ++r) sc[r] += wq[r][h] * fmaxf(o[r], 0.f);
                }
#pragma unroll
                for (int r = 0; r < 4; ++r) S[(4 * g + r) * 2048 + s0 + c] = (s0 + c <= t0 + 4 * g + r) ? f2sort(sc[r]) : 0u;
            }
        }
    }
    __syncthreads();
    if (nblk64 <= 8) idx_select<8>(S + (2 * w) * 2048 + lane, mask64 + (2 * w) * 32, lane);
    else if (nblk64 <= 16) idx_select<16>(S + (2 * w) * 2048 + lane, mask64 + (2 * w) * 32, lane);
    else if (nblk64 <= 24) idx_select<24>(S + (2 * w) * 2048 + lane, mask64 + (2 * w) * 32, lane);
    else idx_select<32>(S + (2 * w) * 2048 + lane, mask64 + (2 * w) * 32, lane);
}

__device__ __forceinline__ void ssd_prep_unit(const Params& p, int unit, char* smem) {
    const int tid = tid_op(), lane = tid & 63, w = tid >> 6, cL = lane & 15, gq = lane >> 4;
    const int h = unit & 7, c = (unit >> 3) & 15, b = unit >> 7, g = h >> 2;
    char* ws = p.ws;
    float* s_acum = (float*)smem; float* s_dt = s_acum + 128; float* s_w = s_dt + 128;
    bf16_t* sXw = (bf16_t*)(smem + 2048); bf16_t* sBt = sXw + 64 * 136;
    const int tok0 = b * 2048 + c * 128;
    const float a_h = -expf(p.a_log[h]);
    const float* DTf = (const float*)(ws + O_DTF);
    __syncthreads();
    if (tid < 128) s_dt[tid] = DTf[(size_t)(tok0 + tid) * 8 + h];
    __syncthreads();
    if (tid < 128) {
        float s = 0.f;
        for (int k = 0; k <= tid; ++k) s += s_dt[k] * a_h;
        s_acum[tid] = s;
        ((float*)(ws + O_ACUM))[(size_t)(b * 8 + h) * 2048 + c * 128 + tid] = s;
    }
    __syncthreads();
    if (tid < 128) {
        const float tot = s_acum[127];
        s_w[tid] = s_dt[tid] * __expf(tot - s_acum[tid]);
        if (tid == 0) ((float*)(ws + O_ATOT))[(b * 8 + h) * 16 + c] = tot;
    }
    __syncthreads();
    const bf16_t* XBCt = (const bf16_t*)(ws + O_XBCT);
    bf16_t* Xt = (bf16_t*)(ws + O_XT); bf16_t* Brm = (bf16_t*)(ws + O_BRM); bf16_t* Crm = (bf16_t*)(ws + O_CRM);
#pragma unroll
    for (int bt = 0; bt < 2; ++bt) {
    const int it0 = bt * 4, itn = bt ? 3 : 4;
    u32x4g cur7[4], prv7[4]; float cw7[4][5];
#pragma unroll
    for (int it = 0; it < 4; ++it) if (it < itn) {
        const int item = tid + 512 * (it0 + it);
        int ch; const int tc = item & 15;
        if (item < 1024) ch = h * 64 + (item >> 4);
        else if (item < 3072) ch = 512 + g * 128 + ((item - 1024) >> 4);
        else ch = 768 + g * 128 + (h & 3) * 32 + ((item - 3072) >> 4);
        const bf16_t* src = XBCt + ((size_t)b * 1024 + ch) * 2048 + c * 128 + tc * 8;
        cur7[it] = *(const u32x4g*)src;
        const bool hasprev = (c * 128 + tc * 8 >= 8);
        prv7[it] = *(const u32x4g*)(hasprev ? src - 8 : src);
        if (!hasprev) prv7[it] = (u32x4g){0u, 0u, 0u, 0u};
        cw7[it][0] = p.conv_w[ch]; cw7[it][1] = p.conv_w[1024 + ch]; cw7[it][2] = p.conv_w[2048 + ch]; cw7[it][3] = p.conv_w[3072 + ch]; cw7[it][4] = p.conv_b[ch];
    }
#pragma unroll
    for (int it = 0; it < 4; ++it) if (it < itn) {
        const int item = tid + 512 * (it0 + it);
        int kind, idx, ch; const int tc = item & 15;
        if (item < 1024) { kind = 0; idx = item >> 4; ch = h * 64 + idx; }
        else if (item < 3072) { kind = 1; idx = (item - 1024) >> 4; ch = 512 + g * 128 + idx; }
        else { kind = 2; idx = (h & 3) * 32 + ((item - 3072) >> 4); ch = 768 + g * 128 + idx; }
        const u32x4g cur = cur7[it], prv = prv7[it];
        float xv[11];
        xv[0] = bf2f((bf16_t)(prv.z >> 16)); xv[1] = bf2f((bf16_t)(prv.w & 0xFFFF)); xv[2] = bf2f((bf16_t)(prv.w >> 16));
        xv[3] = bf2f((bf16_t)(cur.x & 0xFFFF)); xv[4] = bf2f((bf16_t)(cur.x >> 16)); xv[5] = bf2f((bf16_t)(cur.y & 0xFFFF)); xv[6] = bf2f((bf16_t)(cur.y >> 16));
        xv[7] = bf2f((bf16_t)(cur.z & 0xFFFF)); xv[8] = bf2f((bf16_t)(cur.z >> 16)); xv[9] = bf2f((bf16_t)(cur.w & 0xFFFF)); xv[10] = bf2f((bf16_t)(cur.w >> 16));
        const float w0 = cw7[it][0], w1 = cw7[it][1], w2 = cw7[it][2], w3 = cw7[it][3], bias = cw7[it][4];
        float o[8];
#pragma unroll
        for (int j = 0; j < 8; ++j) { const float v = bias + w0 * xv[j] + w1 * xv[j + 1] + w2 * xv[j + 2] + w3 * xv[j + 3]; o[j] = bf2f(f2bf(silu_f(v))); }
        if (kind == 0) {
            *(uint4*)(Xt + ((size_t)b * 512 + ch) * 2048 + c * 128 + tc * 8) = make_uint4(pack2(o[0], o[1]), pack2(o[2], o[3]), pack2(o[4], o[5]), pack2(o[6], o[7]));
            float q[8];
#pragma unroll
            for (int j = 0; j < 8; ++j) q[j] = o[j] * s_w[tc * 8 + j];
            *(uint4*)(sXw + idx * 136 + tc * 8) = make_uint4(pack2(q[0], q[1]), pack2(q[2], q[3]), pack2(q[4], q[5]), pack2(q[6], q[7]));
        } else if (kind == 1) {
            *(uint4*)(sBt + idx * 136 + tc * 8) = make_uint4(pack2(o[0], o[1]), pack2(o[2], o[3]), pack2(o[4], o[5]), pack2(o[6], o[7]));
            if ((h & 3) == 0) {
#pragma unroll
                for (int j = 0; j < 8; ++j) Brm[(size_t)(tok0 + tc * 8 + j) * 256 + g * 128 + idx] = f2bf(o[j]);
            }
        } else {
#pragma unroll
            for (int j = 0; j < 8; ++j) Crm[(size_t)(tok0 + tc * 8 + j) * 256 + g * 128 + idx] = f2bf(o[j]);
        }
    }
    }
    __syncthreads();
    f32x4 acc[4];
#pragma unroll
    for (int i = 0; i < 4; ++i) acc[i] = (f32x4){0.f, 0.f, 0.f, 0.f};
#pragma unroll
    for (int ks = 0; ks < 4; ++ks) {
        const bf16x8 bb = ld8(sBt + (16 * w + cL) * 136 + ks * 32 + gq * 8);
#pragma unroll
        for (int pt = 0; pt < 4; ++pt) acc[pt] = mfma16(ld8(sXw + (16 * pt + cL) * 136 + ks * 32 + gq * 8), bb, acc[pt]);
    }
    float* ST = (float*)(ws + O_ST) + ((size_t)((b * 16 + c) * 8 + h)) * 8192;
#pragma unroll
    for (int pt = 0; pt < 4; ++pt)
#pragma unroll
        for (int r = 0; r < 4; ++r) ST[(16 * pt + 4 * gq + r) * 128 + 16 * w + cL] = acc[pt][r];
}

__device__ __forceinline__ void phase2c(const Params& p) {
    char* ws = p.ws;
    const int idx = blockIdx.x * 512 + tid_op();
    if (idx >= 64 * 2048) return;
    const int bh = idx >> 11, e4 = idx & 2047, b = bh >> 3, h = bh & 7;
    const float* ST = (const float*)(ws + O_ST); const float* ATOT = (const float*)(ws + O_ATOT);
    float4 sv[16]; float4 at4[4];
#pragma unroll
    for (int c = 0; c < 16; ++c) sv[c] = *(const float4*)(ST + ((size_t)((b * 16 + c) * 8 + h)) * 8192 + (size_t)e4 * 4);
#pragma unroll
    for (int k = 0; k < 4; ++k) at4[k] = *(const float4*)(ATOT + bh * 16 + 4 * k);
    const float at[16] = {at4[0].x, at4[0].y, at4[0].z, at4[0].w, at4[1].x, at4[1].y, at4[1].z, at4[1].w, at4[2].x, at4[2].y, at4[2].z, at4[2].w, at4[3].x, at4[3].y, at4[3].z, at4[3].w};
    float4 car = make_float4(0.f, 0.f, 0.f, 0.f);
    bf16_t* CAR = (bf16_t*)(ws + O_CAR);
#pragma unroll
    for (int c = 0; c < 16; ++c) {
        *(uint2*)(CAR + ((size_t)((b * 16 + c) * 8 + h)) * 8192 + (size_t)e4 * 4) = make_uint2(pack2(car.x, car.y), pack2(car.z, car.w));
        const float dec = __expf(at[c]);
        car.x = dec * car.x + sv[c].x; car.y = dec * car.y + sv[c].y; car.z = dec * car.z + sv[c].z; car.w = dec * car.w + sv[c].w;
    }
}

#define ATT_LDK 80
#define ATT_LDV 136
#define ATT_KBYTES (128 * ATT_LDK * 2)
#define ATT_VBYTES (64 * ATT_LDV * 2)
__device__ __forceinline__ void attn_unit(const Params& p, int unit, char* smem) {
    const int tid = tid_op(), lane = tid & 63, w = tid >> 6, cL = lane & 15, gq = lane >> 4;
    const int qb = 15 - (unit >> 6), bh = unit & 63, b = bh >> 3, h = bh & 7;
    char* ws = p.ws;
    const int q0 = qb * 128 + 16 * w;
    const int ntile = qb + 1;
    const int wmax = (q0 + 15) >> 6;
    const bf16_t* Q = (const bf16_t*)(ws + O_QB) + (size_t)bh * 2048 * 64;
    const bf16_t* Kp = (const bf16_t*)(ws + O_KB) + (size_t)bh * 2048 * 64;
    const bf16_t* V = (const bf16_t*)(ws + O_VT) + (size_t)bh * 64 * 2048;
    const unsigned long long* mrow = (const unsigned long long*)(ws + O_MASK) + (size_t)(b * 2048 + q0 + cL) * 32;
    const int lr = tid >> 3, lc = (tid & 7) * 8;
    bf16x8 qf[2];
    qf[0] = ld8(Q + (size_t)(q0 + cL) * 64 + gq * 8); qf[1] = ld8(Q + (size_t)(q0 + cL) * 64 + 32 + gq * 8);
    float m_run = -1e30f, l_run = 0.f;
    f32x4 o[4];
#pragma unroll
    for (int i = 0; i < 4; ++i) o[i] = (f32x4){0.f, 0.f, 0.f, 0.f};
    char* sK = smem; char* sV = smem + 2 * ATT_KBYTES;
#define ATT_GLOAD(T, K0, K1, V0, V1) { const int s_ = (T) * 128; \
        K0 = *(const u32x4g*)(Kp + (size_t)(s_ + lr) * 64 + lc); K1 = *(const u32x4g*)(Kp + (size_t)(s_ + 64 + lr) * 64 + lc); \
        V0 = *(const u32x4g*)(V + (size_t)lr * 2048 + s_ + lc); V1 = *(const u32x4g*)(V + (size_t)lr * 2048 + s_ + 64 + lc); }
#define ATT_LSTORE(BUF, K0, K1, V0, V1) { bf16_t* k_ = (bf16_t*)(sK + (BUF) * ATT_KBYTES); bf16_t* v_ = (bf16_t*)(sV + (BUF) * ATT_VBYTES); \
        *(u32x4g*)(k_ + lr * ATT_LDK + lc) = K0; *(u32x4g*)(k_ + (64 + lr) * ATT_LDK + lc) = K1; \
        *(u32x4g*)(v_ + lr * ATT_LDV + lc) = V0; *(u32x4g*)(v_ + lr * ATT_LDV + 64 + lc) = V1; }
    u32x4g ka0, ka1, va0, va1, kb0, kb1, vb0, vb1;
    ATT_GLOAD(0, ka0, ka1, va0, va1)
    { const int t1 = (ntile > 1) ? 1 : 0; ATT_GLOAD(t1, kb0, kb1, vb0, vb1) }
    unsigned long long nmb0 = mrow[0], nmb1 = mrow[1];
    __syncthreads();
    ATT_LSTORE(0, ka0, ka1, va0, va1)
    __syncthreads();
    for (int kt = 0; kt < ntile; ++kt) {
        const int cur = kt & 1;
        ka0 = kb0; ka1 = kb1; va0 = vb0; va1 = vb1;
        { const int t2 = (kt + 2 < ntile) ? kt + 2 : ntile - 1; ATT_GLOAD(t2, kb0, kb1, vb0, vb1) }
        {
            const bf16_t* tK = (const bf16_t*)(sK + cur * ATT_KBYTES); const bf16_t* tV = (const bf16_t*)(sV + cur * ATT_VBYTES);
            const unsigned long long mb0 = (2 * kt <= wmax) ? nmb0 : 0ull, mb1 = (2 * kt + 1 <= wmax) ? nmb1 : 0ull;
            { const int tn = (kt + 1 < ntile) ? kt + 1 : kt; nmb0 = mrow[2 * tn]; nmb1 = mrow[2 * tn + 1]; }
            f32x4 st[8];
#pragma unroll
            for (int j = 0; j < 8; ++j) {
                f32x4 a = (f32x4){0.f, 0.f, 0.f, 0.f};
                const bf16_t* kr = tK + (16 * j + cL) * ATT_LDK + gq * 8;
                a = mfma16(ld8(kr), qf[0], a); a = mfma16(ld8(kr + 32), qf[1], a);
                st[j] = a;
            }
            float mx = m_run;
            const unsigned mw[4] = {(unsigned)mb0 >> (4 * gq), (unsigned)(mb0 >> 32) >> (4 * gq), (unsigned)mb1 >> (4 * gq), (unsigned)(mb1 >> 32) >> (4 * gq)};
#pragma unroll
            for (int j = 0; j < 8; ++j)
#pragma unroll
                for (int r = 0; r < 4; ++r) {
                    const bool bit = (mw[j >> 1] & (1u << (16 * (j & 1) + r))) != 0u;
                    const float v = bit ? st[j][r] : -INFINITY;
                    st[j][r] = v; mx = fmaxf(mx, v);
                }
            mx = max_x32(max_x16(mx));
            const float alpha = __builtin_amdgcn_exp2f(m_run - mx); m_run = mx;
            float ls = 0.f;
#pragma unroll
            for (int j = 0; j < 8; ++j)
#pragma unroll
                for (int r = 0; r < 4; ++r) { const float pv = __builtin_amdgcn_exp2f(st[j][r] - mx); st[j][r] = pv; ls += pv; }
            ls = sum_x32(sum_x16(ls));
            l_run = l_run * alpha + ls;
#pragma unroll
            for (int i = 0; i < 4; ++i) o[i] = o[i] * alpha;
#pragma unroll
            for (int kk = 0; kk < 4; ++kk) {
                bf16x8 pf;
#pragma unroll
                for (int r = 0; r < 4; ++r) { pf[r] = (short)f2bf(st[2 * kk][r]); pf[4 + r] = (short)f2bf(st[2 * kk + 1][r]); }
#pragma unroll
                for (int dt = 0; dt < 4; ++dt) {
                    const bf16_t* vr = tV + (16 * dt + cL) * ATT_LDV + 32 * kk + 4 * gq;
                    o[dt] = mfma16(cat4(*(const bf16x4*)vr, *(const bf16x4*)(vr + 16)), pf, o[dt]);
                }
            }
        }
        if (kt + 1 < ntile) ATT_LSTORE(cur ^ 1, ka0, ka1, va0, va1)
        __syncthreads();
    }
#undef ATT_GLOAD
#undef ATT_LSTORE
    const float inv = 1.f / l_run;
    bf16_t* mix = (bf16_t*)(ws + O_MIX) + (size_t)(b * 2048 + q0 + cL) * 1024 + h * 64;
#pragma unroll
    for (int dt = 0; dt < 4; ++dt)
        *(uint2*)(mix + 16 * dt + 4 * gq) = make_uint2(pack2(o[dt][0] * inv, o[dt][1] * inv), pack2(o[dt][2] * inv, o[dt][3] * inv));
}

#define SSD_CAR_BYTES (4 * 64 * 136 * 2)
__device__ __forceinline__ void ssd_main_unit(const Params& p, int unit, char* smem) {
    const int tid = tid_op(), lane = tid & 63, w = tid >> 6, cL = lane & 15, gq = lane >> 4;
    const int g = unit & 1, c = (unit >> 1) & 15, b = unit >> 5;
    char* ws = p.ws;
    float* sAc = (float*)smem;
    float* sDt = sAc + 512;
    const int tok0 = b * 2048 + c * 128;
    const float* ATOT = (const float*)(ws + O_ATOT); const float* ACUM = (const float*)(ws + O_ACUM); const float* DTf = (const float*)(ws + O_DTF);
    const bf16_t* Xt = (const bf16_t*)(ws + O_XT); const bf16_t* Brm = (const bf16_t*)(ws + O_BRM); const bf16_t* Crm = (const bf16_t*)(ws + O_CRM);
    const bf16_t* Zb = (const bf16_t*)(ws + O_ZB);
    __syncthreads();
    {
        const int hh = tid >> 7, l = tid & 127;
        sAc[tid] = ACUM[(size_t)(b * 8 + 4 * g + hh) * 2048 + c * 128 + l];
        sDt[tid] = DTf[(size_t)(tok0 + l) * 8 + 4 * g + hh];
    }
    __syncthreads();
    bf16_t* mix = (bf16_t*)(ws + O_MIX);
    const int lt = w;
    const int ltok = tok0 + 16 * lt + cL;
    bf16x8 Cq[4];
#pragma unroll
    for (int ks = 0; ks < 4; ++ks) Cq[ks] = ld8(Crm + (size_t)ltok * 256 + g * 128 + ks * 32 + gq * 8);
    f32x4 cbT[8];
#pragma unroll
    for (int st = 0; st < 8; ++st) {
        cbT[st] = (f32x4){0.f, 0.f, 0.f, 0.f};
        if (st <= lt) {
            const bf16_t* br = Brm + (size_t)(tok0 + 16 * st + cL) * 256 + g * 128 + gq * 8;
#pragma unroll
            for (int ks = 0; ks < 4; ++ks) cbT[st] = mfma16(ld8(br + ks * 32), Cq[ks], cbT[st]);
        }
    }
    float ssq = 0.f;
#pragma unroll 1
    for (int hh = 0; hh < 4; ++hh) {
        const int h = 4 * g + hh;
        const float* ac = sAc + hh * 128; const float* dtl = sDt + hh * 128;
        const float al = ac[16 * lt + cL];
        const bf16_t* xh = Xt + ((size_t)b * 512 + h * 64) * 2048 + c * 128;
        const bf16_t* zh = Zb + (size_t)tok0 * 512 + h * 64;
        const bf16_t* carh = (const bf16_t*)(ws + O_CAR) + ((size_t)((b * 16 + c) * 8 + h)) * 8192;
        bf16x8 xf[4][4];
#pragma unroll
        for (int kk = 0; kk < 4; ++kk)
#pragma unroll
            for (int pt = 0; pt < 4; ++pt) {
                const int kc = (2 * kk <= lt) ? kk : 0;
                const unsigned xo = (unsigned)((16 * pt + cL) * 2048 + 32 * kc + 4 * gq);
                xf[kk][pt] = cat4(*(const bf16x4*)(xh + xo), *(const bf16x4*)(xh + xo + 16));
            }
        f32x4 acc1[4], acc2[4];
#pragma unroll
        for (int i = 0; i < 4; ++i) { acc1[i] = (f32x4){0.f, 0.f, 0.f, 0.f}; acc2[i] = (f32x4){0.f, 0.f, 0.f, 0.f}; }
#pragma unroll
        for (int kk = 0; kk < 4; ++kk) {
            if (2 * kk <= lt) {
                bf16x8 mf;
#pragma unroll
                for (int half = 0; half < 2; ++half) {
                    const int st = 2 * kk + half;
#pragma unroll
                    for (int r = 0; r < 4; ++r) {
                        const int sl = 16 * st + 4 * gq + r;
                        float v = 0.f;
                        if (st <= lt && sl <= 16 * lt + cL) v = cbT[st][r] * __expf(al - ac[sl]) * dtl[sl];
                        mf[half * 4 + r] = (short)f2bf(v);
                    }
                }
#pragma unroll
                for (int pt = 0; pt < 4; ++pt) acc1[pt] = mfma16(xf[kk][pt], mf, acc1[pt]);
            }
        }
        uint2 zz[4]; bf16_t xsv[4][4];
#pragma unroll
        for (int pt = 0; pt < 4; ++pt) {
            zz[pt] = *(const uint2*)(zh + (unsigned)((16 * lt + cL) * 512 + 16 * pt + 4 * gq));
#pragma unroll
            for (int r = 0; r < 4; ++r) xsv[pt][r] = xh[(unsigned)((16 * pt + 4 * gq + r) * 2048 + 16 * lt + cL)];
        }
#pragma unroll
        for (int ks = 0; ks < 4; ++ks)
#pragma unroll
            for (int pt = 0; pt < 4; ++pt) acc2[pt] = mfma16(ld8(carh + (unsigned)((16 * pt + cL) * 128 + ks * 32 + gq * 8)), Cq[ks], acc2[pt]);
        const float el = __expf(al), dsk = p.d_skip[h];
#pragma unroll
        for (int pt = 0; pt < 4; ++pt) {
            const float zf[4] = {bf2f((bf16_t)(zz[pt].x & 0xFFFF)), bf2f((bf16_t)(zz[pt].x >> 16)), bf2f((bf16_t)(zz[pt].y & 0xFFFF)), bf2f((bf16_t)(zz[pt].y >> 16))};
            float yv[4];
#pragma unroll
            for (int r = 0; r < 4; ++r) {
                float t = acc1[pt][r] + el * acc2[pt][r] + bf2f(xsv[pt][r]) * dsk;
                t *= silu_f(zf[r]);
                yv[r] = t; ssq += t * t;
            }
            *(uint2*)(mix + (size_t)ltok * 1024 + 512 + h * 64 + 16 * pt + 4 * gq) = make_uint2(pack2(yv[0], yv[1]), pack2(yv[2], yv[3]));
        }
    }
    ssq = sum_x32(sum_x16(ssq));
    const float rstd = rsqrtf(ssq * (1.f / 256.f) + LN_EPS);
#pragma unroll
    for (int hh = 0; hh < 4; ++hh)
#pragma unroll
        for (int pt = 0; pt < 4; ++pt) {
            const int ch = (4 * g + hh) * 64 + 16 * pt + 4 * gq;
            const float4 nw = *(const float4*)(p.norm_w + ch);
            const uint2 yy = *(const uint2*)(mix + (size_t)ltok * 1024 + 512 + ch);
            const float y0 = bf2f((bf16_t)(yy.x & 0xFFFF)), y1 = bf2f((bf16_t)(yy.x >> 16)), y2 = bf2f((bf16_t)(yy.y & 0xFFFF)), y3 = bf2f((bf16_t)(yy.y >> 16));
            *(uint2*)(mix + (size_t)ltok * 1024 + 512 + ch) = make_uint2(pack2(y0 * rstd * nw.x, y1 * rstd * nw.y), pack2(y2 * rstd * nw.z, y3 * rstd * nw.w));
        }
}

__device__ __forceinline__ void phase2(const Params& p, char* smem, int which = 3) {
    const int G = gridDim.x;
    for (int k = 0; k * G < 2048; ++k) {
        const int u = k * G + ((k & 1) ? (G - 1 - (int)blockIdx.x) : (int)blockIdx.x);
        if (u >= 2048) continue;
        if (u < 1024) { if (which & 1) indexer_unit(p, u, smem); } else { if (which & 2) ssd_prep_unit(p, u - 1024, smem); }
    }
}
__device__ __forceinline__ void phase3(const Params& p, char* smem, int which = 3) {
    const int G = gridDim.x;
    for (int k = 0; k * G < 1024 + 256; ++k) {
        const int u = k * G + ((k & 1) ? (G - 1 - (int)blockIdx.x) : (int)blockIdx.x);
        if (u >= 1024 + 256) continue;
        if (u < 256) { if (which & 1) ssd_main_unit(p, u, smem); } else { if (which & 2) attn_unit(p, u - 256, smem); }
    }
}

struct OutEpi {
    const float* x; float* y;
    __device__ __forceinline__ void operator()(const f32x4 (&acc)[4][4], int mb, int nb, int lane, char* lds) const {
        const int c = lane & 15, g = lane >> 4;
        float* L = (float*)lds;
#pragma unroll
        for (int half = 0; half < 2; ++half) {
#pragma unroll
            for (int mi2 = 0; mi2 < 2; ++mi2)
#pragma unroll
                for (int r = 0; r < 4; ++r)
#pragma unroll
                    for (int ni = 0; ni < 4; ++ni) L[(16 * mi2 + 4 * g + r) * 68 + 16 * ni + c] = acc[2 * half + mi2][ni][r];
#pragma unroll
            for (int i = 0; i < 8; ++i) {
                const int row = 4 * i + g;
                const float4 a = *(const float4*)(L + row * 68 + 4 * c);
                const size_t o = (size_t)(mb + 32 * half + row) * 1024 + nb + 4 * c;
                const float4 xv = *(const float4*)(x + o);
                *(float4*)(y + o) = make_float4(ALPHA * xv.x + a.x, ALPHA * xv.y + a.y, ALPHA * xv.z + a.z, ALPHA * xv.w + a.w);
            }
        }
    }
};
__device__ __forceinline__ void phase4(const Params& p, char* smem, const XcdMap xm) {
    pg8::Gemm g{(const bf16_t*)(p.ws + O_MIX), (const bf16_t*)(p.ws + O_WOUT_T), NTOK, 1024, 1024};
    pg8::StaticOrder S; S.init(NTOK, 1024, (int)gridDim.x, (int)blockIdx.x);
    pg8::EpiResBf16 E{(bf16_t*)(p.ws + O_HB), p.x, 1024, ALPHA};
    pg8::gemm_phase<pg8::EpiResBf16, pg8::StaticOrder, false>((PG8_LAS unsigned char*)smem, g, S, E, nullptr);
}

__device__ __forceinline__ void phase5(const Params& p) {
    const int lane = tid_op() & 63, w = tid_op() >> 6;
    bf16_t* hb = (bf16_t*)(p.ws + O_HB);
    for (int row = blockIdx.x * 8 + w; row < NTOK; row += gridDim.x * 8) {
        bf16_t* yr = hb + (size_t)row * 1024 + 8 * lane;
        float v[16]; float s = 0.f;
#pragma unroll
        for (int j = 0; j < 2; ++j) {
            const uint4 r = *(const uint4*)(yr + 512 * j);
            const unsigned rw[4] = {r.x, r.y, r.z, r.w};
#pragma unroll
            for (int k = 0; k < 4; ++k) { v[8 * j + 2 * k] = __uint_as_float(rw[k] << 16); v[8 * j + 2 * k + 1] = __uint_as_float(rw[k] & 0xFFFF0000u); }
        }
#pragma unroll
        for (int k = 0; k < 16; ++k) s += v[k];
        const float mean = wave_sum(s) * (1.f / 1024.f);
        float q = 0.f;
#pragma unroll
        for (int k = 0; k < 16; ++k) { const float a = v[k] - mean; q += a * a; }
        const float rstd = rsqrtf(wave_sum(q) * (1.f / 1024.f) + LN_EPS);
#pragma unroll
        for (int j = 0; j < 2; ++j) {
            const int col = 8 * lane + 512 * j;
            const float4 g0 = *(const float4*)(p.ln1_g + col), g1 = *(const float4*)(p.ln1_g + col + 4), b0 = *(const float4*)(p.ln1_b + col), b1 = *(const float4*)(p.ln1_b + col + 4);
            const float gg[8] = {g0.x, g0.y, g0.z, g0.w, g1.x, g1.y, g1.z, g1.w}, bb[8] = {b0.x, b0.y, b0.z, b0.w, b1.x, b1.y, b1.z, b1.w};
            float o[8];
#pragma unroll
            for (int k = 0; k < 8; ++k) o[k] = (v[8 * j + k] - mean) * rstd * gg[k] + bb[k];
            *(uint4*)(yr + 512 * j) = make_uint4(pack2(o[0], o[1]), pack2(o[2], o[3]), pack2(o[4], o[5]), pack2(o[6], o[7]));
        }
    }
    convert_rows<false>(p, (size_t)V_EARLY * 256, (size_t)16384 * 256, (int)blockIdx.x, (int)gridDim.x);
}

struct QpEpi {
    bf16_t* qp;
    __device__ __forceinline__ void operator()(const f32x4 (&acc)[4][4], int mb, int nb, int lane, char* lds) const {
        const int c = lane & 15, g = lane >> 4;
        bf16_t* L = (bf16_t*)lds;
#pragma unroll
        for (int mi = 0; mi < 4; ++mi)
#pragma unroll
            for (int r = 0; r < 4; ++r)
#pragma unroll
                for (int ni = 0; ni < 4; ++ni) L[(16 * mi + 4 * g + r) * 72 + 16 * ni + c] = f2bf(acc[mi][ni][r]);
#pragma unroll
        for (int i = 0; i < 8; ++i) {
            const int row = 8 * i + (lane >> 3), cc = (lane & 7) * 8;
            *(uint4*)(qp + (size_t)(mb + row) * 2048 + nb + cc) = *(const uint4*)(L + row * 72 + cc);
        }
    }
};
__device__ __forceinline__ void phase6(const Params& p, char* smem, const XcdMap xm) {
    pg8::Gemm g{(const bf16_t*)(p.ws + O_HB), (const bf16_t*)(p.ws + O_WQ_T), NTOK, 2048, 1024};
    pg8::StaticOrder S; S.init(NTOK, 2048, (int)gridDim.x, (int)blockIdx.x);
    pg8::EpiBf16Plain E{(bf16_t*)(p.ws + O_QP), 2048};
    pg8::gemm_phase<pg8::EpiBf16Plain, pg8::StaticOrder, false>((PG8_LAS unsigned char*)smem, g, S, E, nullptr);
}

__device__ __forceinline__ float gelu_erf(float d) { return 0.5f * d * (1.f + erff(d * 0.70710678118654752f)); }
typedef unsigned u32x4n __attribute__((ext_vector_type(4)));
__device__ __forceinline__ long lo64n(const u32x4n v) { return (long)(((unsigned long long)v.y << 32) | v.x); }
__device__ __forceinline__ long hi64n(const u32x4n v) { return (long)(((unsigned long long)v.w << 32) | v.z); }
struct P8aRows { u32x4n a[16]; };
__device__ __forceinline__ void p8a_load(P8aRows& R, const unsigned char* U8, int eid, int gq) {
    const unsigned char* urow = U8 + (size_t)eid * 1024 + 16 * gq;
#pragma unroll
    for (int j = 0; j < 16; ++j) R.a[j] = *(const u32x4n*)(urow + 64 * j);
}
__device__ __forceinline__ float p8_dot16(const u32x4n r, const f32x2 (&hp)[8]) {
    f32x2 acc = __builtin_amdgcn_cvt_pk_f32_fp8((int)r.x, false) * hp[0];
    acc += __builtin_amdgcn_cvt_pk_f32_fp8((int)r.x, true) * hp[1];
    acc += __builtin_amdgcn_cvt_pk_f32_fp8((int)r.y, false) * hp[2]; acc += __builtin_amdgcn_cvt_pk_f32_fp8((int)r.y, true) * hp[3];
    acc += __builtin_amdgcn_cvt_pk_f32_fp8((int)r.z, false) * hp[4]; acc += __builtin_amdgcn_cvt_pk_f32_fp8((int)r.z, true) * hp[5];
    acc += __builtin_amdgcn_cvt_pk_f32_fp8((int)r.w, false) * hp[6]; acc += __builtin_amdgcn_cvt_pk_f32_fp8((int)r.w, true) * hp[7];
    return acc.x + acc.y;
}
__device__ __forceinline__ float p8_reduce16(const float (&p)[16], int lane) {
    float q[8], r4[4], t2[2];
#pragma unroll
    for (int k = 0; k < 8; ++k) { const u32x2_t sw = __builtin_amdgcn_permlane32_swap(__float_as_uint(p[k]), __float_as_uint(p[k + 8]), false, false); q[k] = __uint_as_float(sw.x) + __uint_as_float(sw.y); }
#pragma unroll
    for (int k = 0; k < 4; ++k) { const u32x2_t sw = __builtin_amdgcn_permlane16_swap(__float_as_uint(q[k]), __float_as_uint(q[k + 4]), false, false); r4[k] = __uint_as_float(sw.x) + __uint_as_float(sw.y); }
    const bool b3 = (lane & 8) != 0, b2 = (lane & 4) != 0;
#pragma unroll
    for (int k = 0; k < 2; ++k) { const float snd = b3 ? r4[k] : r4[k + 2], keep = b3 ? r4[k + 2] : r4[k]; t2[k] = keep + dpp_f<0x128, 0xF, true>(snd); }
    const float snd = b2 ? t2[0] : t2[1], keep = b2 ? t2[1] : t2[0];
    float z = keep + dpp_f<0x141, 0xF, true>(snd);
    z += dpp_f<0xB1, 0xF, true>(z); z += dpp_f<0x4E, 0xF, true>(z);
    return z;
}
__constant__ unsigned char CAND_I[64] = {0,0,0,0,0,0,0,0,0,0,0,0,0,0,0,0, 1,1,1,1,1,1,1,1, 2,2,2,2,2, 3,3,3,3, 4,4,4, 5,5, 6,6, 7,7, 8,9,10,11,12,13,14,15, 0,0,0,0,0,0,0,0,0,0,0,0,0,0};
__constant__ unsigned char CAND_J[64] = {0,1,2,3,4,5,6,7,8,9,10,11,12,13,14,15, 0,1,2,3,4,5,6,7, 0,1,2,3,4, 0,1,2,3, 0,1,2, 0,1, 0,1, 0,1, 0,0,0,0,0,0,0,0, 0,0,0,0,0,0,0,0,0,0,0,0,0,0};
__device__ __forceinline__ unsigned rowmax_u(unsigned v) { return row_max_u(v); }
struct PeerSel { int ev[4]; float gv[4]; };
__device__ __forceinline__ PeerSel peer_select(const Params& p, int wunit, const char* ktab) {
    const int lane = tid_op() & 63, cL = lane & 15, gq = lane >> 4, rowbase = lane & 48;
    const int tg = wunit >> 3, h = wunit & 7, tok0 = tg * 16;
    char* ws = p.ws;
    const bf16_t* QP = (const bf16_t*)(ws + O_QP);
    unsigned top[2][4];
#pragma unroll
    for (int half = 0; half < 2; ++half) {
        const bf16_t* KB = (const bf16_t*)(ktab + half * (128 * 144 * 2));
        bf16x8 a[4];
#pragma unroll
        for (int ks = 0; ks < 4; ++ks) a[ks] = ld8(QP + (size_t)(tok0 + cL) * 2048 + h * 256 + half * 128 + ks * 32 + gq * 8);
        unsigned pk[8][4];
#pragma unroll
        for (int nt = 0; nt < 8; ++nt) {
            f32x4 acc = (f32x4){0.f, 0.f, 0.f, 0.f};
#pragma unroll
            for (int ks = 0; ks < 4; ++ks) acc = mfma16(a[ks], ld8(KB + (16 * nt + cL) * 144 + ks * 32 + gq * 8), acc);
#pragma unroll
            for (int r = 0; r < 4; ++r) pk[nt][r] = (f2sort(acc[r]) & ~0x7Fu) | (unsigned)(127 - (16 * nt + cL));
        }
#pragma unroll
        for (int r = 0; r < 4; ++r) top[half][r] = 0u;
#define PS_CAS(A, B) { const unsigned hi_ = max(pk[A][r], pk[B][r]), lo_ = min(pk[A][r], pk[B][r]); pk[A][r] = hi_; pk[B][r] = lo_; }
#pragma unroll
        for (int r = 0; r < 4; ++r) {
            PS_CAS(0, 1) PS_CAS(2, 3) PS_CAS(4, 5) PS_CAS(6, 7)
            PS_CAS(0, 2) PS_CAS(1, 3) PS_CAS(4, 6) PS_CAS(5, 7)
            PS_CAS(1, 2) PS_CAS(5, 6)
            PS_CAS(0, 4) PS_CAS(1, 5) PS_CAS(2, 6) PS_CAS(3, 7)
            PS_CAS(2, 4) PS_CAS(3, 5)
            PS_CAS(1, 2) PS_CAS(3, 4) PS_CAS(5, 6)
        }
#undef PS_CAS
        for (int it = 0; it < 16; ++it) {
#pragma unroll
            for (int r = 0; r < 4; ++r) {
                const unsigned gm = rowmax_u(pk[0][r]);
                if (cL == it) top[half][r] = gm;
                const bool pop = (pk[0][r] == gm);
#pragma unroll
                for (int nt = 0; nt < 7; ++nt) pk[nt][r] = pop ? pk[nt + 1][r] : pk[nt][r];
                pk[7][r] = pop ? 0u : pk[7][r];
            }
        }
    }
    unsigned ck[4][4];
#pragma unroll
    for (int s = 0; s < 4; ++s) {
        const int q = s * 16 + cL; const int ci = CAND_I[q], cj = CAND_J[q];
#pragma unroll
        for (int r = 0; r < 4; ++r) {
            const unsigned t1 = (unsigned)__shfl((int)top[0][r], rowbase + ci), t2 = (unsigned)__shfl((int)top[1][r], rowbase + cj);
            const float f = sort2f(t1 & ~0x7Fu) + sort2f(t2 & ~0x7Fu);
            ck[s][r] = (q < 50) ? ((f2sort(f) & ~0x3Fu) | (unsigned)(63 - q)) : 0u;
        }
    }
    unsigned best[4] = {0u, 0u, 0u, 0u};
#define PS_CAS(A, B) { const unsigned hi_ = max(ck[A][r], ck[B][r]), lo_ = min(ck[A][r], ck[B][r]); ck[A][r] = hi_; ck[B][r] = lo_; }
#pragma unroll
    for (int r = 0; r < 4; ++r) { PS_CAS(0, 1) PS_CAS(2, 3) PS_CAS(0, 2) PS_CAS(1, 3) PS_CAS(1, 2) }
#undef PS_CAS
    for (int it = 0; it < 16; ++it) {
#pragma unroll
        for (int r = 0; r < 4; ++r) {
            const unsigned gm = rowmax_u(ck[0][r]);
            if (cL == it) best[r] = gm;
            const bool pop = (ck[0][r] == gm);
            ck[0][r] = pop ? ck[1][r] : ck[0][r]; ck[1][r] = pop ? ck[2][r] : ck[1][r]; ck[2][r] = pop ? ck[3][r] : ck[2][r]; ck[3][r] = pop ? 0u : ck[3][r];
        }
    }
    PeerSel S_;
#pragma unroll
    for (int r = 0; r < 4; ++r) {
        const float fv = sort2f(best[r] & ~0x3Fu);
        const int q = 63 - (int)(best[r] & 63u);
        const int ci = CAND_I[q], cj = CAND_J[q];
        const unsigned t1 = (unsigned)__shfl((int)top[0][r], rowbase + ci), t2 = (unsigned)__shfl((int)top[1][r], rowbase + cj);
        S_.ev[r] = (127 - (int)(t1 & 127u)) * 128 + (127 - (int)(t2 & 127u));
        const float mx = __shfl(fv, rowbase);
        const float ex = __expf(fv - mx);
        const float sm = row_sum(ex);
        S_.gv[r] = ex / sm;
    }
    return S_;
}
#define PU_ROWEID(SEL, TT, I) __builtin_amdgcn_readlane(SEL.ev[(TT) & 3], 16 * ((TT) >> 2) + (I))
__device__ __forceinline__ void peer_blocks(const Params& p, int wunit, const PeerSel& S_, const PeerSel& N_, bool has_next, P8aRows& R0, P8aRows& R1) {
    const int lane = tid_op() & 63;
    const int tok0 = (wunit >> 3) * 16, h = wunit & 7;
    char* ws = p.ws;
    const unsigned char* U8 = (const unsigned char*)(ws + O_U8) + 16 * lane;
    const bf16_t* H = (const bf16_t*)(ws + O_HB) + (size_t)tok0 * 1024 + 16 * lane;
    unsigned* ACT = (unsigned*)(ws + O_ACT) + (size_t)tok0 * 128 + h * 16;
#define PU_STEP(RC, TT) { \
        f32x2 hp[8]; \
        _Pragma("unroll") for (int k = 0; k < 2; ++k) { const u32x4n hv_ = *(const u32x4n*)(H + (TT) * 1024 + 8 * k); \
            hp[4 * k] = (f32x2){__uint_as_float(hv_.x << 16), __uint_as_float(hv_.x & 0xFFFF0000u)}; hp[4 * k + 1] = (f32x2){__uint_as_float(hv_.y << 16), __uint_as_float(hv_.y & 0xFFFF0000u)}; \
            hp[4 * k + 2] = (f32x2){__uint_as_float(hv_.z << 16), __uint_as_float(hv_.z & 0xFFFF0000u)}; hp[4 * k + 3] = (f32x2){__uint_as_float(hv_.w << 16), __uint_as_float(hv_.w & 0xFFFF0000u)}; } \
        float pp[16]; \
        _Pragma("unroll") for (int i = 0; i < 16; ++i) { \
            pp[i] = p8_dot16(RC.a[i], hp); \
            if ((TT) < 14) RC.a[i] = *(const u32x4n*)(U8 + (size_t)PU_ROWEID(S_, ((TT) + 2) & 15, i) * 1024); \
            else if (has_next) RC.a[i] = *(const u32x4n*)(U8 + (size_t)PU_ROWEID(N_, ((TT) + 2) & 15, i) * 1024); } \
        const float dot = p8_reduce16(pp, lane) * (1.f / 32.f); \
        const int src_ = 16 * ((TT) >> 2) + (lane >> 2); \
        const float gt_ = __shfl(S_.gv[(TT) & 3], src_); const int ei_ = __shfl(S_.ev[(TT) & 3], src_); \
        const float act_ = gelu_erf(dot) * gt_; \
        if ((lane & 3) == 0) ACT[(TT) * 128 + (lane >> 2)] = (unsigned)ei_ | ((unsigned)f2bf(act_) << 16); }
    PU_STEP(R0, 0) PU_STEP(R1, 1) PU_STEP(R0, 2) PU_STEP(R1, 3) PU_STEP(R0, 4) PU_STEP(R1, 5) PU_STEP(R0, 6) PU_STEP(R1, 7)
    PU_STEP(R0, 8) PU_STEP(R1, 9) PU_STEP(R0, 10) PU_STEP(R1, 11) PU_STEP(R0, 12) PU_STEP(R1, 13) PU_STEP(R0, 14) PU_STEP(R1, 15)
#undef PU_STEP
}
__device__ __forceinline__ void phase7(const Params& p, char* smem) {
    const int lane = tid_op() & 63;
    const int w = __builtin_amdgcn_readfirstlane(tid_op() >> 6);
    const int stride = gridDim.x * 8;
    const unsigned char* U8 = (const unsigned char*)(p.ws + O_U8) + 16 * lane;
    {
        const int tid = tid_op();
        __syncthreads();
#pragma unroll
        for (int k = 0; k < 8; ++k) {
            const int c = tid + 512 * k, half = c >> 11, row = (c >> 4) & 127, ch = c & 15;
            *(uint4*)(smem + half * (128 * 144 * 2) + row * 288 + ch * 16) = *(const uint4*)(p.ws + (half ? O_K2B : O_K1B) + (size_t)row * 256 + ch * 16);
        }
        __syncthreads();
    }
    for (int u = blockIdx.x * 8 + w; u < 8192; u += stride) {
        const PeerSel s0 = peer_select(p, u, smem);
        P8aRows R0, R1;
#pragma unroll
        for (int i = 0; i < 16; ++i) { R0.a[i] = *(const u32x4n*)(U8 + (size_t)PU_ROWEID(s0, 0, i) * 1024); R1.a[i] = *(const u32x4n*)(U8 + (size_t)PU_ROWEID(s0, 1, i) * 1024); }
        peer_blocks(p, u, s0, s0, false, R0, R1);
    }
}
#undef PU_ROWEID

__device__ __forceinline__ float dot16_fp8(const uint4& r, const float (&hv)[16]) {
    const f32x2 a0 = __builtin_amdgcn_cvt_pk_f32_fp8((int)r.x, false), a1 = __builtin_amdgcn_cvt_pk_f32_fp8((int)r.x, true);
    const f32x2 b0 = __builtin_amdgcn_cvt_pk_f32_fp8((int)r.y, false), b1 = __builtin_amdgcn_cvt_pk_f32_fp8((int)r.y, true);
    const f32x2 c0 = __builtin_amdgcn_cvt_pk_f32_fp8((int)r.z, false), c1 = __builtin_amdgcn_cvt_pk_f32_fp8((int)r.z, true);
    const f32x2 d0 = __builtin_amdgcn_cvt_pk_f32_fp8((int)r.w, false), d1 = __builtin_amdgcn_cvt_pk_f32_fp8((int)r.w, true);
    return (hv[0] * a0.x + hv[1] * a0.y + hv[2] * a1.x + hv[3] * a1.y) + (hv[4] * b0.x + hv[5] * b0.y + hv[6] * b1.x + hv[7] * b1.y)
         + (hv[8] * c0.x + hv[9] * c0.y + hv[10] * c1.x + hv[11] * c1.y) + (hv[12] * d0.x + hv[13] * d0.y + hv[14] * d1.x + hv[15] * d1.y);
}
struct P8bRows { u32x4n v[8]; };
struct P8bMeta { u32x4n m[4]; };
__device__ __forceinline__ void p8b_meta(P8bMeta& M, const unsigned* ACT, int row, int e8) {
#pragma unroll
    for (int k = 0; k < 4; ++k) M.m[k] = *(const u32x4n*)(ACT + (size_t)row * 128 + e8 * 16 + 4 * k);
}
template <int HALF> __device__ __forceinline__ void p8b_load(P8bRows& R, const P8bMeta& M, const unsigned char* V8) {
#pragma unroll
    for (int k = 0; k < 2; ++k) {
        const u32x4n mm = M.m[2 * HALF + k];
        R.v[4 * k + 0] = *(const u32x4n*)(V8 + (size_t)(mm.x & 0xFFFFu) * 128); R.v[4 * k + 1] = *(const u32x4n*)(V8 + (size_t)(mm.y & 0xFFFFu) * 128);
        R.v[4 * k + 2] = *(const u32x4n*)(V8 + (size_t)(mm.z & 0xFFFFu) * 128); R.v[4 * k + 3] = *(const u32x4n*)(V8 + (size_t)(mm.w & 0xFFFFu) * 128);
    }
}
template <int HALF> __device__ __forceinline__ void p8b_accum(f32x2 (&acc)[8], const P8bRows& R, const P8bMeta& M) {
#pragma unroll
    for (int k = 0; k < 2; ++k) {
        const u32x4n mm = M.m[2 * HALF + k];
        const unsigned mw[4] = {mm.x, mm.y, mm.z, mm.w};
#pragma unroll
        for (int q = 0; q < 4; ++q) {
            const float a1 = __uint_as_float(mw[q] & 0xFFFF0000u);
            const f32x2 av = (f32x2){a1, a1};
            const u32x4n x = R.v[4 * k + q];
            acc[0] += av * __builtin_amdgcn_cvt_pk_f32_fp8((int)x.x, false); acc[1] += av * __builtin_amdgcn_cvt_pk_f32_fp8((int)x.x, true);
            acc[2] += av * __builtin_amdgcn_cvt_pk_f32_fp8((int)x.y, false); acc[3] += av * __builtin_amdgcn_cvt_pk_f32_fp8((int)x.y, true);
            acc[4] += av * __builtin_amdgcn_cvt_pk_f32_fp8((int)x.z, false); acc[5] += av * __builtin_amdgcn_cvt_pk_f32_fp8((int)x.z, true);
            acc[6] += av * __builtin_amdgcn_cvt_pk_f32_fp8((int)x.w, false); acc[7] += av * __builtin_amdgcn_cvt_pk_f32_fp8((int)x.w, true);
        }
    }
}
__device__ __forceinline__ void p8b_store(const f32x2 (&acc)[8], float* hr, const bf16_t* hb, int e8) {
    float r[16];
#pragma unroll
    for (int j = 0; j < 8; ++j) { r[2 * j] = acc[j].x; r[2 * j + 1] = acc[j].y; }
#pragma unroll
    for (int j = 0; j < 16; ++j) { r[j] += dpp_f<0x128, 0xF, true>(r[j]); r[j] = sum_x32(sum_x16(r[j])); }
    if (e8 == 0) {
#pragma unroll
        for (int j = 0; j < 2; ++j) {
            const uint4 hw = *(const uint4*)(hb + 8 * j);
            *(float4*)(hr + 8 * j) = make_float4(ALPHA * __uint_as_float(hw.x << 16) + r[8 * j], ALPHA * __uint_as_float(hw.x & 0xFFFF0000u) + r[8 * j + 1],
                                                 ALPHA * __uint_as_float(hw.y << 16) + r[8 * j + 2], ALPHA * __uint_as_float(hw.y & 0xFFFF0000u) + r[8 * j + 3]);
            *(float4*)(hr + 8 * j + 4) = make_float4(ALPHA * __uint_as_float(hw.z << 16) + r[8 * j + 4], ALPHA * __uint_as_float(hw.z & 0xFFFF0000u) + r[8 * j + 5],
                                                     ALPHA * __uint_as_float(hw.w << 16) + r[8 * j + 6], ALPHA * __uint_as_float(hw.w & 0xFFFF0000u) + r[8 * j + 7]);
        }
    }
}
__device__ __forceinline__ void phase8b(const Params& p, const XcdMap xm, float* outp) {
    const int lane = tid_op() & 63, w = tid_op() >> 6, e8 = lane >> 3, c8 = lane & 7;
    char* ws = p.ws;
    const unsigned char* V8 = (const unsigned char*)(ws + O_V8) + (size_t)xm.slice * 16384 * 128 + 16 * c8;
    const unsigned* ACT = (const unsigned*)(ws + O_ACT);
    const int stride = xm.nloc * 8;
    int row = xm.rank * 8 + w;
    if (row >= NTOK) return;
    float* const hbase = outp + xm.slice * 128 + 16 * c8;
    const bf16_t* const hbb = (const bf16_t*)(ws + O_HB) + xm.slice * 128 + 16 * c8;
    P8bMeta Mc, Mn; P8bRows Ra, Rb;
    p8b_meta(Mc, ACT, row, e8);
    p8b_meta(Mn, ACT, (row + stride < NTOK) ? row + stride : row, e8);
    p8b_load<0>(Ra, Mc, V8);
    for (; row < NTOK; row += stride) {
        f32x2 acc[8];
#pragma unroll
        for (int j = 0; j < 8; ++j) acc[j] = (f32x2){0.f, 0.f};
        p8b_load<1>(Rb, Mc, V8);
        p8b_accum<0>(acc, Ra, Mc);
        p8b_load<0>(Ra, Mn, V8);
        p8b_accum<1>(acc, Rb, Mc);
        p8b_store(acc, hbase + (size_t)row * 1024, hbb + (size_t)row * 1024, e8);
        Mc = Mn;
        const int r2 = row + 2 * stride;
        p8b_meta(Mn, ACT, r2 < NTOK ? r2 : row, e8);
    }
}
__device__ __forceinline__ void phase8c(const Params& p) {
    const int lane = tid_op() & 63, w = tid_op() >> 6;
    for (int row = blockIdx.x * 8 + w; row < NTOK; row += gridDim.x * 8) {
        float* yr = p.out + (size_t)row * 1024;
        float4 v[4]; float s = 0.f;
#pragma unroll
        for (int j = 0; j < 4; ++j) { v[j] = *(const float4*)(yr + 4 * lane + 256 * j); s += v[j].x + v[j].y + v[j].z + v[j].w; }
        const float mean = wave_sum(s) * (1.f / 1024.f);
        float q = 0.f;
#pragma unroll
        for (int j = 0; j < 4; ++j) { const float a = v[j].x - mean, b2 = v[j].y - mean, c2 = v[j].z - mean, d = v[j].w - mean; q += a * a + b2 * b2 + c2 * c2 + d * d; }
        const float rstd = rsqrtf(wave_sum(q) * (1.f / 1024.f) + LN_EPS);
#pragma unroll
        for (int j = 0; j < 4; ++j) {
            const int col = 4 * lane + 256 * j;
            const float4 gg = *(const float4*)(p.ln2_g + col), bb = *(const float4*)(p.ln2_b + col);
            float4 o;
            o.x = (v[j].x - mean) * rstd * gg.x + bb.x; o.y = (v[j].y - mean) * rstd * gg.y + bb.y; o.z = (v[j].z - mean) * rstd * gg.z + bb.z; o.w = (v[j].w - mean) * rstd * gg.w + bb.w;
            *(float4*)(yr + col) = o;
        }
    }
}

typedef const __attribute__((address_space(4))) Params* ParamsK;
__device__ __forceinline__ Params params_reload() {
#if defined(__HIP_DEVICE_COMPILE__)
    auto ka = __builtin_amdgcn_kernarg_segment_ptr();
    asm volatile("" : "+s"(ka));
    Params r; __builtin_memcpy(&r, (const __attribute__((address_space(4))) void*)ka, sizeof(Params));
    return r;
#else
    return Params{};
#endif
}
#if ONE_LAUNCH
__global__ void __launch_bounds__(512, 2) fwd_megakernel(Params p) {
    __shared__ __attribute__((aligned(16))) char smem[SMEM_BYTES];
    cg::grid_group grid = cg::this_grid();
    volatile LAS unsigned* st = (volatile LAS unsigned*)(smem + SMEM_BYTES - 16);
    if (threadIdx.x == 0) { st[0] = 0u; st[1] = 0u; st[2] = 0u; st[3] = 0u; }
    __syncthreads();
    const XcdBarrier xb = xcd_barrier_post((unsigned*)(p.ws + O_BAR), st);
#define GRID_BAR() do { if (p.use_cg) grid.sync(); else xcd_barrier(xb); } while (0)
#ifndef DUP
#define DUP -1
#endif
#define PP (params_reload())
#define RUNPH(k, call) { int n_ = (DUP == k) ? 2 : 1; asm volatile("" : "+s"(n_)); _Pragma("unroll 1") for (int i_ = 0; i_ < n_; ++i_) { call; GRID_BAR(); } }
    RUNPH(0, phase0(PP))
    XcdMap xm;
    if (st[2]) { xm.slice = (int)xb.x; xm.rank = (int)st[3]; xm.nloc = (int)st[0]; }
    else { xm.slice = blockIdx.x & 7; xm.rank = blockIdx.x >> 3; xm.nloc = gridDim.x >> 3; }
    xm.slice = __builtin_amdgcn_readfirstlane(xm.slice); xm.rank = __builtin_amdgcn_readfirstlane(xm.rank); xm.nloc = __builtin_amdgcn_readfirstlane(xm.nloc);
    RUNPH(1, phase1(PP, smem, xm))
    RUNPH(2, phase2(PP, smem))
    if (DUP == 20) { int wh_ = 1; asm volatile("" : "+s"(wh_)); phase2(PP, smem, wh_); GRID_BAR(); }
    if (DUP == 21) { int wh_ = 2; asm volatile("" : "+s"(wh_)); phase2(PP, smem, wh_); GRID_BAR(); }
    phase2c(PP); GRID_BAR();
    RUNPH(3, phase3(PP, smem))
    if (DUP == 30) { int wh_ = 1; asm volatile("" : "+s"(wh_)); phase3(PP, smem, wh_); GRID_BAR(); }
    if (DUP == 31) { int wh_ = 2; asm volatile("" : "+s"(wh_)); phase3(PP, smem, wh_); GRID_BAR(); }
    RUNPH(4, phase4(PP, smem, xm))
    phase5(PP); GRID_BAR();
    RUNPH(6, phase6(PP, smem, xm))
    RUNPH(7, phase7(PP, smem))
#ifdef SCRAMBLE
    { const int x_ = xm.slice, r_ = xm.rank; xm.slice = (x_ + r_) & 7; xm.rank = (r_ >> 3) * 8 + x_; xm.nloc = 32; }
#endif
    if (DUP == 9) { phase8b(PP, xm, (float*)(PP.ws + O_QP)); GRID_BAR(); }
    phase8b(PP, xm, PP.out); GRID_BAR();
    phase8c(PP);
}
#else
__global__ void __launch_bounds__(512, 2) k_phase0(Params p) { phase0(p); }
__global__ void __launch_bounds__(512, 2) k_phase1(Params p) { __shared__ __attribute__((aligned(16))) char smem[SMEM_BYTES]; XcdMap xm; xm.slice = blockIdx.x & 7; xm.rank = blockIdx.x >> 3; xm.nloc = gridDim.x >> 3; phase1(p, smem, xm); }
__global__ void __launch_bounds__(512, 2) k_phase2(Params p) { __shared__ __attribute__((aligned(16))) char smem[SMEM_BYTES]; phase2(p, smem); }
__global__ void __launch_bounds__(512, 2) k_phase2c(Params p) { phase2c(p); }
__global__ void __launch_bounds__(512, 2) k_phase3(Params p) { __shared__ __attribute__((aligned(16))) char smem[SMEM_BYTES]; phase3(p, smem); }
__global__ void __launch_bounds__(512, 2) k_phase4(Params p) { __shared__ __attribute__((aligned(16))) char smem[SMEM_BYTES]; XcdMap xm; xm.slice = blockIdx.x & 7; xm.rank = blockIdx.x >> 3; xm.nloc = gridDim.x >> 3; phase4(p, smem, xm); }
__global__ void __launch_bounds__(512, 2) k_phase5(Params p) { phase5(p); }
__global__ void __launch_bounds__(512, 2) k_phase6(Params p) { __shared__ __attribute__((aligned(16))) char smem[SMEM_BYTES]; XcdMap xm; xm.slice = blockIdx.x & 7; xm.rank = blockIdx.x >> 3; xm.nloc = gridDim.x >> 3; phase6(p, smem, xm); }
__global__ void __launch_bounds__(512, 2) k_phase7(Params p) { __shared__ __attribute__((aligned(16))) char smem_[SMEM_BYTES]; phase7(p, smem_); }
__global__ void __launch_bounds__(512, 2) k_phase8b(Params p) { XcdMap xm; xm.slice = blockIdx.x & 7; xm.rank = blockIdx.x >> 3; xm.nloc = gridDim.x >> 3; phase8b(p, xm, p.out); }
__global__ void __launch_bounds__(512, 2) k_phase8c(Params p) { phase8c(p); }
#endif

extern "C" void kernel_launch(void* const* d_in, const int* in_sizes, int n_in, void* d_out, int out_size, void* d_ws, size_t ws_size, hipStream_t stream) {
    Params p{};
    p.x = (const float*)d_in[0]; p.pos = (const int*)d_in[1]; p.w_in = (const float*)d_in[2]; p.conv_w = (const float*)d_in[3]; p.conv_b = (const float*)d_in[4];
    p.dt_bias = (const float*)d_in[5]; p.a_log = (const float*)d_in[6]; p.d_skip = (const float*)d_in[7]; p.norm_w = (const float*)d_in[8]; p.w_out = (const float*)d_in[9];
    p.ln1_g = (const float*)d_in[10]; p.ln1_b = (const float*)d_in[11]; p.wq = (const float*)d_in[12]; p.k1 = (const float*)d_in[13]; p.k2 = (const float*)d_in[14];
    p.u = (const float*)d_in[15]; p.v = (const float*)d_in[16]; p.ln2_g = (const float*)d_in[17]; p.ln2_b = (const float*)d_in[18];
    p.out = (float*)d_out; p.ws = (char*)d_ws;
    if (ws_size < WS_NEEDED) { fprintf(stderr, "kernel_launch: workspace too small (%zu < %zu)\n", ws_size, (size_t)WS_NEEDED); return; }
#if ONE_LAUNCH
    static int grid_blocks = 0;
    if (!grid_blocks) {
        int dev = 0, cus = 0, per_cu = 0;
        hipGetDevice(&dev);
        hipDeviceGetAttribute(&cus, hipDeviceAttributeMultiprocessorCount, dev);
        hipOccupancyMaxActiveBlocksPerMultiprocessor(&per_cu, fwd_megakernel, 512, 0);
        if (per_cu > 1) per_cu = 1;
        if (per_cu < 1) per_cu = 1;
        grid_blocks = cus * per_cu;
    }
    (void)hipMemsetAsync((char*)d_ws + O_BAR, 0, XCD_BAR_WORDS * 4, stream);
    void* args[] = {&p};
    hipError_t e = hipLaunchCooperativeKernel((void*)fwd_megakernel, dim3(grid_blocks), dim3(512), args, 0, stream);
    if (e != hipSuccess) fprintf(stderr, "cooperative launch failed: %s (grid %d)\n", hipGetErrorString(e), grid_blocks);
#else
    const int G = 512;
    k_phase0<<<G, 512, 0, stream>>>(p);
    k_phase1<<<G, 512, 0, stream>>>(p);
    k_phase2<<<G, 512, 0, stream>>>(p);
    k_phase2c<<<G, 512, 0, stream>>>(p);
    k_phase3<<<G, 512, 0, stream>>>(p);
    k_phase4<<<G, 512, 0, stream>>>(p);
    k_phase5<<<G, 512, 0, stream>>>(p);
    k_phase6<<<G, 512, 0, stream>>>(p);
    k_phase7<<<G, 512, 0, stream>>>(p);
    k_phase8b<<<G, 512, 0, stream>>>(p);
    k_phase8c<<<G, 512, 0, stream>>>(p);
#endif
}
```

```cpp
#include <hip/hip_runtime.h>
#include <hip/hip_cooperative_groups.h>
#include <stdint.h>
#include <stdio.h>
namespace cg = cooperative_groups;

typedef unsigned short bf16_t;
typedef short bf16x8 __attribute__((ext_vector_type(8)));
typedef short bf16x4 __attribute__((ext_vector_type(4)));
typedef float f32x4 __attribute__((ext_vector_type(4)));
typedef float f32x2 __attribute__((ext_vector_type(2)));

#ifndef ONE_LAUNCH
#define ONE_LAUNCH 1
#endif

constexpr int NB = 8, SEQ = 2048, DM = 1024, NTOK = NB * SEQ;
constexpr int NP = 3584;
constexpr int QOFF = 0, KOFF = 512, VOFF = 1024, IQOFF = 1536, MISCOFF = 1792, ZOFF = 1856, XBCOFF = 2368, NUSED = 3392;
constexpr float ALPHA = 1.189207115002721f;
constexpr float LN_EPS = 1e-5f;

constexpr size_t MB = 1024 * 1024;
constexpr size_t O_WIN_T = 0;
constexpr size_t O_WOUT_T = O_WIN_T + (size_t)NP * 1024 * 2;
constexpr size_t O_WQ_T = O_WOUT_T + 2 * MB;
constexpr size_t O_K1B = O_WQ_T + 4 * MB;
constexpr size_t O_K2B = O_K1B + 32768;
constexpr size_t O_CS64 = O_K2B + 32768;
constexpr size_t O_CS32 = O_CS64 + 4 * MB;
constexpr size_t O_BAR = O_CS32 + 2 * MB;
constexpr size_t O_R1 = O_BAR + 65536;
constexpr size_t O_XB = O_R1;
constexpr size_t O_XT = O_R1;
constexpr size_t O_BRM = O_XT + 16 * MB;
constexpr size_t O_CRM = O_BRM + 8 * MB;
constexpr size_t O_QB = O_XB + 32 * MB;
constexpr size_t O_KB = O_QB + 16 * MB;
constexpr size_t O_VT = O_KB + 16 * MB;
constexpr size_t O_IQB = O_VT + 16 * MB;
constexpr size_t O_IKB = O_IQB + 8 * MB;
constexpr size_t O_IWF = O_IKB + 1 * MB;
constexpr size_t O_DTF = O_IWF + MB / 2;
constexpr size_t O_ZB = O_DTF + MB / 2;
constexpr size_t O_XBCT = O_ZB + 16 * MB;
constexpr size_t O_CAR = O_XBCT;
constexpr size_t O_ACUM = O_XBCT + 32 * MB;
constexpr size_t O_ATOT = O_ACUM + MB / 2;
constexpr size_t O_ST = O_ATOT + MB / 2;
constexpr size_t O_MIX = O_ST;
constexpr size_t O_MASK = O_ST + 32 * MB;
constexpr size_t O_R1_END = O_MASK + 4 * MB;
constexpr size_t O_HB = O_R1;
constexpr size_t O_QP = O_HB + 32 * MB;
constexpr size_t O_ACT = O_QP + 64 * MB;
constexpr size_t O_R2_END = O_ACT + 8 * MB;
static_assert(O_R2_END <= O_ST, "region 2 must not reach MIX");
constexpr size_t O_U8 = O_R1_END;
constexpr size_t O_V8 = O_U8 + 16 * MB;
constexpr size_t WS_NEEDED = O_V8 + 16 * MB;
static_assert(WS_NEEDED <= 256 * MB, "workspace too large");

struct Params {
    const float* x; const int* pos; const float* w_in; const float* conv_w; const float* conv_b; const float* dt_bias;
    const float* a_log; const float* d_skip; const float* norm_w; const float* w_out; const float* ln1_g; const float* ln1_b;
    const float* wq; const float* k1; const float* k2; const float* u; const float* v; const float* ln2_g; const float* ln2_b;
    float* out; char* ws; int use_cg; int pad_;
};

#define SMEM_BYTES 133120

__device__ __forceinline__ int tid_op() { int t = threadIdx.x; asm volatile("" : "+v"(t)); return t; }
__device__ __forceinline__ bf16_t f2bf(float f) {
    unsigned u = __float_as_uint(f);
    u += 0x7FFFu + ((u >> 16) & 1u);
    return (bf16_t)(u >> 16);
}
__device__ __forceinline__ float bf2f(bf16_t b) { return __uint_as_float(((unsigned)b) << 16); }
__device__ __forceinline__ unsigned pack2(float a, float b) { return (unsigned)f2bf(a) | ((unsigned)f2bf(b) << 16); }
__device__ __forceinline__ unsigned f2sort(float f) { unsigned u = __float_as_uint(f); return (u & 0x80000000u) ? ~u : (u | 0x80000000u); }
__device__ __forceinline__ float sort2f(unsigned s) { unsigned u = (s & 0x80000000u) ? (s & 0x7FFFFFFFu) : ~s; return __uint_as_float(u); }
__device__ __forceinline__ f32x4 mfma16(bf16x8 a, bf16x8 b, f32x4 c) { return __builtin_amdgcn_mfma_f32_16x16x32_bf16(a, b, c, 0, 0, 0); }
__device__ __forceinline__ float silu_f(float v) { return v / (1.f + __expf(-v)); }
__device__ __forceinline__ bf16x8 ld8(const bf16_t* p) { return *(const bf16x8*)p; }
__device__ __forceinline__ bf16x8 cat4(bf16x4 lo, bf16x4 hi) { return __builtin_shufflevector(lo, hi, 0, 1, 2, 3, 4, 5, 6, 7); }


template <int CTRL, int ROWMASK, bool BC> __device__ __forceinline__ int dpp_i(int v) { return __builtin_amdgcn_update_dpp(0, v, CTRL, ROWMASK, 0xF, BC); }
template <int CTRL, int ROWMASK, bool BC> __device__ __forceinline__ float dpp_f(float v) { return __builtin_bit_cast(float, __builtin_amdgcn_update_dpp(0, __builtin_bit_cast(int, v), CTRL, ROWMASK, 0xF, BC)); }
__device__ __forceinline__ float row_sum(float v) { v += dpp_f<0xB1, 0xF, true>(v); v += dpp_f<0x4E, 0xF, true>(v); v += dpp_f<0x141, 0xF, true>(v); v += dpp_f<0x140, 0xF, true>(v); return v; }
__device__ __forceinline__ unsigned row_sum_u(unsigned v) { v += (unsigned)dpp_i<0xB1, 0xF, true>((int)v); v += (unsigned)dpp_i<0x4E, 0xF, true>((int)v); v += (unsigned)dpp_i<0x141, 0xF, true>((int)v); v += (unsigned)dpp_i<0x140, 0xF, true>((int)v); return v; }
__device__ __forceinline__ unsigned row_max_u(unsigned v) {
    v = max(v, (unsigned)dpp_i<0xB1, 0xF, true>((int)v)); v = max(v, (unsigned)dpp_i<0x4E, 0xF, true>((int)v));
    v = max(v, (unsigned)dpp_i<0x141, 0xF, true>((int)v)); v = max(v, (unsigned)dpp_i<0x140, 0xF, true>((int)v)); return v;
}
__device__ __forceinline__ float wave_sum_u(float v) {
    v = row_sum(v);
    v += dpp_f<0x142, 0xA, false>(v);
    v += dpp_f<0x143, 0xC, false>(v);
    return __builtin_bit_cast(float, __builtin_amdgcn_readlane(__builtin_bit_cast(int, v), 63));
}
typedef unsigned u32x2_t __attribute__((ext_vector_type(2)));
__device__ __forceinline__ float sum_x16(float v) { const u32x2_t r = __builtin_amdgcn_permlane16_swap(__float_as_uint(v), __float_as_uint(v), false, false); return __uint_as_float(r.x) + __uint_as_float(r.y); }
__device__ __forceinline__ float sum_x32(float v) { const u32x2_t r = __builtin_amdgcn_permlane32_swap(__float_as_uint(v), __float_as_uint(v), false, false); return __uint_as_float(r.x) + __uint_as_float(r.y); }
__device__ __forceinline__ float max_x16(float v) { const u32x2_t r = __builtin_amdgcn_permlane16_swap(__float_as_uint(v), __float_as_uint(v), false, false); return fmaxf(__uint_as_float(r.x), __uint_as_float(r.y)); }
__device__ __forceinline__ float max_x32(float v) { const u32x2_t r = __builtin_amdgcn_permlane32_swap(__float_as_uint(v), __float_as_uint(v), false, false); return fmaxf(__uint_as_float(r.x), __uint_as_float(r.y)); }
__device__ __forceinline__ float wave_sum(float v) { return sum_x32(sum_x16(row_sum(v))); }

#define XB_TMO      128
#define XB_XCNT(j)  (256  + 64 * (j))
#define XB_XSUB(j)  (1280 + 64 * (j))
#define XB_XGEN(j)  (2304 + 64 * (j))
#define XB_TOP      3328
#define XB_TOPGEN   3392
#define XCD_BAR_WORDS 3456
#define XB_SPIN_CAP (1u << 22)
#define LAS __attribute__((address_space(3)))
__device__ __forceinline__ unsigned xb_ld(unsigned* p)              { return __hip_atomic_load(p, __ATOMIC_RELAXED, __HIP_MEMORY_SCOPE_AGENT); }
__device__ __forceinline__ unsigned xb_add(unsigned* p, unsigned v) { return __hip_atomic_fetch_add(p, v, __ATOMIC_RELAXED, __HIP_MEMORY_SCOPE_AGENT); }
__device__ __forceinline__ unsigned xb_xcc_id() { return (unsigned)__builtin_amdgcn_s_getreg((3 << 11) | 20) & 0xFu; }
#define XB_SPIN(cond, bar) do { unsigned _sp = 0; while (cond) { __builtin_amdgcn_s_sleep(1); \
    if ((++_sp & 255u) == 0u) { if (xb_ld(&(bar)[XB_TMO])) break; if (_sp > XB_SPIN_CAP) { atomicAdd(&(bar)[XB_TMO], 1u); break; } } } } while (0)
struct XcdBarrier { unsigned* bar; unsigned x; volatile LAS unsigned* st; };
__device__ __forceinline__ XcdBarrier xcd_barrier_post(unsigned* bar, volatile LAS unsigned* st) {
    XcdBarrier b; b.bar = bar; b.x = xb_xcc_id(); b.st = st;
    if (threadIdx.x == 0) st[3] = xb_add(&bar[XB_XCNT(b.x)], 1u);
    return b;
}
__device__ __forceinline__ void xcd_barrier_complete(unsigned* bar, unsigned x, unsigned& nloc, unsigned& nx, unsigned& low8) {
    const unsigned G = gridDim.x * gridDim.y * gridDim.z;
    unsigned sum, cnt, mine, lo, sp = 0u;
    for (;;) {
        sum = 0u; cnt = 0u; mine = 0u; lo = 0u;
#pragma unroll
        for (unsigned j = 0; j < 16; ++j) { const unsigned c = xb_ld(&bar[XB_XCNT(j)]); sum += c; cnt += (c > 0u) ? 1u : 0u; lo += (j < 8u && c > 0u) ? 1u : 0u; mine = (j == x) ? c : mine; }
        if (sum == G) break;
        __builtin_amdgcn_s_sleep(1);
        if ((++sp & 255u) == 0u) { if (xb_ld(&bar[XB_TMO])) break; if (sp > XB_SPIN_CAP) { atomicAdd(&bar[XB_TMO], 1u); break; } }
    }
    nloc = mine > 0u ? mine : 1u; nx = cnt > 0u ? cnt : 1u; low8 = (lo == 8u && cnt == 8u) ? 1u : 0u;
}
__device__ __forceinline__ void xcd_barrier(const XcdBarrier& b) {
    asm volatile("s_waitcnt vmcnt(0)" ::: "memory");
    __syncthreads();
    if (threadIdx.x == 0) {
        unsigned* bar = b.bar;
        __builtin_amdgcn_s_waitcnt(0);
        unsigned nloc = b.st[0], nx = b.st[1];
        if (nloc == 0u) { unsigned low8; xcd_barrier_complete(bar, b.x, nloc, nx, low8); b.st[0] = nloc; b.st[1] = nx; b.st[2] = low8; }
        const unsigned old = xb_add(&bar[XB_XSUB(b.x)], 1u);
        const unsigned gen = old / nloc;
        if (old + 1u == (gen + 1u) * nloc) {
            __builtin_amdgcn_fence(__ATOMIC_RELEASE, "agent");
            asm volatile("s_waitcnt vmcnt(0)" ::: "memory");
            const unsigned og = xb_add(&bar[XB_TOP], 1u);
            const unsigned tg = og / nx;
            if (og + 1u == (tg + 1u) * nx) xb_add(&bar[XB_TOPGEN], 1u);
            else XB_SPIN(xb_ld(&bar[XB_TOPGEN]) == tg, bar);
            __builtin_amdgcn_fence(__ATOMIC_ACQUIRE, "agent");
            xb_add(&bar[XB_XGEN(b.x)], 1u);
            asm volatile("s_waitcnt vmcnt(0)" ::: "memory");
        } else {
            XB_SPIN(xb_ld(&bar[XB_XGEN(b.x)]) == gen, bar);
            __builtin_amdgcn_fence(__ATOMIC_ACQUIRE, "agent");
            asm volatile("s_waitcnt vmcnt(0)" ::: "memory");
        }
    }
    __syncthreads();
}

__device__ __forceinline__ int rot_perm(int gcol, int H) { const int j = (gcol % H) >> 3, e = gcol & 7; return (gcol / H) * H + 4 * j + (e & 3) + ((e >> 2) ? H / 2 : 0); }
__device__ __forceinline__ int win_src_col(int n) {
    if (n < 1024) return rot_perm(n, 64);
    if (n < 1536) return n;
    if (n < 1824) return 1536 + rot_perm(n - 1536, 32);
    if (n < 1832) return n;
    if (n < 1840) return 3368 + (n - 1832);
    if (n < 1856) return -1;
    if (n < 2368) return 1832 + (n - 1856);
    if (n < 3392) return 2344 + (n - 2368);
    return -1;
}
__device__ __forceinline__ void p0_transpose(const float* __restrict__ W, int N, int Nout, bool remap, bf16_t* __restrict__ Wt, int gtid, int gsz) {
    const int items = Nout * 128;
    for (int it = gtid; it < items; it += gsz) {
        const int n = it % Nout, kc = it / Nout;
        const int src = remap ? win_src_col(n) : n;
        unsigned w[4] = {0, 0, 0, 0};
        if (src >= 0) {
            float f[8];
#pragma unroll
            for (int j = 0; j < 8; ++j) f[j] = W[(size_t)(kc * 8 + j) * N + src];
#pragma unroll
            for (int j = 0; j < 4; ++j) w[j] = pack2(f[2 * j], f[2 * j + 1]);
        }
        *(uint4*)(Wt + (size_t)n * 1024 + kc * 8) = make_uint4(w[0], w[1], w[2], w[3]);
    }
}
__device__ __forceinline__ void p0_convert(const float* __restrict__ src, bf16_t* __restrict__ dst, size_t n4, size_t gtid, size_t gsz) {
    for (size_t i = gtid; i < n4; i += gsz) {
        const float4 f = ((const float4*)src)[i];
        ((uint2*)dst)[i] = make_uint2(pack2(f.x, f.y), pack2(f.z, f.w));
    }
}
__device__ __forceinline__ void phase0(const Params& p) {
    const int gtid = blockIdx.x * blockDim.x + tid_op(), gsz = gridDim.x * blockDim.x;
    p0_transpose(p.w_in, 3376, NP, true, (bf16_t*)(p.ws + O_WIN_T), gtid, gsz);
    p0_transpose(p.w_out, 1024, 1024, false, (bf16_t*)(p.ws + O_WOUT_T), gtid, gsz);
    p0_transpose(p.wq, 2048, 2048, false, (bf16_t*)(p.ws + O_WQ_T), gtid, gsz);
    p0_convert(p.k1, (bf16_t*)(p.ws + O_K1B), 128 * 128 / 4, gtid, gsz);
    p0_convert(p.k2, (bf16_t*)(p.ws + O_K2B), 128 * 128 / 4, gtid, gsz);
    p0_convert(p.x, (bf16_t*)(p.ws + O_XB), (size_t)NTOK * DM / 4, gtid, gsz);
    float2* cs64 = (float2*)(p.ws + O_CS64); float2* cs32 = (float2*)(p.ws + O_CS32);
    for (int it = gtid; it < NTOK * 48; it += gsz) {
        const int m = it / 48, i = it % 48;
        const float ps = (float)p.pos[m];
        if (i < 32) { const float inv = powf(10000.f, -(float)(2 * i) / 64.f); const float a = ps * inv; cs64[m * 32 + i] = make_float2(cosf(a), sinf(a)); }
        else { const int k = i - 32; const float inv = powf(10000.f, -(float)(2 * k) / 32.f); const float a = ps * inv; cs32[m * 16 + k] = make_float2(cosf(a), sinf(a)); }
    }
}

struct XcdMap { int slice, rank, nloc; };
__device__ __forceinline__ bool gemm_next_tile(const XcdMap& xm, int it, int ntn, int& tm, int& tn) {
    const int j = xm.rank + xm.nloc * it;
    if (j >= 8 * ntn) return false;
    tm = 8 * xm.slice + j / ntn; tn = j % ntn; return true;
}
#define GEMM_LDK 80
#define GEMM_LDS_A (256 * GEMM_LDK * 2)
#define GEMM_LDS_STAGE (GEMM_LDS_A + 128 * GEMM_LDK * 2)
typedef unsigned u32x4g __attribute__((ext_vector_type(4)));
struct GemmRegs { u32x4g a0, a1, a2, a3, b0, b1; };
__device__ __forceinline__ void gemm_gload(GemmRegs& r, const bf16_t* ga, const bf16_t* gb, size_t astep) {
    r.a0 = *(const u32x4g*)(ga); r.a1 = *(const u32x4g*)(ga + astep); r.a2 = *(const u32x4g*)(ga + 2 * astep); r.a3 = *(const u32x4g*)(ga + 3 * astep);
    r.b0 = *(const u32x4g*)(gb); r.b1 = *(const u32x4g*)(gb + astep);
}
__device__ __forceinline__ void gemm_lstore(const GemmRegs& r, bf16_t* wa, bf16_t* wb) {
    *(u32x4g*)(wa) = r.a0; *(u32x4g*)(wa + 64 * GEMM_LDK) = r.a1; *(u32x4g*)(wa + 128 * GEMM_LDK) = r.a2; *(u32x4g*)(wa + 192 * GEMM_LDK) = r.a3;
    *(u32x4g*)(wb) = r.b0; *(u32x4g*)(wb + 64 * GEMM_LDK) = r.b1;
}
__device__ __forceinline__ void gemm_compute(f32x4 (&acc)[4][4], const bf16_t* sA, const bf16_t* sB, int wm, int wn, int lane) {
#pragma unroll
    for (int ks = 0; ks < 2; ++ks) {
        bf16x8 a[4], b[4];
#pragma unroll
        for (int i = 0; i < 4; ++i) a[i] = ld8(sA + (wm * 64 + i * 16 + (lane & 15)) * GEMM_LDK + ks * 32 + (lane >> 4) * 8);
#pragma unroll
        for (int i = 0; i < 4; ++i) b[i] = ld8(sB + (wn * 64 + i * 16 + (lane & 15)) * GEMM_LDK + ks * 32 + (lane >> 4) * 8);
#pragma unroll
        for (int i = 0; i < 4; ++i)
#pragma unroll
            for (int j = 0; j < 4; ++j) acc[i][j] = mfma16(a[i], b[j], acc[i][j]);
    }
}
template <class Epi>
__device__ __forceinline__ void gemm_tile(const bf16_t* __restrict__ A, const bf16_t* __restrict__ Bt, int K, int m0, int n0, const Epi& epi, char* smem) {
    const int tid = tid_op(), lane = tid & 63, w = tid >> 6, wm = w >> 1, wn = w & 1;
    f32x4 acc[4][4];
#pragma unroll
    for (int i = 0; i < 4; ++i)
#pragma unroll
        for (int j = 0; j < 4; ++j) acc[i][j] = (f32x4){0.f, 0.f, 0.f, 0.f};
    const int lrow = tid >> 3, lkc = (tid & 7) * 8;
    const bf16_t* ga = A + (size_t)(m0 + lrow) * K + lkc;
    const bf16_t* gb = Bt + (size_t)(n0 + lrow) * K + lkc;
    const size_t astep = (size_t)64 * K;
    bf16_t* sA0 = (bf16_t*)smem; bf16_t* sB0 = (bf16_t*)(smem + GEMM_LDS_A);
    bf16_t* sA1 = (bf16_t*)(smem + GEMM_LDS_STAGE); bf16_t* sB1 = (bf16_t*)(smem + GEMM_LDS_STAGE + GEMM_LDS_A);
    const int woff = lrow * GEMM_LDK + lkc;
    GemmRegs r0, r1;
    gemm_gload(r0, ga, gb, astep);
    gemm_gload(r1, ga + 64, gb + 64, astep);
    __syncthreads();
    gemm_lstore(r0, sA0 + woff, sB0 + woff);
    __syncthreads();
    const int nk = K / 64;
    for (int k = 0; k < nk; k += 2) {
        { const int kk = (k + 2 < nk) ? k + 2 : nk - 1; gemm_gload(r0, ga + kk * 64, gb + kk * 64, astep); }
        gemm_compute(acc, sA0, sB0, wm, wn, lane);
        gemm_lstore(r1, sA1 + woff, sB1 + woff);
        __syncthreads();
        { const int kk = (k + 3 < nk) ? k + 3 : nk - 1; gemm_gload(r1, ga + kk * 64, gb + kk * 64, astep); }
        gemm_compute(acc, sA1, sB1, wm, wn, lane);
        gemm_lstore(r0, sA0 + woff, sB0 + woff);
        __syncthreads();
    }
    epi(acc, m0 + wm * 64, n0 + wn * 64, lane, smem + w * 9216);
}

namespace pg8 {
#define PG8_LAS __attribute__((address_space(3)))
typedef unsigned short bf16_t;
typedef short bf16x8 __attribute__((ext_vector_type(8)));
typedef float f32x4 __attribute__((ext_vector_type(4)));
typedef unsigned u32x4 __attribute__((ext_vector_type(4)));
constexpr int BM = 256, BK = 64, HALF = 128, HTB = HALF * BK * 2  , STAGE_BYTES = 8 * HTB, NXCD = 8, WGM = 8;

__host__ __device__ __forceinline__ int lds_byte(int r, int c) { const int st = (r >> 4) * 2 + (c >> 5), rr = r & 15, cc = c & 31, ob = rr * 64 + cc * 2; return st * 1024 + (ob ^ (((ob >> 9) & 1) << 5)); }
__host__ __device__ __forceinline__ void stage_rc(int b, int& R, int& C) { const int st = b / 1024, sb = b % 1024, swz = sb ^ (((sb >> 9) & 1) << 5); R = (st >> 1) * 16 + swz / 64; C = (st & 1) * 32 + (swz % 64) / 2; }
__host__ __device__ __forceinline__ int perm32(int rho) { const int n = rho >> 4, i = rho & 15; return 8 * (i >> 2) + 4 * n + (i & 3); }

struct Unit { int pm, pn; };
struct Gemm { const bf16_t* A; const bf16_t* Bt; int M, N, K; };

struct StaticOrder {
    int nM, nN, nwg, G, c;
    __host__ __device__ void init(int M, int N, int G_, int c_) { nM = M / BM; nN = N / BM; nwg = nM * nN; G = G_; c = c_; }
    __host__ __device__ bool next(int i, Unit& u) const {
        const long L = (long)i * G + c; if (L >= nwg) return false;
        int wgid = (int)L; { const int q = nwg / NXCD, r = nwg % NXCD, xcd = wgid % NXCD, off = wgid / NXCD; wgid = (xcd < r ? xcd * (q + 1) : r * (q + 1) + (xcd - r) * q) + off; }
        const int nig = WGM * nN, gid = wgid / nig, fm = gid * WGM, gsz = (nM - fm) < WGM ? (nM - fm) : WGM;
        u.pm = fm + ((wgid % nig) % gsz); u.pn = (wgid % nig) / gsz; return true;
    }
    __device__ __forceinline__ void a_ready(const Unit&) const {}
    __device__ __forceinline__ void done(const Unit&) const {}
};
__device__ __forceinline__ unsigned cvt_pk_bf16(float lo, float hi) { unsigned r; asm volatile("v_cvt_pk_bf16_f32 %0, %1, %2" : "=v"(r) : "v"(lo), "v"(hi)); return r; }

struct EpiBf16Plain {
    static constexpr bool PERM = true, AFTER_DRAIN = false;
    bf16_t* O; int ldc;
    __device__ __forceinline__ void operator()(const f32x4 (&acc)[2][2][4][2], const Unit& u, int wr, int wc, int fr, int fq) const {
        const int row0 = u.pm * BM + wr * 64 + fr, col0 = u.pn * BM + wc * 32 + 8 * fq;
#pragma unroll
        for (int ai = 0; ai < 2; ++ai)
#pragma unroll
            for (int m = 0; m < 4; ++m) { bf16_t* rowp = O + (size_t)(row0 + ai * HALF + m * 16) * ldc + col0;
#pragma unroll
                for (int bj = 0; bj < 2; ++bj) { const f32x4 v0 = acc[ai][bj][m][0], v1 = acc[ai][bj][m][1];
                    u32x4 w; w.x = cvt_pk_bf16(v0[0], v0[1]); w.y = cvt_pk_bf16(v0[2], v0[3]); w.z = cvt_pk_bf16(v1[0], v1[1]); w.w = cvt_pk_bf16(v1[2], v1[3]);
                    *(u32x4*)(rowp + bj * HALF) = w; } }
    }
};
struct EpiResF32 {
    static constexpr bool PERM = false, AFTER_DRAIN = false;
    float* Y; const float* X; int ldc; float alpha;
    __device__ __forceinline__ void operator()(const f32x4 (&acc)[2][2][4][2], const Unit& u, int wr, int wc, int fr, int fq) const {
        const int row0 = u.pm * BM + wr * 64 + fr, col0 = u.pn * BM + wc * 32 + 4 * fq;
#pragma unroll
        for (int ai = 0; ai < 2; ++ai)
#pragma unroll
            for (int m = 0; m < 4; ++m) { const size_t ro = (size_t)(row0 + ai * HALF + m * 16) * ldc + col0;
#pragma unroll
                for (int bj = 0; bj < 2; ++bj)
#pragma unroll
                    for (int n = 0; n < 2; ++n) { const f32x4 xv = *(const f32x4*)(X + ro + bj * HALF + n * 16); *(f32x4*)(Y + ro + bj * HALF + n * 16) = xv * alpha + acc[ai][bj][m][n]; } }
    }
};
struct EpiResBf16 {
    static constexpr bool PERM = true, AFTER_DRAIN = false;
    bf16_t* Y; const float* X; int ldc; float alpha;
    __device__ __forceinline__ void operator()(const f32x4 (&acc)[2][2][4][2], const Unit& u, int wr, int wc, int fr, int fq) const {
        const int row0 = u.pm * BM + wr * 64 + fr, col0 = u.pn * BM + wc * 32 + 8 * fq;
#pragma unroll
        for (int ai = 0; ai < 2; ++ai)
#pragma unroll
            for (int m = 0; m < 4; ++m) { const size_t ro = (size_t)(row0 + ai * HALF + m * 16) * ldc + col0;
#pragma unroll
                for (int bj = 0; bj < 2; ++bj) {
                    const f32x4 x0 = *(const f32x4*)(X + ro + bj * HALF), x1 = *(const f32x4*)(X + ro + bj * HALF + 4);
                    const f32x4 v0 = x0 * alpha + acc[ai][bj][m][0], v1 = x1 * alpha + acc[ai][bj][m][1];
                    u32x4 w; w.x = cvt_pk_bf16(v0[0], v0[1]); w.y = cvt_pk_bf16(v0[2], v0[3]); w.z = cvt_pk_bf16(v1[0], v1[1]); w.w = cvt_pk_bf16(v1[2], v1[3]);
                    *(u32x4*)(Y + ro + bj * HALF) = w; } }
    }
};
template <class Epi, class Sched, bool STAMP = false>
__device__ __forceinline__ void gemm_phase(PG8_LAS unsigned char* lds, const Gemm g, const Sched& S, const Epi& E, unsigned long long* stamps) {
    const int tid = tid_op(), wid = __builtin_amdgcn_readfirstlane(tid >> 6), lane = tid & 63, wr = wid >> 2, wc = wid & 3, fr = lane & 15, fq = lane >> 4;
    const int K = g.K, nt = K / BK;
    int ts_lo = 0, ts_hi = 0, nts = 0; const unsigned long long rt_entry = STAMP ? (unsigned long long)wall_clock64() : 0ull;
#define PG8_STAMP() do { if (STAMP && wid == 0 && nts < 64) { const unsigned long long _c = (unsigned long long)clock64(); \
        ts_lo = (lane == nts) ? (int)(unsigned)_c : ts_lo; ts_hi = (lane == nts) ? (int)(unsigned)(_c >> 32) : ts_hi; ++nts; } } while (0)
    PG8_STAMP();
    unsigned voffA[2], voffB[2];
#pragma unroll
    for (int i = 0; i < 2; ++i) { int R, C; stage_rc(tid * 16 + i * 8192, R, C); const int Rb = Epi::PERM ? ((R & ~31) + perm32(R & 31)) : R;
        voffA[i] = (unsigned)(R * K + C) * 2u; voffB[i] = (unsigned)(Rb * K + C) * 2u; }
    const size_t kstep = (size_t)(BK * 2);
    const size_t hstep = (size_t)HALF * K * 2;
    const size_t tstep = 2 * hstep;
    const unsigned ldsw = (unsigned)wid * 1024u;
    const int aoff = lds_byte(wr * 64 + fr, fq * 8), boff = lds_byte(wc * 32 + fr, fq * 8);
#define PG8_SA(b, h) (((b) * 2 + (h)) * HTB)
#define PG8_SB(b, h) ((4 + (b) * 2 + (h)) * HTB)
#define PG8_STAGE(bufoff, gbase, voff) do { _Pragma("unroll") for (int _i = 0; _i < 2; ++_i) \
        __builtin_amdgcn_global_load_lds((const unsigned*)((const char*)(gbase) + (voff)[_i]), (PG8_LAS unsigned*)(lds + (bufoff) + ldsw + _i * 8192), 16, 0, 0); } while (0)
#define PG8_LDA(dst, b, h) do { _Pragma("unroll") for (int m = 0; m < 4; ++m) _Pragma("unroll") for (int k = 0; k < 2; ++k) dst[m][k] = *(const PG8_LAS bf16x8*)(lds + PG8_SA(b, h) + aoff + m * 2048 + k * 1024); } while (0)
#define PG8_LDB(dst, b, h) do { _Pragma("unroll") for (int n = 0; n < 2; ++n) _Pragma("unroll") for (int k = 0; k < 2; ++k) dst[n][k] = *(const PG8_LAS bf16x8*)(lds + PG8_SB(b, h) + boff + n * 2048 + k * 1024); } while (0)
#define PG8_MMA(ai, bj, At, Bt) do { __builtin_amdgcn_s_setprio(1); _Pragma("unroll") for (int m = 0; m < 4; ++m) _Pragma("unroll") for (int n = 0; n < 2; ++n) _Pragma("unroll") for (int k = 0; k < 2; ++k) \
        acc[ai][bj][m][n] = __builtin_amdgcn_mfma_f32_16x16x32_bf16(Bt[n][k], At[m][k], acc[ai][bj][m][n], 0, 0, 0); __builtin_amdgcn_s_setprio(0); } while (0)
#define PG8_WAIT_V(n) asm volatile("s_waitcnt vmcnt(" #n ")" ::: "memory")
#define PG8_WAIT_L(n) asm volatile("s_waitcnt lgkmcnt(" #n ")" ::: "memory")
#define PG8_BAR __builtin_amdgcn_s_barrier()
#define PG8_SCHED __builtin_amdgcn_sched_barrier(0)
    Unit cur, nxt; int ui = 0;
    if (!S.next(0, cur)) return;
    f32x4 acc[2][2][4][2];
#pragma unroll
    for (int a = 0; a < 2; ++a)
#pragma unroll
        for (int b = 0; b < 2; ++b)
#pragma unroll
            for (int m = 0; m < 4; ++m)
#pragma unroll
                for (int n = 0; n < 2; ++n) acc[a][b][m][n] = (f32x4){0.f, 0.f, 0.f, 0.f};
    bf16x8 At[4][2], B0[2][2], B1[2][2];
    const char* cA = (const char*)g.A + (size_t)cur.pm * tstep; const char* cB = (const char*)g.Bt + (size_t)cur.pn * tstep;
    S.a_ready(cur);
    PG8_STAGE(PG8_SB(0, 0), cB, voffB); PG8_STAGE(PG8_SA(0, 0), cA, voffA); PG8_STAGE(PG8_SB(0, 1), cB + hstep, voffB); PG8_STAGE(PG8_SA(0, 1), cA + hstep, voffA);
    if (wr == 1) PG8_BAR;
    PG8_WAIT_V(4); PG8_BAR;
    PG8_STAGE(PG8_SB(1, 0), cB + kstep, voffB); PG8_STAGE(PG8_SA(1, 0), cA + kstep, voffA); PG8_STAGE(PG8_SB(1, 1), cB + hstep + kstep, voffB);
    PG8_WAIT_V(6); PG8_BAR;
    PG8_STAMP();
    for (;;) {
        const bool has_next = S.next(ui + 1, nxt);
        const char* nA = has_next ? (const char*)g.A + (size_t)nxt.pm * tstep : cA; const char* nB = has_next ? (const char*)g.Bt + (size_t)nxt.pn * tstep : cB;
        for (int t = 0; t < nt; t += 2) {
            const bool last = (t == nt - 2);
            const char* a1 = cA + (size_t)(t + 1) * kstep;
            const char* a2 = last ? nA : cA + (size_t)(t + 2) * kstep; const char* b2 = last ? nB : cB + (size_t)(t + 2) * kstep;
            const char* a3 = a2 + kstep; const char* b3 = b2 + kstep;
            if (last && has_next) S.a_ready(nxt);
            PG8_LDB(B0, 0, 0); PG8_SCHED; PG8_LDA(At, 0, 0); PG8_STAGE(PG8_SA(1, 1), a1 + hstep, voffA);
            PG8_WAIT_L(8); PG8_BAR; PG8_WAIT_L(0); PG8_MMA(0, 0, At, B0); PG8_BAR; PG8_SCHED;
            PG8_LDB(B1, 0, 1); PG8_STAGE(PG8_SB(0, 0), b2, voffB);
            PG8_BAR; PG8_WAIT_L(0); PG8_MMA(0, 1, At, B1); PG8_BAR;
            PG8_LDA(At, 0, 1); PG8_STAGE(PG8_SA(0, 0), a2, voffA);
            PG8_BAR; PG8_WAIT_L(0); PG8_MMA(1, 0, At, B0); PG8_BAR; PG8_SCHED;
            PG8_STAGE(PG8_SB(0, 1), b2 + hstep, voffB);
            PG8_WAIT_V(6); PG8_BAR; PG8_MMA(1, 1, At, B1); PG8_BAR;
            PG8_LDB(B0, 1, 0); PG8_SCHED; PG8_LDA(At, 1, 0); PG8_STAGE(PG8_SA(0, 1), a2 + hstep, voffA);
            PG8_WAIT_L(8); PG8_BAR; PG8_WAIT_L(0); PG8_MMA(0, 0, At, B0); PG8_BAR; PG8_SCHED;
            PG8_LDB(B1, 1, 1); PG8_STAGE(PG8_SB(1, 0), b3, voffB);
            PG8_BAR; PG8_WAIT_L(0); PG8_MMA(0, 1, At, B1); PG8_BAR;
            PG8_LDA(At, 1, 1); PG8_STAGE(PG8_SA(1, 0), a3, voffA);
            PG8_BAR; PG8_WAIT_L(0); PG8_MMA(1, 0, At, B0); PG8_BAR; PG8_SCHED;
            PG8_STAGE(PG8_SB(1, 1), b3 + hstep, voffB);
            PG8_WAIT_V(6); PG8_BAR; PG8_MMA(1, 1, At, B1); PG8_BAR;
        }
        PG8_STAMP();
        if constexpr (!Epi::AFTER_DRAIN) { E(acc, cur, wr, wc, fr, fq); S.done(cur); }
        PG8_STAMP();
        if (!has_next) break;
#pragma unroll
        for (int a = 0; a < 2; ++a)
#pragma unroll
            for (int b = 0; b < 2; ++b)
#pragma unroll
                for (int m = 0; m < 4; ++m)
#pragma unroll
                    for (int n = 0; n < 2; ++n) acc[a][b][m][n] = (f32x4){0.f, 0.f, 0.f, 0.f};
        cur = nxt; cA = nA; cB = nB; ++ui;
    }
    PG8_WAIT_V(0);
    if (wr == 0) PG8_BAR;
    PG8_BAR;
    if constexpr (Epi::AFTER_DRAIN) { E.fused(acc, cur, wr, wc, fr, fq, lds, wid, lane); S.done(cur); }
    PG8_STAMP();
    if (STAMP && wid == 0) { stamps[lane] = lane < nts ? (((unsigned long long)(unsigned)ts_hi << 32) | (unsigned)ts_lo) : 0ull;
        if (lane == 62) stamps[62] = rt_entry; if (lane == 63) stamps[63] = (unsigned long long)wall_clock64(); }
#undef PG8_STAMP
#undef PG8_SA
#undef PG8_SB
#undef PG8_STAGE
#undef PG8_LDA
#undef PG8_LDB
#undef PG8_MMA
#undef PG8_WAIT_V
#undef PG8_WAIT_L
#undef PG8_BAR
#undef PG8_SCHED
}
}

struct ProjEpi8 {
    static constexpr bool PERM = true, AFTER_DRAIN = false;
    char* ws; const float* dt_bias;
    __device__ __forceinline__ uint4 rot8(const pg8::f32x4 v0, const pg8::f32x4 v1, const float* tab, float sc) const {
        const float4 c01 = *(const float4*)tab, c23 = *(const float4*)(tab + 4);
        const float o10 = (v0[0] * c01.x - v1[0] * c01.y) * sc, o11 = (v0[1] * c01.z - v1[1] * c01.w) * sc, o12 = (v0[2] * c23.x - v1[2] * c23.y) * sc, o13 = (v0[3] * c23.z - v1[3] * c23.w) * sc;
        const float o20 = (v1[0] * c01.x + v0[0] * c01.y) * sc, o21 = (v1[1] * c01.z + v0[1] * c01.w) * sc, o22 = (v1[2] * c23.x + v0[2] * c23.y) * sc, o23 = (v1[3] * c23.z + v0[3] * c23.w) * sc;
        return make_uint4(pack2(o10, o11), pack2(o12, o13), pack2(o20, o21), pack2(o22, o23));
    }
    template <int SEG> __device__ __forceinline__ void store_row(const pg8::f32x4 v0, const pg8::f32x4 v1, const int cg, const int row) const {
        const int b = row >> 11, t = row & 2047;
        if (SEG == 0) {
            const bool isq = cg < 512; const int head = (cg & 511) >> 6, j = (cg & 63) >> 3;
            bf16_t* dst = (bf16_t*)(ws + (isq ? O_QB : O_KB)) + ((size_t)(b * 8 + head) * 2048 + t) * 64 + 8 * j;
            *(uint4*)dst = rot8(v0, v1, (const float*)(ws + O_CS64) + ((size_t)row * 32 + 4 * j) * 2, isq ? 0.125f * 1.4426950408889634f : 1.f);
        } else if (SEG == 1) {
            bf16_t* dst = (bf16_t*)(ws + O_VT) + ((size_t)(b * 8 + ((cg - 1024) >> 6)) * 64 + (cg & 63)) * 2048 + t;
#pragma unroll
            for (int e = 0; e < 4; ++e) { dst[(size_t)e * 2048] = f2bf(v0[e]); dst[(size_t)(e + 4) * 2048] = f2bf(v1[e]); }
        } else if (SEG == 2) {
            const int j = (cg & 31) >> 3;
            *(uint4*)((bf16_t*)(ws + O_IQB) + ((size_t)row * 8 + ((cg - 1536) >> 5)) * 32 + 8 * j) = rot8(v0, v1, (const float*)(ws + O_CS32) + ((size_t)row * 16 + 4 * j) * 2, 0.17677669529663687f);
        } else if (SEG == 3) {
            if (cg < 1824) {
                const int j = (cg & 31) >> 3;
                *(uint4*)((bf16_t*)(ws + O_IKB) + (size_t)row * 32 + 8 * j) = rot8(v0, v1, (const float*)(ws + O_CS32) + ((size_t)row * 16 + 4 * j) * 2, 1.f);
            } else if (cg == 1824) {
                const float k8 = 0.35355339059327373f; float* d = (float*)(ws + O_IWF) + (size_t)row * 8;
                *(float4*)d = make_float4(v0[0] * k8, v0[1] * k8, v0[2] * k8, v0[3] * k8); *(float4*)(d + 4) = make_float4(v1[0] * k8, v1[1] * k8, v1[2] * k8, v1[3] * k8);
            } else if (cg == 1832) {
                float o[8];
#pragma unroll
                for (int e = 0; e < 4; ++e) { const float a0 = v0[e] + dt_bias[e], a1 = v1[e] + dt_bias[4 + e]; o[e] = (a0 > 20.f) ? a0 : __logf(1.f + __expf(a0)); o[4 + e] = (a1 > 20.f) ? a1 : __logf(1.f + __expf(a1)); }
                float* d = (float*)(ws + O_DTF) + (size_t)row * 8;
                *(float4*)d = make_float4(o[0], o[1], o[2], o[3]); *(float4*)(d + 4) = make_float4(o[4], o[5], o[6], o[7]);
            }
        } else if (SEG == 4) {
            *(uint4*)((bf16_t*)(ws + O_ZB) + (size_t)row * 512 + (cg - ZOFF)) = make_uint4(pack2(v0[0], v0[1]), pack2(v0[2], v0[3]), pack2(v1[0], v1[1]), pack2(v1[2], v1[3]));
        } else {
            bf16_t* dst = (bf16_t*)(ws + O_XBCT) + ((size_t)b * 1024 + (cg - XBCOFF)) * 2048 + t;
#pragma unroll
            for (int e = 0; e < 4; ++e) { dst[(size_t)e * 2048] = f2bf(v0[e]); dst[(size_t)(e + 4) * 2048] = f2bf(v1[e]); }
        }
    }
    template <int SEG, int BJ> __device__ __forceinline__ void rows8(const pg8::f32x4 (&acc)[2][2][4][2], const int cg, const int row0) const {
#pragma unroll
        for (int ai = 0; ai < 2; ++ai)
#pragma unroll
            for (int m = 0; m < 4; ++m) store_row<SEG>(acc[ai][BJ][m][0], acc[ai][BJ][m][1], cg, row0 + ai * 128 + m * 16);
    }
    template <int BJ> __device__ __forceinline__ void half(const pg8::f32x4 (&acc)[2][2][4][2], const pg8::Unit& u, int wr, int wc, int fr, int fq) const {
        const int cw = u.pn * 256 + BJ * 128 + wc * 32;
        const int cg = cw + 8 * fq, row0 = u.pm * 256 + wr * 64 + fr;
        if (cw < 1024) rows8<0, BJ>(acc, cg, row0);
        else if (cw < 1536) rows8<1, BJ>(acc, cg, row0);
        else if (cw < 1792) rows8<2, BJ>(acc, cg, row0);
        else if (cw < 1856) rows8<3, BJ>(acc, cg, row0);
        else if (cw < 2368) rows8<4, BJ>(acc, cg, row0);
        else if (cw < NUSED) rows8<5, BJ>(acc, cg, row0);
    }
    __device__ __forceinline__ void operator()(const pg8::f32x4 (&acc)[2][2][4][2], const pg8::Unit& u, int wr, int wc, int fr, int fq) const {
        half<0>(acc, u, wr, wc, fr, fq); half<1>(acc, u, wr, wc, fr, fq);
    }
};
#ifndef V_EARLY
#define V_EARLY 8192
#endif
template <bool DO_U> __device__ __forceinline__ void convert_rows(const Params& p, size_t i_begin, size_t i_end, int wg, int nwg) {
    unsigned* u8 = (unsigned*)(p.ws + O_U8); unsigned* v8 = (unsigned*)(p.ws + O_V8);
    const size_t gsz = (size_t)nwg * 512;
    for (size_t i0 = i_begin + (size_t)wg * 512 + tid_op(); i0 < i_end; i0 += 8 * gsz) {
        float4 fv[8];
#pragma unroll
        for (int k = 0; k < 8; ++k) { const size_t i = i0 + k * gsz; const size_t ic = i < i_end ? i : i0; fv[k] = ((const float4*)p.v)[ic]; }
#pragma unroll
        for (int k = 0; k < 8; ++k) {
            const size_t i = i0 + k * gsz;
            if (i < i_end) {
                int pv = __builtin_amdgcn_cvt_pk_fp8_f32(fv[k].x, fv[k].y, 0, false); pv = __builtin_amdgcn_cvt_pk_fp8_f32(fv[k].z, fv[k].w, pv, true);
                const size_t e = i >> 8, c4 = i & 255;
                v8[((c4 >> 5) * 16384 + e) * 32 + (c4 & 31)] = (unsigned)pv;
            }
        }
    }
    if (DO_U) {
        for (size_t i0 = (size_t)wg * 512 + tid_op(); i0 < (size_t)16384 * 256; i0 += 8 * gsz) {
            float4 fu[8];
#pragma unroll
            for (int k = 0; k < 8; ++k) { const size_t i = i0 + k * gsz; const size_t ic = i < (size_t)16384 * 256 ? i : i0; fu[k] = ((const float4*)p.u)[ic]; }
#pragma unroll
            for (int k = 0; k < 8; ++k) {
                const size_t i = i0 + k * gsz;
                if (i < (size_t)16384 * 256) {
                    int pk = __builtin_amdgcn_cvt_pk_fp8_f32(fu[k].x * 32.f, fu[k].y * 32.f, 0, false); pk = __builtin_amdgcn_cvt_pk_fp8_f32(fu[k].z * 32.f, fu[k].w * 32.f, pk, true);
                    u8[i] = (unsigned)pk;
                }
            }
        }
    }
}
__device__ __forceinline__ void phase1(const Params& p, char* smem, const XcdMap xm) {
    char* ws = p.ws;
    ProjEpi8 e; e.ws = ws; e.dt_bias = p.dt_bias;
    pg8::Gemm g{(const bf16_t*)(ws + O_XB), (const bf16_t*)(ws + O_WIN_T), NTOK, NP, 1024};
    pg8::StaticOrder S; S.init(NTOK, NP, (int)gridDim.x, (int)blockIdx.x);
    pg8::gemm_phase<ProjEpi8, pg8::StaticOrder, false>((PG8_LAS unsigned char*)smem, g, S, e, nullptr);
    const int G = (int)gridDim.x, first = (64 * (NP / 256)) % G;
    if ((int)blockIdx.x >= first) convert_rows<true>(p, 0, (size_t)V_EARLY * 256, (int)blockIdx.x - first, G - first);
}

#define IDX_NT 16
#define IDX_LDS_SCORES (16 * 2048 * 4)
__device__ __forceinline__ unsigned wave_sum_cnt(unsigned v) {
    v = row_sum_u(v);
    v += (unsigned)dpp_i<0x142, 0xA, false>((int)v);
    v += (unsigned)dpp_i<0x143, 0xC, false>((int)v);
    return (unsigned)__builtin_amdgcn_readlane((int)v, 63);
}
template <int NR> __device__ __forceinline__ unsigned idx_count_ge(const unsigned (&k)[NR], unsigned cand) {
    unsigned n = 0u;
#pragma unroll
    for (int i = 0; i < NR; ++i) n += (k[i] >= cand) ? 1u : 0u;
    return wave_sum_cnt(n);
}
template <int NR> __device__ __forceinline__ unsigned long long idx_words(const unsigned (&k)[NR], unsigned K, bool exact, int lane) {
    unsigned long long wd = 0ull;
    if (exact) {
#pragma unroll
        for (int i = 0; i < NR; ++i) { const unsigned long long bal = __ballot(k[i] >= K); if (lane == i) wd = bal; }
    } else {
        unsigned n = 0u;
#pragma unroll
        for (int i = 0; i < NR; ++i) n += (k[i] > K) ? 1u : 0u;
        unsigned rem = 256u - wave_sum_cnt(n);
#pragma unroll 1
        for (int i = 0; i < NR; ++i) {
            unsigned ki = k[0];
#pragma unroll
            for (int j = 1; j < NR; ++j) ki = (j == i) ? k[j] : ki;
            const unsigned long long gt = __ballot(ki > K), eq = __ballot(ki == K);
            unsigned long long take = 0ull, e = eq;
            while (rem > 0u && e) { take |= e & (~e + 1ull); e &= e - 1ull; --rem; }
            if (lane == i) wd = gt | take;
        }
    }
    return wd;
}
template <int NR> __device__ __forceinline__ void idx_select(const unsigned* Sa, unsigned long long* mrow, int lane) {
    unsigned ka[NR], kb[NR];
#pragma unroll
    for (int i = 0; i < NR; ++i) { ka[i] = Sa[64 * i]; kb[i] = Sa[2048 + 64 * i]; }
    unsigned Ka = 0u, Kb = 0u; bool da = false, db = false;
    for (int bit = 31; bit >= 0; --bit) {
        const unsigned ca = Ka | (1u << bit), cb = Kb | (1u << bit);
        const unsigned ta = idx_count_ge<NR>(ka, ca), tb = idx_count_ge<NR>(kb, cb);
        if (!da && ta >= 256u) { Ka = ca; da = (ta == 256u); }
        if (!db && tb >= 256u) { Kb = cb; db = (tb == 256u); }
        if (da && db) break;
    }
    const unsigned long long wa = idx_words<NR>(ka, Ka, da, lane), wb = idx_words<NR>(kb, Kb, db, lane);
    if (lane < NR) { mrow[lane] = wa; mrow[32 + lane] = wb; }
}
__device__ __forceinline__ void indexer_unit(const Params& p, int unit, char* smem) {
    const int tid = tid_op(), lane = tid & 63, w = tid >> 6, c = lane & 15, g = lane >> 4;
    const int b = unit & 7, grp = 127 - (unit >> 3), t0 = grp * 16;
    char* ws = p.ws;
    unsigned long long* mask64 = (unsigned long long*)(ws + O_MASK) + (size_t)(b * 2048 + t0) * 32;
    const int nblk64 = (t0 + 16 + 63) >> 6;
    if (t0 < 256) {
        for (int i = tid; i < 16 * nblk64; i += 512) {
            const int q = i / nblk64, wd = i % nblk64, t = t0 + q, s0 = wd * 64;
            const unsigned long long bits = (t >= s0 + 63) ? ~0ull : (t < s0 ? 0ull : ((1ull << (t - s0 + 1)) - 1ull));
            mask64[q * 32 + wd] = bits;
        }
        return;
    }
    const int ntile = (nblk64 + 1) >> 1;
    const bf16_t* IQb = (const bf16_t*)(ws + O_IQB); const bf16_t* IKb = (const bf16_t*)(ws + O_IKB); const float* IWf = (const float*)(ws + O_IWF);
    unsigned* S = (unsigned*)smem;
    float* siw = (float*)(smem + IDX_LDS_SCORES);
    __syncthreads();
    if (tid < 128) siw[tid] = IWf[(size_t)(b * 2048 + t0) * 8 + tid];
    {
        const int nr = (nblk64 <= 8) ? 8 : (nblk64 <= 16) ? 16 : (nblk64 <= 24) ? 24 : 32, kfrom = 8 * ntile * 16, kto = nr * 64;
        for (int i = tid; i < 16 * (kto - kfrom); i += 512) { const int q = i / (kto - kfrom), k = kfrom + i % (kto - kfrom); S[q * 2048 + k] = 0u; }
    }
    __syncthreads();
    {
        bf16x8 aq[8];
#pragma unroll
        for (int h = 0; h < 8; ++h) aq[h] = ld8(IQb + ((size_t)(b * 2048 + t0 + c) * 8 + h) * 32 + g * 8);
        float wq[4][8];
#pragma unroll
        for (int r = 0; r < 4; ++r)
#pragma unroll
            for (int h = 0; h < 8; ++h) wq[r][h] = siw[(4 * g + r) * 8 + h];
        bf16x8 bk[IDX_NT];
#pragma unroll
        for (int i = 0; i < IDX_NT; ++i) {
            const int ti = (i < ntile) ? (w * ntile + i) : (w * ntile);
            bk[i] = ld8(IKb + (size_t)(b * 2048 + ti * 16 + c) * 32 + g * 8);
        }
#pragma unroll
        for (int i = 0; i < IDX_NT; ++i) {
            if (i < ntile) {
                const int s0 = (w * ntile + i) * 16;
                float sc[4] = {0.f, 0.f, 0.f, 0.f};
#pragma unroll
                for (int h = 0; h < 8; ++h) {
                    const f32x4 o = mfma16(aq[h], bk[i], (f32x4){0.f, 0.f, 0.f, 0.f});
#pragma unroll
                    for (int r = 0; r < 4; ++r) sc[r] += wq[r][h] * fmaxf(o[r], 0.f);
                }
#pragma unroll
                for (int r = 0; r < 4; ++r) S[(4 * g + r) * 2048 + s0 + c] = (s0 + c <= t0 + 4 * g + r) ? f2sort(sc[r]) : 0u;
            }
        }
    }
    __syncthreads();
    if (nblk64 <= 8) idx_select<8>(S + (2 * w) * 2048 + lane, mask64 + (2 * w) * 32, lane);
    else if (nblk64 <= 16) idx_select<16>(S + (2 * w) * 2048 + lane, mask64 + (2 * w) * 32, lane);
    else if (nblk64 <= 24) idx_select<24>(S + (2 * w) * 2048 + lane, mask64 + (2 * w) * 32, lane);
    else idx_select<32>(S + (2 * w) * 2048 + lane, mask64 + (2 * w) * 32, lane);
}

__device__ __forceinline__ void ssd_conv8(const u32x4g cur, const u32x4g prv, const float w0, const float w1, const float w2, const float w3, const float bias, float (&o)[8]) {
    float xv[11];
    xv[0] = bf2f((bf16_t)(prv.z >> 16)); xv[1] = bf2f((bf16_t)(prv.w & 0xFFFF)); xv[2] = bf2f((bf16_t)(prv.w >> 16));
    xv[3] = bf2f((bf16_t)(cur.x & 0xFFFF)); xv[4] = bf2f((bf16_t)(cur.x >> 16)); xv[5] = bf2f((bf16_t)(cur.y & 0xFFFF)); xv[6] = bf2f((bf16_t)(cur.y >> 16));
    xv[7] = bf2f((bf16_t)(cur.z & 0xFFFF)); xv[8] = bf2f((bf16_t)(cur.z >> 16)); xv[9] = bf2f((bf16_t)(cur.w & 0xFFFF)); xv[10] = bf2f((bf16_t)(cur.w >> 16));
#pragma unroll
    for (int j = 0; j < 8; ++j) { const float v = bias + w0 * xv[j] + w1 * xv[j + 1] + w2 * xv[j + 2] + w3 * xv[j + 3]; o[j] = bf2f(f2bf(silu_f(v))); }
}
__device__ __forceinline__ void ssd_prep_unit(const Params& p, int unit, char* smem) {
    const int tid = tid_op(), lane = tid & 63, w = tid >> 6, cL = lane & 15, gq = lane >> 4;
    const int g = unit & 1, c = (unit >> 1) & 15, b = unit >> 5;
    char* ws = p.ws;
    float* s_acum = (float*)smem; float* s_dt = s_acum + 512; float* s_w = s_dt + 512; float* s_tot = s_w + 512;
    bf16_t* sBt = (bf16_t*)(smem + 6144 + 64); bf16_t* sXw = sBt + 128 * 136; bf16_t* sCt = sXw;
    s_tot = (float*)(smem + 6144);
    const int tok0 = b * 2048 + c * 128;
    const bf16_t* XBCt = (const bf16_t*)(ws + O_XBCT);
    bf16_t* Xt = (bf16_t*)(ws + O_XT); bf16_t* Brm = (bf16_t*)(ws + O_BRM); bf16_t* Crm = (bf16_t*)(ws + O_CRM);
    __syncthreads();
    u32x4g cur8[8], prv8[8]; float cw8[8][5];
    const bool hasprev0 = (c * 128 >= 8);
#pragma unroll
    for (int it = 0; it < 8; ++it) {
        const int item = tid + 512 * it, tc = item & 15, ch = 512 + ((item >> 4) & 128) * 2 + g * 128 + ((item >> 4) & 127);
        const bf16_t* src = XBCt + ((size_t)b * 1024 + ch) * 2048 + c * 128 + tc * 8;
        cur8[it] = *(const u32x4g*)src;
        const bool hasprev = hasprev0 || tc > 0;
        prv8[it] = *(const u32x4g*)(hasprev ? src - 8 : src);
        if (!hasprev) prv8[it] = (u32x4g){0u, 0u, 0u, 0u};
        cw8[it][0] = p.conv_w[ch]; cw8[it][1] = p.conv_w[1024 + ch]; cw8[it][2] = p.conv_w[2048 + ch]; cw8[it][3] = p.conv_w[3072 + ch]; cw8[it][4] = p.conv_b[ch];
    }
    {
        const int hh = tid >> 7, l = tid & 127, h = 4 * g + hh;
        const float a_h = -expf(p.a_log[h]);
        const float dtv = ((const float*)(ws + O_DTF))[(size_t)(tok0 + l) * 8 + h];
        float v = dtv * a_h;
#pragma unroll
        for (int d = 1; d < 64; d <<= 1) { const float t = __shfl_up(v, d); if (lane >= d) v += t; }
        if (lane == 63) s_tot[w] = v;
        __syncthreads();
        if (w & 1) v += s_tot[w - 1];
        const float tot = s_tot[2 * hh] + s_tot[2 * hh + 1];
        s_acum[tid] = v; s_dt[tid] = dtv; s_w[tid] = dtv * __expf(tot - v);
        ((float*)(ws + O_ACUM))[(size_t)(b * 8 + h) * 2048 + c * 128 + l] = v;
        if (l == 0) ((float*)(ws + O_ATOT))[(b * 8 + h) * 16 + c] = tot;
    }
#pragma unroll
    for (int it = 0; it < 8; ++it) {
        const int item = tid + 512 * it, tc = item & 15, n = (item >> 4) & 127;
        float o[8];
        ssd_conv8(cur8[it], prv8[it], cw8[it][0], cw8[it][1], cw8[it][2], cw8[it][3], cw8[it][4], o);
        bf16_t* dst = ((item >> 4) & 128) ? sCt : sBt;
        *(uint4*)(dst + n * 136 + tc * 8) = make_uint4(pack2(o[0], o[1]), pack2(o[2], o[3]), pack2(o[4], o[5]), pack2(o[6], o[7]));
    }
#pragma unroll
    for (int it = 0; it < 8; ++it) {
        const int item = tid + 512 * it, tc = item & 15, ch = g * 256 + (item >> 4);
        const bf16_t* src = XBCt + ((size_t)b * 1024 + ch) * 2048 + c * 128 + tc * 8;
        cur8[it] = *(const u32x4g*)src;
        const bool hasprev = hasprev0 || tc > 0;
        prv8[it] = *(const u32x4g*)(hasprev ? src - 8 : src);
        if (!hasprev) prv8[it] = (u32x4g){0u, 0u, 0u, 0u};
        cw8[it][0] = p.conv_w[ch]; cw8[it][1] = p.conv_w[1024 + ch]; cw8[it][2] = p.conv_w[2048 + ch]; cw8[it][3] = p.conv_w[3072 + ch]; cw8[it][4] = p.conv_b[ch];
    }
    __syncthreads();
    {
        const int t = tid & 127, cb = tid >> 7;
#pragma unroll
        for (int m = 0; m < 2; ++m) {
            const bf16_t* srcT = (m ? sCt : sBt) + (cb * 32) * 136 + t;
            bf16_t* dst = (m ? Crm : Brm) + (size_t)(tok0 + t) * 256 + g * 128 + cb * 32;
#pragma unroll
            for (int q = 0; q < 4; ++q) {
                unsigned wv[4];
#pragma unroll
                for (int k = 0; k < 4; ++k) wv[k] = (unsigned)srcT[(8 * q + 2 * k) * 136] | ((unsigned)srcT[(8 * q + 2 * k + 1) * 136] << 16);
                *(uint4*)(dst + 8 * q) = make_uint4(wv[0], wv[1], wv[2], wv[3]);
            }
        }
    }
    __syncthreads();
#pragma unroll
    for (int it = 0; it < 8; ++it) {
        const int item = tid + 512 * it, tc = item & 15, hp = item >> 4, ch = g * 256 + hp;
        float o[8];
        ssd_conv8(cur8[it], prv8[it], cw8[it][0], cw8[it][1], cw8[it][2], cw8[it][3], cw8[it][4], o);
        *(uint4*)(Xt + ((size_t)b * 512 + ch) * 2048 + c * 128 + tc * 8) = make_uint4(pack2(o[0], o[1]), pack2(o[2], o[3]), pack2(o[4], o[5]), pack2(o[6], o[7]));
        const float* sw = s_w + (hp >> 6) * 128 + tc * 8;
        float q[8];
#pragma unroll
        for (int j = 0; j < 8; ++j) q[j] = o[j] * sw[j];
        *(uint4*)(sXw + hp * 136 + tc * 8) = make_uint4(pack2(q[0], q[1]), pack2(q[2], q[3]), pack2(q[4], q[5]), pack2(q[6], q[7]));
    }
    __syncthreads();
    bf16x8 bb[4];
#pragma unroll
    for (int ks = 0; ks < 4; ++ks) bb[ks] = ld8(sBt + (16 * w + cL) * 136 + ks * 32 + gq * 8);
#pragma unroll
    for (int hh = 0; hh < 4; ++hh) {
        f32x4 acc[4];
#pragma unroll
        for (int i = 0; i < 4; ++i) acc[i] = (f32x4){0.f, 0.f, 0.f, 0.f};
#pragma unroll
        for (int ks = 0; ks < 4; ++ks)
#pragma unroll
            for (int pt = 0; pt < 4; ++pt) acc[pt] = mfma16(ld8(sXw + (hh * 64 + 16 * pt + cL) * 136 + ks * 32 + gq * 8), bb[ks], acc[pt]);
        float* ST = (float*)(ws + O_ST) + ((size_t)((b * 16 + c) * 8 + 4 * g + hh)) * 8192;
#pragma unroll
        for (int pt = 0; pt < 4; ++pt)
#pragma unroll
            for (int r = 0; r < 4; ++r) ST[(16 * pt + 4 * gq + r) * 128 + 16 * w + cL] = acc[pt][r];
    }
}

__device__ __forceinline__ void phase2c(const Params& p) {
    char* ws = p.ws;
    const int idx = blockIdx.x * 512 + tid_op();
    if (idx >= 64 * 2048) return;
    const int bh = idx >> 11, e4 = idx & 2047, b = bh >> 3, h = bh & 7;
    const float* ST = (const float*)(ws + O_ST); const float* ATOT = (const float*)(ws + O_ATOT);
    float4 sv[16]; float4 at4[4];
#pragma unroll
    for (int c = 0; c < 16; ++c) sv[c] = *(const float4*)(ST + ((size_t)((b * 16 + c) * 8 + h)) * 8192 + (size_t)e4 * 4);
#pragma unroll
    for (int k = 0; k < 4; ++k) at4[k] = *(const float4*)(ATOT + bh * 16 + 4 * k);
    const float at[16] = {at4[0].x, at4[0].y, at4[0].z, at4[0].w, at4[1].x, at4[1].y, at4[1].z, at4[1].w, at4[2].x, at4[2].y, at4[2].z, at4[2].w, at4[3].x, at4[3].y, at4[3].z, at4[3].w};
    float4 car = make_float4(0.f, 0.f, 0.f, 0.f);
    bf16_t* CAR = (bf16_t*)(ws + O_CAR);
#pragma unroll
    for (int c = 0; c < 16; ++c) {
        *(uint2*)(CAR + ((size_t)((b * 16 + c) * 8 + h)) * 8192 + (size_t)e4 * 4) = make_uint2(pack2(car.x, car.y), pack2(car.z, car.w));
        const float dec = __expf(at[c]);
        car.x = dec * car.x + sv[c].x; car.y = dec * car.y + sv[c].y; car.z = dec * car.z + sv[c].z; car.w = dec * car.w + sv[c].w;
    }
}

#define ATT_LDK 80
#define ATT_LDV 136
#define ATT_KBYTES (128 * ATT_LDK * 2)
#define ATT_VBYTES (64 * ATT_LDV * 2)
__device__ __forceinline__ void attn_unit(const Params& p, int unit, char* smem) {
    const int tid = tid_op(), lane = tid & 63, w = tid >> 6, cL = lane & 15, gq = lane >> 4;
    const int qb = 15 - (unit >> 6), bh = unit & 63, b = bh >> 3, h = bh & 7;
    char* ws = p.ws;
    const int q0 = qb * 128 + 16 * w;
    const int ntile = qb + 1;
    const int wmax = (q0 + 15) >> 6;
    const bf16_t* Q = (const bf16_t*)(ws + O_QB) + (size_t)bh * 2048 * 64;
    const bf16_t* Kp = (const bf16_t*)(ws + O_KB) + (size_t)bh * 2048 * 64;
    const bf16_t* V = (const bf16_t*)(ws + O_VT) + (size_t)bh * 64 * 2048;
    const unsigned long long* mrow = (const unsigned long long*)(ws + O_MASK) + (size_t)(b * 2048 + q0 + cL) * 32;
    const int lr = tid >> 3, lc = (tid & 7) * 8;
    bf16x8 qf[2];
    qf[0] = ld8(Q + (size_t)(q0 + cL) * 64 + gq * 8); qf[1] = ld8(Q + (size_t)(q0 + cL) * 64 + 32 + gq * 8);
    float m_run = -1e30f, l_run = 0.f;
    f32x4 o[4];
#pragma unroll
    for (int i = 0; i < 4; ++i) o[i] = (f32x4){0.f, 0.f, 0.f, 0.f};
    char* sK = smem; char* sV = smem + 2 * ATT_KBYTES;
#define ATT_GLOAD(T, K0, K1, V0, V1) { const int s_ = (T) * 128; \
        K0 = *(const u32x4g*)(Kp + (size_t)(s_ + lr) * 64 + lc); K1 = *(const u32x4g*)(Kp + (size_t)(s_ + 64 + lr) * 64 + lc); \
        V0 = *(const u32x4g*)(V + (size_t)lr * 2048 + s_ + lc); V1 = *(const u32x4g*)(V + (size_t)lr * 2048 + s_ + 64 + lc); }
#define ATT_LSTORE(BUF, K0, K1, V0, V1) { bf16_t* k_ = (bf16_t*)(sK + (BUF) * ATT_KBYTES); bf16_t* v_ = (bf16_t*)(sV + (BUF) * ATT_VBYTES); \
        *(u32x4g*)(k_ + lr * ATT_LDK + lc) = K0; *(u32x4g*)(k_ + (64 + lr) * ATT_LDK + lc) = K1; \
        *(u32x4g*)(v_ + lr * ATT_LDV + lc) = V0; *(u32x4g*)(v_ + lr * ATT_LDV + 64 + lc) = V1; }
    u32x4g ka0, ka1, va0, va1, kb0, kb1, vb0, vb1;
    ATT_GLOAD(0, ka0, ka1, va0, va1)
    { const int t1 = (ntile > 1) ? 1 : 0; ATT_GLOAD(t1, kb0, kb1, vb0, vb1) }
    unsigned long long nmb0 = mrow[0], nmb1 = mrow[1];
    __syncthreads();
    ATT_LSTORE(0, ka0, ka1, va0, va1)
    __syncthreads();
    for (int kt = 0; kt < ntile; ++kt) {
        const int cur = kt & 1;
        ka0 = kb0; ka1 = kb1; va0 = vb0; va1 = vb1;
        { const int t2 = (kt + 2 < ntile) ? kt + 2 : ntile - 1; ATT_GLOAD(t2, kb0, kb1, vb0, vb1) }
        {
            const bf16_t* tK = (const bf16_t*)(sK + cur * ATT_KBYTES); const bf16_t* tV = (const bf16_t*)(sV + cur * ATT_VBYTES);
            const unsigned long long mb0 = (2 * kt <= wmax) ? nmb0 : 0ull, mb1 = (2 * kt + 1 <= wmax) ? nmb1 : 0ull;
            { const int tn = (kt + 1 < ntile) ? kt + 1 : kt; nmb0 = mrow[2 * tn]; nmb1 = mrow[2 * tn + 1]; }
            f32x4 st[8];
#pragma unroll
            for (int j = 0; j < 8; ++j) {
                f32x4 a = (f32x4){0.f, 0.f, 0.f, 0.f};
                const bf16_t* kr = tK + (16 * j + cL) * ATT_LDK + gq * 8;
                a = mfma16(ld8(kr), qf[0], a); a = mfma16(ld8(kr + 32), qf[1], a);
                st[j] = a;
            }
            float mx = m_run;
            const unsigned mw[4] = {(unsigned)mb0 >> (4 * gq), (unsigned)(mb0 >> 32) >> (4 * gq), (unsigned)mb1 >> (4 * gq), (unsigned)(mb1 >> 32) >> (4 * gq)};
#pragma unroll
            for (int j = 0; j < 8; ++j)
#pragma unroll
                for (int r = 0; r < 4; ++r) {
                    const bool bit = (mw[j >> 1] & (1u << (16 * (j & 1) + r))) != 0u;
                    const float v = bit ? st[j][r] : -INFINITY;
                    st[j][r] = v; mx = fmaxf(mx, v);
                }
            mx = max_x32(max_x16(mx));
            const float alpha = __builtin_amdgcn_exp2f(m_run - mx); m_run = mx;
            float ls = 0.f;
#pragma unroll
            for (int j = 0; j < 8; ++j)
#pragma unroll
                for (int r = 0; r < 4; ++r) { const float pv = __builtin_amdgcn_exp2f(st[j][r] - mx); st[j][r] = pv; ls += pv; }
            ls = sum_x32(sum_x16(ls));
            l_run = l_run * alpha + ls;
#pragma unroll
            for (int i = 0; i < 4; ++i) o[i] = o[i] * alpha;
#pragma unroll
            for (int kk = 0; kk < 4; ++kk) {
                bf16x8 pf;
#pragma unroll
                for (int r = 0; r < 4; ++r) { pf[r] = (short)f2bf(st[2 * kk][r]); pf[4 + r] = (short)f2bf(st[2 * kk + 1][r]); }
#pragma unroll
                for (int dt = 0; dt < 4; ++dt) {
                    const bf16_t* vr = tV + (16 * dt + cL) * ATT_LDV + 32 * kk + 4 * gq;
                    o[dt] = mfma16(cat4(*(const bf16x4*)vr, *(const bf16x4*)(vr + 16)), pf, o[dt]);
                }
            }
        }
        if (kt + 1 < ntile) ATT_LSTORE(cur ^ 1, ka0, ka1, va0, va1)
        __syncthreads();
    }
#undef ATT_GLOAD
#undef ATT_LSTORE
    const float inv = 1.f / l_run;
    bf16_t* mix = (bf16_t*)(ws + O_MIX) + (size_t)(b * 2048 + q0 + cL) * 1024 + h * 64;
#pragma unroll
    for (int dt = 0; dt < 4; ++dt)
        *(uint2*)(mix + 16 * dt + 4 * gq) = make_uint2(pack2(o[dt][0] * inv, o[dt][1] * inv), pack2(o[dt][2] * inv, o[dt][3] * inv));
}

#define SSM_TILE (128 * 136 * 2)
struct SsdPair { u32x4g x[4], car[4], z[4]; };
__device__ __forceinline__ void ssd_pair_load(SsdPair& P, const char* ws, int b, int c, int g, int pr, int tid) {
    const int row0 = tid >> 4, c16 = tid & 15;
    const int tok0 = b * 2048 + c * 128;
#pragma unroll
    for (int k = 0; k < 4; ++k) {
        const int row = row0 + 32 * k;
        const int h = 4 * g + 2 * pr + (row >> 6), pp = row & 63;
        P.x[k] = *(const u32x4g*)((const bf16_t*)(ws + O_XT) + ((size_t)b * 512 + h * 64 + pp) * 2048 + c * 128 + c16 * 8);
        P.car[k] = *(const u32x4g*)((const bf16_t*)(ws + O_CAR) + ((size_t)((b * 16 + c) * 8 + h)) * 8192 + pp * 128 + c16 * 8);
        P.z[k] = *(const u32x4g*)((const bf16_t*)(ws + O_ZB) + (size_t)(tok0 + row) * 512 + (4 * g + 2 * pr) * 64 + c16 * 8);
    }
}
__device__ __forceinline__ void ssd_pair_store(const SsdPair& P, char* tiles, int tid) {
    const int row0 = tid >> 4, c16 = tid & 15;
#pragma unroll
    for (int k = 0; k < 4; ++k) {
        const int off = ((row0 + 32 * k) * 136 + c16 * 8) * 2;
        *(u32x4g*)(tiles + off) = P.x[k]; *(u32x4g*)(tiles + SSM_TILE + off) = P.car[k]; *(u32x4g*)(tiles + 2 * SSM_TILE + off) = P.z[k];
    }
}
__device__ __forceinline__ void ssd_main_unit(const Params& p, int unit, char* smem) {
    const int tid = tid_op(), lane = tid & 63, w = tid >> 6, cL = lane & 15, gq = lane >> 4;
    const int g = unit & 1, c = (unit >> 1) & 15, b = unit >> 5;
    char* ws = p.ws;
    float* sAc = (float*)smem;
    float* sDt = sAc + 512;
    char* tiles = smem + 4096;
    const int tok0 = b * 2048 + c * 128;
    const int lt = (w < 4) ? w : 11 - w;
    const int ltok = tok0 + 16 * lt + cL;
    __syncthreads();
    SsdPair P;
    {
        const int row0 = tid >> 4, c16 = tid & 15;
        u32x4g bv[4], cv[4];
#pragma unroll
        for (int k = 0; k < 4; ++k) {
            const size_t go = (size_t)(tok0 + row0 + 32 * k) * 256 + g * 128 + c16 * 8;
            bv[k] = *(const u32x4g*)((const bf16_t*)(ws + O_BRM) + go); cv[k] = *(const u32x4g*)((const bf16_t*)(ws + O_CRM) + go);
        }
        const int hh = tid >> 7, l = tid & 127;
        const float av = ((const float*)(ws + O_ACUM))[(size_t)(b * 8 + 4 * g + hh) * 2048 + c * 128 + l];
        const float dv = ((const float*)(ws + O_DTF))[(size_t)(tok0 + l) * 8 + 4 * g + hh];
        ssd_pair_load(P, ws, b, c, g, 0, tid);
#pragma unroll
        for (int k = 0; k < 4; ++k) {
            const int off = ((row0 + 32 * k) * 136 + c16 * 8) * 2;
            *(u32x4g*)(tiles + off) = bv[k]; *(u32x4g*)(tiles + SSM_TILE + off) = cv[k];
        }
        sAc[tid] = av; sDt[tid] = dv;
    }
    __syncthreads();
    bf16x8 Cq[4];
    f32x4 cbT[8];
    {
        const bf16_t* sB = (const bf16_t*)tiles; const bf16_t* sC = (const bf16_t*)(tiles + SSM_TILE);
#pragma unroll
        for (int ks = 0; ks < 4; ++ks) Cq[ks] = ld8(sC + (16 * lt + cL) * 136 + ks * 32 + gq * 8);
#pragma unroll
        for (int st = 0; st < 8; ++st) {
            cbT[st] = (f32x4){0.f, 0.f, 0.f, 0.f};
            if (st <= lt) {
#pragma unroll
                for (int ks = 0; ks < 4; ++ks) cbT[st] = mfma16(ld8(sB + (16 * st + cL) * 136 + ks * 32 + gq * 8), Cq[ks], cbT[st]);
            }
        }
    }
    __syncthreads();
    float ssq = 0.f;
    u32x4g y0raw[4] = {};
    float* s_rstd = (float*)(tiles + 3 * SSM_TILE);
    bf16_t* mix = (bf16_t*)(ws + O_MIX);
#pragma unroll
    for (int pr = 0; pr < 2; ++pr) {
        if (pr) {
            ssd_pair_load(P, ws, b, c, g, 1, tid);
            __syncthreads();
#pragma unroll
            for (int k = 0; k < 4; ++k) y0raw[k] = *(const u32x4g*)(tiles + 2 * SSM_TILE + (((tid >> 4) + 32 * k) * 136 + (tid & 15) * 8) * 2);
            __syncthreads();
        }
        ssd_pair_store(P, tiles, tid);
        __syncthreads();
        const bf16_t* sX = (const bf16_t*)tiles; const bf16_t* sCar = (const bf16_t*)(tiles + SSM_TILE); const bf16_t* sZ = (const bf16_t*)(tiles + 2 * SSM_TILE);
#pragma unroll 1
        for (int h2 = 0; h2 < 2; ++h2) {
            const int hh = 2 * pr + h2, h = 4 * g + hh;
            const float* ac = sAc + hh * 128; const float* dtl = sDt + hh * 128;
            const float al = ac[16 * lt + cL];
            const bf16_t* xh = sX + h2 * 64 * 136; const bf16_t* carh = sCar + h2 * 64 * 136;
            f32x4 acc1[4], acc2[4];
#pragma unroll
            for (int i = 0; i < 4; ++i) { acc1[i] = (f32x4){0.f, 0.f, 0.f, 0.f}; acc2[i] = (f32x4){0.f, 0.f, 0.f, 0.f}; }
#pragma unroll
            for (int kk = 0; kk < 4; ++kk) {
                if (2 * kk <= lt) {
                    bf16x8 mf;
#pragma unroll
                    for (int half = 0; half < 2; ++half) {
                        const int st = 2 * kk + half;
#pragma unroll
                        for (int r = 0; r < 4; ++r) {
                            const int sl = 16 * st + 4 * gq + r;
                            float v = 0.f;
                            if (st <= lt && sl <= 16 * lt + cL) v = cbT[st][r] * __expf(al - ac[sl]) * dtl[sl];
                            mf[half * 4 + r] = (short)f2bf(v);
                        }
                    }
#pragma unroll
                    for (int pt = 0; pt < 4; ++pt) {
                        const bf16_t* xr = xh + (16 * pt + cL) * 136 + 32 * kk + 4 * gq;
                        acc1[pt] = mfma16(cat4(*(const bf16x4*)xr, *(const bf16x4*)(xr + 16)), mf, acc1[pt]);
                    }
                }
            }
#pragma unroll
            for (int ks = 0; ks < 4; ++ks)
#pragma unroll
                for (int pt = 0; pt < 4; ++pt) acc2[pt] = mfma16(ld8(carh + (16 * pt + cL) * 136 + ks * 32 + gq * 8), Cq[ks], acc2[pt]);
            const float el = __expf(al), dsk = p.d_skip[h];
#pragma unroll
            for (int pt = 0; pt < 4; ++pt) {
                const uint2 zz = *(const uint2*)(sZ + (16 * lt + cL) * 136 + h2 * 64 + 16 * pt + 4 * gq);
                const float zf[4] = {bf2f((bf16_t)(zz.x & 0xFFFF)), bf2f((bf16_t)(zz.x >> 16)), bf2f((bf16_t)(zz.y & 0xFFFF)), bf2f((bf16_t)(zz.y >> 16))};
                float yv[4];
#pragma unroll
                for (int r = 0; r < 4; ++r) {
                    const float xs = bf2f(xh[(16 * pt + 4 * gq + r) * 136 + 16 * lt + cL]);
                    float t = acc1[pt][r] + el * acc2[pt][r] + xs * dsk;
                    t *= silu_f(zf[r]);
                    yv[r] = bf2f(f2bf(t)); ssq += t * t;
                }
                *(uint2*)((bf16_t*)(tiles + 2 * SSM_TILE) + (16 * lt + cL) * 136 + h2 * 64 + 16 * pt + 4 * gq) = make_uint2(pack2(yv[0], yv[1]), pack2(yv[2], yv[3]));
            }
        }
    }
    ssq = sum_x32(sum_x16(ssq));
    if (gq == 0) s_rstd[16 * lt + cL] = rsqrtf(ssq * (1.f / 256.f) + LN_EPS);
    __syncthreads();
    {
        const int row0 = tid >> 4, c16 = tid & 15;
#pragma unroll
        for (int pr = 0; pr < 2; ++pr) {
            const int ch = (4 * g + 2 * pr) * 64 + c16 * 8;
            const float4 n0 = *(const float4*)(p.norm_w + ch), n1 = *(const float4*)(p.norm_w + ch + 4);
#pragma unroll
            for (int k = 0; k < 4; ++k) {
                const int row = row0 + 32 * k;
                const u32x4g y = pr ? *(const u32x4g*)(tiles + 2 * SSM_TILE + (row * 136 + c16 * 8) * 2) : y0raw[k];
                const float rs = s_rstd[row];
                u32x4g o;
                o.x = pack2(__uint_as_float(y.x << 16) * rs * n0.x, __uint_as_float(y.x & 0xFFFF0000u) * rs * n0.y);
                o.y = pack2(__uint_as_float(y.y << 16) * rs * n0.z, __uint_as_float(y.y & 0xFFFF0000u) * rs * n0.w);
                o.z = pack2(__uint_as_float(y.z << 16) * rs * n1.x, __uint_as_float(y.z & 0xFFFF0000u) * rs * n1.y);
                o.w = pack2(__uint_as_float(y.w << 16) * rs * n1.z, __uint_as_float(y.w & 0xFFFF0000u) * rs * n1.w);
                *(u32x4g*)(mix + (size_t)(tok0 + row) * 1024 + 512 + ch) = o;
            }
        }
    }
}

__device__ __forceinline__ void phase2(const Params& p, char* smem, int which = 3) {
    const int G = gridDim.x;
    if (which & 2) for (int u = blockIdx.x; u < 256; u += G) ssd_prep_unit(p, u, smem);
    if (which & 1) for (int k = 0; k * G < 1024; ++k) {
        const int u = k * G + ((k & 1) ? (G - 1 - (int)blockIdx.x) : (int)blockIdx.x);
        if (u < 1024) indexer_unit(p, u, smem);
    }
}
__device__ __forceinline__ void phase3(const Params& p, char* smem, int which = 3) {
    const int G = gridDim.x;
    for (int k = 0; k * G < 1024 + 256; ++k) {
        const int u = k * G + ((k & 1) ? (G - 1 - (int)blockIdx.x) : (int)blockIdx.x);
        if (u >= 1024 + 256) continue;
        if (u < 256) { if (which & 1) ssd_main_unit(p, u, smem); } else { if (which & 2) attn_unit(p, u - 256, smem); }
    }
}

struct OutEpi {
    const float* x; float* y;
    __device__ __forceinline__ void operator()(const f32x4 (&acc)[4][4], int mb, int nb, int lane, char* lds) const {
        const int c = lane & 15, g = lane >> 4;
        float* L = (float*)lds;
#pragma unroll
        for (int half = 0; half < 2; ++half) {
#pragma unroll
            for (int mi2 = 0; mi2 < 2; ++mi2)
#pragma unroll
                for (int r = 0; r < 4; ++r)
#pragma unroll
                    for (int ni = 0; ni < 4; ++ni) L[(16 * mi2 + 4 * g + r) * 68 + 16 * ni + c] = acc[2 * half + mi2][ni][r];
#pragma unroll
            for (int i = 0; i < 8; ++i) {
                const int row = 4 * i + g;
                const float4 a = *(const float4*)(L + row * 68 + 4 * c);
                const size_t o = (size_t)(mb + 32 * half + row) * 1024 + nb + 4 * c;
                const float4 xv = *(const float4*)(x + o);
                *(float4*)(y + o) = make_float4(ALPHA * xv.x + a.x, ALPHA * xv.y + a.y, ALPHA * xv.z + a.z, ALPHA * xv.w + a.w);
            }
        }
    }
};
__device__ __forceinline__ void phase4(const Params& p, char* smem, const XcdMap xm) {
    pg8::Gemm g{(const bf16_t*)(p.ws + O_MIX), (const bf16_t*)(p.ws + O_WOUT_T), NTOK, 1024, 1024};
    pg8::StaticOrder S; S.init(NTOK, 1024, (int)gridDim.x, (int)blockIdx.x);
    pg8::EpiResBf16 E{(bf16_t*)(p.ws + O_HB), p.x, 1024, ALPHA};
    pg8::gemm_phase<pg8::EpiResBf16, pg8::StaticOrder, false>((PG8_LAS unsigned char*)smem, g, S, E, nullptr);
}

__device__ __forceinline__ void phase5(const Params& p) {
    const int lane = tid_op() & 63, w = tid_op() >> 6;
    bf16_t* hb = (bf16_t*)(p.ws + O_HB);
    for (int row = blockIdx.x * 8 + w; row < NTOK; row += gridDim.x * 8) {
        bf16_t* yr = hb + (size_t)row * 1024 + 8 * lane;
        float v[16]; float s = 0.f;
#pragma unroll
        for (int j = 0; j < 2; ++j) {
            const uint4 r = *(const uint4*)(yr + 512 * j);
            const unsigned rw[4] = {r.x, r.y, r.z, r.w};
#pragma unroll
            for (int k = 0; k < 4; ++k) { v[8 * j + 2 * k] = __uint_as_float(rw[k] << 16); v[8 * j + 2 * k + 1] = __uint_as_float(rw[k] & 0xFFFF0000u); }
        }
#pragma unroll
        for (int k = 0; k < 16; ++k) s += v[k];
        const float mean = wave_sum(s) * (1.f / 1024.f);
        float q = 0.f;
#pragma unroll
        for (int k = 0; k < 16; ++k) { const float a = v[k] - mean; q += a * a; }
        const float rstd = rsqrtf(wave_sum(q) * (1.f / 1024.f) + LN_EPS);
#pragma unroll
        for (int j = 0; j < 2; ++j) {
            const int col = 8 * lane + 512 * j;
            const float4 g0 = *(const float4*)(p.ln1_g + col), g1 = *(const float4*)(p.ln1_g + col + 4), b0 = *(const float4*)(p.ln1_b + col), b1 = *(const float4*)(p.ln1_b + col + 4);
            const float gg[8] = {g0.x, g0.y, g0.z, g0.w, g1.x, g1.y, g1.z, g1.w}, bb[8] = {b0.x, b0.y, b0.z, b0.w, b1.x, b1.y, b1.z, b1.w};
            float o[8];
#pragma unroll
            for (int k = 0; k < 8; ++k) o[k] = (v[8 * j + k] - mean) * rstd * gg[k] + bb[k];
            *(uint4*)(yr + 512 * j) = make_uint4(pack2(o[0], o[1]), pack2(o[2], o[3]), pack2(o[4], o[5]), pack2(o[6], o[7]));
        }
    }
    convert_rows<false>(p, (size_t)V_EARLY * 256, (size_t)16384 * 256, (int)blockIdx.x, (int)gridDim.x);
}

struct QpEpi {
    bf16_t* qp;
    __device__ __forceinline__ void operator()(const f32x4 (&acc)[4][4], int mb, int nb, int lane, char* lds) const {
        const int c = lane & 15, g = lane >> 4;
        bf16_t* L = (bf16_t*)lds;
#pragma unroll
        for (int mi = 0; mi < 4; ++mi)
#pragma unroll
            for (int r = 0; r < 4; ++r)
#pragma unroll
                for (int ni = 0; ni < 4; ++ni) L[(16 * mi + 4 * g + r) * 72 + 16 * ni + c] = f2bf(acc[mi][ni][r]);
#pragma unroll
        for (int i = 0; i < 8; ++i) {
            const int row = 8 * i + (lane >> 3), cc = (lane & 7) * 8;
            *(uint4*)(qp + (size_t)(mb + row) * 2048 + nb + cc) = *(const uint4*)(L + row * 72 + cc);
        }
    }
};
__device__ __forceinline__ void phase6(const Params& p, char* smem, const XcdMap xm) {
    pg8::Gemm g{(const bf16_t*)(p.ws + O_HB), (const bf16_t*)(p.ws + O_WQ_T), NTOK, 2048, 1024};
    pg8::StaticOrder S; S.init(NTOK, 2048, (int)gridDim.x, (int)blockIdx.x);
    pg8::EpiBf16Plain E{(bf16_t*)(p.ws + O_QP), 2048};
    pg8::gemm_phase<pg8::EpiBf16Plain, pg8::StaticOrder, false>((PG8_LAS unsigned char*)smem, g, S, E, nullptr);
}

__device__ __forceinline__ float gelu_erf(float d) { return 0.5f * d * (1.f + erff(d * 0.70710678118654752f)); }
typedef unsigned u32x4n __attribute__((ext_vector_type(4)));
__device__ __forceinline__ long lo64n(const u32x4n v) { return (long)(((unsigned long long)v.y << 32) | v.x); }
__device__ __forceinline__ long hi64n(const u32x4n v) { return (long)(((unsigned long long)v.w << 32) | v.z); }
struct P8aRows { u32x4n a[16]; };
__device__ __forceinline__ void p8a_load(P8aRows& R, const unsigned char* U8, int eid, int gq) {
    const unsigned char* urow = U8 + (size_t)eid * 1024 + 16 * gq;
#pragma unroll
    for (int j = 0; j < 16; ++j) R.a[j] = *(const u32x4n*)(urow + 64 * j);
}
__device__ __forceinline__ float p8_dot16(const u32x4n r, const f32x2 (&hp)[8]) {
    f32x2 acc = __builtin_amdgcn_cvt_pk_f32_fp8((int)r.x, false) * hp[0];
    acc += __builtin_amdgcn_cvt_pk_f32_fp8((int)r.x, true) * hp[1];
    acc += __builtin_amdgcn_cvt_pk_f32_fp8((int)r.y, false) * hp[2]; acc += __builtin_amdgcn_cvt_pk_f32_fp8((int)r.y, true) * hp[3];
    acc += __builtin_amdgcn_cvt_pk_f32_fp8((int)r.z, false) * hp[4]; acc += __builtin_amdgcn_cvt_pk_f32_fp8((int)r.z, true) * hp[5];
    acc += __builtin_amdgcn_cvt_pk_f32_fp8((int)r.w, false) * hp[6]; acc += __builtin_amdgcn_cvt_pk_f32_fp8((int)r.w, true) * hp[7];
    return acc.x + acc.y;
}
__device__ __forceinline__ float p8_reduce16(const float (&p)[16], int lane) {
    float q[8], r4[4], t2[2];
#pragma unroll
    for (int k = 0; k < 8; ++k) { const u32x2_t sw = __builtin_amdgcn_permlane32_swap(__float_as_uint(p[k]), __float_as_uint(p[k + 8]), false, false); q[k] = __uint_as_float(sw.x) + __uint_as_float(sw.y); }
#pragma unroll
    for (int k = 0; k < 4; ++k) { const u32x2_t sw = __builtin_amdgcn_permlane16_swap(__float_as_uint(q[k]), __float_as_uint(q[k + 4]), false, false); r4[k] = __uint_as_float(sw.x) + __uint_as_float(sw.y); }
    const bool b3 = (lane & 8) != 0, b2 = (lane & 4) != 0;
#pragma unroll
    for (int k = 0; k < 2; ++k) { const float snd = b3 ? r4[k] : r4[k + 2], keep = b3 ? r4[k + 2] : r4[k]; t2[k] = keep + dpp_f<0x128, 0xF, true>(snd); }
    const float snd = b2 ? t2[0] : t2[1], keep = b2 ? t2[1] : t2[0];
    float z = keep + dpp_f<0x141, 0xF, true>(snd);
    z += dpp_f<0xB1, 0xF, true>(z); z += dpp_f<0x4E, 0xF, true>(z);
    return z;
}
__constant__ unsigned char CAND_I[64] = {0,0,0,0,0,0,0,0,0,0,0,0,0,0,0,0, 1,1,1,1,1,1,1,1, 2,2,2,2,2, 3,3,3,3, 4,4,4, 5,5, 6,6, 7,7, 8,9,10,11,12,13,14,15, 0,0,0,0,0,0,0,0,0,0,0,0,0,0};
__constant__ unsigned char CAND_J[64] = {0,1,2,3,4,5,6,7,8,9,10,11,12,13,14,15, 0,1,2,3,4,5,6,7, 0,1,2,3,4, 0,1,2,3, 0,1,2, 0,1, 0,1, 0,1, 0,0,0,0,0,0,0,0, 0,0,0,0,0,0,0,0,0,0,0,0,0,0};
__device__ __forceinline__ unsigned rowmax_u(unsigned v) { return row_max_u(v); }
struct PeerSel { int ev[4]; float gv[4]; };
__device__ __forceinline__ PeerSel peer_select(const Params& p, int wunit, const char* ktab) {
    const int lane = tid_op() & 63, cL = lane & 15, gq = lane >> 4, rowbase = lane & 48;
    const int tg = wunit >> 3, h = wunit & 7, tok0 = tg * 16;
    char* ws = p.ws;
    const bf16_t* QP = (const bf16_t*)(ws + O_QP);
    unsigned top[2][4];
#pragma unroll
    for (int half = 0; half < 2; ++half) {
        const bf16_t* KB = (const bf16_t*)(ktab + half * (128 * 144 * 2));
        bf16x8 a[4];
#pragma unroll
        for (int ks = 0; ks < 4; ++ks) a[ks] = ld8(QP + (size_t)(tok0 + cL) * 2048 + h * 256 + half * 128 + ks * 32 + gq * 8);
        unsigned pk[8][4];
#pragma unroll
        for (int nt = 0; nt < 8; ++nt) {
            f32x4 acc = (f32x4){0.f, 0.f, 0.f, 0.f};
#pragma unroll
            for (int ks = 0; ks < 4; ++ks) acc = mfma16(a[ks], ld8(KB + (16 * nt + cL) * 144 + ks * 32 + gq * 8), acc);
#pragma unroll
            for (int r = 0; r < 4; ++r) pk[nt][r] = (f2sort(acc[r]) & ~0x7Fu) | (unsigned)(127 - (16 * nt + cL));
        }
#pragma unroll
        for (int r = 0; r < 4; ++r) top[half][r] = 0u;
#define PS_CAS(A, B) { const unsigned hi_ = max(pk[A][r], pk[B][r]), lo_ = min(pk[A][r], pk[B][r]); pk[A][r] = hi_; pk[B][r] = lo_; }
#pragma unroll
        for (int r = 0; r < 4; ++r) {
            PS_CAS(0, 1) PS_CAS(2, 3) PS_CAS(4, 5) PS_CAS(6, 7)
            PS_CAS(0, 2) PS_CAS(1, 3) PS_CAS(4, 6) PS_CAS(5, 7)
            PS_CAS(1, 2) PS_CAS(5, 6)
            PS_CAS(0, 4) PS_CAS(1, 5) PS_CAS(2, 6) PS_CAS(3, 7)
            PS_CAS(2, 4) PS_CAS(3, 5)
            PS_CAS(1, 2) PS_CAS(3, 4) PS_CAS(5, 6)
        }
#undef PS_CAS
        for (int it = 0; it < 16; ++it) {
#pragma unroll
            for (int r = 0; r < 4; ++r) {
                const unsigned gm = rowmax_u(pk[0][r]);
                if (cL == it) top[half][r] = gm;
                const bool pop = (pk[0][r] == gm);
#pragma unroll
                for (int nt = 0; nt < 7; ++nt) pk[nt][r] = pop ? pk[nt + 1][r] : pk[nt][r];
                pk[7][r] = pop ? 0u : pk[7][r];
            }
        }
    }
    unsigned ck[4][4];
#pragma unroll
    for (int s = 0; s < 4; ++s) {
        const int q = s * 16 + cL; const int ci = CAND_I[q], cj = CAND_J[q];
#pragma unroll
        for (int r = 0; r < 4; ++r) {
            const unsigned t1 = (unsigned)__shfl((int)top[0][r], rowbase + ci), t2 = (unsigned)__shfl((int)top[1][r], rowbase + cj);
            const float f = sort2f(t1 & ~0x7Fu) + sort2f(t2 & ~0x7Fu);
            ck[s][r] = (q < 50) ? ((f2sort(f) & ~0x3Fu) | (unsigned)(63 - q)) : 0u;
        }
    }
    unsigned best[4] = {0u, 0u, 0u, 0u};
#define PS_CAS(A, B) { const unsigned hi_ = max(ck[A][r], ck[B][r]), lo_ = min(ck[A][r], ck[B][r]); ck[A][r] = hi_; ck[B][r] = lo_; }
#pragma unroll
    for (int r = 0; r < 4; ++r) { PS_CAS(0, 1) PS_CAS(2, 3) PS_CAS(0, 2) PS_CAS(1, 3) PS_CAS(1, 2) }
#undef PS_CAS
    for (int it = 0; it < 16; ++it) {
#pragma unroll
        for (int r = 0; r < 4; ++r) {
            const unsigned gm = rowmax_u(ck[0][r]);
            if (cL == it) best[r] = gm;
            const bool pop = (ck[0][r] == gm);
            ck[0][r] = pop ? ck[1][r] : ck[0][r]; ck[1][r] = pop ? ck[2][r] : ck[1][r]; ck[2][r] = pop ? ck[3][r] : ck[2][r]; ck[3][r] = pop ? 0u : ck[3][r];
        }
    }
    PeerSel S_;
#pragma unroll
    for (int r = 0; r < 4; ++r) {
        const float fv = sort2f(best[r] & ~0x3Fu);
        const int q = 63 - (int)(best[r] & 63u);
        const int ci = CAND_I[q], cj = CAND_J[q];
        const unsigned t1 = (unsigned)__shfl((int)top[0][r], rowbase + ci), t2 = (unsigned)__shfl((int)top[1][r], rowbase + cj);
        S_.ev[r] = (127 - (int)(t1 & 127u)) * 128 + (127 - (int)(t2 & 127u));
        const float mx = __shfl(fv, rowbase);
        const float ex = __expf(fv - mx);
        const float sm = row_sum(ex);
        S_.gv[r] = ex / sm;
    }
    return S_;
}
#define PU_ROWEID(SEL, TT, I) __builtin_amdgcn_readlane(SEL.ev[(TT) & 3], 16 * ((TT) >> 2) + (I))
__device__ __forceinline__ void peer_blocks(const Params& p, int wunit, const PeerSel& S_, const PeerSel& N_, bool has_next, P8aRows& R0, P8aRows& R1) {
    const int lane = tid_op() & 63;
    const int tok0 = (wunit >> 3) * 16, h = wunit & 7;
    char* ws = p.ws;
    const unsigned char* U8 = (const unsigned char*)(ws + O_U8) + 16 * lane;
    const bf16_t* H = (const bf16_t*)(ws + O_HB) + (size_t)tok0 * 1024 + 16 * lane;
    unsigned* ACT = (unsigned*)(ws + O_ACT) + (size_t)tok0 * 128 + h * 16;
#define PU_STEP(RC, TT) { \
        f32x2 hp[8]; \
        _Pragma("unroll") for (int k = 0; k < 2; ++k) { const u32x4n hv_ = *(const u32x4n*)(H + (TT) * 1024 + 8 * k); \
            hp[4 * k] = (f32x2){__uint_as_float(hv_.x << 16), __uint_as_float(hv_.x & 0xFFFF0000u)}; hp[4 * k + 1] = (f32x2){__uint_as_float(hv_.y << 16), __uint_as_float(hv_.y & 0xFFFF0000u)}; \
            hp[4 * k + 2] = (f32x2){__uint_as_float(hv_.z << 16), __uint_as_float(hv_.z & 0xFFFF0000u)}; hp[4 * k + 3] = (f32x2){__uint_as_float(hv_.w << 16), __uint_as_float(hv_.w & 0xFFFF0000u)}; } \
        float pp[16]; \
        _Pragma("unroll") for (int i = 0; i < 16; ++i) { \
            pp[i] = p8_dot16(RC.a[i], hp); \
            if ((TT) < 14) RC.a[i] = *(const u32x4n*)(U8 + (size_t)PU_ROWEID(S_, ((TT) + 2) & 15, i) * 1024); \
            else if (has_next) RC.a[i] = *(const u32x4n*)(U8 + (size_t)PU_ROWEID(N_, ((TT) + 2) & 15, i) * 1024); } \
        const float dot = p8_reduce16(pp, lane) * (1.f / 32.f); \
        const int src_ = 16 * ((TT) >> 2) + (lane >> 2); \
        const float gt_ = __shfl(S_.gv[(TT) & 3], src_); const int ei_ = __shfl(S_.ev[(TT) & 3], src_); \
        const float act_ = gelu_erf(dot) * gt_; \
        if ((lane & 3) == 0) ACT[(TT) * 128 + (lane >> 2)] = (unsigned)ei_ | ((unsigned)f2bf(act_) << 16); }
    PU_STEP(R0, 0) PU_STEP(R1, 1) PU_STEP(R0, 2) PU_STEP(R1, 3) PU_STEP(R0, 4) PU_STEP(R1, 5) PU_STEP(R0, 6) PU_STEP(R1, 7)
    PU_STEP(R0, 8) PU_STEP(R1, 9) PU_STEP(R0, 10) PU_STEP(R1, 11) PU_STEP(R0, 12) PU_STEP(R1, 13) PU_STEP(R0, 14) PU_STEP(R1, 15)
#undef PU_STEP
}
__device__ __forceinline__ void phase7(const Params& p, char* smem) {
    const int lane = tid_op() & 63;
    const int w = __builtin_amdgcn_readfirstlane(tid_op() >> 6);
    const int stride = gridDim.x * 8;
    const unsigned char* U8 = (const unsigned char*)(p.ws + O_U8) + 16 * lane;
    {
        const int tid = tid_op();
        __syncthreads();
#pragma unroll
        for (int k = 0; k < 8; ++k) {
            const int c = tid + 512 * k, half = c >> 11, row = (c >> 4) & 127, ch = c & 15;
            *(uint4*)(smem + half * (128 * 144 * 2) + row * 288 + ch * 16) = *(const uint4*)(p.ws + (half ? O_K2B : O_K1B) + (size_t)row * 256 + ch * 16);
        }
        __syncthreads();
    }
    for (int u = blockIdx.x * 8 + w; u < 8192; u += stride) {
        const PeerSel s0 = peer_select(p, u, smem);
        P8aRows R0, R1;
#pragma unroll
        for (int i = 0; i < 16; ++i) { R0.a[i] = *(const u32x4n*)(U8 + (size_t)PU_ROWEID(s0, 0, i) * 1024); R1.a[i] = *(const u32x4n*)(U8 + (size_t)PU_ROWEID(s0, 1, i) * 1024); }
        peer_blocks(p, u, s0, s0, false, R0, R1);
    }
}
#undef PU_ROWEID

__device__ __forceinline__ float dot16_fp8(const uint4& r, const float (&hv)[16]) {
    const f32x2 a0 = __builtin_amdgcn_cvt_pk_f32_fp8((int)r.x, false), a1 = __builtin_amdgcn_cvt_pk_f32_fp8((int)r.x, true);
    const f32x2 b0 = __builtin_amdgcn_cvt_pk_f32_fp8((int)r.y, false), b1 = __builtin_amdgcn_cvt_pk_f32_fp8((int)r.y, true);
    const f32x2 c0 = __builtin_amdgcn_cvt_pk_f32_fp8((int)r.z, false), c1 = __builtin_amdgcn_cvt_pk_f32_fp8((int)r.z, true);
    const f32x2 d0 = __builtin_amdgcn_cvt_pk_f32_fp8((int)r.w, false), d1 = __builtin_amdgcn_cvt_pk_f32_fp8((int)r.w, true);
    return (hv[0] * a0.x + hv[1] * a0.y + hv[2] * a1.x + hv[3] * a1.y) + (hv[4] * b0.x + hv[5] * b0.y + hv[6] * b1.x + hv[7] * b1.y)
         + (hv[8] * c0.x + hv[9] * c0.y + hv[10] * c1.x + hv[11] * c1.y) + (hv[12] * d0.x + hv[13] * d0.y + hv[14] * d1.x + hv[15] * d1.y);
}
struct P8bRows { u32x4n v[8]; };
struct P8bMeta { u32x4n m[4]; };
__device__ __forceinline__ void p8b_meta(P8bMeta& M, const unsigned* ACT, int row, int e8) {
#pragma unroll
    for (int k = 0; k < 4; ++k) M.m[k] = *(const u32x4n*)(ACT + (size_t)row * 128 + e8 * 16 + 4 * k);
}
template <int HALF> __device__ __forceinline__ void p8b_load(P8bRows& R, const P8bMeta& M, const unsigned char* V8) {
#pragma unroll
    for (int k = 0; k < 2; ++k) {
        const u32x4n mm = M.m[2 * HALF + k];
        R.v[4 * k + 0] = *(const u32x4n*)(V8 + (size_t)(mm.x & 0xFFFFu) * 128); R.v[4 * k + 1] = *(const u32x4n*)(V8 + (size_t)(mm.y & 0xFFFFu) * 128);
        R.v[4 * k + 2] = *(const u32x4n*)(V8 + (size_t)(mm.z & 0xFFFFu) * 128); R.v[4 * k + 3] = *(const u32x4n*)(V8 + (size_t)(mm.w & 0xFFFFu) * 128);
    }
}
template <int HALF> __device__ __forceinline__ void p8b_accum(f32x2 (&acc)[8], const P8bRows& R, const P8bMeta& M) {
#pragma unroll
    for (int k = 0; k < 2; ++k) {
        const u32x4n mm = M.m[2 * HALF + k];
        const unsigned mw[4] = {mm.x, mm.y, mm.z, mm.w};
#pragma unroll
        for (int q = 0; q < 4; ++q) {
            const float a1 = __uint_as_float(mw[q] & 0xFFFF0000u);
            const f32x2 av = (f32x2){a1, a1};
            const u32x4n x = R.v[4 * k + q];
            acc[0] += av * __builtin_amdgcn_cvt_pk_f32_fp8((int)x.x, false); acc[1] += av * __builtin_amdgcn_cvt_pk_f32_fp8((int)x.x, true);
            acc[2] += av * __builtin_amdgcn_cvt_pk_f32_fp8((int)x.y, false); acc[3] += av * __builtin_amdgcn_cvt_pk_f32_fp8((int)x.y, true);
            acc[4] += av * __builtin_amdgcn_cvt_pk_f32_fp8((int)x.z, false); acc[5] += av * __builtin_amdgcn_cvt_pk_f32_fp8((int)x.z, true);
            acc[6] += av * __builtin_amdgcn_cvt_pk_f32_fp8((int)x.w, false); acc[7] += av * __builtin_amdgcn_cvt_pk_f32_fp8((int)x.w, true);
        }
    }
}
__device__ __forceinline__ void p8b_store(const f32x2 (&acc)[8], float* hr, const bf16_t* hb, int e8) {
    float r[16];
#pragma unroll
    for (int j = 0; j < 8; ++j) { r[2 * j] = acc[j].x; r[2 * j + 1] = acc[j].y; }
#pragma unroll
    for (int j = 0; j < 16; ++j) { r[j] += dpp_f<0x128, 0xF, true>(r[j]); r[j] = sum_x32(sum_x16(r[j])); }
    if (e8 == 0) {
#pragma unroll
        for (int j = 0; j < 2; ++j) {
            const uint4 hw = *(const uint4*)(hb + 8 * j);
            *(float4*)(hr + 8 * j) = make_float4(ALPHA * __uint_as_float(hw.x << 16) + r[8 * j], ALPHA * __uint_as_float(hw.x & 0xFFFF0000u) + r[8 * j + 1],
                                                 ALPHA * __uint_as_float(hw.y << 16) + r[8 * j + 2], ALPHA * __uint_as_float(hw.y & 0xFFFF0000u) + r[8 * j + 3]);
            *(float4*)(hr + 8 * j + 4) = make_float4(ALPHA * __uint_as_float(hw.z << 16) + r[8 * j + 4], ALPHA * __uint_as_float(hw.z & 0xFFFF0000u) + r[8 * j + 5],
                                                     ALPHA * __uint_as_float(hw.w << 16) + r[8 * j + 6], ALPHA * __uint_as_float(hw.w & 0xFFFF0000u) + r[8 * j + 7]);
        }
    }
}
__device__ __forceinline__ void phase8b(const Params& p, const XcdMap xm, float* outp) {
    const int lane = tid_op() & 63, w = tid_op() >> 6, e8 = lane >> 3, c8 = lane & 7;
    char* ws = p.ws;
    const unsigned char* V8 = (const unsigned char*)(ws + O_V8) + (size_t)xm.slice * 16384 * 128 + 16 * c8;
    const unsigned* ACT = (const unsigned*)(ws + O_ACT);
    const int stride = xm.nloc * 8;
    int row = xm.rank * 8 + w;
    if (row >= NTOK) return;
    float* const hbase = outp + xm.slice * 128 + 16 * c8;
    const bf16_t* const hbb = (const bf16_t*)(ws + O_HB) + xm.slice * 128 + 16 * c8;
    P8bMeta Mc, Mn; P8bRows Ra, Rb;
    p8b_meta(Mc, ACT, row, e8);
    p8b_meta(Mn, ACT, (row + stride < NTOK) ? row + stride : row, e8);
    p8b_load<0>(Ra, Mc, V8);
    for (; row < NTOK; row += stride) {
        f32x2 acc[8];
#pragma unroll
        for (int j = 0; j < 8; ++j) acc[j] = (f32x2){0.f, 0.f};
        p8b_load<1>(Rb, Mc, V8);
        p8b_accum<0>(acc, Ra, Mc);
        p8b_load<0>(Ra, Mn, V8);
        p8b_accum<1>(acc, Rb, Mc);
        p8b_store(acc, hbase + (size_t)row * 1024, hbb + (size_t)row * 1024, e8);
        Mc = Mn;
        const int r2 = row + 2 * stride;
        p8b_meta(Mn, ACT, r2 < NTOK ? r2 : row, e8);
    }
}
__device__ __forceinline__ void phase8c(const Params& p) {
    const int lane = tid_op() & 63, w = tid_op() >> 6;
    for (int row = blockIdx.x * 8 + w; row < NTOK; row += gridDim.x * 8) {
        float* yr = p.out + (size_t)row * 1024;
        float4 v[4]; float s = 0.f;
#pragma unroll
        for (int j = 0; j < 4; ++j) { v[j] = *(const float4*)(yr + 4 * lane + 256 * j); s += v[j].x + v[j].y + v[j].z + v[j].w; }
        const float mean = wave_sum(s) * (1.f / 1024.f);
        float q = 0.f;
#pragma unroll
        for (int j = 0; j < 4; ++j) { const float a = v[j].x - mean, b2 = v[j].y - mean, c2 = v[j].z - mean, d = v[j].w - mean; q += a * a + b2 * b2 + c2 * c2 + d * d; }
        const float rstd = rsqrtf(wave_sum(q) * (1.f / 1024.f) + LN_EPS);
#pragma unroll
        for (int j = 0; j < 4; ++j) {
            const int col = 4 * lane + 256 * j;
            const float4 gg = *(const float4*)(p.ln2_g + col), bb = *(const float4*)(p.ln2_b + col);
            float4 o;
            o.x = (v[j].x - mean) * rstd * gg.x + bb.x; o.y = (v[j].y - mean) * rstd * gg.y + bb.y; o.z = (v[j].z - mean) * rstd * gg.z + bb.z; o.w = (v[j].w - mean) * rstd * gg.w + bb.w;
            *(float4*)(yr + col) = o;
        }
    }
}

typedef const __attribute__((address_space(4))) Params* ParamsK;
__device__ __forceinline__ Params params_reload() {
#if defined(__HIP_DEVICE_COMPILE__)
    auto ka = __builtin_amdgcn_kernarg_segment_ptr();
    asm volatile("" : "+s"(ka));
    Params r; __builtin_memcpy(&r, (const __attribute__((address_space(4))) void*)ka, sizeof(Params));
    return r;
#else
    return Params{};
#endif
}
#if ONE_LAUNCH
__global__ void __launch_bounds__(512, 2) fwd_megakernel(Params p) {
    __shared__ __attribute__((aligned(16))) char smem[SMEM_BYTES];
    cg::grid_group grid = cg::this_grid();
    volatile LAS unsigned* st = (volatile LAS unsigned*)(smem + SMEM_BYTES - 16);
    if (threadIdx.x == 0) { st[0] = 0u; st[1] = 0u; st[2] = 0u; st[3] = 0u; }
    __syncthreads();
    const XcdBarrier xb = xcd_barrier_post((unsigned*)(p.ws + O_BAR), st);
#define GRID_BAR() do { if (p.use_cg) grid.sync(); else xcd_barrier(xb); } while (0)
#ifndef DUP
#define DUP -1
#endif
#define PP (params_reload())
#define RUNPH(k, call) { int n_ = (DUP == k) ? 2 : 1; asm volatile("" : "+s"(n_)); _Pragma("unroll 1") for (int i_ = 0; i_ < n_; ++i_) { call; GRID_BAR(); } }
    RUNPH(0, phase0(PP))
    XcdMap xm;
    if (st[2]) { xm.slice = (int)xb.x; xm.rank = (int)st[3]; xm.nloc = (int)st[0]; }
    else { xm.slice = blockIdx.x & 7; xm.rank = blockIdx.x >> 3; xm.nloc = gridDim.x >> 3; }
    xm.slice = __builtin_amdgcn_readfirstlane(xm.slice); xm.rank = __builtin_amdgcn_readfirstlane(xm.rank); xm.nloc = __builtin_amdgcn_readfirstlane(xm.nloc);
    RUNPH(1, phase1(PP, smem, xm))
    RUNPH(2, phase2(PP, smem))
    if (DUP == 20) { int wh_ = 1; asm volatile("" : "+s"(wh_)); phase2(PP, smem, wh_); GRID_BAR(); }
    if (DUP == 21) { int wh_ = 2; asm volatile("" : "+s"(wh_)); phase2(PP, smem, wh_); GRID_BAR(); }
    phase2c(PP); GRID_BAR();
    RUNPH(3, phase3(PP, smem))
    if (DUP == 30) { int wh_ = 1; asm volatile("" : "+s"(wh_)); phase3(PP, smem, wh_); GRID_BAR(); }
    if (DUP == 31) { int wh_ = 2; asm volatile("" : "+s"(wh_)); phase3(PP, smem, wh_); GRID_BAR(); }
    RUNPH(4, phase4(PP, smem, xm))
    phase5(PP); GRID_BAR();
    RUNPH(6, phase6(PP, smem, xm))
    RUNPH(7, phase7(PP, smem))
#ifdef SCRAMBLE
    { const int x_ = xm.slice, r_ = xm.rank; xm.slice = (x_ + r_) & 7; xm.rank = (r_ >> 3) * 8 + x_; xm.nloc = 32; }
#endif
    if (DUP == 9) { phase8b(PP, xm, (float*)(PP.ws + O_QP)); GRID_BAR(); }
    phase8b(PP, xm, PP.out); GRID_BAR();
    phase8c(PP);
}
#else
__global__ void __launch_bounds__(512, 2) k_phase0(Params p) { phase0(p); }
__global__ void __launch_bounds__(512, 2) k_phase1(Params p) { __shared__ __attribute__((aligned(16))) char smem[SMEM_BYTES]; XcdMap xm; xm.slice = blockIdx.x & 7; xm.rank = blockIdx.x >> 3; xm.nloc = gridDim.x >> 3; phase1(p, smem, xm); }
__global__ void __launch_bounds__(512, 2) k_phase2(Params p) { __shared__ __attribute__((aligned(16))) char smem[SMEM_BYTES]; phase2(p, smem); }
__global__ void __launch_bounds__(512, 2) k_phase2c(Params p) { phase2c(p); }
__global__ void __launch_bounds__(512, 2) k_phase3(Params p) { __shared__ __attribute__((aligned(16))) char smem[SMEM_BYTES]; phase3(p, smem); }
__global__ void __launch_bounds__(512, 2) k_phase4(Params p) { __shared__ __attribute__((aligned(16))) char smem[SMEM_BYTES]; XcdMap xm; xm.slice = blockIdx.x & 7; xm.rank = blockIdx.x >> 3; xm.nloc = gridDim.x >> 3; phase4(p, smem, xm); }
__global__ void __launch_bounds__(512, 2) k_phase5(Params p) { phase5(p); }
__global__ void __launch_bounds__(512, 2) k_phase6(Params p) { __shared__ __attribute__((aligned(16))) char smem[SMEM_BYTES]; XcdMap xm; xm.slice = blockIdx.x & 7; xm.rank = blockIdx.x >> 3; xm.nloc = gridDim.x >> 3; phase6(p, smem, xm); }
__global__ void __launch_bounds__(512, 2) k_phase7(Params p) { __shared__ __attribute__((aligned(16))) char smem_[SMEM_BYTES]; phase7(p, smem_); }
__global__ void __launch_bounds__(512, 2) k_phase8b(Params p) { XcdMap xm; xm.slice = blockIdx.x & 7; xm.rank = blockIdx.x >> 3; xm.nloc = gridDim.x >> 3; phase8b(p, xm, p.out); }
__global__ void __launch_bounds__(512, 2) k_phase8c(Params p) { phase8c(p); }
#endif

extern "C" void kernel_launch(void* const* d_in, const int* in_sizes, int n_in, void* d_out, int out_size, void* d_ws, size_t ws_size, hipStream_t stream) {
    Params p{};
    p.x = (const float*)d_in[0]; p.pos = (const int*)d_in[1]; p.w_in = (const float*)d_in[2]; p.conv_w = (const float*)d_in[3]; p.conv_b = (const float*)d_in[4];
    p.dt_bias = (const float*)d_in[5]; p.a_log = (const float*)d_in[6]; p.d_skip = (const float*)d_in[7]; p.norm_w = (const float*)d_in[8]; p.w_out = (const float*)d_in[9];
    p.ln1_g = (const float*)d_in[10]; p.ln1_b = (const float*)d_in[11]; p.wq = (const float*)d_in[12]; p.k1 = (const float*)d_in[13]; p.k2 = (const float*)d_in[14];
    p.u = (const float*)d_in[15]; p.v = (const float*)d_in[16]; p.ln2_g = (const float*)d_in[17]; p.ln2_b = (const float*)d_in[18];
    p.out = (float*)d_out; p.ws = (char*)d_ws;
    if (ws_size < WS_NEEDED) { fprintf(stderr, "kernel_launch: workspace too small (%zu < %zu)\n", ws_size, (size_t)WS_NEEDED); return; }
#if ONE_LAUNCH
    static int grid_blocks = 0;
    if (!grid_blocks) {
        int dev = 0, cus = 0, per_cu = 0;
        hipGetDevice(&dev);
        hipDeviceGetAttribute(&cus, hipDeviceAttributeMultiprocessorCount, dev);
        hipOccupancyMaxActiveBlocksPerMultiprocessor(&per_cu, fwd_megakernel, 512, 0);
        if (per_cu > 1) per_cu = 1;
        if (per_cu < 1) per_cu = 1;
        grid_blocks = cus * per_cu;
    }
    (void)hipMemsetAsync((char*)d_ws + O_BAR, 0, XCD_BAR_WORDS * 4, stream);
    void* args[] = {&p};
    hipError_t e = hipLaunchCooperativeKernel((void*)fwd_megakernel, dim3(grid_blocks), dim3(512), args, 0, stream);
    if (e != hipSuccess) fprintf(stderr, "cooperative launch failed: %s (grid %d)\n", hipGetErrorString(e), grid_blocks);
#else
    const int G = 512;
    k_phase0<<<G, 512, 0, stream>>>(p);
    k_phase1<<<G, 512, 0, stream>>>(p);
    k_phase2<<<G, 512, 0, stream>>>(p);
    k_phase2c<<<G, 512, 0, stream>>>(p);
    k_phase3<<<G, 512, 0, stream>>>(p);
    k_phase4<<<G, 512, 0, stream>>>(p);
    k_phase5<<<G, 512, 0, stream>>>(p);
    k_phase6<<<G, 512, 0, stream>>>(p);
    k_phase7<<<G, 512, 0, stream>>>(p);
    k_phase8b<<<G, 512, 0, stream>>>(p);
    k_phase8c<<<G, 512, 0, stream>>>(p);
#endif
}
```

```cpp
#include <hip/hip_runtime.h>
#include <hip/hip_cooperative_groups.h>
#include <stdint.h>
#include <stdio.h>
namespace cg = cooperative_groups;

typedef unsigned short bf16_t;
typedef short bf16x8 __attribute__((ext_vector_type(8)));
typedef short bf16x4 __attribute__((ext_vector_type(4)));
typedef float f32x4 __attribute__((ext_vector_type(4)));
typedef float f32x2 __attribute__((ext_vector_type(2)));

#ifndef ONE_LAUNCH
#define ONE_LAUNCH 1
#endif

constexpr int NB = 8, SEQ = 2048, DM = 1024, NTOK = NB * SEQ;
constexpr int NP = 3584;
constexpr int QOFF = 0, KOFF = 512, VOFF = 1024, IQOFF = 1536, MISCOFF = 1792, ZOFF = 1856, XBCOFF = 2368, NUSED = 3392;
constexpr float ALPHA = 1.189207115002721f;
constexpr float LN_EPS = 1e-5f;

constexpr size_t MB = 1024 * 1024;
constexpr size_t O_WIN_T = 0;
constexpr size_t O_WOUT_T = O_WIN_T + (size_t)NP * 1024 * 2;
constexpr size_t O_WQ_T = O_WOUT_T + 2 * MB;
constexpr size_t O_K1B = O_WQ_T + 4 * MB;
constexpr size_t O_K2B = O_K1B + 32768;
constexpr size_t O_CS64 = O_K2B + 32768;
constexpr size_t O_CS32 = O_CS64 + 4 * MB;
constexpr size_t O_BAR = O_CS32 + 2 * MB;
constexpr size_t O_R1 = O_BAR + 65536;
constexpr size_t O_XB = O_R1;
constexpr size_t O_XT = O_R1;
constexpr size_t O_BRM = O_XT + 16 * MB;
constexpr size_t O_CRM = O_BRM + 8 * MB;
constexpr size_t O_QB = O_XB + 32 * MB;
constexpr size_t O_KB = O_QB + 16 * MB;
constexpr size_t O_VT = O_KB + 16 * MB;
constexpr size_t O_IQB = O_VT + 16 * MB;
constexpr size_t O_IKB = O_IQB + 8 * MB;
constexpr size_t O_IWF = O_IKB + 1 * MB;
constexpr size_t O_DTF = O_IWF + MB / 2;
constexpr size_t O_ZB = O_DTF + MB / 2;
constexpr size_t O_XBCT = O_ZB + 16 * MB;
constexpr size_t O_CAR = O_XBCT;
constexpr size_t O_ACUM = O_XBCT + 32 * MB;
constexpr size_t O_ATOT = O_ACUM + MB / 2;
constexpr size_t O_ST = O_ATOT + MB / 2;
constexpr size_t O_MIX = O_ST;
constexpr size_t O_MASK = O_ST + 32 * MB;
constexpr size_t O_R1_END = O_MASK + 4 * MB;
constexpr size_t O_HB = O_R1;
constexpr size_t O_QP = O_HB + 32 * MB;
constexpr size_t O_ACT = O_QP + 64 * MB;
constexpr size_t O_R2_END = O_ACT + 8 * MB;
static_assert(O_R2_END <= O_ST, "region 2 must not reach MIX");
constexpr size_t O_U8 = O_R1_END;
constexpr size_t O_V8 = O_U8 + 16 * MB;
constexpr size_t WS_NEEDED = O_V8 + 16 * MB;
static_assert(WS_NEEDED <= 256 * MB, "workspace too large");

struct Params {
    const float* x; const int* pos; const float* w_in; const float* conv_w; const float* conv_b; const float* dt_bias;
    const float* a_log; const float* d_skip; const float* norm_w; const float* w_out; const float* ln1_g; const float* ln1_b;
    const float* wq; const float* k1; const float* k2; const float* u; const float* v; const float* ln2_g; const float* ln2_b;
    float* out; char* ws; int use_cg; int pad_;
};

#define SMEM_BYTES 133120

__device__ __forceinline__ int tid_op() { int t = threadIdx.x; asm volatile("" : "+v"(t)); return t; }
typedef __bf16 bf16x2n __attribute__((ext_vector_type(2)));
typedef float f32x2c __attribute__((ext_vector_type(2)));
__device__ __forceinline__ unsigned pack2(float a, float b) { const bf16x2n r = __builtin_convertvector((f32x2c){a, b}, bf16x2n); return __builtin_bit_cast(unsigned, r); }
__device__ __forceinline__ bf16_t f2bf(float f) { return (bf16_t)(pack2(f, 0.f) & 0xFFFFu); }
__device__ __forceinline__ float bf2f(bf16_t b) { return __uint_as_float(((unsigned)b) << 16); }
__device__ __forceinline__ unsigned f2sort(float f) { unsigned u = __float_as_uint(f); return (u & 0x80000000u) ? ~u : (u | 0x80000000u); }
__device__ __forceinline__ float sort2f(unsigned s) { unsigned u = (s & 0x80000000u) ? (s & 0x7FFFFFFFu) : ~s; return __uint_as_float(u); }
__device__ __forceinline__ f32x4 mfma16(bf16x8 a, bf16x8 b, f32x4 c) { return __builtin_amdgcn_mfma_f32_16x16x32_bf16(a, b, c, 0, 0, 0); }
__device__ __forceinline__ float silu_f(float v) { return v * __builtin_amdgcn_rcpf(1.f + __expf(-v)); }
__device__ __forceinline__ bf16x8 ld8(const bf16_t* p) { return *(const bf16x8*)p; }
__device__ __forceinline__ bf16x8 cat4(bf16x4 lo, bf16x4 hi) { return __builtin_shufflevector(lo, hi, 0, 1, 2, 3, 4, 5, 6, 7); }


template <int CTRL, int ROWMASK, bool BC> __device__ __forceinline__ int dpp_i(int v) { return __builtin_amdgcn_update_dpp(0, v, CTRL, ROWMASK, 0xF, BC); }
template <int CTRL, int ROWMASK, bool BC> __device__ __forceinline__ float dpp_f(float v) { return __builtin_bit_cast(float, __builtin_amdgcn_update_dpp(0, __builtin_bit_cast(int, v), CTRL, ROWMASK, 0xF, BC)); }
__device__ __forceinline__ float row_sum(float v) { v += dpp_f<0xB1, 0xF, true>(v); v += dpp_f<0x4E, 0xF, true>(v); v += dpp_f<0x141, 0xF, true>(v); v += dpp_f<0x140, 0xF, true>(v); return v; }
__device__ __forceinline__ unsigned row_sum_u(unsigned v) { v += (unsigned)dpp_i<0xB1, 0xF, true>((int)v); v += (unsigned)dpp_i<0x4E, 0xF, true>((int)v); v += (unsigned)dpp_i<0x141, 0xF, true>((int)v); v += (unsigned)dpp_i<0x140, 0xF, true>((int)v); return v; }
__device__ __forceinline__ unsigned row_max_u(unsigned v) {
    v = max(v, (unsigned)dpp_i<0xB1, 0xF, true>((int)v)); v = max(v, (unsigned)dpp_i<0x4E, 0xF, true>((int)v));
    v = max(v, (unsigned)dpp_i<0x141, 0xF, true>((int)v)); v = max(v, (unsigned)dpp_i<0x140, 0xF, true>((int)v)); return v;
}
__device__ __forceinline__ float wave_sum_u(float v) {
    v = row_sum(v);
    v += dpp_f<0x142, 0xA, false>(v);
    v += dpp_f<0x143, 0xC, false>(v);
    return __builtin_bit_cast(float, __builtin_amdgcn_readlane(__builtin_bit_cast(int, v), 63));
}
typedef unsigned u32x2_t __attribute__((ext_vector_type(2)));
__device__ __forceinline__ float sum_x16(float v) { const u32x2_t r = __builtin_amdgcn_permlane16_swap(__float_as_uint(v), __float_as_uint(v), false, false); return __uint_as_float(r.x) + __uint_as_float(r.y); }
__device__ __forceinline__ float sum_x32(float v) { const u32x2_t r = __builtin_amdgcn_permlane32_swap(__float_as_uint(v), __float_as_uint(v), false, false); return __uint_as_float(r.x) + __uint_as_float(r.y); }
__device__ __forceinline__ float max_x16(float v) { const u32x2_t r = __builtin_amdgcn_permlane16_swap(__float_as_uint(v), __float_as_uint(v), false, false); return fmaxf(__uint_as_float(r.x), __uint_as_float(r.y)); }
__device__ __forceinline__ float max_x32(float v) { const u32x2_t r = __builtin_amdgcn_permlane32_swap(__float_as_uint(v), __float_as_uint(v), false, false); return fmaxf(__uint_as_float(r.x), __uint_as_float(r.y)); }
__device__ __forceinline__ float wave_sum(float v) { return sum_x32(sum_x16(row_sum(v))); }

#define XB_TMO      128
#define XB_XCNT(j)  (256  + 64 * (j))
#define XB_XSUB(j)  (1280 + 64 * (j))
#define XB_XGEN(j)  (2304 + 64 * (j))
#define XB_TOP      3328
#define XB_TOPGEN   3392
#define XCD_BAR_WORDS 3456
#define XB_SPIN_CAP (1u << 22)
#define LAS __attribute__((address_space(3)))
__device__ __forceinline__ unsigned xb_ld(unsigned* p)              { return __hip_atomic_load(p, __ATOMIC_RELAXED, __HIP_MEMORY_SCOPE_AGENT); }
__device__ __forceinline__ unsigned xb_add(unsigned* p, unsigned v) { return __hip_atomic_fetch_add(p, v, __ATOMIC_RELAXED, __HIP_MEMORY_SCOPE_AGENT); }
__device__ __forceinline__ unsigned xb_xcc_id() { return (unsigned)__builtin_amdgcn_s_getreg((3 << 11) | 20) & 0xFu; }
#define XB_SPIN(cond, bar) do { unsigned _sp = 0; while (cond) { __builtin_amdgcn_s_sleep(1); \
    if ((++_sp & 255u) == 0u) { if (xb_ld(&(bar)[XB_TMO])) break; if (_sp > XB_SPIN_CAP) { atomicAdd(&(bar)[XB_TMO], 1u); break; } } } } while (0)
struct XcdBarrier { unsigned* bar; unsigned x; volatile LAS unsigned* st; };
__device__ __forceinline__ XcdBarrier xcd_barrier_post(unsigned* bar, volatile LAS unsigned* st) {
    XcdBarrier b; b.bar = bar; b.x = xb_xcc_id(); b.st = st;
    if (threadIdx.x == 0) st[3] = xb_add(&bar[XB_XCNT(b.x)], 1u);
    return b;
}
__device__ __forceinline__ void xcd_barrier_complete(unsigned* bar, unsigned x, unsigned& nloc, unsigned& nx, unsigned& low8) {
    const unsigned G = gridDim.x * gridDim.y * gridDim.z;
    unsigned sum, cnt, mine, lo, sp = 0u;
    for (;;) {
        sum = 0u; cnt = 0u; mine = 0u; lo = 0u;
#pragma unroll
        for (unsigned j = 0; j < 16; ++j) { const unsigned c = xb_ld(&bar[XB_XCNT(j)]); sum += c; cnt += (c > 0u) ? 1u : 0u; lo += (j < 8u && c > 0u) ? 1u : 0u; mine = (j == x) ? c : mine; }
        if (sum == G) break;
        __builtin_amdgcn_s_sleep(1);
        if ((++sp & 255u) == 0u) { if (xb_ld(&bar[XB_TMO])) break; if (sp > XB_SPIN_CAP) { atomicAdd(&bar[XB_TMO], 1u); break; } }
    }
    nloc = mine > 0u ? mine : 1u; nx = cnt > 0u ? cnt : 1u; low8 = (lo == 8u && cnt == 8u) ? 1u : 0u;
}
__device__ __forceinline__ void xcd_barrier(const XcdBarrier& b) {
    asm volatile("s_waitcnt vmcnt(0)" ::: "memory");
    __syncthreads();
    if (threadIdx.x == 0) {
        unsigned* bar = b.bar;
        __builtin_amdgcn_s_waitcnt(0);
        unsigned nloc = b.st[0], nx = b.st[1];
        if (nloc == 0u) { unsigned low8; xcd_barrier_complete(bar, b.x, nloc, nx, low8); b.st[0] = nloc; b.st[1] = nx; b.st[2] = low8; }
        const unsigned old = xb_add(&bar[XB_XSUB(b.x)], 1u);
        const unsigned gen = old / nloc;
        if (old + 1u == (gen + 1u) * nloc) {
            __builtin_amdgcn_fence(__ATOMIC_RELEASE, "agent");
            asm volatile("s_waitcnt vmcnt(0)" ::: "memory");
            const unsigned og = xb_add(&bar[XB_TOP], 1u);
            const unsigned tg = og / nx;
            if (og + 1u == (tg + 1u) * nx) xb_add(&bar[XB_TOPGEN], 1u);
            else XB_SPIN(xb_ld(&bar[XB_TOPGEN]) == tg, bar);
            __builtin_amdgcn_fence(__ATOMIC_ACQUIRE, "agent");
            xb_add(&bar[XB_XGEN(b.x)], 1u);
            asm volatile("s_waitcnt vmcnt(0)" ::: "memory");
        } else {
            XB_SPIN(xb_ld(&bar[XB_XGEN(b.x)]) == gen, bar);
            __builtin_amdgcn_fence(__ATOMIC_ACQUIRE, "agent");
            asm volatile("s_waitcnt vmcnt(0)" ::: "memory");
        }
    }
    __syncthreads();
}

__device__ __forceinline__ int rot_perm(int gcol, int H) { const int j = (gcol % H) >> 3, e = gcol & 7; return (gcol / H) * H + 4 * j + (e & 3) + ((e >> 2) ? H / 2 : 0); }
__device__ __forceinline__ int win_src_col(int n) {
    if (n < 1024) return rot_perm(n, 64);
    if (n < 1536) return n;
    if (n < 1824) return 1536 + rot_perm(n - 1536, 32);
    if (n < 1832) return n;
    if (n < 1840) return 3368 + (n - 1832);
    if (n < 1856) return -1;
    if (n < 2368) return 1832 + (n - 1856);
    if (n < 3392) return 2344 + (n - 2368);
    return -1;
}
__device__ __forceinline__ void p0_transpose(const float* __restrict__ W, int N, int Nout, bool remap, bf16_t* __restrict__ Wt, int gtid, int gsz) {
    const int items = Nout * 128;
    for (int it = gtid; it < items; it += gsz) {
        const int n = it % Nout, kc = it / Nout;
        const int src = remap ? win_src_col(n) : n;
        unsigned w[4] = {0, 0, 0, 0};
        if (src >= 0) {
            float f[8];
#pragma unroll
            for (int j = 0; j < 8; ++j) f[j] = W[(size_t)(kc * 8 + j) * N + src];
#pragma unroll
            for (int j = 0; j < 4; ++j) w[j] = pack2(f[2 * j], f[2 * j + 1]);
        }
        *(uint4*)(Wt + (size_t)n * 1024 + kc * 8) = make_uint4(w[0], w[1], w[2], w[3]);
    }
}
__device__ __forceinline__ void p0_convert(const float* __restrict__ src, bf16_t* __restrict__ dst, size_t n4, size_t gtid, size_t gsz) {
    for (size_t i = gtid; i < n4; i += gsz) {
        const float4 f = ((const float4*)src)[i];
        ((uint2*)dst)[i] = make_uint2(pack2(f.x, f.y), pack2(f.z, f.w));
    }
}
__device__ __forceinline__ void phase0(const Params& p) {
    const int gtid = blockIdx.x * blockDim.x + tid_op(), gsz = gridDim.x * blockDim.x;
    p0_transpose(p.w_in, 3376, NP, true, (bf16_t*)(p.ws + O_WIN_T), gtid, gsz);
    p0_transpose(p.w_out, 1024, 1024, false, (bf16_t*)(p.ws + O_WOUT_T), gtid, gsz);
    p0_transpose(p.wq, 2048, 2048, false, (bf16_t*)(p.ws + O_WQ_T), gtid, gsz);
    p0_convert(p.k1, (bf16_t*)(p.ws + O_K1B), 128 * 128 / 4, gtid, gsz);
    p0_convert(p.k2, (bf16_t*)(p.ws + O_K2B), 128 * 128 / 4, gtid, gsz);
    p0_convert(p.x, (bf16_t*)(p.ws + O_XB), (size_t)NTOK * DM / 4, gtid, gsz);
    float2* cs64 = (float2*)(p.ws + O_CS64); float2* cs32 = (float2*)(p.ws + O_CS32);
    for (int it = gtid; it < NTOK * 48; it += gsz) {
        const int m = it / 48, i = it % 48;
        const float ps = (float)p.pos[m];
        if (i < 32) { const float inv = powf(10000.f, -(float)(2 * i) / 64.f); const float a = ps * inv; cs64[m * 32 + i] = make_float2(cosf(a), sinf(a)); }
        else { const int k = i - 32; const float inv = powf(10000.f, -(float)(2 * k) / 32.f); const float a = ps * inv; cs32[m * 16 + k] = make_float2(cosf(a), sinf(a)); }
    }
}

struct XcdMap { int slice, rank, nloc; };
__device__ __forceinline__ bool gemm_next_tile(const XcdMap& xm, int it, int ntn, int& tm, int& tn) {
    const int j = xm.rank + xm.nloc * it;
    if (j >= 8 * ntn) return false;
    tm = 8 * xm.slice + j / ntn; tn = j % ntn; return true;
}
#define GEMM_LDK 80
#define GEMM_LDS_A (256 * GEMM_LDK * 2)
#define GEMM_LDS_STAGE (GEMM_LDS_A + 128 * GEMM_LDK * 2)
typedef unsigned u32x4g __attribute__((ext_vector_type(4)));
struct GemmRegs { u32x4g a0, a1, a2, a3, b0, b1; };
__device__ __forceinline__ void gemm_gload(GemmRegs& r, const bf16_t* ga, const bf16_t* gb, size_t astep) {
    r.a0 = *(const u32x4g*)(ga); r.a1 = *(const u32x4g*)(ga + astep); r.a2 = *(const u32x4g*)(ga + 2 * astep); r.a3 = *(const u32x4g*)(ga + 3 * astep);
    r.b0 = *(const u32x4g*)(gb); r.b1 = *(const u32x4g*)(gb + astep);
}
__device__ __forceinline__ void gemm_lstore(const GemmRegs& r, bf16_t* wa, bf16_t* wb) {
    *(u32x4g*)(wa) = r.a0; *(u32x4g*)(wa + 64 * GEMM_LDK) = r.a1; *(u32x4g*)(wa + 128 * GEMM_LDK) = r.a2; *(u32x4g*)(wa + 192 * GEMM_LDK) = r.a3;
    *(u32x4g*)(wb) = r.b0; *(u32x4g*)(wb + 64 * GEMM_LDK) = r.b1;
}
__device__ __forceinline__ void gemm_compute(f32x4 (&acc)[4][4], const bf16_t* sA, const bf16_t* sB, int wm, int wn, int lane) {
#pragma unroll
    for (int ks = 0; ks < 2; ++ks) {
        bf16x8 a[4], b[4];
#pragma unroll
        for (int i = 0; i < 4; ++i) a[i] = ld8(sA + (wm * 64 + i * 16 + (lane & 15)) * GEMM_LDK + ks * 32 + (lane >> 4) * 8);
#pragma unroll
        for (int i = 0; i < 4; ++i) b[i] = ld8(sB + (wn * 64 + i * 16 + (lane & 15)) * GEMM_LDK + ks * 32 + (lane >> 4) * 8);
#pragma unroll
        for (int i = 0; i < 4; ++i)
#pragma unroll
            for (int j = 0; j < 4; ++j) acc[i][j] = mfma16(a[i], b[j], acc[i][j]);
    }
}
template <class Epi>
__device__ __forceinline__ void gemm_tile(const bf16_t* __restrict__ A, const bf16_t* __restrict__ Bt, int K, int m0, int n0, const Epi& epi, char* smem) {
    const int tid = tid_op(), lane = tid & 63, w = tid >> 6, wm = w >> 1, wn = w & 1;
    f32x4 acc[4][4];
#pragma unroll
    for (int i = 0; i < 4; ++i)
#pragma unroll
        for (int j = 0; j < 4; ++j) acc[i][j] = (f32x4){0.f, 0.f, 0.f, 0.f};
    const int lrow = tid >> 3, lkc = (tid & 7) * 8;
    const bf16_t* ga = A + (size_t)(m0 + lrow) * K + lkc;
    const bf16_t* gb = Bt + (size_t)(n0 + lrow) * K + lkc;
    const size_t astep = (size_t)64 * K;
    bf16_t* sA0 = (bf16_t*)smem; bf16_t* sB0 = (bf16_t*)(smem + GEMM_LDS_A);
    bf16_t* sA1 = (bf16_t*)(smem + GEMM_LDS_STAGE); bf16_t* sB1 = (bf16_t*)(smem + GEMM_LDS_STAGE + GEMM_LDS_A);
    const int woff = lrow * GEMM_LDK + lkc;
    GemmRegs r0, r1;
    gemm_gload(r0, ga, gb, astep);
    gemm_gload(r1, ga + 64, gb + 64, astep);
    __syncthreads();
    gemm_lstore(r0, sA0 + woff, sB0 + woff);
    __syncthreads();
    const int nk = K / 64;
    for (int k = 0; k < nk; k += 2) {
        { const int kk = (k + 2 < nk) ? k + 2 : nk - 1; gemm_gload(r0, ga + kk * 64, gb + kk * 64, astep); }
        gemm_compute(acc, sA0, sB0, wm, wn, lane);
        gemm_lstore(r1, sA1 + woff, sB1 + woff);
        __syncthreads();
        { const int kk = (k + 3 < nk) ? k + 3 : nk - 1; gemm_gload(r1, ga + kk * 64, gb + kk * 64, astep); }
        gemm_compute(acc, sA1, sB1, wm, wn, lane);
        gemm_lstore(r0, sA0 + woff, sB0 + woff);
        __syncthreads();
    }
    epi(acc, m0 + wm * 64, n0 + wn * 64, lane, smem + w * 9216);
}

namespace pg8 {
#define PG8_LAS __attribute__((address_space(3)))
typedef unsigned short bf16_t;
typedef short bf16x8 __attribute__((ext_vector_type(8)));
typedef float f32x4 __attribute__((ext_vector_type(4)));
typedef unsigned u32x4 __attribute__((ext_vector_type(4)));
constexpr int BM = 256, BK = 64, HALF = 128, HTB = HALF * BK * 2  , STAGE_BYTES = 8 * HTB, NXCD = 8, WGM = 8;

__host__ __device__ __forceinline__ int lds_byte(int r, int c) { const int st = (r >> 4) * 2 + (c >> 5), rr = r & 15, cc = c & 31, ob = rr * 64 + cc * 2; return st * 1024 + (ob ^ (((ob >> 9) & 1) << 5)); }
__host__ __device__ __forceinline__ void stage_rc(int b, int& R, int& C) { const int st = b / 1024, sb = b % 1024, swz = sb ^ (((sb >> 9) & 1) << 5); R = (st >> 1) * 16 + swz / 64; C = (st & 1) * 32 + (swz % 64) / 2; }
__host__ __device__ __forceinline__ int perm32(int rho) { const int n = rho >> 4, i = rho & 15; return 8 * (i >> 2) + 4 * n + (i & 3); }

struct Unit { int pm, pn; };
struct Gemm { const bf16_t* A; const bf16_t* Bt; int M, N, K; };

struct StaticOrder {
    int nM, nN, nwg, G, c;
    __host__ __device__ void init(int M, int N, int G_, int c_) { nM = M / BM; nN = N / BM; nwg = nM * nN; G = G_; c = c_; }
    __host__ __device__ bool next(int i, Unit& u) const {
        const long L = (long)i * G + c; if (L >= nwg) return false;
        int wgid = (int)L; { const int q = nwg / NXCD, r = nwg % NXCD, xcd = wgid % NXCD, off = wgid / NXCD; wgid = (xcd < r ? xcd * (q + 1) : r * (q + 1) + (xcd - r) * q) + off; }
        const int nig = WGM * nN, gid = wgid / nig, fm = gid * WGM, gsz = (nM - fm) < WGM ? (nM - fm) : WGM;
        u.pm = fm + ((wgid % nig) % gsz); u.pn = (wgid % nig) / gsz; return true;
    }
    __device__ __forceinline__ void a_ready(const Unit&) const {}
    __device__ __forceinline__ void done(const Unit&) const {}
};
__device__ __forceinline__ unsigned cvt_pk_bf16(float lo, float hi) { return ::pack2(lo, hi); }

struct EpiBf16Plain {
    static constexpr bool PERM = true, AFTER_DRAIN = false;
    bf16_t* O; int ldc;
    __device__ __forceinline__ void operator()(const f32x4 (&acc)[2][2][4][2], const Unit& u, int wr, int wc, int fr, int fq) const {
        const int row0 = u.pm * BM + wr * 64 + fr, col0 = u.pn * BM + wc * 32 + 8 * fq;
#pragma unroll
        for (int ai = 0; ai < 2; ++ai)
#pragma unroll
            for (int m = 0; m < 4; ++m) { bf16_t* rowp = O + (size_t)(row0 + ai * HALF + m * 16) * ldc + col0;
#pragma unroll
                for (int bj = 0; bj < 2; ++bj) { const f32x4 v0 = acc[ai][bj][m][0], v1 = acc[ai][bj][m][1];
                    u32x4 w; w.x = cvt_pk_bf16(v0[0], v0[1]); w.y = cvt_pk_bf16(v0[2], v0[3]); w.z = cvt_pk_bf16(v1[0], v1[1]); w.w = cvt_pk_bf16(v1[2], v1[3]);
                    *(u32x4*)(rowp + bj * HALF) = w; } }
    }
};
struct EpiResF32 {
    static constexpr bool PERM = false, AFTER_DRAIN = false;
    float* Y; const float* X; int ldc; float alpha;
    __device__ __forceinline__ void operator()(const f32x4 (&acc)[2][2][4][2], const Unit& u, int wr, int wc, int fr, int fq) const {
        const int row0 = u.pm * BM + wr * 64 + fr, col0 = u.pn * BM + wc * 32 + 4 * fq;
#pragma unroll
        for (int ai = 0; ai < 2; ++ai)
#pragma unroll
            for (int m = 0; m < 4; ++m) { const size_t ro = (size_t)(row0 + ai * HALF + m * 16) * ldc + col0;
#pragma unroll
                for (int bj = 0; bj < 2; ++bj)
#pragma unroll
                    for (int n = 0; n < 2; ++n) { const f32x4 xv = *(const f32x4*)(X + ro + bj * HALF + n * 16); *(f32x4*)(Y + ro + bj * HALF + n * 16) = xv * alpha + acc[ai][bj][m][n]; } }
    }
};
struct EpiResBf16 {
    static constexpr bool PERM = true, AFTER_DRAIN = false;
    bf16_t* Y; const float* X; int ldc; float alpha;
    __device__ __forceinline__ void operator()(const f32x4 (&acc)[2][2][4][2], const Unit& u, int wr, int wc, int fr, int fq) const {
        const int row0 = u.pm * BM + wr * 64 + fr, col0 = u.pn * BM + wc * 32 + 8 * fq;
#pragma unroll
        for (int ai = 0; ai < 2; ++ai)
#pragma unroll
            for (int m = 0; m < 4; ++m) { const size_t ro = (size_t)(row0 + ai * HALF + m * 16) * ldc + col0;
#pragma unroll
                for (int bj = 0; bj < 2; ++bj) {
                    const f32x4 x0 = *(const f32x4*)(X + ro + bj * HALF), x1 = *(const f32x4*)(X + ro + bj * HALF + 4);
                    const f32x4 v0 = x0 * alpha + acc[ai][bj][m][0], v1 = x1 * alpha + acc[ai][bj][m][1];
                    u32x4 w; w.x = cvt_pk_bf16(v0[0], v0[1]); w.y = cvt_pk_bf16(v0[2], v0[3]); w.z = cvt_pk_bf16(v1[0], v1[1]); w.w = cvt_pk_bf16(v1[2], v1[3]);
                    *(u32x4*)(Y + ro + bj * HALF) = w; } }
    }
};
template <class Epi, class Sched, bool STAMP = false>
__device__ __forceinline__ void gemm_phase(PG8_LAS unsigned char* lds, const Gemm g, const Sched& S, const Epi& E, unsigned long long* stamps) {
    const int tid = tid_op(), wid = __builtin_amdgcn_readfirstlane(tid >> 6), lane = tid & 63, wr = wid >> 2, wc = wid & 3, fr = lane & 15, fq = lane >> 4;
    const int K = g.K, nt = K / BK;
    int ts_lo = 0, ts_hi = 0, nts = 0; const unsigned long long rt_entry = STAMP ? (unsigned long long)wall_clock64() : 0ull;
#define PG8_STAMP() do { if (STAMP && wid == 0 && nts < 64) { const unsigned long long _c = (unsigned long long)clock64(); \
        ts_lo = (lane == nts) ? (int)(unsigned)_c : ts_lo; ts_hi = (lane == nts) ? (int)(unsigned)(_c >> 32) : ts_hi; ++nts; } } while (0)
    PG8_STAMP();
    unsigned voffA[2], voffB[2];
#pragma unroll
    for (int i = 0; i < 2; ++i) { int R, C; stage_rc(tid * 16 + i * 8192, R, C); const int Rb = Epi::PERM ? ((R & ~31) + perm32(R & 31)) : R;
        voffA[i] = (unsigned)(R * K + C) * 2u; voffB[i] = (unsigned)(Rb * K + C) * 2u; }
    const size_t kstep = (size_t)(BK * 2);
    const size_t hstep = (size_t)HALF * K * 2;
    const size_t tstep = 2 * hstep;
    const unsigned ldsw = (unsigned)wid * 1024u;
    const int aoff = lds_byte(wr * 64 + fr, fq * 8), boff = lds_byte(wc * 32 + fr, fq * 8);
#define PG8_SA(b, h) (((b) * 2 + (h)) * HTB)
#define PG8_SB(b, h) ((4 + (b) * 2 + (h)) * HTB)
#define PG8_STAGE(bufoff, gbase, voff) do { _Pragma("unroll") for (int _i = 0; _i < 2; ++_i) \
        __builtin_amdgcn_global_load_lds((const unsigned*)((const char*)(gbase) + (voff)[_i]), (PG8_LAS unsigned*)(lds + (bufoff) + ldsw + _i * 8192), 16, 0, 0); } while (0)
#define PG8_LDA(dst, b, h) do { _Pragma("unroll") for (int m = 0; m < 4; ++m) _Pragma("unroll") for (int k = 0; k < 2; ++k) dst[m][k] = *(const PG8_LAS bf16x8*)(lds + PG8_SA(b, h) + aoff + m * 2048 + k * 1024); } while (0)
#define PG8_LDB(dst, b, h) do { _Pragma("unroll") for (int n = 0; n < 2; ++n) _Pragma("unroll") for (int k = 0; k < 2; ++k) dst[n][k] = *(const PG8_LAS bf16x8*)(lds + PG8_SB(b, h) + boff + n * 2048 + k * 1024); } while (0)
#define PG8_MMA(ai, bj, At, Bt) do { __builtin_amdgcn_s_setprio(1); _Pragma("unroll") for (int m = 0; m < 4; ++m) _Pragma("unroll") for (int n = 0; n < 2; ++n) _Pragma("unroll") for (int k = 0; k < 2; ++k) \
        acc[ai][bj][m][n] = __builtin_amdgcn_mfma_f32_16x16x32_bf16(Bt[n][k], At[m][k], acc[ai][bj][m][n], 0, 0, 0); __builtin_amdgcn_s_setprio(0); } while (0)
#define PG8_WAIT_V(n) asm volatile("s_waitcnt vmcnt(" #n ")" ::: "memory")
#define PG8_WAIT_L(n) asm volatile("s_waitcnt lgkmcnt(" #n ")" ::: "memory")
#define PG8_BAR __builtin_amdgcn_s_barrier()
#define PG8_SCHED __builtin_amdgcn_sched_barrier(0)
    Unit cur, nxt; int ui = 0;
    if (!S.next(0, cur)) return;
    f32x4 acc[2][2][4][2];
#pragma unroll
    for (int a = 0; a < 2; ++a)
#pragma unroll
        for (int b = 0; b < 2; ++b)
#pragma unroll
            for (int m = 0; m < 4; ++m)
#pragma unroll
                for (int n = 0; n < 2; ++n) acc[a][b][m][n] = (f32x4){0.f, 0.f, 0.f, 0.f};
    bf16x8 At[4][2], B0[2][2], B1[2][2];
    const char* cA = (const char*)g.A + (size_t)cur.pm * tstep; const char* cB = (const char*)g.Bt + (size_t)cur.pn * tstep;
    S.a_ready(cur);
    PG8_STAGE(PG8_SB(0, 0), cB, voffB); PG8_STAGE(PG8_SA(0, 0), cA, voffA); PG8_STAGE(PG8_SB(0, 1), cB + hstep, voffB); PG8_STAGE(PG8_SA(0, 1), cA + hstep, voffA);
    if (wr == 1) PG8_BAR;
    PG8_WAIT_V(4); PG8_BAR;
    PG8_STAGE(PG8_SB(1, 0), cB + kstep, voffB); PG8_STAGE(PG8_SA(1, 0), cA + kstep, voffA); PG8_STAGE(PG8_SB(1, 1), cB + hstep + kstep, voffB);
    PG8_WAIT_V(6); PG8_BAR;
    PG8_STAMP();
    for (;;) {
        const bool has_next = S.next(ui + 1, nxt);
        const char* nA = has_next ? (const char*)g.A + (size_t)nxt.pm * tstep : cA; const char* nB = has_next ? (const char*)g.Bt + (size_t)nxt.pn * tstep : cB;
        for (int t = 0; t < nt; t += 2) {
            const bool last = (t == nt - 2);
            const char* a1 = cA + (size_t)(t + 1) * kstep;
            const char* a2 = last ? nA : cA + (size_t)(t + 2) * kstep; const char* b2 = last ? nB : cB + (size_t)(t + 2) * kstep;
            const char* a3 = a2 + kstep; const char* b3 = b2 + kstep;
            if (last && has_next) S.a_ready(nxt);
            PG8_LDB(B0, 0, 0); PG8_SCHED; PG8_LDA(At, 0, 0); PG8_STAGE(PG8_SA(1, 1), a1 + hstep, voffA);
            PG8_WAIT_L(8); PG8_BAR; PG8_WAIT_L(0); PG8_MMA(0, 0, At, B0); PG8_BAR; PG8_SCHED;
            PG8_LDB(B1, 0, 1); PG8_STAGE(PG8_SB(0, 0), b2, voffB);
            PG8_BAR; PG8_WAIT_L(0); PG8_MMA(0, 1, At, B1); PG8_BAR;
            PG8_LDA(At, 0, 1); PG8_STAGE(PG8_SA(0, 0), a2, voffA);
            PG8_BAR; PG8_WAIT_L(0); PG8_MMA(1, 0, At, B0); PG8_BAR; PG8_SCHED;
            PG8_STAGE(PG8_SB(0, 1), b2 + hstep, voffB);
            PG8_WAIT_V(6); PG8_BAR; PG8_MMA(1, 1, At, B1); PG8_BAR;
            PG8_LDB(B0, 1, 0); PG8_SCHED; PG8_LDA(At, 1, 0); PG8_STAGE(PG8_SA(0, 1), a2 + hstep, voffA);
            PG8_WAIT_L(8); PG8_BAR; PG8_WAIT_L(0); PG8_MMA(0, 0, At, B0); PG8_BAR; PG8_SCHED;
            PG8_LDB(B1, 1, 1); PG8_STAGE(PG8_SB(1, 0), b3, voffB);
            PG8_BAR; PG8_WAIT_L(0); PG8_MMA(0, 1, At, B1); PG8_BAR;
            PG8_LDA(At, 1, 1); PG8_STAGE(PG8_SA(1, 0), a3, voffA);
            PG8_BAR; PG8_WAIT_L(0); PG8_MMA(1, 0, At, B0); PG8_BAR; PG8_SCHED;
            PG8_STAGE(PG8_SB(1, 1), b3 + hstep, voffB);
            PG8_WAIT_V(6); PG8_BAR; PG8_MMA(1, 1, At, B1); PG8_BAR;
        }
        PG8_STAMP();
        if constexpr (!Epi::AFTER_DRAIN) { E(acc, cur, wr, wc, fr, fq); S.done(cur); }
        PG8_STAMP();
        if (!has_next) break;
#pragma unroll
        for (int a = 0; a < 2; ++a)
#pragma unroll
            for (int b = 0; b < 2; ++b)
#pragma unroll
                for (int m = 0; m < 4; ++m)
#pragma unroll
                    for (int n = 0; n < 2; ++n) acc[a][b][m][n] = (f32x4){0.f, 0.f, 0.f, 0.f};
        cur = nxt; cA = nA; cB = nB; ++ui;
    }
    PG8_WAIT_V(0);
    if (wr == 0) PG8_BAR;
    PG8_BAR;
    if constexpr (Epi::AFTER_DRAIN) { E.fused(acc, cur, wr, wc, fr, fq, lds, wid, lane); S.done(cur); }
    PG8_STAMP();
    if (STAMP && wid == 0) { stamps[lane] = lane < nts ? (((unsigned long long)(unsigned)ts_hi << 32) | (unsigned)ts_lo) : 0ull;
        if (lane == 62) stamps[62] = rt_entry; if (lane == 63) stamps[63] = (unsigned long long)wall_clock64(); }
#undef PG8_STAMP
#undef PG8_SA
#undef PG8_SB
#undef PG8_STAGE
#undef PG8_LDA
#undef PG8_LDB
#undef PG8_MMA
#undef PG8_WAIT_V
#undef PG8_WAIT_L
#undef PG8_BAR
#undef PG8_SCHED
}
}

struct ProjEpi8 {
    static constexpr bool PERM = true, AFTER_DRAIN = false;
    char* ws; const float* dt_bias;
    __device__ __forceinline__ uint4 rot8(const pg8::f32x4 v0, const pg8::f32x4 v1, const float* tab, float sc) const {
        const float4 c01 = *(const float4*)tab, c23 = *(const float4*)(tab + 4);
        const float o10 = (v0[0] * c01.x - v1[0] * c01.y) * sc, o11 = (v0[1] * c01.z - v1[1] * c01.w) * sc, o12 = (v0[2] * c23.x - v1[2] * c23.y) * sc, o13 = (v0[3] * c23.z - v1[3] * c23.w) * sc;
        const float o20 = (v1[0] * c01.x + v0[0] * c01.y) * sc, o21 = (v1[1] * c01.z + v0[1] * c01.w) * sc, o22 = (v1[2] * c23.x + v0[2] * c23.y) * sc, o23 = (v1[3] * c23.z + v0[3] * c23.w) * sc;
        return make_uint4(pack2(o10, o11), pack2(o12, o13), pack2(o20, o21), pack2(o22, o23));
    }
    template <int SEG> __device__ __forceinline__ void store_row(const pg8::f32x4 v0, const pg8::f32x4 v1, const int cg, const int row) const {
        const int b = row >> 11, t = row & 2047;
        if (SEG == 0) {
            const bool isq = cg < 512; const int head = (cg & 511) >> 6, j = (cg & 63) >> 3;
            bf16_t* dst = (bf16_t*)(ws + (isq ? O_QB : O_KB)) + ((size_t)(b * 8 + head) * 2048 + t) * 64 + 8 * j;
            *(uint4*)dst = rot8(v0, v1, (const float*)(ws + O_CS64) + ((size_t)row * 32 + 4 * j) * 2, isq ? 0.125f * 1.4426950408889634f : 1.f);
        } else if (SEG == 1) {
            bf16_t* dst = (bf16_t*)(ws + O_VT) + ((size_t)(b * 8 + ((cg - 1024) >> 6)) * 64 + (cg & 63)) * 2048 + t;
#pragma unroll
            for (int e = 0; e < 4; ++e) { dst[(size_t)e * 2048] = f2bf(v0[e]); dst[(size_t)(e + 4) * 2048] = f2bf(v1[e]); }
        } else if (SEG == 2) {
            const int j = (cg & 31) >> 3;
            *(uint4*)((bf16_t*)(ws + O_IQB) + ((size_t)row * 8 + ((cg - 1536) >> 5)) * 32 + 8 * j) = rot8(v0, v1, (const float*)(ws + O_CS32) + ((size_t)row * 16 + 4 * j) * 2, 0.17677669529663687f);
        } else if (SEG == 3) {
            if (cg < 1824) {
                const int j = (cg & 31) >> 3;
                *(uint4*)((bf16_t*)(ws + O_IKB) + (size_t)row * 32 + 8 * j) = rot8(v0, v1, (const float*)(ws + O_CS32) + ((size_t)row * 16 + 4 * j) * 2, 1.f);
            } else if (cg == 1824) {
                const float k8 = 0.35355339059327373f; float* d = (float*)(ws + O_IWF) + (size_t)row * 8;
                *(float4*)d = make_float4(v0[0] * k8, v0[1] * k8, v0[2] * k8, v0[3] * k8); *(float4*)(d + 4) = make_float4(v1[0] * k8, v1[1] * k8, v1[2] * k8, v1[3] * k8);
            } else if (cg == 1832) {
                float o[8];
#pragma unroll
                for (int e = 0; e < 4; ++e) { const float a0 = v0[e] + dt_bias[e], a1 = v1[e] + dt_bias[4 + e]; o[e] = (a0 > 20.f) ? a0 : __logf(1.f + __expf(a0)); o[4 + e] = (a1 > 20.f) ? a1 : __logf(1.f + __expf(a1)); }
                float* d = (float*)(ws + O_DTF) + (size_t)row * 8;
                *(float4*)d = make_float4(o[0], o[1], o[2], o[3]); *(float4*)(d + 4) = make_float4(o[4], o[5], o[6], o[7]);
            }
        } else if (SEG == 4) {
            *(uint4*)((bf16_t*)(ws + O_ZB) + (size_t)row * 512 + (cg - ZOFF)) = make_uint4(pack2(v0[0], v0[1]), pack2(v0[2], v0[3]), pack2(v1[0], v1[1]), pack2(v1[2], v1[3]));
        } else {
            bf16_t* dst = (bf16_t*)(ws + O_XBCT) + ((size_t)b * 1024 + (cg - XBCOFF)) * 2048 + t;
#pragma unroll
            for (int e = 0; e < 4; ++e) { dst[(size_t)e * 2048] = f2bf(v0[e]); dst[(size_t)(e + 4) * 2048] = f2bf(v1[e]); }
        }
    }
    template <int SEG, int BJ> __device__ __forceinline__ void rows8(const pg8::f32x4 (&acc)[2][2][4][2], const int cg, const int row0) const {
#pragma unroll
        for (int ai = 0; ai < 2; ++ai)
#pragma unroll
            for (int m = 0; m < 4; ++m) store_row<SEG>(acc[ai][BJ][m][0], acc[ai][BJ][m][1], cg, row0 + ai * 128 + m * 16);
    }
    template <int BJ> __device__ __forceinline__ void half(const pg8::f32x4 (&acc)[2][2][4][2], const pg8::Unit& u, int wr, int wc, int fr, int fq) const {
        const int cw = u.pn * 256 + BJ * 128 + wc * 32;
        const int cg = cw + 8 * fq, row0 = u.pm * 256 + wr * 64 + fr;
        if (cw < 1024) rows8<0, BJ>(acc, cg, row0);
        else if (cw < 1536) rows8<1, BJ>(acc, cg, row0);
        else if (cw < 1792) rows8<2, BJ>(acc, cg, row0);
        else if (cw < 1856) rows8<3, BJ>(acc, cg, row0);
        else if (cw < 2368) rows8<4, BJ>(acc, cg, row0);
        else if (cw < NUSED) rows8<5, BJ>(acc, cg, row0);
    }
    __device__ __forceinline__ void operator()(const pg8::f32x4 (&acc)[2][2][4][2], const pg8::Unit& u, int wr, int wc, int fr, int fq) const {
        half<0>(acc, u, wr, wc, fr, fq); half<1>(acc, u, wr, wc, fr, fq);
    }
};
#ifndef V_EARLY
#define V_EARLY 8192
#endif
template <bool DO_U> __device__ __forceinline__ void convert_rows(const Params& p, size_t i_begin, size_t i_end, int wg, int nwg) {
    unsigned* u8 = (unsigned*)(p.ws + O_U8); unsigned* v8 = (unsigned*)(p.ws + O_V8);
    const size_t gsz = (size_t)nwg * 512;
    for (size_t i0 = i_begin + (size_t)wg * 512 + tid_op(); i0 < i_end; i0 += 8 * gsz) {
        float4 fv[8];
#pragma unroll
        for (int k = 0; k < 8; ++k) { const size_t i = i0 + k * gsz; const size_t ic = i < i_end ? i : i0; fv[k] = ((const float4*)p.v)[ic]; }
#pragma unroll
        for (int k = 0; k < 8; ++k) {
            const size_t i = i0 + k * gsz;
            if (i < i_end) {
                int pv = __builtin_amdgcn_cvt_pk_fp8_f32(fv[k].x, fv[k].y, 0, false); pv = __builtin_amdgcn_cvt_pk_fp8_f32(fv[k].z, fv[k].w, pv, true);
                const size_t e = i >> 8, c4 = i & 255;
                v8[((c4 >> 5) * 16384 + e) * 32 + (c4 & 31)] = (unsigned)pv;
            }
        }
    }
    if (DO_U) {
        for (size_t i0 = (size_t)wg * 512 + tid_op(); i0 < (size_t)16384 * 256; i0 += 8 * gsz) {
            float4 fu[8];
#pragma unroll
            for (int k = 0; k < 8; ++k) { const size_t i = i0 + k * gsz; const size_t ic = i < (size_t)16384 * 256 ? i : i0; fu[k] = ((const float4*)p.u)[ic]; }
#pragma unroll
            for (int k = 0; k < 8; ++k) {
                const size_t i = i0 + k * gsz;
                if (i < (size_t)16384 * 256) {
                    int pk = __builtin_amdgcn_cvt_pk_fp8_f32(fu[k].x * 32.f, fu[k].y * 32.f, 0, false); pk = __builtin_amdgcn_cvt_pk_fp8_f32(fu[k].z * 32.f, fu[k].w * 32.f, pk, true);
                    u8[i] = (unsigned)pk;
                }
            }
        }
    }
}
__device__ __forceinline__ void phase1(const Params& p, char* smem, const XcdMap xm) {
    char* ws = p.ws;
    ProjEpi8 e; e.ws = ws; e.dt_bias = p.dt_bias;
    pg8::Gemm g{(const bf16_t*)(ws + O_XB), (const bf16_t*)(ws + O_WIN_T), NTOK, NP, 1024};
    pg8::StaticOrder S; S.init(NTOK, NP, (int)gridDim.x, (int)blockIdx.x);
    pg8::gemm_phase<ProjEpi8, pg8::StaticOrder, false>((PG8_LAS unsigned char*)smem, g, S, e, nullptr);
    const int G = (int)gridDim.x, first = (64 * (NP / 256)) % G;
    if ((int)blockIdx.x >= first) convert_rows<true>(p, 0, (size_t)V_EARLY * 256, (int)blockIdx.x - first, G - first);
}

#define IDX_NT 16
#define IDX_LDS_SCORES (16 * 2048 * 4)
__device__ __forceinline__ unsigned wave_sum_cnt(unsigned v) {
    v = row_sum_u(v);
    v += (unsigned)dpp_i<0x142, 0xA, false>((int)v);
    v += (unsigned)dpp_i<0x143, 0xC, false>((int)v);
    return (unsigned)__builtin_amdgcn_readlane((int)v, 63);
}
template <int NR> __device__ __forceinline__ unsigned idx_count_ge(const unsigned (&k)[NR], unsigned cand) {
    unsigned n = 0u;
#pragma unroll
    for (int i = 0; i < NR; ++i) n += (k[i] >= cand) ? 1u : 0u;
    return wave_sum_cnt(n);
}
template <int NR> __device__ __forceinline__ unsigned long long idx_words(const unsigned (&k)[NR], unsigned K, bool exact, int lane) {
    unsigned long long wd = 0ull;
    if (exact) {
#pragma unroll
        for (int i = 0; i < NR; ++i) { const unsigned long long bal = __ballot(k[i] >= K); if (lane == i) wd = bal; }
    } else {
        unsigned n = 0u;
#pragma unroll
        for (int i = 0; i < NR; ++i) n += (k[i] > K) ? 1u : 0u;
        unsigned rem = 256u - wave_sum_cnt(n);
#pragma unroll 1
        for (int i = 0; i < NR; ++i) {
            unsigned ki = k[0];
#pragma unroll
            for (int j = 1; j < NR; ++j) ki = (j == i) ? k[j] : ki;
            const unsigned long long gt = __ballot(ki > K), eq = __ballot(ki == K);
            unsigned long long take = 0ull, e = eq;
            while (rem > 0u && e) { take |= e & (~e + 1ull); e &= e - 1ull; --rem; }
            if (lane == i) wd = gt | take;
        }
    }
    return wd;
}
template <int NR> __device__ __forceinline__ void idx_select(const unsigned* Sa, unsigned long long* mrow, int lane) {
    unsigned ka[NR], kb[NR];
#pragma unroll
    for (int i = 0; i < NR; ++i) { ka[i] = Sa[64 * i]; kb[i] = Sa[2048 + 64 * i]; }
    unsigned Ka = 0u, Kb = 0u; bool da = false, db = false;
    for (int bit = 31; bit >= 0; --bit) {
        const unsigned ca = Ka | (1u << bit), cb = Kb | (1u << bit);
        const unsigned ta = idx_count_ge<NR>(ka, ca), tb = idx_count_ge<NR>(kb, cb);
        if (!da && ta >= 256u) { Ka = ca; da = (ta == 256u); }
        if (!db && tb >= 256u) { Kb = cb; db = (tb == 256u); }
        if (da && db) break;
    }
    const unsigned long long wa = idx_words<NR>(ka, Ka, da, lane), wb = idx_words<NR>(kb, Kb, db, lane);
    if (lane < NR) { mrow[lane] = wa; mrow[32 + lane] = wb; }
}
__device__ __forceinline__ void indexer_unit(const Params& p, int unit, char* smem) {
    const int tid = tid_op(), lane = tid & 63, w = tid >> 6, c = lane & 15, g = lane >> 4;
    const int b = unit & 7, grp = 127 - (unit >> 3), t0 = grp * 16;
    char* ws = p.ws;
    unsigned long long* mask64 = (unsigned long long*)(ws + O_MASK) + (size_t)(b * 2048 + t0) * 32;
    const int nblk64 = (t0 + 16 + 63) >> 6;
    if (t0 < 256) {
        for (int i = tid; i < 16 * nblk64; i += 512) {
            const int q = i / nblk64, wd = i % nblk64, t = t0 + q, s0 = wd * 64;
            const unsigned long long bits = (t >= s0 + 63) ? ~0ull : (t < s0 ? 0ull : ((1ull << (t - s0 + 1)) - 1ull));
            mask64[q * 32 + wd] = bits;
        }
        return;
    }
    const int ntile = (nblk64 + 1) >> 1;
    const bf16_t* IQb = (const bf16_t*)(ws + O_IQB); const bf16_t* IKb = (const bf16_t*)(ws + O_IKB); const float* IWf = (const float*)(ws + O_IWF);
    unsigned* S = (unsigned*)smem;
    float* siw = (float*)(smem + IDX_LDS_SCORES);
    __syncthreads();
    if (tid < 128) siw[tid] = IWf[(size_t)(b * 2048 + t0) * 8 + tid];
    {
        const int nr = (nblk64 <= 8) ? 8 : (nblk64 <= 16) ? 16 : (nblk64 <= 24) ? 24 : 32, kfrom = 8 * ntile * 16, kto = nr * 64;
        for (int i = tid; i < 16 * (kto - kfrom); i += 512) { const int q = i / (kto - kfrom), k = kfrom + i % (kto - kfrom); S[q * 2048 + k] = 0u; }
    }
    __syncthreads();
    {
        bf16x8 aq[8];
#pragma unroll
        for (int h = 0; h < 8; ++h) aq[h] = ld8(IQb + ((size_t)(b * 2048 + t0 + c) * 8 + h) * 32 + g * 8);
        float wq[4][8];
#pragma unroll
        for (int r = 0; r < 4; ++r)
#pragma unroll
            for (int h = 0; h < 8; ++h) wq[r][h] = siw[(4 * g + r) * 8 + h];
        bf16x8 bk[IDX_NT];
#pragma unroll
        for (int i = 0; i < IDX_NT; ++i) {
            const int ti = (i < ntile) ? (w * ntile + i) : (w * ntile);
            bk[i] = ld8(IKb + (size_t)(b * 2048 + ti * 16 + c) * 32 + g * 8);
        }
#pragma unroll
        for (int i = 0; i < IDX_NT; ++i) {
            if (i < ntile) {
                const int s0 = (w * ntile + i) * 16;
                float sc[4] = {0.f, 0.f, 0.f, 0.f};
#pragma unroll
                for (int h = 0; h < 8; ++h) {
                    const f32x4 o = mfma16(aq[h], bk[i], (f32x4){0.f, 0.f, 0.f, 0.f});
#pragma unroll
                    for (int r = 0; r < 4; ++r) sc[r] += wq[r][h] * fmaxf(o[r], 0.f);
                }
#pragma unroll
                for (int r = 0; r < 4; ++r) S[(4 * g + r) * 2048 + s0 + c] = (s0 + c <= t0 + 4 * g + r) ? f2sort(sc[r]) : 0u;
            }
        }
    }
    __syncthreads();
    if (nblk64 <= 8) idx_select<8>(S + (2 * w) * 2048 + lane, mask64 + (2 * w) * 32, lane);
    else if (nblk64 <= 16) idx_select<16>(S + (2 * w) * 2048 + lane, mask64 + (2 * w) * 32, lane);
    else if (nblk64 <= 24) idx_select<24>(S + (2 * w) * 2048 + lane, mask64 + (2 * w) * 32, lane);
    else idx_select<32>(S + (2 * w) * 2048 + lane, mask64 + (2 * w) * 32, lane);
}

__device__ __forceinline__ void ssd_conv8(const u32x4g cur, const u32x4g prv, const float w0, const float w1, const float w2, const float w3, const float bias, float (&o)[8]) {
    float xv[11];
    xv[0] = bf2f((bf16_t)(prv.z >> 16)); xv[1] = bf2f((bf16_t)(prv.w & 0xFFFF)); xv[2] = bf2f((bf16_t)(prv.w >> 16));
    xv[3] = bf2f((bf16_t)(cur.x & 0xFFFF)); xv[4] = bf2f((bf16_t)(cur.x >> 16)); xv[5] = bf2f((bf16_t)(cur.y & 0xFFFF)); xv[6] = bf2f((bf16_t)(cur.y >> 16));
    xv[7] = bf2f((bf16_t)(cur.z & 0xFFFF)); xv[8] = bf2f((bf16_t)(cur.z >> 16)); xv[9] = bf2f((bf16_t)(cur.w & 0xFFFF)); xv[10] = bf2f((bf16_t)(cur.w >> 16));
#pragma unroll
    for (int j = 0; j < 8; ++j) { const float v = bias + w0 * xv[j] + w1 * xv[j + 1] + w2 * xv[j + 2] + w3 * xv[j + 3]; o[j] = bf2f(f2bf(silu_f(v))); }
}
__device__ __forceinline__ void ssd_prep_unit(const Params& p, int unit, char* smem) {
    const int tid = tid_op(), lane = tid & 63, w = tid >> 6, cL = lane & 15, gq = lane >> 4;
    const int g = unit & 1, c = (unit >> 1) & 15, b = unit >> 5;
    char* ws = p.ws;
    float* s_acum = (float*)smem; float* s_dt = s_acum + 512; float* s_w = s_dt + 512; float* s_tot = s_w + 512;
    bf16_t* sBt = (bf16_t*)(smem + 6144 + 64); bf16_t* sXw = sBt + 128 * 136; bf16_t* sCt = sXw;
    s_tot = (float*)(smem + 6144);
    const int tok0 = b * 2048 + c * 128;
    const bf16_t* XBCt = (const bf16_t*)(ws + O_XBCT);
    bf16_t* Xt = (bf16_t*)(ws + O_XT); bf16_t* Brm = (bf16_t*)(ws + O_BRM); bf16_t* Crm = (bf16_t*)(ws + O_CRM);
    __syncthreads();
    u32x4g cur8[8], prv8[8]; float cw8[8][5];
    const bool hasprev0 = (c * 128 >= 8);
#pragma unroll
    for (int it = 0; it < 8; ++it) {
        const int item = tid + 512 * it, tc = item & 15, ch = 512 + ((item >> 4) & 128) * 2 + g * 128 + ((item >> 4) & 127);
        const bf16_t* src = XBCt + ((size_t)b * 1024 + ch) * 2048 + c * 128 + tc * 8;
        cur8[it] = *(const u32x4g*)src;
        const bool hasprev = hasprev0 || tc > 0;
        prv8[it] = *(const u32x4g*)(hasprev ? src - 8 : src);
        if (!hasprev) prv8[it] = (u32x4g){0u, 0u, 0u, 0u};
        cw8[it][0] = p.conv_w[ch]; cw8[it][1] = p.conv_w[1024 + ch]; cw8[it][2] = p.conv_w[2048 + ch]; cw8[it][3] = p.conv_w[3072 + ch]; cw8[it][4] = p.conv_b[ch];
    }
    {
        const int hh = tid >> 7, l = tid & 127, h = 4 * g + hh;
        const float a_h = -expf(p.a_log[h]);
        const float dtv = ((const float*)(ws + O_DTF))[(size_t)(tok0 + l) * 8 + h];
        float v = dtv * a_h;
#pragma unroll
        for (int d = 1; d < 64; d <<= 1) { const float t = __shfl_up(v, d); if (lane >= d) v += t; }
        if (lane == 63) s_tot[w] = v;
        __syncthreads();
        if (w & 1) v += s_tot[w - 1];
        const float tot = s_tot[2 * hh] + s_tot[2 * hh + 1];
        s_acum[tid] = v; s_dt[tid] = dtv; s_w[tid] = dtv * __expf(tot - v);
        ((float*)(ws + O_ACUM))[(size_t)(b * 8 + h) * 2048 + c * 128 + l] = v;
        if (l == 0) ((float*)(ws + O_ATOT))[(b * 8 + h) * 16 + c] = tot;
    }
#pragma unroll
    for (int it = 0; it < 8; ++it) {
        const int item = tid + 512 * it, tc = item & 15, n = (item >> 4) & 127;
        float o[8];
        ssd_conv8(cur8[it], prv8[it], cw8[it][0], cw8[it][1], cw8[it][2], cw8[it][3], cw8[it][4], o);
        bf16_t* dst = ((item >> 4) & 128) ? sCt : sBt;
        *(uint4*)(dst + n * 136 + tc * 8) = make_uint4(pack2(o[0], o[1]), pack2(o[2], o[3]), pack2(o[4], o[5]), pack2(o[6], o[7]));
    }
#pragma unroll
    for (int it = 0; it < 8; ++it) {
        const int item = tid + 512 * it, tc = item & 15, ch = g * 256 + (item >> 4);
        const bf16_t* src = XBCt + ((size_t)b * 1024 + ch) * 2048 + c * 128 + tc * 8;
        cur8[it] = *(const u32x4g*)src;
        const bool hasprev = hasprev0 || tc > 0;
        prv8[it] = *(const u32x4g*)(hasprev ? src - 8 : src);
        if (!hasprev) prv8[it] = (u32x4g){0u, 0u, 0u, 0u};
        cw8[it][0] = p.conv_w[ch]; cw8[it][1] = p.conv_w[1024 + ch]; cw8[it][2] = p.conv_w[2048 + ch]; cw8[it][3] = p.conv_w[3072 + ch]; cw8[it][4] = p.conv_b[ch];
    }
    __syncthreads();
    {
        const int t = tid & 127, cb = tid >> 7;
#pragma unroll
        for (int m = 0; m < 2; ++m) {
            const bf16_t* srcT = (m ? sCt : sBt) + (cb * 32) * 136 + t;
            bf16_t* dst = (m ? Crm : Brm) + (size_t)(tok0 + t) * 256 + g * 128 + cb * 32;
#pragma unroll
            for (int q = 0; q < 4; ++q) {
                unsigned wv[4];
#pragma unroll
                for (int k = 0; k < 4; ++k) wv[k] = (unsigned)srcT[(8 * q + 2 * k) * 136] | ((unsigned)srcT[(8 * q + 2 * k + 1) * 136] << 16);
                *(uint4*)(dst + 8 * q) = make_uint4(wv[0], wv[1], wv[2], wv[3]);
            }
        }
    }
    __syncthreads();
#pragma unroll
    for (int it = 0; it < 8; ++it) {
        const int item = tid + 512 * it, tc = item & 15, hp = item >> 4, ch = g * 256 + hp;
        float o[8];
        ssd_conv8(cur8[it], prv8[it], cw8[it][0], cw8[it][1], cw8[it][2], cw8[it][3], cw8[it][4], o);
        *(uint4*)(Xt + ((size_t)b * 512 + ch) * 2048 + c * 128 + tc * 8) = make_uint4(pack2(o[0], o[1]), pack2(o[2], o[3]), pack2(o[4], o[5]), pack2(o[6], o[7]));
        const float* sw = s_w + (hp >> 6) * 128 + tc * 8;
        float q[8];
#pragma unroll
        for (int j = 0; j < 8; ++j) q[j] = o[j] * sw[j];
        *(uint4*)(sXw + hp * 136 + tc * 8) = make_uint4(pack2(q[0], q[1]), pack2(q[2], q[3]), pack2(q[4], q[5]), pack2(q[6], q[7]));
    }
    __syncthreads();
    bf16x8 bb[4];
#pragma unroll
    for (int ks = 0; ks < 4; ++ks) bb[ks] = ld8(sBt + (16 * w + cL) * 136 + ks * 32 + gq * 8);
#pragma unroll
    for (int hh = 0; hh < 4; ++hh) {
        f32x4 acc[4];
#pragma unroll
        for (int i = 0; i < 4; ++i) acc[i] = (f32x4){0.f, 0.f, 0.f, 0.f};
#pragma unroll
        for (int ks = 0; ks < 4; ++ks)
#pragma unroll
            for (int pt = 0; pt < 4; ++pt) acc[pt] = mfma16(ld8(sXw + (hh * 64 + 16 * pt + cL) * 136 + ks * 32 + gq * 8), bb[ks], acc[pt]);
        float* ST = (float*)(ws + O_ST) + ((size_t)((b * 16 + c) * 8 + 4 * g + hh)) * 8192;
#pragma unroll
        for (int pt = 0; pt < 4; ++pt)
#pragma unroll
            for (int r = 0; r < 4; ++r) ST[(16 * pt + 4 * gq + r) * 128 + 16 * w + cL] = acc[pt][r];
    }
}

__device__ __forceinline__ void phase2c(const Params& p) {
    char* ws = p.ws;
    const int idx = blockIdx.x * 512 + tid_op();
    if (idx >= 64 * 2048) return;
    const int bh = idx >> 11, e4 = idx & 2047, b = bh >> 3, h = bh & 7;
    const float* ST = (const float*)(ws + O_ST); const float* ATOT = (const float*)(ws + O_ATOT);
    float4 sv[16]; float4 at4[4];
#pragma unroll
    for (int c = 0; c < 16; ++c) sv[c] = *(const float4*)(ST + ((size_t)((b * 16 + c) * 8 + h)) * 8192 + (size_t)e4 * 4);
#pragma unroll
    for (int k = 0; k < 4; ++k) at4[k] = *(const float4*)(ATOT + bh * 16 + 4 * k);
    const float at[16] = {at4[0].x, at4[0].y, at4[0].z, at4[0].w, at4[1].x, at4[1].y, at4[1].z, at4[1].w, at4[2].x, at4[2].y, at4[2].z, at4[2].w, at4[3].x, at4[3].y, at4[3].z, at4[3].w};
    float4 car = make_float4(0.f, 0.f, 0.f, 0.f);
    bf16_t* CAR = (bf16_t*)(ws + O_CAR);
#pragma unroll
    for (int c = 0; c < 16; ++c) {
        *(uint2*)(CAR + ((size_t)((b * 16 + c) * 8 + h)) * 8192 + (size_t)e4 * 4) = make_uint2(pack2(car.x, car.y), pack2(car.z, car.w));
        const float dec = __expf(at[c]);
        car.x = dec * car.x + sv[c].x; car.y = dec * car.y + sv[c].y; car.z = dec * car.z + sv[c].z; car.w = dec * car.w + sv[c].w;
    }
}

#define ATT_LDK 80
#define ATT_LDV 136
#define ATT_KBYTES (128 * ATT_LDK * 2)
#define ATT_VBYTES (64 * ATT_LDV * 2)
__device__ __forceinline__ void attn_unit(const Params& p, int unit, char* smem) {
    const int tid = tid_op(), lane = tid & 63, w = tid >> 6, cL = lane & 15, gq = lane >> 4;
    const int qb = 15 - (unit >> 6), bh = unit & 63, b = bh >> 3, h = bh & 7;
    char* ws = p.ws;
    const int q0 = qb * 128 + 16 * w;
    const int ntile = qb + 1;
    const int wmax = (q0 + 15) >> 6;
    const bf16_t* Q = (const bf16_t*)(ws + O_QB) + (size_t)bh * 2048 * 64;
    const bf16_t* Kp = (const bf16_t*)(ws + O_KB) + (size_t)bh * 2048 * 64;
    const bf16_t* V = (const bf16_t*)(ws + O_VT) + (size_t)bh * 64 * 2048;
    const unsigned long long* mrow = (const unsigned long long*)(ws + O_MASK) + (size_t)(b * 2048 + q0 + cL) * 32;
    const int lr = tid >> 3, lc = (tid & 7) * 8;
    bf16x8 qf[2];
    qf[0] = ld8(Q + (size_t)(q0 + cL) * 64 + gq * 8); qf[1] = ld8(Q + (size_t)(q0 + cL) * 64 + 32 + gq * 8);
    float m_run = -1e30f, l_run = 0.f;
    f32x4 o[4];
#pragma unroll
    for (int i = 0; i < 4; ++i) o[i] = (f32x4){0.f, 0.f, 0.f, 0.f};
    char* sK = smem; char* sV = smem + 2 * ATT_KBYTES;
#define ATT_GLOAD(T, K0, K1, V0, V1) { const int s_ = (T) * 128; \
        K0 = *(const u32x4g*)(Kp + (size_t)(s_ + lr) * 64 + lc); K1 = *(const u32x4g*)(Kp + (size_t)(s_ + 64 + lr) * 64 + lc); \
        V0 = *(const u32x4g*)(V + (size_t)lr * 2048 + s_ + lc); V1 = *(const u32x4g*)(V + (size_t)lr * 2048 + s_ + 64 + lc); }
#define ATT_LSTORE(BUF, K0, K1, V0, V1) { bf16_t* k_ = (bf16_t*)(sK + (BUF) * ATT_KBYTES); bf16_t* v_ = (bf16_t*)(sV + (BUF) * ATT_VBYTES); \
        *(u32x4g*)(k_ + lr * ATT_LDK + lc) = K0; *(u32x4g*)(k_ + (64 + lr) * ATT_LDK + lc) = K1; \
        *(u32x4g*)(v_ + lr * ATT_LDV + lc) = V0; *(u32x4g*)(v_ + lr * ATT_LDV + 64 + lc) = V1; }
    u32x4g ka0, ka1, va0, va1, kb0, kb1, vb0, vb1;
    ATT_GLOAD(0, ka0, ka1, va0, va1)
    { const int t1 = (ntile > 1) ? 1 : 0; ATT_GLOAD(t1, kb0, kb1, vb0, vb1) }
    unsigned long long nmb0 = mrow[0], nmb1 = mrow[1];
    __syncthreads();
    ATT_LSTORE(0, ka0, ka1, va0, va1)
    __syncthreads();
    for (int kt = 0; kt < ntile; ++kt) {
        const int cur = kt & 1;
        ka0 = kb0; ka1 = kb1; va0 = vb0; va1 = vb1;
        { const int t2 = (kt + 2 < ntile) ? kt + 2 : ntile - 1; ATT_GLOAD(t2, kb0, kb1, vb0, vb1) }
        {
            const bf16_t* tK = (const bf16_t*)(sK + cur * ATT_KBYTES); const bf16_t* tV = (const bf16_t*)(sV + cur * ATT_VBYTES);
            const unsigned long long mb0 = (2 * kt <= wmax) ? nmb0 : 0ull, mb1 = (2 * kt + 1 <= wmax) ? nmb1 : 0ull;
            { const int tn = (kt + 1 < ntile) ? kt + 1 : kt; nmb0 = mrow[2 * tn]; nmb1 = mrow[2 * tn + 1]; }
            f32x4 st[8];
#pragma unroll
            for (int j = 0; j < 8; ++j) {
                f32x4 a = (f32x4){0.f, 0.f, 0.f, 0.f};
                const bf16_t* kr = tK + (16 * j + cL) * ATT_LDK + gq * 8;
                a = mfma16(ld8(kr), qf[0], a); a = mfma16(ld8(kr + 32), qf[1], a);
                st[j] = a;
            }
            float mx = m_run;
            const unsigned mw[4] = {(unsigned)mb0 >> (4 * gq), (unsigned)(mb0 >> 32) >> (4 * gq), (unsigned)mb1 >> (4 * gq), (unsigned)(mb1 >> 32) >> (4 * gq)};
#pragma unroll
            for (int j = 0; j < 8; ++j)
#pragma unroll
                for (int r = 0; r < 4; ++r) {
                    const bool bit = (mw[j >> 1] & (1u << (16 * (j & 1) + r))) != 0u;
                    const float v = bit ? st[j][r] : -INFINITY;
                    st[j][r] = v; mx = fmaxf(mx, v);
                }
            mx = max_x32(max_x16(mx));
            const float alpha = __builtin_amdgcn_exp2f(m_run - mx); m_run = mx;
            float ls = 0.f;
#pragma unroll
            for (int j = 0; j < 8; ++j)
#pragma unroll
                for (int r = 0; r < 4; ++r) { const float pv = __builtin_amdgcn_exp2f(st[j][r] - mx); st[j][r] = pv; ls += pv; }
            ls = sum_x32(sum_x16(ls));
            l_run = l_run * alpha + ls;
#pragma unroll
            for (int i = 0; i < 4; ++i) o[i] = o[i] * alpha;
#pragma unroll
            for (int kk = 0; kk < 4; ++kk) {
                const u32x4g pw = (u32x4g){pack2(st[2 * kk][0], st[2 * kk][1]), pack2(st[2 * kk][2], st[2 * kk][3]), pack2(st[2 * kk + 1][0], st[2 * kk + 1][1]), pack2(st[2 * kk + 1][2], st[2 * kk + 1][3])};
                const bf16x8 pf = __builtin_bit_cast(bf16x8, pw);
#pragma unroll
                for (int dt = 0; dt < 4; ++dt) {
                    const bf16_t* vr = tV + (16 * dt + cL) * ATT_LDV + 32 * kk + 4 * gq;
                    o[dt] = mfma16(cat4(*(const bf16x4*)vr, *(const bf16x4*)(vr + 16)), pf, o[dt]);
                }
            }
        }
        if (kt + 1 < ntile) ATT_LSTORE(cur ^ 1, ka0, ka1, va0, va1)
        __syncthreads();
    }
#undef ATT_GLOAD
#undef ATT_LSTORE
    const float inv = 1.f / l_run;
    bf16_t* mix = (bf16_t*)(ws + O_MIX) + (size_t)(b * 2048 + q0 + cL) * 1024 + h * 64;
#pragma unroll
    for (int dt = 0; dt < 4; ++dt)
        *(uint2*)(mix + 16 * dt + 4 * gq) = make_uint2(pack2(o[dt][0] * inv, o[dt][1] * inv), pack2(o[dt][2] * inv, o[dt][3] * inv));
}

#define SSM_TILE (128 * 136 * 2)
struct SsdPair { u32x4g x[4], car[4], z[4]; };
__device__ __forceinline__ void ssd_pair_load(SsdPair& P, const char* ws, int b, int c, int g, int pr, int tid) {
    const int row0 = tid >> 4, c16 = tid & 15;
    const int tok0 = b * 2048 + c * 128;
#pragma unroll
    for (int k = 0; k < 4; ++k) {
        const int row = row0 + 32 * k;
        const int h = 4 * g + 2 * pr + (row >> 6), pp = row & 63;
        P.x[k] = *(const u32x4g*)((const bf16_t*)(ws + O_XT) + ((size_t)b * 512 + h * 64 + pp) * 2048 + c * 128 + c16 * 8);
        P.car[k] = *(const u32x4g*)((const bf16_t*)(ws + O_CAR) + ((size_t)((b * 16 + c) * 8 + h)) * 8192 + pp * 128 + c16 * 8);
        P.z[k] = *(const u32x4g*)((const bf16_t*)(ws + O_ZB) + (size_t)(tok0 + row) * 512 + (4 * g + 2 * pr) * 64 + c16 * 8);
    }
}
__device__ __forceinline__ void ssd_pair_store(const SsdPair& P, char* tiles, int tid) {
    const int row0 = tid >> 4, c16 = tid & 15;
#pragma unroll
    for (int k = 0; k < 4; ++k) {
        const int off = ((row0 + 32 * k) * 136 + c16 * 8) * 2;
        *(u32x4g*)(tiles + off) = P.x[k]; *(u32x4g*)(tiles + SSM_TILE + off) = P.car[k]; *(u32x4g*)(tiles + 2 * SSM_TILE + off) = P.z[k];
    }
}
__device__ __forceinline__ void ssd_main_unit(const Params& p, int unit, char* smem) {
    const int tid = tid_op(), lane = tid & 63, w = tid >> 6, cL = lane & 15, gq = lane >> 4;
    const int g = unit & 1, c = (unit >> 1) & 15, b = unit >> 5;
    char* ws = p.ws;
    float* sAc = (float*)smem;
    float* sDt = sAc + 512;
    char* tiles = smem + 4096;
    const int tok0 = b * 2048 + c * 128;
    const int lt = (w < 4) ? w : 11 - w;
    const int ltok = tok0 + 16 * lt + cL;
    __syncthreads();
    SsdPair P;
    {
        const int row0 = tid >> 4, c16 = tid & 15;
        u32x4g bv[4], cv[4];
#pragma unroll
        for (int k = 0; k < 4; ++k) {
            const size_t go = (size_t)(tok0 + row0 + 32 * k) * 256 + g * 128 + c16 * 8;
            bv[k] = *(const u32x4g*)((const bf16_t*)(ws + O_BRM) + go); cv[k] = *(const u32x4g*)((const bf16_t*)(ws + O_CRM) + go);
        }
        const int hh = tid >> 7, l = tid & 127;
        const float av = ((const float*)(ws + O_ACUM))[(size_t)(b * 8 + 4 * g + hh) * 2048 + c * 128 + l];
        const float dv = ((const float*)(ws + O_DTF))[(size_t)(tok0 + l) * 8 + 4 * g + hh];
        ssd_pair_load(P, ws, b, c, g, 0, tid);
#pragma unroll
        for (int k = 0; k < 4; ++k) {
            const int off = ((row0 + 32 * k) * 136 + c16 * 8) * 2;
            *(u32x4g*)(tiles + off) = bv[k]; *(u32x4g*)(tiles + SSM_TILE + off) = cv[k];
        }
        sAc[tid] = av; sDt[tid] = dv;
    }
    __syncthreads();
    bf16x8 Cq[4];
    f32x4 cbT[8];
    {
        const bf16_t* sB = (const bf16_t*)tiles; const bf16_t* sC = (const bf16_t*)(tiles + SSM_TILE);
#pragma unroll
        for (int ks = 0; ks < 4; ++ks) Cq[ks] = ld8(sC + (16 * lt + cL) * 136 + ks * 32 + gq * 8);
#pragma unroll
        for (int st = 0; st < 8; ++st) {
            cbT[st] = (f32x4){0.f, 0.f, 0.f, 0.f};
            if (st <= lt) {
#pragma unroll
                for (int ks = 0; ks < 4; ++ks) cbT[st] = mfma16(ld8(sB + (16 * st + cL) * 136 + ks * 32 + gq * 8), Cq[ks], cbT[st]);
            }
        }
    }
    __syncthreads();
    float ssq = 0.f;
    u32x4g y0raw[4] = {};
    float* s_rstd = (float*)(tiles + 3 * SSM_TILE);
    bf16_t* mix = (bf16_t*)(ws + O_MIX);
#pragma unroll
    for (int pr = 0; pr < 2; ++pr) {
        if (pr) {
            ssd_pair_load(P, ws, b, c, g, 1, tid);
            __syncthreads();
#pragma unroll
            for (int k = 0; k < 4; ++k) y0raw[k] = *(const u32x4g*)(tiles + 2 * SSM_TILE + (((tid >> 4) + 32 * k) * 136 + (tid & 15) * 8) * 2);
            __syncthreads();
        }
        ssd_pair_store(P, tiles, tid);
        __syncthreads();
        const bf16_t* sX = (const bf16_t*)tiles; const bf16_t* sCar = (const bf16_t*)(tiles + SSM_TILE); const bf16_t* sZ = (const bf16_t*)(tiles + 2 * SSM_TILE);
#pragma unroll 1
        for (int h2 = 0; h2 < 2; ++h2) {
            const int hh = 2 * pr + h2, h = 4 * g + hh;
            const float* ac = sAc + hh * 128; const float* dtl = sDt + hh * 128;
            const float al = ac[16 * lt + cL];
            const bf16_t* xh = sX + h2 * 64 * 136; const bf16_t* carh = sCar + h2 * 64 * 136;
            f32x4 acc1[4], acc2[4];
#pragma unroll
            for (int i = 0; i < 4; ++i) { acc1[i] = (f32x4){0.f, 0.f, 0.f, 0.f}; acc2[i] = (f32x4){0.f, 0.f, 0.f, 0.f}; }
#pragma unroll
            for (int kk = 0; kk < 4; ++kk) {
                if (2 * kk <= lt) {
                    float mv[8];
#pragma unroll
                    for (int half = 0; half < 2; ++half) {
                        const int st = 2 * kk + half;
#pragma unroll
                        for (int r = 0; r < 4; ++r) {
                            const int sl = 16 * st + 4 * gq + r;
                            float v = 0.f;
                            if (st <= lt && sl <= 16 * lt + cL) v = cbT[st][r] * __expf(al - ac[sl]) * dtl[sl];
                            mv[half * 4 + r] = v;
                        }
                    }
                    const bf16x8 mf = __builtin_bit_cast(bf16x8, (u32x4g){pack2(mv[0], mv[1]), pack2(mv[2], mv[3]), pack2(mv[4], mv[5]), pack2(mv[6], mv[7])});
#pragma unroll
                    for (int pt = 0; pt < 4; ++pt) {
                        const bf16_t* xr = xh + (16 * pt + cL) * 136 + 32 * kk + 4 * gq;
                        acc1[pt] = mfma16(cat4(*(const bf16x4*)xr, *(const bf16x4*)(xr + 16)), mf, acc1[pt]);
                    }
                }
            }
#pragma unroll
            for (int ks = 0; ks < 4; ++ks)
#pragma unroll
                for (int pt = 0; pt < 4; ++pt) acc2[pt] = mfma16(ld8(carh + (16 * pt + cL) * 136 + ks * 32 + gq * 8), Cq[ks], acc2[pt]);
            const float el = __expf(al), dsk = p.d_skip[h];
#pragma unroll
            for (int pt = 0; pt < 4; ++pt) {
                const uint2 zz = *(const uint2*)(sZ + (16 * lt + cL) * 136 + h2 * 64 + 16 * pt + 4 * gq);
                const float zf[4] = {bf2f((bf16_t)(zz.x & 0xFFFF)), bf2f((bf16_t)(zz.x >> 16)), bf2f((bf16_t)(zz.y & 0xFFFF)), bf2f((bf16_t)(zz.y >> 16))};
                float yv[4];
#pragma unroll
                for (int r = 0; r < 4; ++r) {
                    const float xs = bf2f(xh[(16 * pt + 4 * gq + r) * 136 + 16 * lt + cL]);
                    float t = acc1[pt][r] + el * acc2[pt][r] + xs * dsk;
                    t *= silu_f(zf[r]);
                    yv[r] = bf2f(f2bf(t)); ssq += t * t;
                }
                *(uint2*)((bf16_t*)(tiles + 2 * SSM_TILE) + (16 * lt + cL) * 136 + h2 * 64 + 16 * pt + 4 * gq) = make_uint2(pack2(yv[0], yv[1]), pack2(yv[2], yv[3]));
            }
        }
    }
    ssq = sum_x32(sum_x16(ssq));
    if (gq == 0) s_rstd[16 * lt + cL] = rsqrtf(ssq * (1.f / 256.f) + LN_EPS);
    __syncthreads();
    {
        const int row0 = tid >> 4, c16 = tid & 15;
#pragma unroll
        for (int pr = 0; pr < 2; ++pr) {
            const int ch = (4 * g + 2 * pr) * 64 + c16 * 8;
            const float4 n0 = *(const float4*)(p.norm_w + ch), n1 = *(const float4*)(p.norm_w + ch + 4);
#pragma unroll
            for (int k = 0; k < 4; ++k) {
                const int row = row0 + 32 * k;
                const u32x4g y = pr ? *(const u32x4g*)(tiles + 2 * SSM_TILE + (row * 136 + c16 * 8) * 2) : y0raw[k];
                const float rs = s_rstd[row];
                u32x4g o;
                o.x = pack2(__uint_as_float(y.x << 16) * rs * n0.x, __uint_as_float(y.x & 0xFFFF0000u) * rs * n0.y);
                o.y = pack2(__uint_as_float(y.y << 16) * rs * n0.z, __uint_as_float(y.y & 0xFFFF0000u) * rs * n0.w);
                o.z = pack2(__uint_as_float(y.z << 16) * rs * n1.x, __uint_as_float(y.z & 0xFFFF0000u) * rs * n1.y);
                o.w = pack2(__uint_as_float(y.w << 16) * rs * n1.z, __uint_as_float(y.w & 0xFFFF0000u) * rs * n1.w);
                *(u32x4g*)(mix + (size_t)(tok0 + row) * 1024 + 512 + ch) = o;
            }
        }
    }
}

__device__ __forceinline__ void phase2(const Params& p, char* smem, int which = 3) {
    const int G = gridDim.x;
    if (which & 2) for (int u = blockIdx.x; u < 256; u += G) ssd_prep_unit(p, u, smem);
    if (which & 1) for (int k = 0; k * G < 1024; ++k) {
        const int u = k * G + ((k & 1) ? (G - 1 - (int)blockIdx.x) : (int)blockIdx.x);
        if (u < 1024) indexer_unit(p, u, smem);
    }
}
__device__ __forceinline__ void phase3(const Params& p, char* smem, int which = 3) {
    const int G = gridDim.x;
    for (int k = 0; k * G < 1024 + 256; ++k) {
        const int u = k * G + ((k & 1) ? (G - 1 - (int)blockIdx.x) : (int)blockIdx.x);
        if (u >= 1024 + 256) continue;
        if (u < 256) { if (which & 1) ssd_main_unit(p, u, smem); } else { if (which & 2) attn_unit(p, u - 256, smem); }
    }
}

struct OutEpi {
    const float* x; float* y;
    __device__ __forceinline__ void operator()(const f32x4 (&acc)[4][4], int mb, int nb, int lane, char* lds) const {
        const int c = lane & 15, g = lane >> 4;
        float* L = (float*)lds;
#pragma unroll
        for (int half = 0; half < 2; ++half) {
#pragma unroll
            for (int mi2 = 0; mi2 < 2; ++mi2)
#pragma unroll
                for (int r = 0; r < 4; ++r)
#pragma unroll
                    for (int ni = 0; ni < 4; ++ni) L[(16 * mi2 + 4 * g + r) * 68 + 16 * ni + c] = acc[2 * half + mi2][ni][r];
#pragma unroll
            for (int i = 0; i < 8; ++i) {
                const int row = 4 * i + g;
                const float4 a = *(const float4*)(L + row * 68 + 4 * c);
                const size_t o = (size_t)(mb + 32 * half + row) * 1024 + nb + 4 * c;
                const float4 xv = *(const float4*)(x + o);
                *(float4*)(y + o) = make_float4(ALPHA * xv.x + a.x, ALPHA * xv.y + a.y, ALPHA * xv.z + a.z, ALPHA * xv.w + a.w);
            }
        }
    }
};
__device__ __forceinline__ void phase4(const Params& p, char* smem, const XcdMap xm) {
    pg8::Gemm g{(const bf16_t*)(p.ws + O_MIX), (const bf16_t*)(p.ws + O_WOUT_T), NTOK, 1024, 1024};
    pg8::StaticOrder S; S.init(NTOK, 1024, (int)gridDim.x, (int)blockIdx.x);
    pg8::EpiResBf16 E{(bf16_t*)(p.ws + O_HB), p.x, 1024, ALPHA};
    pg8::gemm_phase<pg8::EpiResBf16, pg8::StaticOrder, false>((PG8_LAS unsigned char*)smem, g, S, E, nullptr);
}

__device__ __forceinline__ void phase5(const Params& p) {
    const int lane = tid_op() & 63, w = tid_op() >> 6;
    bf16_t* hb = (bf16_t*)(p.ws + O_HB);
    for (int row = blockIdx.x * 8 + w; row < NTOK; row += gridDim.x * 8) {
        bf16_t* yr = hb + (size_t)row * 1024 + 8 * lane;
        float v[16]; float s = 0.f;
#pragma unroll
        for (int j = 0; j < 2; ++j) {
            const uint4 r = *(const uint4*)(yr + 512 * j);
            const unsigned rw[4] = {r.x, r.y, r.z, r.w};
#pragma unroll
            for (int k = 0; k < 4; ++k) { v[8 * j + 2 * k] = __uint_as_float(rw[k] << 16); v[8 * j + 2 * k + 1] = __uint_as_float(rw[k] & 0xFFFF0000u); }
        }
#pragma unroll
        for (int k = 0; k < 16; ++k) s += v[k];
        const float mean = wave_sum(s) * (1.f / 1024.f);
        float q = 0.f;
#pragma unroll
        for (int k = 0; k < 16; ++k) { const float a = v[k] - mean; q += a * a; }
        const float rstd = rsqrtf(wave_sum(q) * (1.f / 1024.f) + LN_EPS);
#pragma unroll
        for (int j = 0; j < 2; ++j) {
            const int col = 8 * lane + 512 * j;
            const float4 g0 = *(const float4*)(p.ln1_g + col), g1 = *(const float4*)(p.ln1_g + col + 4), b0 = *(const float4*)(p.ln1_b + col), b1 = *(const float4*)(p.ln1_b + col + 4);
            const float gg[8] = {g0.x, g0.y, g0.z, g0.w, g1.x, g1.y, g1.z, g1.w}, bb[8] = {b0.x, b0.y, b0.z, b0.w, b1.x, b1.y, b1.z, b1.w};
            float o[8];
#pragma unroll
            for (int k = 0; k < 8; ++k) o[k] = (v[8 * j + k] - mean) * rstd * gg[k] + bb[k];
            *(uint4*)(yr + 512 * j) = make_uint4(pack2(o[0], o[1]), pack2(o[2], o[3]), pack2(o[4], o[5]), pack2(o[6], o[7]));
        }
    }
    convert_rows<false>(p, (size_t)V_EARLY * 256, (size_t)16384 * 256, (int)blockIdx.x, (int)gridDim.x);
}

struct QpEpi {
    bf16_t* qp;
    __device__ __forceinline__ void operator()(const f32x4 (&acc)[4][4], int mb, int nb, int lane, char* lds) const {
        const int c = lane & 15, g = lane >> 4;
        bf16_t* L = (bf16_t*)lds;
#pragma unroll
        for (int mi = 0; mi < 4; ++mi)
#pragma unroll
            for (int r = 0; r < 4; ++r)
#pragma unroll
                for (int ni = 0; ni < 4; ++ni) L[(16 * mi + 4 * g + r) * 72 + 16 * ni + c] = f2bf(acc[mi][ni][r]);
#pragma unroll
        for (int i = 0; i < 8; ++i) {
            const int row = 8 * i + (lane >> 3), cc = (lane & 7) * 8;
            *(uint4*)(qp + (size_t)(mb + row) * 2048 + nb + cc) = *(const uint4*)(L + row * 72 + cc);
        }
    }
};
__device__ __forceinline__ void phase6(const Params& p, char* smem, const XcdMap xm) {
    pg8::Gemm g{(const bf16_t*)(p.ws + O_HB), (const bf16_t*)(p.ws + O_WQ_T), NTOK, 2048, 1024};
    pg8::StaticOrder S; S.init(NTOK, 2048, (int)gridDim.x, (int)blockIdx.x);
    pg8::EpiBf16Plain E{(bf16_t*)(p.ws + O_QP), 2048};
    pg8::gemm_phase<pg8::EpiBf16Plain, pg8::StaticOrder, false>((PG8_LAS unsigned char*)smem, g, S, E, nullptr);
}

__device__ __forceinline__ float gelu_erf(float d) { return 0.5f * d * (1.f + erff(d * 0.70710678118654752f)); }
typedef unsigned u32x4n __attribute__((ext_vector_type(4)));
__device__ __forceinline__ long lo64n(const u32x4n v) { return (long)(((unsigned long long)v.y << 32) | v.x); }
__device__ __forceinline__ long hi64n(const u32x4n v) { return (long)(((unsigned long long)v.w << 32) | v.z); }
struct P8aRows { u32x4n a[16]; };
__device__ __forceinline__ void p8a_load(P8aRows& R, const unsigned char* U8, int eid, int gq) {
    const unsigned char* urow = U8 + (size_t)eid * 1024 + 16 * gq;
#pragma unroll
    for (int j = 0; j < 16; ++j) R.a[j] = *(const u32x4n*)(urow + 64 * j);
}
__device__ __forceinline__ float p8_dot16(const u32x4n r, const f32x2 (&hp)[8]) {
    f32x2 acc = __builtin_amdgcn_cvt_pk_f32_fp8((int)r.x, false) * hp[0];
    acc += __builtin_amdgcn_cvt_pk_f32_fp8((int)r.x, true) * hp[1];
    acc += __builtin_amdgcn_cvt_pk_f32_fp8((int)r.y, false) * hp[2]; acc += __builtin_amdgcn_cvt_pk_f32_fp8((int)r.y, true) * hp[3];
    acc += __builtin_amdgcn_cvt_pk_f32_fp8((int)r.z, false) * hp[4]; acc += __builtin_amdgcn_cvt_pk_f32_fp8((int)r.z, true) * hp[5];
    acc += __builtin_amdgcn_cvt_pk_f32_fp8((int)r.w, false) * hp[6]; acc += __builtin_amdgcn_cvt_pk_f32_fp8((int)r.w, true) * hp[7];
    return acc.x + acc.y;
}
__device__ __forceinline__ float p8_reduce16(const float (&p)[16], int lane) {
    float q[8], r4[4], t2[2];
#pragma unroll
    for (int k = 0; k < 8; ++k) { const u32x2_t sw = __builtin_amdgcn_permlane32_swap(__float_as_uint(p[k]), __float_as_uint(p[k + 8]), false, false); q[k] = __uint_as_float(sw.x) + __uint_as_float(sw.y); }
#pragma unroll
    for (int k = 0; k < 4; ++k) { const u32x2_t sw = __builtin_amdgcn_permlane16_swap(__float_as_uint(q[k]), __float_as_uint(q[k + 4]), false, false); r4[k] = __uint_as_float(sw.x) + __uint_as_float(sw.y); }
    const bool b3 = (lane & 8) != 0, b2 = (lane & 4) != 0;
#pragma unroll
    for (int k = 0; k < 2; ++k) { const float snd = b3 ? r4[k] : r4[k + 2], keep = b3 ? r4[k + 2] : r4[k]; t2[k] = keep + dpp_f<0x128, 0xF, true>(snd); }
    const float snd = b2 ? t2[0] : t2[1], keep = b2 ? t2[1] : t2[0];
    float z = keep + dpp_f<0x141, 0xF, true>(snd);
    z += dpp_f<0xB1, 0xF, true>(z); z += dpp_f<0x4E, 0xF, true>(z);
    return z;
}
__constant__ unsigned char CAND_I[64] = {0,0,0,0,0,0,0,0,0,0,0,0,0,0,0,0, 1,1,1,1,1,1,1,1, 2,2,2,2,2, 3,3,3,3, 4,4,4, 5,5, 6,6, 7,7, 8,9,10,11,12,13,14,15, 0,0,0,0,0,0,0,0,0,0,0,0,0,0};
__constant__ unsigned char CAND_J[64] = {0,1,2,3,4,5,6,7,8,9,10,11,12,13,14,15, 0,1,2,3,4,5,6,7, 0,1,2,3,4, 0,1,2,3, 0,1,2, 0,1, 0,1, 0,1, 0,0,0,0,0,0,0,0, 0,0,0,0,0,0,0,0,0,0,0,0,0,0};
__device__ __forceinline__ unsigned rowmax_u(unsigned v) { return row_max_u(v); }
struct PeerSel { int ev[4]; float gv[4]; };
__device__ __forceinline__ PeerSel peer_select(const Params& p, int wunit, const char* ktab) {
    const int lane = tid_op() & 63, cL = lane & 15, gq = lane >> 4, rowbase = lane & 48;
    const int tg = wunit >> 3, h = wunit & 7, tok0 = tg * 16;
    char* ws = p.ws;
    const bf16_t* QP = (const bf16_t*)(ws + O_QP);
    unsigned top[2][4];
#pragma unroll
    for (int half = 0; half < 2; ++half) {
        const bf16_t* KB = (const bf16_t*)(ktab + half * (128 * 144 * 2));
        bf16x8 a[4];
#pragma unroll
        for (int ks = 0; ks < 4; ++ks) a[ks] = ld8(QP + (size_t)(tok0 + cL) * 2048 + h * 256 + half * 128 + ks * 32 + gq * 8);
        unsigned pk[8][4];
#pragma unroll
        for (int nt = 0; nt < 8; ++nt) {
            f32x4 acc = (f32x4){0.f, 0.f, 0.f, 0.f};
#pragma unroll
            for (int ks = 0; ks < 4; ++ks) acc = mfma16(a[ks], ld8(KB + (16 * nt + cL) * 144 + ks * 32 + gq * 8), acc);
#pragma unroll
            for (int r = 0; r < 4; ++r) pk[nt][r] = (f2sort(acc[r]) & ~0x7Fu) | (unsigned)(127 - (16 * nt + cL));
        }
#pragma unroll
        for (int r = 0; r < 4; ++r) top[half][r] = 0u;
#define PS_CAS(A, B) { const unsigned hi_ = max(pk[A][r], pk[B][r]), lo_ = min(pk[A][r], pk[B][r]); pk[A][r] = hi_; pk[B][r] = lo_; }
#pragma unroll
        for (int r = 0; r < 4; ++r) {
            PS_CAS(0, 1) PS_CAS(2, 3) PS_CAS(4, 5) PS_CAS(6, 7)
            PS_CAS(0, 2) PS_CAS(1, 3) PS_CAS(4, 6) PS_CAS(5, 7)
            PS_CAS(1, 2) PS_CAS(5, 6)
            PS_CAS(0, 4) PS_CAS(1, 5) PS_CAS(2, 6) PS_CAS(3, 7)
            PS_CAS(2, 4) PS_CAS(3, 5)
            PS_CAS(1, 2) PS_CAS(3, 4) PS_CAS(5, 6)
        }
#undef PS_CAS
        for (int it = 0; it < 16; ++it) {
#pragma unroll
            for (int r = 0; r < 4; ++r) {
                const unsigned gm = rowmax_u(pk[0][r]);
                if (cL == it) top[half][r] = gm;
                const bool pop = (pk[0][r] == gm);
#pragma unroll
                for (int nt = 0; nt < 7; ++nt) pk[nt][r] = pop ? pk[nt + 1][r] : pk[nt][r];
                pk[7][r] = pop ? 0u : pk[7][r];
            }
        }
    }
    unsigned ck[4][4];
#pragma unroll
    for (int s = 0; s < 4; ++s) {
        const int q = s * 16 + cL; const int ci = CAND_I[q], cj = CAND_J[q];
#pragma unroll
        for (int r = 0; r < 4; ++r) {
            const unsigned t1 = (unsigned)__shfl((int)top[0][r], rowbase + ci), t2 = (unsigned)__shfl((int)top[1][r], rowbase + cj);
            const float f = sort2f(t1 & ~0x7Fu) + sort2f(t2 & ~0x7Fu);
            ck[s][r] = (q < 50) ? ((f2sort(f) & ~0x3Fu) | (unsigned)(63 - q)) : 0u;
        }
    }
    unsigned best[4] = {0u, 0u, 0u, 0u};
#define PS_CAS(A, B) { const unsigned hi_ = max(ck[A][r], ck[B][r]), lo_ = min(ck[A][r], ck[B][r]); ck[A][r] = hi_; ck[B][r] = lo_; }
#pragma unroll
    for (int r = 0; r < 4; ++r) { PS_CAS(0, 1) PS_CAS(2, 3) PS_CAS(0, 2) PS_CAS(1, 3) PS_CAS(1, 2) }
#undef PS_CAS
    for (int it = 0; it < 16; ++it) {
#pragma unroll
        for (int r = 0; r < 4; ++r) {
            const unsigned gm = rowmax_u(ck[0][r]);
            if (cL == it) best[r] = gm;
            const bool pop = (ck[0][r] == gm);
            ck[0][r] = pop ? ck[1][r] : ck[0][r]; ck[1][r] = pop ? ck[2][r] : ck[1][r]; ck[2][r] = pop ? ck[3][r] : ck[2][r]; ck[3][r] = pop ? 0u : ck[3][r];
        }
    }
    PeerSel S_;
#pragma unroll
    for (int r = 0; r < 4; ++r) {
        const float fv = sort2f(best[r] & ~0x3Fu);
        const int q = 63 - (int)(best[r] & 63u);
        const int ci = CAND_I[q], cj = CAND_J[q];
        const unsigned t1 = (unsigned)__shfl((int)top[0][r], rowbase + ci), t2 = (unsigned)__shfl((int)top[1][r], rowbase + cj);
        S_.ev[r] = (127 - (int)(t1 & 127u)) * 128 + (127 - (int)(t2 & 127u));
        const float mx = __shfl(fv, rowbase);
        const float ex = __expf(fv - mx);
        const float sm = row_sum(ex);
        S_.gv[r] = ex / sm;
    }
    return S_;
}
#define PU_ROWEID(SEL, TT, I) __builtin_amdgcn_readlane(SEL.ev[(TT) & 3], 16 * ((TT) >> 2) + (I))
__device__ __forceinline__ void peer_blocks(const Params& p, int wunit, const PeerSel& S_, const PeerSel& N_, bool has_next, P8aRows& R0, P8aRows& R1) {
    const int lane = tid_op() & 63;
    const int tok0 = (wunit >> 3) * 16, h = wunit & 7;
    char* ws = p.ws;
    const unsigned char* U8 = (const unsigned char*)(ws + O_U8) + 16 * lane;
    const bf16_t* H = (const bf16_t*)(ws + O_HB) + (size_t)tok0 * 1024 + 16 * lane;
    unsigned* ACT = (unsigned*)(ws + O_ACT) + (size_t)tok0 * 128 + h * 16;
#define PU_STEP(RC, TT) { \
        f32x2 hp[8]; \
        _Pragma("unroll") for (int k = 0; k < 2; ++k) { const u32x4n hv_ = *(const u32x4n*)(H + (TT) * 1024 + 8 * k); \
            hp[4 * k] = (f32x2){__uint_as_float(hv_.x << 16), __uint_as_float(hv_.x & 0xFFFF0000u)}; hp[4 * k + 1] = (f32x2){__uint_as_float(hv_.y << 16), __uint_as_float(hv_.y & 0xFFFF0000u)}; \
            hp[4 * k + 2] = (f32x2){__uint_as_float(hv_.z << 16), __uint_as_float(hv_.z & 0xFFFF0000u)}; hp[4 * k + 3] = (f32x2){__uint_as_float(hv_.w << 16), __uint_as_float(hv_.w & 0xFFFF0000u)}; } \
        float pp[16]; \
        _Pragma("unroll") for (int i = 0; i < 16; ++i) { \
            pp[i] = p8_dot16(RC.a[i], hp); \
            if ((TT) < 14) RC.a[i] = *(const u32x4n*)(U8 + (size_t)PU_ROWEID(S_, ((TT) + 2) & 15, i) * 1024); \
            else if (has_next) RC.a[i] = *(const u32x4n*)(U8 + (size_t)PU_ROWEID(N_, ((TT) + 2) & 15, i) * 1024); } \
        const float dot = p8_reduce16(pp, lane) * (1.f / 32.f); \
        const int src_ = 16 * ((TT) >> 2) + (lane >> 2); \
        const float gt_ = __shfl(S_.gv[(TT) & 3], src_); const int ei_ = __shfl(S_.ev[(TT) & 3], src_); \
        const float act_ = gelu_erf(dot) * gt_; \
        if ((lane & 3) == 0) ACT[(TT) * 128 + (lane >> 2)] = (unsigned)ei_ | ((unsigned)f2bf(act_) << 16); }
    PU_STEP(R0, 0) PU_STEP(R1, 1) PU_STEP(R0, 2) PU_STEP(R1, 3) PU_STEP(R0, 4) PU_STEP(R1, 5) PU_STEP(R0, 6) PU_STEP(R1, 7)
    PU_STEP(R0, 8) PU_STEP(R1, 9) PU_STEP(R0, 10) PU_STEP(R1, 11) PU_STEP(R0, 12) PU_STEP(R1, 13) PU_STEP(R0, 14) PU_STEP(R1, 15)
#undef PU_STEP
}
__device__ __forceinline__ void phase7(const Params& p, char* smem) {
    const int lane = tid_op() & 63;
    const int w = __builtin_amdgcn_readfirstlane(tid_op() >> 6);
    const int stride = gridDim.x * 8;
    const unsigned char* U8 = (const unsigned char*)(p.ws + O_U8) + 16 * lane;
    {
        const int tid = tid_op();
        __syncthreads();
#pragma unroll
        for (int k = 0; k < 8; ++k) {
            const int c = tid + 512 * k, half = c >> 11, row = (c >> 4) & 127, ch = c & 15;
            *(uint4*)(smem + half * (128 * 144 * 2) + row * 288 + ch * 16) = *(const uint4*)(p.ws + (half ? O_K2B : O_K1B) + (size_t)row * 256 + ch * 16);
        }
        __syncthreads();
    }
    for (int u = blockIdx.x * 8 + w; u < 8192; u += stride) {
        const PeerSel s0 = peer_select(p, u, smem);
        P8aRows R0, R1;
#pragma unroll
        for (int i = 0; i < 16; ++i) { R0.a[i] = *(const u32x4n*)(U8 + (size_t)PU_ROWEID(s0, 0, i) * 1024); R1.a[i] = *(const u32x4n*)(U8 + (size_t)PU_ROWEID(s0, 1, i) * 1024); }
        peer_blocks(p, u, s0, s0, false, R0, R1);
    }
}
#undef PU_ROWEID

__device__ __forceinline__ float dot16_fp8(const uint4& r, const float (&hv)[16]) {
    const f32x2 a0 = __builtin_amdgcn_cvt_pk_f32_fp8((int)r.x, false), a1 = __builtin_amdgcn_cvt_pk_f32_fp8((int)r.x, true);
    const f32x2 b0 = __builtin_amdgcn_cvt_pk_f32_fp8((int)r.y, false), b1 = __builtin_amdgcn_cvt_pk_f32_fp8((int)r.y, true);
    const f32x2 c0 = __builtin_amdgcn_cvt_pk_f32_fp8((int)r.z, false), c1 = __builtin_amdgcn_cvt_pk_f32_fp8((int)r.z, true);
    const f32x2 d0 = __builtin_amdgcn_cvt_pk_f32_fp8((int)r.w, false), d1 = __builtin_amdgcn_cvt_pk_f32_fp8((int)r.w, true);
    return (hv[0] * a0.x + hv[1] * a0.y + hv[2] * a1.x + hv[3] * a1.y) + (hv[4] * b0.x + hv[5] * b0.y + hv[6] * b1.x + hv[7] * b1.y)
         + (hv[8] * c0.x + hv[9] * c0.y + hv[10] * c1.x + hv[11] * c1.y) + (hv[12] * d0.x + hv[13] * d0.y + hv[14] * d1.x + hv[15] * d1.y);
}
struct P8bRows { u32x4n v[8]; };
struct P8bMeta { u32x4n m[4]; };
__device__ __forceinline__ void p8b_meta(P8bMeta& M, const unsigned* ACT, int row, int e8) {
#pragma unroll
    for (int k = 0; k < 4; ++k) M.m[k] = *(const u32x4n*)(ACT + (size_t)row * 128 + e8 * 16 + 4 * k);
}
template <int HALF> __device__ __forceinline__ void p8b_load(P8bRows& R, const P8bMeta& M, const unsigned char* V8) {
#pragma unroll
    for (int k = 0; k < 2; ++k) {
        const u32x4n mm = M.m[2 * HALF + k];
        R.v[4 * k + 0] = *(const u32x4n*)(V8 + (size_t)(mm.x & 0xFFFFu) * 128); R.v[4 * k + 1] = *(const u32x4n*)(V8 + (size_t)(mm.y & 0xFFFFu) * 128);
        R.v[4 * k + 2] = *(const u32x4n*)(V8 + (size_t)(mm.z & 0xFFFFu) * 128); R.v[4 * k + 3] = *(const u32x4n*)(V8 + (size_t)(mm.w & 0xFFFFu) * 128);
    }
}
template <int HALF> __device__ __forceinline__ void p8b_accum(f32x2 (&acc)[8], const P8bRows& R, const P8bMeta& M) {
#pragma unroll
    for (int k = 0; k < 2; ++k) {
        const u32x4n mm = M.m[2 * HALF + k];
        const unsigned mw[4] = {mm.x, mm.y, mm.z, mm.w};
#pragma unroll
        for (int q = 0; q < 4; ++q) {
            const float a1 = __uint_as_float(mw[q] & 0xFFFF0000u);
            const f32x2 av = (f32x2){a1, a1};
            const u32x4n x = R.v[4 * k + q];
            acc[0] += av * __builtin_amdgcn_cvt_pk_f32_fp8((int)x.x, false); acc[1] += av * __builtin_amdgcn_cvt_pk_f32_fp8((int)x.x, true);
            acc[2] += av * __builtin_amdgcn_cvt_pk_f32_fp8((int)x.y, false); acc[3] += av * __builtin_amdgcn_cvt_pk_f32_fp8((int)x.y, true);
            acc[4] += av * __builtin_amdgcn_cvt_pk_f32_fp8((int)x.z, false); acc[5] += av * __builtin_amdgcn_cvt_pk_f32_fp8((int)x.z, true);
            acc[6] += av * __builtin_amdgcn_cvt_pk_f32_fp8((int)x.w, false); acc[7] += av * __builtin_amdgcn_cvt_pk_f32_fp8((int)x.w, true);
        }
    }
}
__device__ __forceinline__ void p8b_store(const f32x2 (&acc)[8], float* hr, const bf16_t* hb, int e8) {
    float r[16];
#pragma unroll
    for (int j = 0; j < 8; ++j) { r[2 * j] = acc[j].x; r[2 * j + 1] = acc[j].y; }
#pragma unroll
    for (int j = 0; j < 16; ++j) { r[j] += dpp_f<0x128, 0xF, true>(r[j]); r[j] = sum_x32(sum_x16(r[j])); }
    if (e8 == 0) {
#pragma unroll
        for (int j = 0; j < 2; ++j) {
            const uint4 hw = *(const uint4*)(hb + 8 * j);
            *(float4*)(hr + 8 * j) = make_float4(ALPHA * __uint_as_float(hw.x << 16) + r[8 * j], ALPHA * __uint_as_float(hw.x & 0xFFFF0000u) + r[8 * j + 1],
                                                 ALPHA * __uint_as_float(hw.y << 16) + r[8 * j + 2], ALPHA * __uint_as_float(hw.y & 0xFFFF0000u) + r[8 * j + 3]);
            *(float4*)(hr + 8 * j + 4) = make_float4(ALPHA * __uint_as_float(hw.z << 16) + r[8 * j + 4], ALPHA * __uint_as_float(hw.z & 0xFFFF0000u) + r[8 * j + 5],
                                                     ALPHA * __uint_as_float(hw.w << 16) + r[8 * j + 6], ALPHA * __uint_as_float(hw.w & 0xFFFF0000u) + r[8 * j + 7]);
        }
    }
}
__device__ __forceinline__ void phase8b(const Params& p, const XcdMap xm, float* outp) {
    const int lane = tid_op() & 63, w = tid_op() >> 6, e8 = lane >> 3, c8 = lane & 7;
    char* ws = p.ws;
    const unsigned char* V8 = (const unsigned char*)(ws + O_V8) + (size_t)xm.slice * 16384 * 128 + 16 * c8;
    const unsigned* ACT = (const unsigned*)(ws + O_ACT);
    const int stride = xm.nloc * 8;
    int row = xm.rank * 8 + w;
    if (row >= NTOK) return;
    float* const hbase = outp + xm.slice * 128 + 16 * c8;
    const bf16_t* const hbb = (const bf16_t*)(ws + O_HB) + xm.slice * 128 + 16 * c8;
    P8bMeta Mc, Mn; P8bRows Ra, Rb;
    p8b_meta(Mc, ACT, row, e8);
    p8b_meta(Mn, ACT, (row + stride < NTOK) ? row + stride : row, e8);
    p8b_load<0>(Ra, Mc, V8);
    for (; row < NTOK; row += stride) {
        f32x2 acc[8];
#pragma unroll
        for (int j = 0; j < 8; ++j) acc[j] = (f32x2){0.f, 0.f};
        p8b_load<1>(Rb, Mc, V8);
        p8b_accum<0>(acc, Ra, Mc);
        p8b_load<0>(Ra, Mn, V8);
        p8b_accum<1>(acc, Rb, Mc);
        p8b_store(acc, hbase + (size_t)row * 1024, hbb + (size_t)row * 1024, e8);
        Mc = Mn;
        const int r2 = row + 2 * stride;
        p8b_meta(Mn, ACT, r2 < NTOK ? r2 : row, e8);
    }
}
__device__ __forceinline__ void phase8c(const Params& p) {
    const int lane = tid_op() & 63, w = tid_op() >> 6;
    for (int row = blockIdx.x * 8 + w; row < NTOK; row += gridDim.x * 8) {
        float* yr = p.out + (size_t)row * 1024;
        float4 v[4]; float s = 0.f;
#pragma unroll
        for (int j = 0; j < 4; ++j) { v[j] = *(const float4*)(yr + 4 * lane + 256 * j); s += v[j].x + v[j].y + v[j].z + v[j].w; }
        const float mean = wave_sum(s) * (1.f / 1024.f);
        float q = 0.f;
#pragma unroll
        for (int j = 0; j < 4; ++j) { const float a = v[j].x - mean, b2 = v[j].y - mean, c2 = v[j].z - mean, d = v[j].w - mean; q += a * a + b2 * b2 + c2 * c2 + d * d; }
        const float rstd = rsqrtf(wave_sum(q) * (1.f / 1024.f) + LN_EPS);
#pragma unroll
        for (int j = 0; j < 4; ++j) {
            const int col = 4 * lane + 256 * j;
            const float4 gg = *(const float4*)(p.ln2_g + col), bb = *(const float4*)(p.ln2_b + col);
            float4 o;
            o.x = (v[j].x - mean) * rstd * gg.x + bb.x; o.y = (v[j].y - mean) * rstd * gg.y + bb.y; o.z = (v[j].z - mean) * rstd * gg.z + bb.z; o.w = (v[j].w - mean) * rstd * gg.w + bb.w;
            *(float4*)(yr + col) = o;
        }
    }
}

typedef const __attribute__((address_space(4))) Params* ParamsK;
__device__ __forceinline__ Params params_reload() {
#if defined(__HIP_DEVICE_COMPILE__)
    auto ka = __builtin_amdgcn_kernarg_segment_ptr();
    asm volatile("" : "+s"(ka));
    Params r; __builtin_memcpy(&r, (const __attribute__((address_space(4))) void*)ka, sizeof(Params));
    return r;
#else
    return Params{};
#endif
}
#if ONE_LAUNCH
__global__ void __launch_bounds__(512, 2) fwd_megakernel(Params p) {
    __shared__ __attribute__((aligned(16))) char smem[SMEM_BYTES];
    cg::grid_group grid = cg::this_grid();
    volatile LAS unsigned* st = (volatile LAS unsigned*)(smem + SMEM_BYTES - 16);
    if (threadIdx.x == 0) { st[0] = 0u; st[1] = 0u; st[2] = 0u; st[3] = 0u; }
    __syncthreads();
    const XcdBarrier xb = xcd_barrier_post((unsigned*)(p.ws + O_BAR), st);
    if (p.use_cg) grid.sync();
#define GRID_BAR() xcd_barrier(xb)
#ifndef DUP
#define DUP -1
#endif
#define PP (params_reload())
#define RUNPH(k, call) { int n_ = (DUP == k) ? 2 : 1; asm volatile("" : "+s"(n_)); _Pragma("unroll 1") for (int i_ = 0; i_ < n_; ++i_) { call; GRID_BAR(); } }
    RUNPH(0, phase0(PP))
    XcdMap xm;
    if (st[2]) { xm.slice = (int)xb.x; xm.rank = (int)st[3]; xm.nloc = (int)st[0]; }
    else { xm.slice = blockIdx.x & 7; xm.rank = blockIdx.x >> 3; xm.nloc = gridDim.x >> 3; }
    xm.slice = __builtin_amdgcn_readfirstlane(xm.slice); xm.rank = __builtin_amdgcn_readfirstlane(xm.rank); xm.nloc = __builtin_amdgcn_readfirstlane(xm.nloc);
    asm volatile("" : "+s"(xm.slice), "+s"(xm.rank), "+s"(xm.nloc));
    RUNPH(1, phase1(PP, smem, xm))
    RUNPH(2, phase2(PP, smem))
    if (DUP == 20) { int wh_ = 1; asm volatile("" : "+s"(wh_)); phase2(PP, smem, wh_); GRID_BAR(); }
    if (DUP == 21) { int wh_ = 2; asm volatile("" : "+s"(wh_)); phase2(PP, smem, wh_); GRID_BAR(); }
    phase2c(PP); GRID_BAR();
    RUNPH(3, phase3(PP, smem))
    if (DUP == 30) { int wh_ = 1; asm volatile("" : "+s"(wh_)); phase3(PP, smem, wh_); GRID_BAR(); }
    if (DUP == 31) { int wh_ = 2; asm volatile("" : "+s"(wh_)); phase3(PP, smem, wh_); GRID_BAR(); }
    RUNPH(4, phase4(PP, smem, xm))
    phase5(PP); GRID_BAR();
    RUNPH(6, phase6(PP, smem, xm))
    RUNPH(7, phase7(PP, smem))
#ifdef SCRAMBLE
    { const int x_ = xm.slice, r_ = xm.rank; xm.slice = (x_ + r_) & 7; xm.rank = (r_ >> 3) * 8 + x_; xm.nloc = 32; }
#endif
    if (DUP == 9) { phase8b(PP, xm, (float*)(PP.ws + O_QP)); GRID_BAR(); }
    phase8b(PP, xm, PP.out); GRID_BAR();
    phase8c(PP);
}
#else
__global__ void __launch_bounds__(512, 2) k_phase0(Params p) { phase0(p); }
__global__ void __launch_bounds__(512, 2) k_phase1(Params p) { __shared__ __attribute__((aligned(16))) char smem[SMEM_BYTES]; XcdMap xm; xm.slice = blockIdx.x & 7; xm.rank = blockIdx.x >> 3; xm.nloc = gridDim.x >> 3; phase1(p, smem, xm); }
__global__ void __launch_bounds__(512, 2) k_phase2(Params p) { __shared__ __attribute__((aligned(16))) char smem[SMEM_BYTES]; phase2(p, smem); }
__global__ void __launch_bounds__(512, 2) k_phase2c(Params p) { phase2c(p); }
__global__ void __launch_bounds__(512, 2) k_phase3(Params p) { __shared__ __attribute__((aligned(16))) char smem[SMEM_BYTES]; phase3(p, smem); }
__global__ void __launch_bounds__(512, 2) k_phase4(Params p) { __shared__ __attribute__((aligned(16))) char smem[SMEM_BYTES]; XcdMap xm; xm.slice = blockIdx.x & 7; xm.rank = blockIdx.x >> 3; xm.nloc = gridDim.x >> 3; phase4(p, smem, xm); }
__global__ void __launch_bounds__(512, 2) k_phase5(Params p) { phase5(p); }
__global__ void __launch_bounds__(512, 2) k_phase6(Params p) { __shared__ __attribute__((aligned(16))) char smem[SMEM_BYTES]; XcdMap xm; xm.slice = blockIdx.x & 7; xm.rank = blockIdx.x >> 3; xm.nloc = gridDim.x >> 3; phase6(p, smem, xm); }
__global__ void __launch_bounds__(512, 2) k_phase7(Params p) { __shared__ __attribute__((aligned(16))) char smem_[SMEM_BYTES]; phase7(p, smem_); }
__global__ void __launch_bounds__(512, 2) k_phase8b(Params p) { XcdMap xm; xm.slice = blockIdx.x & 7; xm.rank = blockIdx.x >> 3; xm.nloc = gridDim.x >> 3; phase8b(p, xm, p.out); }
__global__ void __launch_bounds__(512, 2) k_phase8c(Params p) { phase8c(p); }
#endif

extern "C" void kernel_launch(void* const* d_in, const int* in_sizes, int n_in, void* d_out, int out_size, void* d_ws, size_t ws_size, hipStream_t stream) {
    Params p{};
    p.x = (const float*)d_in[0]; p.pos = (const int*)d_in[1]; p.w_in = (const float*)d_in[2]; p.conv_w = (const float*)d_in[3]; p.conv_b = (const float*)d_in[4];
    p.dt_bias = (const float*)d_in[5]; p.a_log = (const float*)d_in[6]; p.d_skip = (const float*)d_in[7]; p.norm_w = (const float*)d_in[8]; p.w_out = (const float*)d_in[9];
    p.ln1_g = (const float*)d_in[10]; p.ln1_b = (const float*)d_in[11]; p.wq = (const float*)d_in[12]; p.k1 = (const float*)d_in[13]; p.k2 = (const float*)d_in[14];
    p.u = (const float*)d_in[15]; p.v = (const float*)d_in[16]; p.ln2_g = (const float*)d_in[17]; p.ln2_b = (const float*)d_in[18];
    p.out = (float*)d_out; p.ws = (char*)d_ws;
    if (ws_size < WS_NEEDED) { fprintf(stderr, "kernel_launch: workspace too small (%zu < %zu)\n", ws_size, (size_t)WS_NEEDED); return; }
#if ONE_LAUNCH
    static int grid_blocks = 0;
    if (!grid_blocks) {
        int dev = 0, cus = 0, per_cu = 0;
        hipGetDevice(&dev);
        hipDeviceGetAttribute(&cus, hipDeviceAttributeMultiprocessorCount, dev);
        hipOccupancyMaxActiveBlocksPerMultiprocessor(&per_cu, fwd_megakernel, 512, 0);
        if (per_cu > 1) per_cu = 1;
        if (per_cu < 1) per_cu = 1;
        grid_blocks = cus * per_cu;
    }
    (void)hipMemsetAsync((char*)d_ws + O_BAR, 0, XCD_BAR_WORDS * 4, stream);
    void* args[] = {&p};
    hipError_t e = hipLaunchCooperativeKernel((void*)fwd_megakernel, dim3(grid_blocks), dim3(512), args, 0, stream);
    if (e != hipSuccess) fprintf(stderr, "cooperative launch failed: %s (grid %d)\n", hipGetErrorString(e), grid_blocks);
#else
    const int G = 512;
    k_phase0<<<G, 512, 0, stream>>>(p);
    k_phase1<<<G, 512, 0, stream>>>(p);
    k_phase2<<<G, 512, 0, stream>>>(p);
    k_phase2c<<<G, 512, 0, stream>>>(p);
    k_phase3<<<G, 512, 0, stream>>>(p);
    k_phase4<<<G, 512, 0, stream>>>(p);
    k_phase5<<<G, 512, 0, stream>>>(p);
    k_phase6<<<G, 512, 0, stream>>>(p);
    k_phase7<<<G, 512, 0, stream>>>(p);
    k_phase8b<<<G, 512, 0, stream>>>(p);
    k_phase8c<<<G, 512, 0, stream>>>(p);
#endif
}
```

```cpp
#include <hip/hip_runtime.h>
#include <hip/hip_cooperative_groups.h>
#include <stdint.h>
#include <stdio.h>
namespace cg = cooperative_groups;

typedef unsigned short bf16_t;
typedef short bf16x8 __attribute__((ext_vector_type(8)));
typedef short bf16x4 __attribute__((ext_vector_type(4)));
typedef float f32x4 __attribute__((ext_vector_type(4)));
typedef float f32x2 __attribute__((ext_vector_type(2)));

#ifndef ONE_LAUNCH
#define ONE_LAUNCH 1
#endif

constexpr int NB = 8, SEQ = 2048, DM = 1024, NTOK = NB * SEQ;
constexpr int NP = 3584;
constexpr int QOFF = 0, KOFF = 512, VOFF = 1024, IQOFF = 1536, MISCOFF = 1792, ZOFF = 1856, XBCOFF = 2368, NUSED = 3392;
constexpr float ALPHA = 1.189207115002721f;
constexpr float LN_EPS = 1e-5f;

constexpr size_t MB = 1024 * 1024;
constexpr size_t O_WIN_T = 0;
constexpr size_t O_WOUT_T = O_WIN_T + (size_t)NP * 1024 * 2;
constexpr size_t O_WQ_T = O_WOUT_T + 2 * MB;
constexpr size_t O_K1B = O_WQ_T + 4 * MB;
constexpr size_t O_K2B = O_K1B + 32768;
constexpr size_t O_CS64 = O_K2B + 32768;
constexpr size_t O_BAR = O_CS64 + 65536;
constexpr size_t O_R1 = O_BAR + 65536;
constexpr size_t O_XB = O_R1;
constexpr size_t O_QB = O_XB + 32 * MB;
constexpr size_t O_KB = O_QB + 16 * MB;
constexpr size_t O_VT = O_KB + 16 * MB;
constexpr size_t O_IQB = O_VT + 16 * MB;
constexpr size_t O_IKB = O_IQB + 8 * MB;
constexpr size_t O_IWF = O_IKB + 1 * MB;
constexpr size_t O_DTF = O_IWF + MB / 2;
constexpr size_t O_ZB = O_DTF + MB / 2;
constexpr size_t O_XBCT = O_ZB + 16 * MB;
constexpr size_t O_CAR = O_XBCT;
constexpr size_t O_ACUM = O_XBCT + 32 * MB;
constexpr size_t O_ATOT = O_ACUM + MB / 2;
constexpr size_t O_ST = O_ATOT + MB / 2;
constexpr size_t O_MIX = O_ST;
constexpr size_t O_MASK = O_ST + 32 * MB;
constexpr size_t O_R1_END = O_MASK + 4 * MB;
constexpr size_t O_HB = O_R1;
constexpr size_t O_QP = O_HB + 32 * MB;
constexpr size_t O_ACT = O_QP + 64 * MB;
constexpr size_t O_H8 = O_ACT + 8 * MB;
constexpr size_t O_HS = O_H8 + 16 * MB;
constexpr size_t O_EV = O_HS + 65536;
constexpr size_t O_GV = O_EV + 8 * MB;
constexpr size_t O_R2_END = O_GV + 8 * MB;
static_assert(O_R2_END <= O_ST, "region 2 must not reach MIX");
static_assert(O_HB == O_XB, "P4 adds the residual in place");
constexpr size_t O_U8 = O_R1_END;
constexpr size_t O_V8 = O_U8 + 16 * MB;
constexpr size_t O_US = O_V8 + 16 * MB;
constexpr size_t O_XT = O_US + 65536;
constexpr size_t O_BRM = O_XT + 16 * MB;
constexpr size_t O_CRM = O_BRM + 8 * MB;
constexpr size_t WS_NEEDED = O_CRM + 8 * MB;
static_assert(WS_NEEDED <= 256 * MB, "workspace too large");

struct Params {
    const float* x; const int* pos; const float* w_in; const float* conv_w; const float* conv_b; const float* dt_bias;
    const float* a_log; const float* d_skip; const float* norm_w; const float* w_out; const float* ln1_g; const float* ln1_b;
    const float* wq; const float* k1; const float* k2; const float* u; const float* v; const float* ln2_g; const float* ln2_b;
    float* out; char* ws; int use_cg; int pad_;
};

#define SMEM_BYTES 133120

__device__ __forceinline__ int tid_op() { int t = threadIdx.x; asm volatile("" : "+v"(t)); return t; }
typedef __bf16 bf16x2n __attribute__((ext_vector_type(2)));
typedef float f32x2c __attribute__((ext_vector_type(2)));
__device__ __forceinline__ unsigned pack2(float a, float b) { const bf16x2n r = __builtin_convertvector((f32x2c){a, b}, bf16x2n); return __builtin_bit_cast(unsigned, r); }
__device__ __forceinline__ bf16_t f2bf(float f) { return (bf16_t)(pack2(f, 0.f) & 0xFFFFu); }
__device__ __forceinline__ float bf2f(bf16_t b) { return __uint_as_float(((unsigned)b) << 16); }
__device__ __forceinline__ unsigned f2sort(float f) { unsigned u = __float_as_uint(f); return (u & 0x80000000u) ? ~u : (u | 0x80000000u); }
__device__ __forceinline__ float sort2f(unsigned s) { unsigned u = (s & 0x80000000u) ? (s & 0x7FFFFFFFu) : ~s; return __uint_as_float(u); }
__device__ __forceinline__ f32x4 mfma16(bf16x8 a, bf16x8 b, f32x4 c) { return __builtin_amdgcn_mfma_f32_16x16x32_bf16(a, b, c, 0, 0, 0); }
__device__ __forceinline__ float silu_f(float v) { return v * __builtin_amdgcn_rcpf(1.f + __expf(-v)); }
__device__ __forceinline__ bf16x8 ld8(const bf16_t* p) { return *(const bf16x8*)p; }
__device__ __forceinline__ bf16x8 cat4(bf16x4 lo, bf16x4 hi) { return __builtin_shufflevector(lo, hi, 0, 1, 2, 3, 4, 5, 6, 7); }


template <int CTRL, int ROWMASK, bool BC> __device__ __forceinline__ int dpp_i(int v) { return __builtin_amdgcn_update_dpp(0, v, CTRL, ROWMASK, 0xF, BC); }
template <int CTRL, int ROWMASK, bool BC> __device__ __forceinline__ float dpp_f(float v) { return __builtin_bit_cast(float, __builtin_amdgcn_update_dpp(0, __builtin_bit_cast(int, v), CTRL, ROWMASK, 0xF, BC)); }
__device__ __forceinline__ float row_sum(float v) { v += dpp_f<0xB1, 0xF, true>(v); v += dpp_f<0x4E, 0xF, true>(v); v += dpp_f<0x141, 0xF, true>(v); v += dpp_f<0x140, 0xF, true>(v); return v; }
__device__ __forceinline__ unsigned row_sum_u(unsigned v) { v += (unsigned)dpp_i<0xB1, 0xF, true>((int)v); v += (unsigned)dpp_i<0x4E, 0xF, true>((int)v); v += (unsigned)dpp_i<0x141, 0xF, true>((int)v); v += (unsigned)dpp_i<0x140, 0xF, true>((int)v); return v; }
__device__ __forceinline__ unsigned row_max_u(unsigned v) {
    v = max(v, (unsigned)dpp_i<0xB1, 0xF, true>((int)v)); v = max(v, (unsigned)dpp_i<0x4E, 0xF, true>((int)v));
    v = max(v, (unsigned)dpp_i<0x141, 0xF, true>((int)v)); v = max(v, (unsigned)dpp_i<0x140, 0xF, true>((int)v)); return v;
}
__device__ __forceinline__ float wave_sum_u(float v) {
    v = row_sum(v);
    v += dpp_f<0x142, 0xA, false>(v);
    v += dpp_f<0x143, 0xC, false>(v);
    return __builtin_bit_cast(float, __builtin_amdgcn_readlane(__builtin_bit_cast(int, v), 63));
}
typedef unsigned u32x2_t __attribute__((ext_vector_type(2)));
__device__ __forceinline__ float sum_x16(float v) { const u32x2_t r = __builtin_amdgcn_permlane16_swap(__float_as_uint(v), __float_as_uint(v), false, false); return __uint_as_float(r.x) + __uint_as_float(r.y); }
__device__ __forceinline__ float sum_x32(float v) { const u32x2_t r = __builtin_amdgcn_permlane32_swap(__float_as_uint(v), __float_as_uint(v), false, false); return __uint_as_float(r.x) + __uint_as_float(r.y); }
__device__ __forceinline__ float max_x16(float v) { const u32x2_t r = __builtin_amdgcn_permlane16_swap(__float_as_uint(v), __float_as_uint(v), false, false); return fmaxf(__uint_as_float(r.x), __uint_as_float(r.y)); }
__device__ __forceinline__ float max_x32(float v) { const u32x2_t r = __builtin_amdgcn_permlane32_swap(__float_as_uint(v), __float_as_uint(v), false, false); return fmaxf(__uint_as_float(r.x), __uint_as_float(r.y)); }
__device__ __forceinline__ float wave_sum(float v) { return sum_x32(sum_x16(row_sum(v))); }
__device__ __forceinline__ float row_max_f(float v) { v = fmaxf(v, dpp_f<0xB1, 0xF, true>(v)); v = fmaxf(v, dpp_f<0x4E, 0xF, true>(v)); v = fmaxf(v, dpp_f<0x141, 0xF, true>(v)); v = fmaxf(v, dpp_f<0x140, 0xF, true>(v)); return v; }
__device__ __forceinline__ float wave_max(float v) { return max_x32(max_x16(row_max_f(v))); }
__device__ __forceinline__ unsigned quant4_i8(float a, float b, float c, float d, float inv) {
    const int q0 = (int)__builtin_rintf(a * inv), q1 = (int)__builtin_rintf(b * inv), q2 = (int)__builtin_rintf(c * inv), q3 = (int)__builtin_rintf(d * inv);
    return ((unsigned)q0 & 0xFFu) | (((unsigned)q1 & 0xFFu) << 8) | (((unsigned)q2 & 0xFFu) << 16) | ((unsigned)q3 << 24);
}
__device__ __forceinline__ float quant_step(float m) { const unsigned u = (__float_as_uint(m * (1.f / 127.f)) + 0xFFFFu) & 0xFFFF0000u; return __uint_as_float(u); }

#define XB_TMO      128
#define XB_XCNT(j)  (256  + 64 * (j))
#define XB_XSUB(j)  (1280 + 64 * (j))
#define XB_XGEN(j)  (2304 + 64 * (j))
#define XB_TOP      3328
#define XB_TOPGEN   3392
#define XCD_BAR_WORDS 3456
#define XB_SPIN_CAP (1u << 22)
#define LAS __attribute__((address_space(3)))
__device__ __forceinline__ unsigned xb_ld(unsigned* p)              { return __hip_atomic_load(p, __ATOMIC_RELAXED, __HIP_MEMORY_SCOPE_AGENT); }
__device__ __forceinline__ unsigned xb_add(unsigned* p, unsigned v) { return __hip_atomic_fetch_add(p, v, __ATOMIC_RELAXED, __HIP_MEMORY_SCOPE_AGENT); }
__device__ __forceinline__ unsigned xb_xcc_id() { return (unsigned)__builtin_amdgcn_s_getreg((3 << 11) | 20) & 0xFu; }
#define XB_SPIN(cond, bar) do { unsigned _sp = 0; while (cond) { __builtin_amdgcn_s_sleep(1); \
    if ((++_sp & 255u) == 0u) { if (xb_ld(&(bar)[XB_TMO])) break; if (_sp > XB_SPIN_CAP) { atomicAdd(&(bar)[XB_TMO], 1u); break; } } } } while (0)
struct XcdBarrier { unsigned* bar; unsigned x; volatile LAS unsigned* st; };
__device__ __forceinline__ XcdBarrier xcd_barrier_post(unsigned* bar, volatile LAS unsigned* st) {
    XcdBarrier b; b.bar = bar; b.x = xb_xcc_id(); b.st = st;
    if (threadIdx.x == 0) st[3] = xb_add(&bar[XB_XCNT(b.x)], 1u);
    return b;
}
__device__ __forceinline__ void xcd_barrier_complete(unsigned* bar, unsigned x, unsigned& nloc, unsigned& nx, unsigned& low8) {
    const unsigned G = gridDim.x * gridDim.y * gridDim.z;
    unsigned sum, cnt, mine, lo, sp = 0u;
    for (;;) {
        sum = 0u; cnt = 0u; mine = 0u; lo = 0u;
#pragma unroll
        for (unsigned j = 0; j < 16; ++j) { const unsigned c = xb_ld(&bar[XB_XCNT(j)]); sum += c; cnt += (c > 0u) ? 1u : 0u; lo += (j < 8u && c > 0u) ? 1u : 0u; mine = (j == x) ? c : mine; }
        if (sum == G) break;
        __builtin_amdgcn_s_sleep(1);
        if ((++sp & 255u) == 0u) { if (xb_ld(&bar[XB_TMO])) break; if (sp > XB_SPIN_CAP) { atomicAdd(&bar[XB_TMO], 1u); break; } }
    }
    nloc = mine > 0u ? mine : 1u; nx = cnt > 0u ? cnt : 1u; low8 = (lo == 8u && cnt == 8u) ? 1u : 0u;
}
__device__ __forceinline__ void xcd_barrier(const XcdBarrier& b) {
    asm volatile("s_waitcnt vmcnt(0)" ::: "memory");
    __syncthreads();
    if (threadIdx.x == 0) {
        unsigned* bar = b.bar;
        __builtin_amdgcn_s_waitcnt(0);
        unsigned nloc = b.st[0], nx = b.st[1];
        if (nloc == 0u) { unsigned low8; xcd_barrier_complete(bar, b.x, nloc, nx, low8); b.st[0] = nloc; b.st[1] = nx; b.st[2] = low8; }
        const unsigned old = xb_add(&bar[XB_XSUB(b.x)], 1u);
        const unsigned gen = old / nloc;
        if (old + 1u == (gen + 1u) * nloc) {
            __builtin_amdgcn_fence(__ATOMIC_RELEASE, "agent");
            asm volatile("s_waitcnt vmcnt(0)" ::: "memory");
            const unsigned og = xb_add(&bar[XB_TOP], 1u);
            const unsigned tg = og / nx;
            if (og + 1u == (tg + 1u) * nx) xb_add(&bar[XB_TOPGEN], 1u);
            else XB_SPIN(xb_ld(&bar[XB_TOPGEN]) == tg, bar);
            __builtin_amdgcn_fence(__ATOMIC_ACQUIRE, "agent");
            xb_add(&bar[XB_XGEN(b.x)], 1u);
            asm volatile("s_waitcnt vmcnt(0)" ::: "memory");
        } else {
            XB_SPIN(xb_ld(&bar[XB_XGEN(b.x)]) == gen, bar);
            __builtin_amdgcn_fence(__ATOMIC_ACQUIRE, "agent");
            asm volatile("s_waitcnt vmcnt(0)" ::: "memory");
        }
    }
    __syncthreads();
}

#define PCNT_WORD0 4096
#define PCNT_WORDS (64 * 16)
__device__ __forceinline__ void panel_sync(unsigned* bar, int pm, unsigned target) {
    asm volatile("s_waitcnt vmcnt(0)" ::: "memory");
    __syncthreads();
    if (threadIdx.x == 0) {
        unsigned* cnt = bar + PCNT_WORD0 + 16 * pm;
        __builtin_amdgcn_fence(__ATOMIC_RELEASE, "agent");
        asm volatile("s_waitcnt vmcnt(0)" ::: "memory");
        xb_add(cnt, 1u);
        XB_SPIN(xb_ld(cnt) < target, bar);
        __builtin_amdgcn_fence(__ATOMIC_ACQUIRE, "agent");
        asm volatile("s_waitcnt vmcnt(0)" ::: "memory");
    }
    __syncthreads();
}

__device__ __forceinline__ int rot_perm(int gcol, int H) { const int j = (gcol % H) >> 3, e = gcol & 7; return (gcol / H) * H + 4 * j + (e & 3) + ((e >> 2) ? H / 2 : 0); }
__device__ __forceinline__ int win_src_col(int n) {
    if (n < 1024) return rot_perm(n, 64);
    if (n < 1536) return n;
    if (n < 1824) return 1536 + rot_perm(n - 1536, 32);
    if (n < 1832) return n;
    if (n < 1840) return 3368 + (n - 1832);
    if (n < 1856) return -1;
    if (n < 2368) return 1832 + (n - 1856);
    if (n < 3392) return 2344 + (n - 2368);
    return -1;
}
__device__ __forceinline__ void p0_transpose(const float* __restrict__ W, int N, int Nout, bool remap, bf16_t* __restrict__ Wt, int gtid, int gsz) {
    const int items = Nout * 128;
    for (int it = gtid; it < items; it += gsz) {
        const int n = it % Nout, kc = it / Nout;
        const int src = remap ? win_src_col(n) : n;
        unsigned w[4] = {0, 0, 0, 0};
        if (src >= 0) {
            float f[8];
#pragma unroll
            for (int j = 0; j < 8; ++j) f[j] = W[(size_t)(kc * 8 + j) * N + src];
#pragma unroll
            for (int j = 0; j < 4; ++j) w[j] = pack2(f[2 * j], f[2 * j + 1]);
        }
        *(uint4*)(Wt + (size_t)n * 1024 + kc * 8) = make_uint4(w[0], w[1], w[2], w[3]);
    }
}
__device__ __forceinline__ void p0_convert(const float* __restrict__ src, bf16_t* __restrict__ dst, size_t n4, size_t gtid, size_t gsz) {
    for (size_t i = gtid; i < n4; i += gsz) {
        const float4 f = ((const float4*)src)[i];
        ((uint2*)dst)[i] = make_uint2(pack2(f.x, f.y), pack2(f.z, f.w));
    }
}
__device__ __forceinline__ void phase0(const Params& p) {
    const int gtid = blockIdx.x * blockDim.x + tid_op(), gsz = gridDim.x * blockDim.x;
    p0_transpose(p.w_in, 3376, NP, true, (bf16_t*)(p.ws + O_WIN_T), gtid, gsz);
    p0_transpose(p.w_out, 1024, 1024, false, (bf16_t*)(p.ws + O_WOUT_T), gtid, gsz);
    p0_transpose(p.wq, 2048, 2048, false, (bf16_t*)(p.ws + O_WQ_T), gtid, gsz);
    p0_convert(p.k1, (bf16_t*)(p.ws + O_K1B), 128 * 128 / 4, gtid, gsz);
    p0_convert(p.k2, (bf16_t*)(p.ws + O_K2B), 128 * 128 / 4, gtid, gsz);
    p0_convert(p.x, (bf16_t*)(p.ws + O_XB), (size_t)NTOK * DM / 4, gtid, gsz);
    float* posf = (float*)(p.ws + O_CS64);
    for (int it = gtid; it < NTOK; it += gsz) posf[it] = (float)p.pos[it];
}

typedef const __attribute__((address_space(4))) Params* ParamsK;
__device__ __forceinline__ Params params_reload() {
#if defined(__HIP_DEVICE_COMPILE__)
    auto ka = __builtin_amdgcn_kernarg_segment_ptr();
    asm volatile("" : "+s"(ka));
    Params r; __builtin_memcpy(&r, (const __attribute__((address_space(4))) void*)ka, sizeof(Params));
#define PR_UNI(F, T) { const unsigned long long v_ = (unsigned long long)r.F; const unsigned lo_ = (unsigned)__builtin_amdgcn_readfirstlane((int)(unsigned)v_), hi_ = (unsigned)__builtin_amdgcn_readfirstlane((int)(unsigned)(v_ >> 32)); r.F = (T)(__attribute__((address_space(1))) void*)(((unsigned long long)hi_ << 32) | lo_); }
    PR_UNI(x, const float*) PR_UNI(pos, const int*) PR_UNI(w_in, const float*) PR_UNI(conv_w, const float*) PR_UNI(conv_b, const float*) PR_UNI(dt_bias, const float*)
    PR_UNI(a_log, const float*) PR_UNI(d_skip, const float*) PR_UNI(norm_w, const float*) PR_UNI(w_out, const float*) PR_UNI(ln1_g, const float*) PR_UNI(ln1_b, const float*)
    PR_UNI(wq, const float*) PR_UNI(k1, const float*) PR_UNI(k2, const float*) PR_UNI(u, const float*) PR_UNI(v, const float*) PR_UNI(ln2_g, const float*) PR_UNI(ln2_b, const float*)
    PR_UNI(out, float*) PR_UNI(ws, char*)
#undef PR_UNI
    return r;
#else
    return Params{};
#endif
}
struct XcdMap { int slice, rank, nloc; };
__device__ __forceinline__ bool gemm_next_tile(const XcdMap& xm, int it, int ntn, int& tm, int& tn) {
    const int j = xm.rank + xm.nloc * it;
    if (j >= 8 * ntn) return false;
    tm = 8 * xm.slice + j / ntn; tn = j % ntn; return true;
}
#define GEMM_LDK 80
#define GEMM_LDS_A (256 * GEMM_LDK * 2)
#define GEMM_LDS_STAGE (GEMM_LDS_A + 128 * GEMM_LDK * 2)
typedef unsigned u32x4g __attribute__((ext_vector_type(4)));
struct GemmRegs { u32x4g a0, a1, a2, a3, b0, b1; };
__device__ __forceinline__ void gemm_gload(GemmRegs& r, const bf16_t* ga, const bf16_t* gb, size_t astep) {
    r.a0 = *(const u32x4g*)(ga); r.a1 = *(const u32x4g*)(ga + astep); r.a2 = *(const u32x4g*)(ga + 2 * astep); r.a3 = *(const u32x4g*)(ga + 3 * astep);
    r.b0 = *(const u32x4g*)(gb); r.b1 = *(const u32x4g*)(gb + astep);
}
__device__ __forceinline__ void gemm_lstore(const GemmRegs& r, bf16_t* wa, bf16_t* wb) {
    *(u32x4g*)(wa) = r.a0; *(u32x4g*)(wa + 64 * GEMM_LDK) = r.a1; *(u32x4g*)(wa + 128 * GEMM_LDK) = r.a2; *(u32x4g*)(wa + 192 * GEMM_LDK) = r.a3;
    *(u32x4g*)(wb) = r.b0; *(u32x4g*)(wb + 64 * GEMM_LDK) = r.b1;
}
__device__ __forceinline__ void gemm_compute(f32x4 (&acc)[4][4], const bf16_t* sA, const bf16_t* sB, int wm, int wn, int lane) {
#pragma unroll
    for (int ks = 0; ks < 2; ++ks) {
        bf16x8 a[4], b[4];
#pragma unroll
        for (int i = 0; i < 4; ++i) a[i] = ld8(sA + (wm * 64 + i * 16 + (lane & 15)) * GEMM_LDK + ks * 32 + (lane >> 4) * 8);
#pragma unroll
        for (int i = 0; i < 4; ++i) b[i] = ld8(sB + (wn * 64 + i * 16 + (lane & 15)) * GEMM_LDK + ks * 32 + (lane >> 4) * 8);
#pragma unroll
        for (int i = 0; i < 4; ++i)
#pragma unroll
            for (int j = 0; j < 4; ++j) acc[i][j] = mfma16(a[i], b[j], acc[i][j]);
    }
}
template <class Epi>
__device__ __forceinline__ void gemm_tile(const bf16_t* __restrict__ A, const bf16_t* __restrict__ Bt, int K, int m0, int n0, const Epi& epi, char* smem) {
    const int tid = tid_op(), lane = tid & 63, w = tid >> 6, wm = w >> 1, wn = w & 1;
    f32x4 acc[4][4];
#pragma unroll
    for (int i = 0; i < 4; ++i)
#pragma unroll
        for (int j = 0; j < 4; ++j) acc[i][j] = (f32x4){0.f, 0.f, 0.f, 0.f};
    const int lrow = tid >> 3, lkc = (tid & 7) * 8;
    const bf16_t* ga = A + (size_t)(m0 + lrow) * K + lkc;
    const bf16_t* gb = Bt + (size_t)(n0 + lrow) * K + lkc;
    const size_t astep = (size_t)64 * K;
    bf16_t* sA0 = (bf16_t*)smem; bf16_t* sB0 = (bf16_t*)(smem + GEMM_LDS_A);
    bf16_t* sA1 = (bf16_t*)(smem + GEMM_LDS_STAGE); bf16_t* sB1 = (bf16_t*)(smem + GEMM_LDS_STAGE + GEMM_LDS_A);
    const int woff = lrow * GEMM_LDK + lkc;
    GemmRegs r0, r1;
    gemm_gload(r0, ga, gb, astep);
    gemm_gload(r1, ga + 64, gb + 64, astep);
    __syncthreads();
    gemm_lstore(r0, sA0 + woff, sB0 + woff);
    __syncthreads();
    const int nk = K / 64;
    for (int k = 0; k < nk; k += 2) {
        { const int kk = (k + 2 < nk) ? k + 2 : nk - 1; gemm_gload(r0, ga + kk * 64, gb + kk * 64, astep); }
        gemm_compute(acc, sA0, sB0, wm, wn, lane);
        gemm_lstore(r1, sA1 + woff, sB1 + woff);
        __syncthreads();
        { const int kk = (k + 3 < nk) ? k + 3 : nk - 1; gemm_gload(r1, ga + kk * 64, gb + kk * 64, astep); }
        gemm_compute(acc, sA1, sB1, wm, wn, lane);
        gemm_lstore(r0, sA0 + woff, sB0 + woff);
        __syncthreads();
    }
    epi(acc, m0 + wm * 64, n0 + wn * 64, lane, smem + w * 9216);
}

namespace pg8 {
#define PG8_LAS __attribute__((address_space(3)))
typedef unsigned short bf16_t;
typedef short bf16x8 __attribute__((ext_vector_type(8)));
typedef float f32x4 __attribute__((ext_vector_type(4)));
typedef unsigned u32x4 __attribute__((ext_vector_type(4)));
constexpr int BM = 256, BK = 64, HALF = 128, HTB = HALF * BK * 2  , STAGE_BYTES = 8 * HTB, NXCD = 8, WGM = 8;

__host__ __device__ __forceinline__ int lds_byte(int r, int c) { const int st = (r >> 4) * 2 + (c >> 5), rr = r & 15, cc = c & 31, ob = rr * 64 + cc * 2; return st * 1024 + (ob ^ (((ob >> 9) & 1) << 5)); }
__host__ __device__ __forceinline__ void stage_rc(int b, int& R, int& C) { const int st = b / 1024, sb = b % 1024, swz = sb ^ (((sb >> 9) & 1) << 5); R = (st >> 1) * 16 + swz / 64; C = (st & 1) * 32 + (swz % 64) / 2; }
__host__ __device__ __forceinline__ int perm32(int rho) { const int n = rho >> 4, i = rho & 15; return 8 * (i >> 2) + 4 * n + (i & 3); }

struct Unit { int pm, pn; };
struct Gemm { const bf16_t* A; const bf16_t* Bt; int M, N, K; };

struct StaticOrder {
    int nM, nN, nwg, G, c;
    __host__ __device__ void init(int M, int N, int G_, int c_) { nM = M / BM; nN = N / BM; nwg = nM * nN; G = G_; c = c_; }
    __host__ __device__ bool next(int i, Unit& u) const {
        const long L = (long)i * G + c; if (L >= nwg) return false;
        int wgid = (int)L; { const int q = nwg / NXCD, r = nwg % NXCD, xcd = wgid % NXCD, off = wgid / NXCD; wgid = (xcd < r ? xcd * (q + 1) : r * (q + 1) + (xcd - r) * q) + off; }
        const int nig = WGM * nN, gid = wgid / nig, fm = gid * WGM, gsz = (nM - fm) < WGM ? (nM - fm) : WGM;
        u.pm = fm + ((wgid % nig) % gsz); u.pn = (wgid % nig) / gsz; return true;
    }
    __device__ __forceinline__ void a_ready(const Unit&) const {}
    __device__ __forceinline__ void done(const Unit&) const {}
};
__device__ __forceinline__ unsigned cvt_pk_bf16(float lo, float hi) { return ::pack2(lo, hi); }

struct EpiBf16Plain {
    static constexpr bool PERM = true, AFTER_DRAIN = false;
    bf16_t* O; int ldc;
    __device__ __forceinline__ void operator()(const f32x4 (&acc)[2][2][4][2], const Unit& u, int wr, int wc, int fr, int fq) const {
        const int row0 = u.pm * BM + wr * 64 + fr, col0 = u.pn * BM + wc * 32 + 8 * fq;
#pragma unroll
        for (int ai = 0; ai < 2; ++ai)
#pragma unroll
            for (int m = 0; m < 4; ++m) { bf16_t* rowp = O + (size_t)(row0 + ai * HALF + m * 16) * ldc + col0;
#pragma unroll
                for (int bj = 0; bj < 2; ++bj) { const f32x4 v0 = acc[ai][bj][m][0], v1 = acc[ai][bj][m][1];
                    u32x4 w; w.x = cvt_pk_bf16(v0[0], v0[1]); w.y = cvt_pk_bf16(v0[2], v0[3]); w.z = cvt_pk_bf16(v1[0], v1[1]); w.w = cvt_pk_bf16(v1[2], v1[3]);
                    *(u32x4*)(rowp + bj * HALF) = w; } }
    }
};
struct EpiResF32 {
    static constexpr bool PERM = false, AFTER_DRAIN = false;
    float* Y; const float* X; int ldc; float alpha;
    __device__ __forceinline__ void operator()(const f32x4 (&acc)[2][2][4][2], const Unit& u, int wr, int wc, int fr, int fq) const {
        const int row0 = u.pm * BM + wr * 64 + fr, col0 = u.pn * BM + wc * 32 + 4 * fq;
#pragma unroll
        for (int ai = 0; ai < 2; ++ai)
#pragma unroll
            for (int m = 0; m < 4; ++m) { const size_t ro = (size_t)(row0 + ai * HALF + m * 16) * ldc + col0;
#pragma unroll
                for (int bj = 0; bj < 2; ++bj)
#pragma unroll
                    for (int n = 0; n < 2; ++n) { const f32x4 xv = *(const f32x4*)(X + ro + bj * HALF + n * 16); *(f32x4*)(Y + ro + bj * HALF + n * 16) = xv * alpha + acc[ai][bj][m][n]; } }
    }
};
struct EpiResBf16 {
    static constexpr bool PERM = true, AFTER_DRAIN = false;
    bf16_t* Y; const float* X; int ldc; float alpha;
    __device__ __forceinline__ void operator()(const f32x4 (&acc)[2][2][4][2], const Unit& u, int wr, int wc, int fr, int fq) const {
        const int row0 = u.pm * BM + wr * 64 + fr, col0 = u.pn * BM + wc * 32 + 8 * fq;
#pragma unroll
        for (int ai = 0; ai < 2; ++ai)
#pragma unroll
            for (int m = 0; m < 4; ++m) { const size_t ro = (size_t)(row0 + ai * HALF + m * 16) * ldc + col0;
#pragma unroll
                for (int bj = 0; bj < 2; ++bj) {
                    const f32x4 x0 = *(const f32x4*)(X + ro + bj * HALF), x1 = *(const f32x4*)(X + ro + bj * HALF + 4);
                    const f32x4 v0 = x0 * alpha + acc[ai][bj][m][0], v1 = x1 * alpha + acc[ai][bj][m][1];
                    u32x4 w; w.x = cvt_pk_bf16(v0[0], v0[1]); w.y = cvt_pk_bf16(v0[2], v0[3]); w.z = cvt_pk_bf16(v1[0], v1[1]); w.w = cvt_pk_bf16(v1[2], v1[3]);
                    *(u32x4*)(Y + ro + bj * HALF) = w; } }
    }
};
struct EpiResInPlace {
    static constexpr bool PERM = true, AFTER_DRAIN = false;
    bf16_t* Y; int ldc; float alpha;
    __device__ __forceinline__ void operator()(const f32x4 (&acc)[2][2][4][2], const Unit& u, int wr, int wc, int fr, int fq) const {
        const int row0 = u.pm * BM + wr * 64 + fr, col0 = u.pn * BM + wc * 32 + 8 * fq;
#pragma unroll
        for (int ai = 0; ai < 2; ++ai)
#pragma unroll
            for (int m = 0; m < 4; ++m) { const size_t ro = (size_t)(row0 + ai * HALF + m * 16) * ldc + col0;
#pragma unroll
                for (int bj = 0; bj < 2; ++bj) {
                    const u32x4 xr = *(const u32x4*)(Y + ro + bj * HALF);
                    const f32x4 x0 = {__uint_as_float(xr.x << 16), __uint_as_float(xr.x & 0xFFFF0000u), __uint_as_float(xr.y << 16), __uint_as_float(xr.y & 0xFFFF0000u)};
                    const f32x4 x1 = {__uint_as_float(xr.z << 16), __uint_as_float(xr.z & 0xFFFF0000u), __uint_as_float(xr.w << 16), __uint_as_float(xr.w & 0xFFFF0000u)};
                    const f32x4 v0 = x0 * alpha + acc[ai][bj][m][0], v1 = x1 * alpha + acc[ai][bj][m][1];
                    u32x4 w; w.x = cvt_pk_bf16(v0[0], v0[1]); w.y = cvt_pk_bf16(v0[2], v0[3]); w.z = cvt_pk_bf16(v1[0], v1[1]); w.w = cvt_pk_bf16(v1[2], v1[3]);
                    *(u32x4*)(Y + ro + bj * HALF) = w; } }
    }
};
template <class Epi, class Sched, bool STAMP = false>
__device__ __forceinline__ void gemm_phase(PG8_LAS unsigned char* lds, const Gemm g, const Sched& S, const Epi& E, unsigned long long* stamps) {
    const int tid = tid_op(), wid = __builtin_amdgcn_readfirstlane(tid >> 6), lane = tid & 63, wr = wid >> 2, wc = wid & 3, fr = lane & 15, fq = lane >> 4;
    const int K = g.K, nt = K / BK;
    int ts_lo = 0, ts_hi = 0, nts = 0; const unsigned long long rt_entry = STAMP ? (unsigned long long)wall_clock64() : 0ull;
#define PG8_STAMP() do { if (STAMP && wid == 0 && nts < 64) { const unsigned long long _c = (unsigned long long)clock64(); \
        ts_lo = (lane == nts) ? (int)(unsigned)_c : ts_lo; ts_hi = (lane == nts) ? (int)(unsigned)(_c >> 32) : ts_hi; ++nts; } } while (0)
    PG8_STAMP();
    unsigned voffA[2], voffB[2];
#pragma unroll
    for (int i = 0; i < 2; ++i) { int R, C; stage_rc(tid * 16 + i * 8192, R, C); const int Rb = Epi::PERM ? ((R & ~31) + perm32(R & 31)) : R;
        voffA[i] = (unsigned)(R * K + C) * 2u; voffB[i] = (unsigned)(Rb * K + C) * 2u; }
    const size_t kstep = (size_t)(BK * 2);
    const size_t hstep = (size_t)HALF * K * 2;
    const size_t tstep = 2 * hstep;
    const unsigned ldsw = (unsigned)wid * 1024u;
    const int aoff = lds_byte(wr * 64 + fr, fq * 8), boff = lds_byte(wc * 32 + fr, fq * 8);
#define PG8_SA(b, h) (((b) * 2 + (h)) * HTB)
#define PG8_SB(b, h) ((4 + (b) * 2 + (h)) * HTB)
#define PG8_STAGE(bufoff, gbase, voff) do { _Pragma("unroll") for (int _i = 0; _i < 2; ++_i) \
        __builtin_amdgcn_global_load_lds((const unsigned*)((const char*)(gbase) + (voff)[_i]), (PG8_LAS unsigned*)(lds + (bufoff) + ldsw + _i * 8192), 16, 0, 0); } while (0)
#define PG8_LDA(dst, b, h) do { _Pragma("unroll") for (int m = 0; m < 4; ++m) _Pragma("unroll") for (int k = 0; k < 2; ++k) dst[m][k] = *(const PG8_LAS bf16x8*)(lds + PG8_SA(b, h) + aoff + m * 2048 + k * 1024); } while (0)
#define PG8_LDB(dst, b, h) do { _Pragma("unroll") for (int n = 0; n < 2; ++n) _Pragma("unroll") for (int k = 0; k < 2; ++k) dst[n][k] = *(const PG8_LAS bf16x8*)(lds + PG8_SB(b, h) + boff + n * 2048 + k * 1024); } while (0)
#define PG8_MMA(ai, bj, At, Bt) do { __builtin_amdgcn_s_setprio(1); _Pragma("unroll") for (int m = 0; m < 4; ++m) _Pragma("unroll") for (int n = 0; n < 2; ++n) _Pragma("unroll") for (int k = 0; k < 2; ++k) \
        acc[ai][bj][m][n] = __builtin_amdgcn_mfma_f32_16x16x32_bf16(Bt[n][k], At[m][k], acc[ai][bj][m][n], 0, 0, 0); __builtin_amdgcn_s_setprio(0); } while (0)
#define PG8_WAIT_V(n) asm volatile("s_waitcnt vmcnt(" #n ")" ::: "memory")
#define PG8_WAIT_L(n) asm volatile("s_waitcnt lgkmcnt(" #n ")" ::: "memory")
#define PG8_BAR __builtin_amdgcn_s_barrier()
#define PG8_SCHED __builtin_amdgcn_sched_barrier(0)
    Unit cur, nxt; int ui = 0;
    if (!S.next(0, cur)) return;
    f32x4 acc[2][2][4][2];
#pragma unroll
    for (int a = 0; a < 2; ++a)
#pragma unroll
        for (int b = 0; b < 2; ++b)
#pragma unroll
            for (int m = 0; m < 4; ++m)
#pragma unroll
                for (int n = 0; n < 2; ++n) acc[a][b][m][n] = (f32x4){0.f, 0.f, 0.f, 0.f};
    bf16x8 At[4][2], B0[2][2], B1[2][2];
    const char* cA = (const char*)g.A + (size_t)cur.pm * tstep; const char* cB = (const char*)g.Bt + (size_t)cur.pn * tstep;
    S.a_ready(cur);
    PG8_STAGE(PG8_SB(0, 0), cB, voffB); PG8_STAGE(PG8_SA(0, 0), cA, voffA); PG8_STAGE(PG8_SB(0, 1), cB + hstep, voffB); PG8_STAGE(PG8_SA(0, 1), cA + hstep, voffA);
    if (wr == 1) PG8_BAR;
    PG8_WAIT_V(4); PG8_BAR;
    PG8_STAGE(PG8_SB(1, 0), cB + kstep, voffB); PG8_STAGE(PG8_SA(1, 0), cA + kstep, voffA); PG8_STAGE(PG8_SB(1, 1), cB + hstep + kstep, voffB);
    PG8_WAIT_V(6); PG8_BAR;
    PG8_STAMP();
    for (;;) {
        const bool has_next = S.next(ui + 1, nxt);
        const char* nA = has_next ? (const char*)g.A + (size_t)nxt.pm * tstep : cA; const char* nB = has_next ? (const char*)g.Bt + (size_t)nxt.pn * tstep : cB;
        for (int t = 0; t < nt; t += 2) {
            const bool last = (t == nt - 2);
            const char* a1 = cA + (size_t)(t + 1) * kstep;
            const char* a2 = last ? nA : cA + (size_t)(t + 2) * kstep; const char* b2 = last ? nB : cB + (size_t)(t + 2) * kstep;
            const char* a3 = a2 + kstep; const char* b3 = b2 + kstep;
            if (last && has_next) S.a_ready(nxt);
            PG8_LDB(B0, 0, 0); PG8_SCHED; PG8_LDA(At, 0, 0); PG8_STAGE(PG8_SA(1, 1), a1 + hstep, voffA);
            PG8_WAIT_L(8); PG8_BAR; PG8_WAIT_L(0); PG8_MMA(0, 0, At, B0); PG8_BAR; PG8_SCHED;
            PG8_LDB(B1, 0, 1); PG8_STAGE(PG8_SB(0, 0), b2, voffB);
            PG8_BAR; PG8_WAIT_L(0); PG8_MMA(0, 1, At, B1); PG8_BAR;
            PG8_LDA(At, 0, 1); PG8_STAGE(PG8_SA(0, 0), a2, voffA);
            PG8_BAR; PG8_WAIT_L(0); PG8_MMA(1, 0, At, B0); PG8_BAR; PG8_SCHED;
            PG8_STAGE(PG8_SB(0, 1), b2 + hstep, voffB);
            PG8_WAIT_V(6); PG8_BAR; PG8_MMA(1, 1, At, B1); PG8_BAR;
            PG8_LDB(B0, 1, 0); PG8_SCHED; PG8_LDA(At, 1, 0); PG8_STAGE(PG8_SA(0, 1), a2 + hstep, voffA);
            PG8_WAIT_L(8); PG8_BAR; PG8_WAIT_L(0); PG8_MMA(0, 0, At, B0); PG8_BAR; PG8_SCHED;
            PG8_LDB(B1, 1, 1); PG8_STAGE(PG8_SB(1, 0), b3, voffB);
            PG8_BAR; PG8_WAIT_L(0); PG8_MMA(0, 1, At, B1); PG8_BAR;
            PG8_LDA(At, 1, 1); PG8_STAGE(PG8_SA(1, 0), a3, voffA);
            PG8_BAR; PG8_WAIT_L(0); PG8_MMA(1, 0, At, B0); PG8_BAR; PG8_SCHED;
            PG8_STAGE(PG8_SB(1, 1), b3 + hstep, voffB);
            PG8_WAIT_V(6); PG8_BAR; PG8_MMA(1, 1, At, B1); PG8_BAR;
        }
        PG8_STAMP();
        if constexpr (!Epi::AFTER_DRAIN) { E(acc, cur, wr, wc, fr, fq); S.done(cur); }
        PG8_STAMP();
        if (!has_next) break;
#pragma unroll
        for (int a = 0; a < 2; ++a)
#pragma unroll
            for (int b = 0; b < 2; ++b)
#pragma unroll
                for (int m = 0; m < 4; ++m)
#pragma unroll
                    for (int n = 0; n < 2; ++n) acc[a][b][m][n] = (f32x4){0.f, 0.f, 0.f, 0.f};
        cur = nxt; cA = nA; cB = nB; ++ui;
    }
    PG8_WAIT_V(0);
    if (wr == 0) PG8_BAR;
    PG8_BAR;
    if constexpr (Epi::AFTER_DRAIN) { E.fused(acc, cur, wr, wc, fr, fq, lds, wid, lane); S.done(cur); }
    PG8_STAMP();
    if (STAMP && wid == 0) { stamps[lane] = lane < nts ? (((unsigned long long)(unsigned)ts_hi << 32) | (unsigned)ts_lo) : 0ull;
        if (lane == 62) stamps[62] = rt_entry; if (lane == 63) stamps[63] = (unsigned long long)wall_clock64(); }
#undef PG8_STAMP
#undef PG8_SA
#undef PG8_SB
#undef PG8_STAGE
#undef PG8_LDA
#undef PG8_LDB
#undef PG8_MMA
#undef PG8_WAIT_V
#undef PG8_WAIT_L
#undef PG8_BAR
#undef PG8_SCHED
}
}

struct ProjEpi8 {
    static constexpr bool PERM = true, AFTER_DRAIN = false;
    char* ws; const float* dt_bias;
    template <int H> __device__ __forceinline__ uint4 rot8(const pg8::f32x4 v0, const pg8::f32x4 v1, const float ps, const int j, float sc) const {
        float cs[4], sn[4];
        int jj = j; asm volatile("" : "+v"(jj));
#pragma unroll
        for (int e = 0; e < 4; ++e) {
            const float invrev = __builtin_amdgcn_exp2f(-(float)(4 * jj + e) * (2.f / (float)H) * 13.287712379549449f) * 0.15915494309189535f;
            const float rev = __builtin_amdgcn_fractf(ps * invrev);
            cs[e] = __builtin_amdgcn_cosf(rev); sn[e] = __builtin_amdgcn_sinf(rev);
        }
        const float o10 = (v0[0] * cs[0] - v1[0] * sn[0]) * sc, o11 = (v0[1] * cs[1] - v1[1] * sn[1]) * sc, o12 = (v0[2] * cs[2] - v1[2] * sn[2]) * sc, o13 = (v0[3] * cs[3] - v1[3] * sn[3]) * sc;
        const float o20 = (v1[0] * cs[0] + v0[0] * sn[0]) * sc, o21 = (v1[1] * cs[1] + v0[1] * sn[1]) * sc, o22 = (v1[2] * cs[2] + v0[2] * sn[2]) * sc, o23 = (v1[3] * cs[3] + v0[3] * sn[3]) * sc;
        return make_uint4(pack2(o10, o11), pack2(o12, o13), pack2(o20, o21), pack2(o22, o23));
    }
    template <int SEG> __device__ __forceinline__ void store_row(const pg8::f32x4 v0, const pg8::f32x4 v1, const int cg, const int row) const {
        const int b = row >> 11, t = row & 2047;
        if (SEG == 0 || SEG == 2 || SEG == 3) __builtin_amdgcn_sched_barrier(0);
        if (SEG == 0) {
            const bool isq = cg < 512; const int head = (cg & 511) >> 6, j = (cg & 63) >> 3;
            bf16_t* dst = (bf16_t*)(ws + (isq ? O_QB : O_KB)) + ((size_t)(b * 8 + head) * 2048 + t) * 64 + 8 * j;
            *(uint4*)dst = rot8<64>(v0, v1, ((const float*)(ws + O_CS64))[row], j, isq ? 0.125f * 1.4426950408889634f : 1.f);
        } else if (SEG == 1) {
            bf16_t* dst = (bf16_t*)(ws + O_VT) + ((size_t)(b * 8 + ((cg - 1024) >> 6)) * 64 + (cg & 63)) * 2048 + t;
#pragma unroll
            for (int e = 0; e < 4; ++e) { dst[(size_t)e * 2048] = f2bf(v0[e]); dst[(size_t)(e + 4) * 2048] = f2bf(v1[e]); }
        } else if (SEG == 2) {
            const int j = (cg & 31) >> 3;
            *(uint4*)((bf16_t*)(ws + O_IQB) + ((size_t)row * 8 + ((cg - 1536) >> 5)) * 32 + 8 * j) = rot8<32>(v0, v1, ((const float*)(ws + O_CS64))[row], j, 0.17677669529663687f);
        } else if (SEG == 3) {
            if (cg < 1824) {
                const int j = (cg & 31) >> 3;
                *(uint4*)((bf16_t*)(ws + O_IKB) + (size_t)row * 32 + 8 * j) = rot8<32>(v0, v1, ((const float*)(ws + O_CS64))[row], j, 1.f);
            } else if (cg == 1824) {
                const float k8 = 0.35355339059327373f; float* d = (float*)(ws + O_IWF) + (size_t)row * 8;
                *(float4*)d = make_float4(v0[0] * k8, v0[1] * k8, v0[2] * k8, v0[3] * k8); *(float4*)(d + 4) = make_float4(v1[0] * k8, v1[1] * k8, v1[2] * k8, v1[3] * k8);
            } else if (cg == 1832) {
                float o[8];
#pragma unroll
                for (int e = 0; e < 4; ++e) { const float a0 = v0[e] + dt_bias[e], a1 = v1[e] + dt_bias[4 + e]; o[e] = (a0 > 20.f) ? a0 : __logf(1.f + __expf(a0)); o[4 + e] = (a1 > 20.f) ? a1 : __logf(1.f + __expf(a1)); }
                float* d = (float*)(ws + O_DTF) + (size_t)row * 8;
                *(float4*)d = make_float4(o[0], o[1], o[2], o[3]); *(float4*)(d + 4) = make_float4(o[4], o[5], o[6], o[7]);
            }
        } else if (SEG == 4) {
            *(uint4*)((bf16_t*)(ws + O_ZB) + (size_t)row * 512 + (cg - ZOFF)) = make_uint4(pack2(v0[0], v0[1]), pack2(v0[2], v0[3]), pack2(v1[0], v1[1]), pack2(v1[2], v1[3]));
        } else {
            bf16_t* dst = (bf16_t*)(ws + O_XBCT) + ((size_t)b * 1024 + (cg - XBCOFF)) * 2048 + t;
#pragma unroll
            for (int e = 0; e < 4; ++e) { dst[(size_t)e * 2048] = f2bf(v0[e]); dst[(size_t)(e + 4) * 2048] = f2bf(v1[e]); }
        }
    }
    template <int SEG, int BJ> __device__ __forceinline__ void rows8(const pg8::f32x4 (&acc)[2][2][4][2], const int cg, const int row0) const {
#pragma unroll
        for (int ai = 0; ai < 2; ++ai)
#pragma unroll
            for (int m = 0; m < 4; ++m) store_row<SEG>(acc[ai][BJ][m][0], acc[ai][BJ][m][1], cg, row0 + ai * 128 + m * 16);
    }
    template <int BJ> __device__ __forceinline__ void half(const pg8::f32x4 (&acc)[2][2][4][2], const pg8::Unit& u, int wr, int wc, int fr, int fq) const {
        const int cw = u.pn * 256 + BJ * 128 + wc * 32;
        const int cg = cw + 8 * fq, row0 = u.pm * 256 + wr * 64 + fr;
        if (cw < 1024) rows8<0, BJ>(acc, cg, row0);
        else if (cw < 1536) rows8<1, BJ>(acc, cg, row0);
        else if (cw < 1792) rows8<2, BJ>(acc, cg, row0);
        else if (cw < 1856) rows8<3, BJ>(acc, cg, row0);
        else if (cw < 2368) rows8<4, BJ>(acc, cg, row0);
        else if (cw < NUSED) rows8<5, BJ>(acc, cg, row0);
    }
    __device__ __forceinline__ void operator()(const pg8::f32x4 (&acc)[2][2][4][2], const pg8::Unit& u, int wr, int wc, int fr, int fq) const {
        half<0>(acc, u, wr, wc, fr, fq); half<1>(acc, u, wr, wc, fr, fq);
    }
};
#ifndef V_EARLY
#define V_EARLY 8192
#endif
template <bool DO_U> __device__ __forceinline__ void convert_rows(const Params& p, size_t i_begin, size_t i_end, int wg, int nwg) {
    unsigned* u8 = (unsigned*)(p.ws + O_U8); unsigned* v8 = (unsigned*)(p.ws + O_V8);
    const size_t gsz = (size_t)nwg * 512;
    for (size_t i0 = i_begin + (size_t)wg * 512 + tid_op(); i0 < i_end; i0 += 8 * gsz) {
        float4 fv[8];
#pragma unroll
        for (int k = 0; k < 8; ++k) { const size_t i = i0 + k * gsz; const size_t ic = i < i_end ? i : i0; fv[k] = ((const float4*)p.v)[ic]; }
#pragma unroll
        for (int k = 0; k < 8; ++k) {
            const size_t i = i0 + k * gsz;
            if (i < i_end) {
                int pv = __builtin_amdgcn_cvt_pk_fp8_f32(fv[k].x, fv[k].y, 0, false); pv = __builtin_amdgcn_cvt_pk_fp8_f32(fv[k].z, fv[k].w, pv, true);
                const size_t e = i >> 8, c4 = i & 255;
                v8[((c4 >> 5) * 16384 + e) * 32 + (c4 & 31)] = (unsigned)pv;
            }
        }
    }
    if (DO_U) {
        const int lane = tid_op() & 63, wv = wg * 8 + (tid_op() >> 6), nwv = nwg * 8;
        bf16_t* us = (bf16_t*)(p.ws + O_US);
        for (int e0 = wv; e0 < 16384; e0 += 2 * nwv) {
            const int e1 = (e0 + nwv < 16384) ? e0 + nwv : e0;
            float4 f0[4], f1[4];
#pragma unroll
            for (int k = 0; k < 4; ++k) { f0[k] = ((const float4*)p.u)[(size_t)e0 * 256 + 64 * k + lane]; f1[k] = ((const float4*)p.u)[(size_t)e1 * 256 + 64 * k + lane]; }
#pragma unroll
            for (int rr = 0; rr < 2; ++rr) {
                const int e = rr ? e1 : e0;
                float m = 0.f;
#pragma unroll
                for (int k = 0; k < 4; ++k) { const float4 f = rr ? f1[k] : f0[k]; m = fmaxf(m, fmaxf(fmaxf(fabsf(f.x), fabsf(f.y)), fmaxf(fabsf(f.z), fabsf(f.w)))); }
                m = wave_max(m);
                const float step = quant_step(m), inv = step > 0.f ? 1.f / step : 0.f;
                u32x4g q;
                { const float4 f = rr ? f1[0] : f0[0]; q.x = quant4_i8(f.x, f.y, f.z, f.w, inv); }
                { const float4 f = rr ? f1[1] : f0[1]; q.y = quant4_i8(f.x, f.y, f.z, f.w, inv); }
                { const float4 f = rr ? f1[2] : f0[2]; q.z = quant4_i8(f.x, f.y, f.z, f.w, inv); }
                { const float4 f = rr ? f1[3] : f0[3]; q.w = quant4_i8(f.x, f.y, f.z, f.w, inv); }
                if (rr == 0 || e1 != e0) {
                    *(u32x4g*)(p.ws + O_U8 + (size_t)e * 1024 + 16 * lane) = q;
                    if (lane == 0) us[e] = (bf16_t)(__float_as_uint(step) >> 16);
                }
            }
        }
    }
}
__device__ __forceinline__ void phase1(const Params& p, char* smem, const XcdMap xm) {
    char* ws = p.ws;
    ProjEpi8 e; e.ws = ws; e.dt_bias = p.dt_bias;
    pg8::Gemm g{(const bf16_t*)(ws + O_XB), (const bf16_t*)(ws + O_WIN_T), NTOK, NP, 1024};
    pg8::StaticOrder S; S.init(NTOK, NP, (int)gridDim.x, (int)blockIdx.x);
    pg8::gemm_phase<ProjEpi8, pg8::StaticOrder, false>((PG8_LAS unsigned char*)smem, g, S, e, nullptr);
    const int G = (int)gridDim.x, first = (64 * (NP / 256)) % G;
    if ((int)blockIdx.x >= first) { const Params q = params_reload(); convert_rows<true>(q, 0, (size_t)V_EARLY * 256, (int)blockIdx.x - first, G - first); }
}

#define IDX_NT 16
#define IDX_LDS_SCORES (16 * 2048 * 4)
__device__ __forceinline__ unsigned wave_sum_cnt(unsigned v) {
    v = row_sum_u(v);
    v += (unsigned)dpp_i<0x142, 0xA, false>((int)v);
    v += (unsigned)dpp_i<0x143, 0xC, false>((int)v);
    return (unsigned)__builtin_amdgcn_readlane((int)v, 63);
}
template <int NR> __device__ __forceinline__ unsigned idx_count_ge(const unsigned (&k)[NR], unsigned cand) {
    unsigned n = 0u;
#pragma unroll
    for (int i = 0; i < NR; ++i) n += (k[i] >= cand) ? 1u : 0u;
    return wave_sum_cnt(n);
}
template <int NR> __device__ __forceinline__ unsigned long long idx_words(const unsigned (&k)[NR], unsigned K, bool exact, int lane) {
    unsigned long long wd = 0ull;
    if (exact) {
#pragma unroll
        for (int i = 0; i < NR; ++i) { const unsigned long long bal = __ballot(k[i] >= K); if (lane == i) wd = bal; }
    } else {
        unsigned n = 0u;
#pragma unroll
        for (int i = 0; i < NR; ++i) n += (k[i] > K) ? 1u : 0u;
        unsigned rem = 256u - wave_sum_cnt(n);
#pragma unroll 1
        for (int i = 0; i < NR; ++i) {
            unsigned ki = k[0];
#pragma unroll
            for (int j = 1; j < NR; ++j) ki = (j == i) ? k[j] : ki;
            const unsigned long long gt = __ballot(ki > K), eq = __ballot(ki == K);
            unsigned long long take = 0ull, e = eq;
            while (rem > 0u && e) { take |= e & (~e + 1ull); e &= e - 1ull; --rem; }
            if (lane == i) wd = gt | take;
        }
    }
    return wd;
}
template <int NR> __device__ __forceinline__ unsigned idx_finish(const unsigned (&k)[NR], unsigned lo, unsigned hi, bool hinf, unsigned cnt_hi, unsigned* row, int lane, bool& exact) {
    int nb = 0;
    asm volatile("" ::: "memory");
#pragma unroll
    for (int i = 0; i < NR; ++i) {
        const bool inb = (k[i] >= lo) && (hinf || k[i] < hi);
        const unsigned long long m = __ballot(inb);
        const int pos = nb + (int)__builtin_amdgcn_mbcnt_hi((unsigned)(m >> 32), __builtin_amdgcn_mbcnt_lo((unsigned)m, 0u));
        if (inb) row[pos] = k[i];
        nb += (int)__builtin_popcountll(m);
    }
    asm volatile("s_waitcnt lgkmcnt(0)" ::: "memory");
    const unsigned bkey = (lane < nb) ? row[lane] : 0u;
    unsigned gt = 0u, eq = 0u;
    for (int j = 0; j < nb; ++j) { const unsigned bj = (unsigned)__builtin_amdgcn_readlane((int)bkey, j); gt += (bj > bkey) ? 1u : 0u; eq += (bj == bkey) ? 1u : 0u; }
    const unsigned m256 = 256u - cnt_hi;
    const unsigned long long hit = __ballot(lane < nb && gt < m256 && m256 <= gt + eq);
    const int src = (int)__builtin_ctzll(hit | (1ull << 63));
    const unsigned v = (unsigned)__builtin_amdgcn_readlane((int)bkey, src);
    const unsigned g = (unsigned)__builtin_amdgcn_readlane((int)gt, src), e = (unsigned)__builtin_amdgcn_readlane((int)eq, src);
    exact = (cnt_hi + g + e == 256u);
    return v;
}
template <int NR> __device__ __forceinline__ void idx_select(const unsigned* Sa, unsigned long long* mrow, int lane) {
    unsigned ka[NR], kb[NR];
#pragma unroll
    for (int i = 0; i < NR; ++i) { ka[i] = Sa[64 * i]; kb[i] = Sa[2048 + 64 * i]; }
    unsigned Ka = 0u, Kb = 0u, Ha = 0u, Hb = 0u, cla = 64u * NR, clb = 64u * NR, cha = 0u, chb = 0u;
    bool da = false, db = false, fa = false, fb = false, hia = true, hib = true;
    for (int bit = 31; bit >= 0; --bit) {
        const unsigned ca = Ka | (1u << bit), cb = Kb | (1u << bit);
        const unsigned ta = idx_count_ge<NR>(ka, ca), tb = idx_count_ge<NR>(kb, cb);
        if (!da && !fa) { if (ta >= 256u) { Ka = ca; cla = ta; da = (ta == 256u); } else { Ha = ca; hia = false; cha = ta; } fa = (cla - cha <= 64u); }
        if (!db && !fb) { if (tb >= 256u) { Kb = cb; clb = tb; db = (tb == 256u); } else { Hb = cb; hib = false; chb = tb; } fb = (clb - chb <= 64u); }
        if ((da || fa) && (db || fb)) break;
    }
    unsigned* rowa = (unsigned*)Sa - lane;
    if (!da && fa) Ka = idx_finish<NR>(ka, Ka, Ha, hia, cha, rowa, lane, da);
    if (!db && fb) Kb = idx_finish<NR>(kb, Kb, Hb, hib, chb, rowa + 2048, lane, db);
    const unsigned long long wa = idx_words<NR>(ka, Ka, da, lane), wb = idx_words<NR>(kb, Kb, db, lane);
    if (lane < NR) { mrow[lane] = wa; mrow[32 + lane] = wb; }
}
__device__ __forceinline__ void indexer_unit(const Params& p, int unit, char* smem) {
    const int tid = tid_op(), lane = tid & 63, w = tid >> 6, c = lane & 15, g = lane >> 4;
    const int b = unit & 7, grp = 127 - (unit >> 3), t0 = grp * 16;
    char* ws = p.ws;
    unsigned long long* mask64 = (unsigned long long*)(ws + O_MASK) + (size_t)(b * 2048 + t0) * 32;
    const int nblk64 = (t0 + 16 + 63) >> 6;
    if (t0 < 256) {
        for (int i = tid; i < 16 * nblk64; i += 512) {
            const int q = i / nblk64, wd = i % nblk64, t = t0 + q, s0 = wd * 64;
            const unsigned long long bits = (t >= s0 + 63) ? ~0ull : (t < s0 ? 0ull : ((1ull << (t - s0 + 1)) - 1ull));
            mask64[q * 32 + wd] = bits;
        }
        return;
    }
    const int ntile = (nblk64 + 1) >> 1;
    const bf16_t* IQb = (const bf16_t*)(ws + O_IQB); const bf16_t* IKb = (const bf16_t*)(ws + O_IKB); const float* IWf = (const float*)(ws + O_IWF);
    unsigned* S = (unsigned*)smem;
    float* siw = (float*)(smem + IDX_LDS_SCORES);
    const float siwv = IWf[(size_t)(b * 2048 + t0) * 8 + (tid & 127)];
    bf16x8 aq[8];
#pragma unroll
    for (int h = 0; h < 8; ++h) aq[h] = ld8(IQb + ((size_t)(b * 2048 + t0 + c) * 8 + h) * 32 + g * 8);
    bf16x8 bk[IDX_NT];
#pragma unroll
    for (int i = 0; i < IDX_NT; ++i) {
        const int ti = (i < ntile) ? (w * ntile + i) : (w * ntile);
        bk[i] = ld8(IKb + (size_t)(b * 2048 + ti * 16 + c) * 32 + g * 8);
    }
    __syncthreads();
    if (tid < 128) siw[tid] = siwv;
    {
        const int nr = (nblk64 <= 8) ? 8 : (nblk64 <= 16) ? 16 : (nblk64 <= 24) ? 24 : 32, kfrom = 8 * ntile * 16, kto = nr * 64;
        if (kfrom + tid < kto) {
#pragma unroll
            for (int q = 0; q < 16; ++q) S[q * 2048 + kfrom + tid] = 0u;
        }
    }
    __syncthreads();
    {
        float wq[4][8];
#pragma unroll
        for (int r = 0; r < 4; ++r)
#pragma unroll
            for (int h = 0; h < 8; ++h) wq[r][h] = siw[(4 * g + r) * 8 + h];
#pragma unroll
        for (int i = 0; i < IDX_NT; ++i) {
            if (i < ntile) {
                const int s0 = (w * ntile + i) * 16;
                float sc[4] = {0.f, 0.f, 0.f, 0.f};
#pragma unroll
                for (int h = 0; h < 8; ++h) {
                    const f32x4 o = mfma16(aq[h], bk[i], (f32x4){0.f, 0.f, 0.f, 0.f});
#pragma unroll
                    for (int r = 0; r < 4; ++r) sc[r] += wq[r][h] * fmaxf(o[r], 0.f);
                }
#pragma unroll
                for (int r = 0; r < 4; ++r) S[(4 * g + r) * 2048 + s0 + c] = (s0 + c <= t0 + 4 * g + r) ? f2sort(sc[r]) : 0u;
            }
        }
    }
    __syncthreads();
    if (nblk64 <= 8) idx_select<8>(S + (2 * w) * 2048 + lane, mask64 + (2 * w) * 32, lane);
    else if (nblk64 <= 16) idx_select<16>(S + (2 * w) * 2048 + lane, mask64 + (2 * w) * 32, lane);
    else if (nblk64 <= 24) idx_select<24>(S + (2 * w) * 2048 + lane, mask64 + (2 * w) * 32, lane);
    else idx_select<32>(S + (2 * w) * 2048 + lane, mask64 + (2 * w) * 32, lane);
}

__device__ __forceinline__ void ssd_conv8(const u32x4g cur, const u32x4g prv, const float w0, const float w1, const float w2, const float w3, const float bias, float (&o)[8]) {
    float xv[11];
    xv[0] = bf2f((bf16_t)(prv.z >> 16)); xv[1] = bf2f((bf16_t)(prv.w & 0xFFFF)); xv[2] = bf2f((bf16_t)(prv.w >> 16));
    xv[3] = bf2f((bf16_t)(cur.x & 0xFFFF)); xv[4] = bf2f((bf16_t)(cur.x >> 16)); xv[5] = bf2f((bf16_t)(cur.y & 0xFFFF)); xv[6] = bf2f((bf16_t)(cur.y >> 16));
    xv[7] = bf2f((bf16_t)(cur.z & 0xFFFF)); xv[8] = bf2f((bf16_t)(cur.z >> 16)); xv[9] = bf2f((bf16_t)(cur.w & 0xFFFF)); xv[10] = bf2f((bf16_t)(cur.w >> 16));
#pragma unroll
    for (int j = 0; j < 8; ++j) { const float v = bias + w0 * xv[j] + w1 * xv[j + 1] + w2 * xv[j + 2] + w3 * xv[j + 3]; o[j] = bf2f(f2bf(silu_f(v))); }
}
__device__ __forceinline__ void ssd_prep_unit(const Params& p, int unit, char* smem) {
    const int tid = tid_op(), lane = tid & 63, w = tid >> 6, cL = lane & 15, gq = lane >> 4;
    const int g = unit & 1, c = (unit >> 1) & 15, b = unit >> 5;
    char* ws = p.ws;
    float* s_acum = (float*)smem; float* s_dt = s_acum + 512; float* s_w = s_dt + 512; float* s_tot = s_w + 512;
    bf16_t* sBt = (bf16_t*)(smem + 6144 + 64); bf16_t* sXw = sBt + 128 * 136; bf16_t* sCt = sXw;
    s_tot = (float*)(smem + 6144);
    const int tok0 = b * 2048 + c * 128;
    const bf16_t* XBCt = (const bf16_t*)(ws + O_XBCT);
    bf16_t* Xt = (bf16_t*)(ws + O_XT); bf16_t* Brm = (bf16_t*)(ws + O_BRM); bf16_t* Crm = (bf16_t*)(ws + O_CRM);
    __syncthreads();
    u32x4g cur8[8], prv8[8]; float cw8[8][5];
    const bool hasprev0 = (c * 128 >= 8);
#pragma unroll
    for (int it = 0; it < 8; ++it) {
        const int item = tid + 512 * it, tc = item & 15, ch = 512 + ((item >> 4) & 128) * 2 + g * 128 + ((item >> 4) & 127);
        const bf16_t* src = XBCt + ((size_t)b * 1024 + ch) * 2048 + c * 128 + tc * 8;
        cur8[it] = *(const u32x4g*)src;
        const bool hasprev = hasprev0 || tc > 0;
        prv8[it] = *(const u32x4g*)(hasprev ? src - 8 : src);
        if (!hasprev) prv8[it] = (u32x4g){0u, 0u, 0u, 0u};
        cw8[it][0] = p.conv_w[ch]; cw8[it][1] = p.conv_w[1024 + ch]; cw8[it][2] = p.conv_w[2048 + ch]; cw8[it][3] = p.conv_w[3072 + ch]; cw8[it][4] = p.conv_b[ch];
    }
    {
        const int hh = tid >> 7, l = tid & 127, h = 4 * g + hh;
        const float a_h = -expf(p.a_log[h]);
        const float dtv = ((const float*)(ws + O_DTF))[(size_t)(tok0 + l) * 8 + h];
        float v = dtv * a_h;
#pragma unroll
        for (int d = 1; d < 64; d <<= 1) { const float t = __shfl_up(v, d); if (lane >= d) v += t; }
        if (lane == 63) s_tot[w] = v;
        __syncthreads();
        if (w & 1) v += s_tot[w - 1];
        const float tot = s_tot[2 * hh] + s_tot[2 * hh + 1];
        s_acum[tid] = v; s_dt[tid] = dtv; s_w[tid] = dtv * __expf(tot - v);
        ((float*)(ws + O_ACUM))[(size_t)(b * 8 + h) * 2048 + c * 128 + l] = v;
        if (l == 0) ((float*)(ws + O_ATOT))[(b * 8 + h) * 16 + c] = tot;
    }
#pragma unroll
    for (int it = 0; it < 8; ++it) {
        const int item = tid + 512 * it, tc = item & 15, n = (item >> 4) & 127;
        float o[8];
        ssd_conv8(cur8[it], prv8[it], cw8[it][0], cw8[it][1], cw8[it][2], cw8[it][3], cw8[it][4], o);
        bf16_t* dst = ((item >> 4) & 128) ? sCt : sBt;
        *(uint4*)(dst + n * 136 + tc * 8) = make_uint4(pack2(o[0], o[1]), pack2(o[2], o[3]), pack2(o[4], o[5]), pack2(o[6], o[7]));
    }
#pragma unroll
    for (int it = 0; it < 8; ++it) {
        const int item = tid + 512 * it, tc = item & 15, ch = g * 256 + (item >> 4);
        const bf16_t* src = XBCt + ((size_t)b * 1024 + ch) * 2048 + c * 128 + tc * 8;
        cur8[it] = *(const u32x4g*)src;
        const bool hasprev = hasprev0 || tc > 0;
        prv8[it] = *(const u32x4g*)(hasprev ? src - 8 : src);
        if (!hasprev) prv8[it] = (u32x4g){0u, 0u, 0u, 0u};
        cw8[it][0] = p.conv_w[ch]; cw8[it][1] = p.conv_w[1024 + ch]; cw8[it][2] = p.conv_w[2048 + ch]; cw8[it][3] = p.conv_w[3072 + ch]; cw8[it][4] = p.conv_b[ch];
    }
    __syncthreads();
    {
        const int t = tid & 127, cb = tid >> 7;
#pragma unroll
        for (int m = 0; m < 2; ++m) {
            const bf16_t* srcT = (m ? sCt : sBt) + (cb * 32) * 136 + t;
            bf16_t* dst = (m ? Crm : Brm) + (size_t)(tok0 + t) * 256 + g * 128 + cb * 32;
#pragma unroll
            for (int q = 0; q < 4; ++q) {
                unsigned wv[4];
#pragma unroll
                for (int k = 0; k < 4; ++k) wv[k] = (unsigned)srcT[(8 * q + 2 * k) * 136] | ((unsigned)srcT[(8 * q + 2 * k + 1) * 136] << 16);
                *(uint4*)(dst + 8 * q) = make_uint4(wv[0], wv[1], wv[2], wv[3]);
            }
        }
    }
    __syncthreads();
#pragma unroll
    for (int it = 0; it < 8; ++it) {
        const int item = tid + 512 * it, tc = item & 15, hp = item >> 4, ch = g * 256 + hp;
        float o[8];
        ssd_conv8(cur8[it], prv8[it], cw8[it][0], cw8[it][1], cw8[it][2], cw8[it][3], cw8[it][4], o);
        *(uint4*)(Xt + ((size_t)b * 512 + ch) * 2048 + c * 128 + tc * 8) = make_uint4(pack2(o[0], o[1]), pack2(o[2], o[3]), pack2(o[4], o[5]), pack2(o[6], o[7]));
        const float* sw = s_w + (hp >> 6) * 128 + tc * 8;
        float q[8];
#pragma unroll
        for (int j = 0; j < 8; ++j) q[j] = o[j] * sw[j];
        *(uint4*)(sXw + hp * 136 + tc * 8) = make_uint4(pack2(q[0], q[1]), pack2(q[2], q[3]), pack2(q[4], q[5]), pack2(q[6], q[7]));
    }
    __syncthreads();
    bf16x8 bb[4];
#pragma unroll
    for (int ks = 0; ks < 4; ++ks) bb[ks] = ld8(sBt + (16 * w + cL) * 136 + ks * 32 + gq * 8);
#pragma unroll
    for (int hh = 0; hh < 4; ++hh) {
        f32x4 acc[4];
#pragma unroll
        for (int i = 0; i < 4; ++i) acc[i] = (f32x4){0.f, 0.f, 0.f, 0.f};
#pragma unroll
        for (int ks = 0; ks < 4; ++ks)
#pragma unroll
            for (int pt = 0; pt < 4; ++pt) acc[pt] = mfma16(bb[ks], ld8(sXw + (hh * 64 + 16 * pt + cL) * 136 + ks * 32 + gq * 8), acc[pt]);
        bf16_t* ST = (bf16_t*)(ws + O_ST) + ((size_t)((b * 16 + c) * 8 + 4 * g + hh)) * 8192;
#pragma unroll
        for (int pt = 0; pt < 4; ++pt) *(uint2*)(ST + (16 * pt + cL) * 128 + 16 * w + 4 * gq) = make_uint2(pack2(acc[pt][0], acc[pt][1]), pack2(acc[pt][2], acc[pt][3]));
    }
}

__device__ __forceinline__ void phase2c(const Params& p) {
    char* ws = p.ws;
    const int idx = blockIdx.x * 512 + tid_op();
    if (idx >= 64 * 2048) return;
    const int bh = idx >> 11, e4 = idx & 2047, b = bh >> 3, h = bh & 7;
    const bf16_t* ST = (const bf16_t*)(ws + O_ST); const float* ATOT = (const float*)(ws + O_ATOT);
    uint2 sr[16]; float4 at4[4];
#pragma unroll
    for (int c = 0; c < 16; ++c) sr[c] = *(const uint2*)(ST + ((size_t)((b * 16 + c) * 8 + h)) * 8192 + (size_t)e4 * 4);
#pragma unroll
    for (int k = 0; k < 4; ++k) at4[k] = *(const float4*)(ATOT + bh * 16 + 4 * k);
    const float at[16] = {at4[0].x, at4[0].y, at4[0].z, at4[0].w, at4[1].x, at4[1].y, at4[1].z, at4[1].w, at4[2].x, at4[2].y, at4[2].z, at4[2].w, at4[3].x, at4[3].y, at4[3].z, at4[3].w};
    float4 car = make_float4(0.f, 0.f, 0.f, 0.f);
    bf16_t* CAR = (bf16_t*)(ws + O_CAR);
#pragma unroll
    for (int c = 0; c < 16; ++c) {
        *(uint2*)(CAR + ((size_t)((b * 16 + c) * 8 + h)) * 8192 + (size_t)e4 * 4) = make_uint2(pack2(car.x, car.y), pack2(car.z, car.w));
        const float dec = __expf(at[c]);
        car.x = dec * car.x + __uint_as_float(sr[c].x << 16); car.y = dec * car.y + __uint_as_float(sr[c].x & 0xFFFF0000u); car.z = dec * car.z + __uint_as_float(sr[c].y << 16); car.w = dec * car.w + __uint_as_float(sr[c].y & 0xFFFF0000u);
    }
}

#define ATT_LDK 80
#define ATT_LDV 136
#define ATT_KBYTES (128 * ATT_LDK * 2)
#define ATT_VBYTES (64 * ATT_LDV * 2)
__device__ __forceinline__ void attn_unit(const Params& p, int unit, char* smem) {
    const int tid = tid_op(), lane = tid & 63, w = tid >> 6, cL = lane & 15, gq = lane >> 4;
    const int qb = 15 - (unit >> 6), bh = unit & 63, b = bh >> 3, h = bh & 7;
    char* ws = p.ws;
    const int q0 = qb * 128 + 16 * w;
    const int ntile = qb + 1;
    const int wmax = (q0 + 15) >> 6;
    const bf16_t* Q = (const bf16_t*)(ws + O_QB) + (size_t)bh * 2048 * 64;
    const bf16_t* Kp = (const bf16_t*)(ws + O_KB) + (size_t)bh * 2048 * 64;
    const bf16_t* V = (const bf16_t*)(ws + O_VT) + (size_t)bh * 64 * 2048;
    const unsigned long long* mrow = (const unsigned long long*)(ws + O_MASK) + (size_t)(b * 2048 + q0 + cL) * 32;
    const int lr = tid >> 3, lc = (tid & 7) * 8;
    bf16x8 qf[2];
    qf[0] = ld8(Q + (size_t)(q0 + cL) * 64 + gq * 8); qf[1] = ld8(Q + (size_t)(q0 + cL) * 64 + 32 + gq * 8);
    float m_run = -1e30f, l_run = 0.f;
    f32x4 o[4];
#pragma unroll
    for (int i = 0; i < 4; ++i) o[i] = (f32x4){0.f, 0.f, 0.f, 0.f};
    char* sK = smem; char* sV = smem + 2 * ATT_KBYTES;
#define ATT_GLOAD(T, K0, K1, V0, V1) { const int s_ = (T) * 128; \
        K0 = *(const u32x4g*)(Kp + (size_t)(s_ + lr) * 64 + lc); K1 = *(const u32x4g*)(Kp + (size_t)(s_ + 64 + lr) * 64 + lc); \
        V0 = *(const u32x4g*)(V + (size_t)lr * 2048 + s_ + lc); V1 = *(const u32x4g*)(V + (size_t)lr * 2048 + s_ + 64 + lc); }
#define ATT_LSTORE(BUF, K0, K1, V0, V1) { bf16_t* k_ = (bf16_t*)(sK + (BUF) * ATT_KBYTES); bf16_t* v_ = (bf16_t*)(sV + (BUF) * ATT_VBYTES); \
        *(u32x4g*)(k_ + lr * ATT_LDK + lc) = K0; *(u32x4g*)(k_ + (64 + lr) * ATT_LDK + lc) = K1; \
        *(u32x4g*)(v_ + lr * ATT_LDV + lc) = V0; *(u32x4g*)(v_ + lr * ATT_LDV + 64 + lc) = V1; }
    u32x4g ka0, ka1, va0, va1, kb0, kb1, vb0, vb1;
    ATT_GLOAD(0, ka0, ka1, va0, va1)
    { const int t1 = (ntile > 1) ? 1 : 0; ATT_GLOAD(t1, kb0, kb1, vb0, vb1) }
    unsigned long long nmb0 = mrow[0], nmb1 = mrow[1];
    __syncthreads();
    ATT_LSTORE(0, ka0, ka1, va0, va1)
    __syncthreads();
    for (int kt = 0; kt < ntile; ++kt) {
        const int cur = kt & 1;
        ka0 = kb0; ka1 = kb1; va0 = vb0; va1 = vb1;
        { const int t2 = (kt + 2 < ntile) ? kt + 2 : ntile - 1; ATT_GLOAD(t2, kb0, kb1, vb0, vb1) }
        {
            const bf16_t* tK = (const bf16_t*)(sK + cur * ATT_KBYTES); const bf16_t* tV = (const bf16_t*)(sV + cur * ATT_VBYTES);
            const unsigned long long mb0 = (2 * kt <= wmax) ? nmb0 : 0ull, mb1 = (2 * kt + 1 <= wmax) ? nmb1 : 0ull;
            { const int tn = (kt + 1 < ntile) ? kt + 1 : kt; nmb0 = mrow[2 * tn]; nmb1 = mrow[2 * tn + 1]; }
            f32x4 st[8];
#pragma unroll
            for (int j = 0; j < 8; ++j) {
                f32x4 a = (f32x4){0.f, 0.f, 0.f, 0.f};
                const bf16_t* kr = tK + (16 * j + cL) * ATT_LDK + gq * 8;
                a = mfma16(ld8(kr), qf[0], a); a = mfma16(ld8(kr + 32), qf[1], a);
                st[j] = a;
            }
            float mx = m_run;
            const unsigned mw[4] = {(unsigned)mb0 >> (4 * gq), (unsigned)(mb0 >> 32) >> (4 * gq), (unsigned)mb1 >> (4 * gq), (unsigned)(mb1 >> 32) >> (4 * gq)};
#pragma unroll
            for (int j = 0; j < 8; ++j)
#pragma unroll
                for (int r = 0; r < 4; ++r) {
                    const bool bit = (mw[j >> 1] & (1u << (16 * (j & 1) + r))) != 0u;
                    const float v = bit ? st[j][r] : -INFINITY;
                    st[j][r] = v; mx = fmaxf(mx, v);
                }
            mx = max_x32(max_x16(mx));
            const float alpha = __builtin_amdgcn_exp2f(m_run - mx); m_run = mx;
            float ls = 0.f;
#pragma unroll
            for (int j = 0; j < 8; ++j)
#pragma unroll
                for (int r = 0; r < 4; ++r) { const float pv = __builtin_amdgcn_exp2f(st[j][r] - mx); st[j][r] = pv; ls += pv; }
            ls = sum_x32(sum_x16(ls));
            l_run = l_run * alpha + ls;
#pragma unroll
            for (int i = 0; i < 4; ++i) o[i] = o[i] * alpha;
#pragma unroll
            for (int kk = 0; kk < 4; ++kk) {
                const u32x4g pw = (u32x4g){pack2(st[2 * kk][0], st[2 * kk][1]), pack2(st[2 * kk][2], st[2 * kk][3]), pack2(st[2 * kk + 1][0], st[2 * kk + 1][1]), pack2(st[2 * kk + 1][2], st[2 * kk + 1][3])};
                const bf16x8 pf = __builtin_bit_cast(bf16x8, pw);
#pragma unroll
                for (int dt = 0; dt < 4; ++dt) {
                    const bf16_t* vr = tV + (16 * dt + cL) * ATT_LDV + 32 * kk + 4 * gq;
                    o[dt] = mfma16(cat4(*(const bf16x4*)vr, *(const bf16x4*)(vr + 16)), pf, o[dt]);
                }
            }
        }
        if (kt + 1 < ntile) ATT_LSTORE(cur ^ 1, ka0, ka1, va0, va1)
        __syncthreads();
    }
#undef ATT_GLOAD
#undef ATT_LSTORE
    const float inv = 1.f / l_run;
    bf16_t* mix = (bf16_t*)(ws + O_MIX) + (size_t)(b * 2048 + q0 + cL) * 1024 + h * 64;
#pragma unroll
    for (int dt = 0; dt < 4; ++dt)
        *(uint2*)(mix + 16 * dt + 4 * gq) = make_uint2(pack2(o[dt][0] * inv, o[dt][1] * inv), pack2(o[dt][2] * inv, o[dt][3] * inv));
}

__device__ __forceinline__ void attn_unit2(const Params& p, int unit, char* smem) {
    const int tid = tid_op(), lane = tid & 63, w = tid >> 6, cL = lane & 15, gq = lane >> 4;
    const int qb = 7 - (unit >> 6), bh = unit & 63, b = bh >> 3, h = bh & 7;
    char* ws = p.ws;
    const int q0 = qb * 256 + 32 * w;
    const int ntile = 2 * qb + 2;
    const int wmax0 = (q0 + 15) >> 6, wmax1 = (q0 + 31) >> 6;
    const bf16_t* Q = (const bf16_t*)(ws + O_QB) + (size_t)bh * 2048 * 64;
    const bf16_t* Kp = (const bf16_t*)(ws + O_KB) + (size_t)bh * 2048 * 64;
    const bf16_t* V = (const bf16_t*)(ws + O_VT) + (size_t)bh * 64 * 2048;
    const unsigned long long* mrow0 = (const unsigned long long*)(ws + O_MASK) + (size_t)(b * 2048 + q0 + cL) * 32;
    const unsigned long long* mrow1 = mrow0 + 16 * 32;
    const int lr = tid >> 3, lc = (tid & 7) * 8;
    bf16x8 qf[2][2];
#pragma unroll
    for (int s2 = 0; s2 < 2; ++s2) { qf[s2][0] = ld8(Q + (size_t)(q0 + 16 * s2 + cL) * 64 + gq * 8); qf[s2][1] = ld8(Q + (size_t)(q0 + 16 * s2 + cL) * 64 + 32 + gq * 8); }
    float m_run[2] = {-1e30f, -1e30f}, l_run[2] = {0.f, 0.f};
    f32x4 o[2][4];
#pragma unroll
    for (int s2 = 0; s2 < 2; ++s2)
#pragma unroll
        for (int i = 0; i < 4; ++i) o[s2][i] = (f32x4){0.f, 0.f, 0.f, 0.f};
    char* sK = smem; char* sV = smem + 2 * ATT_KBYTES;
#define ATT_GLOAD(T, K0, K1, V0, V1) { const int s_ = (T) * 128; \
        K0 = *(const u32x4g*)(Kp + (size_t)(s_ + lr) * 64 + lc); K1 = *(const u32x4g*)(Kp + (size_t)(s_ + 64 + lr) * 64 + lc); \
        V0 = *(const u32x4g*)(V + (size_t)lr * 2048 + s_ + lc); V1 = *(const u32x4g*)(V + (size_t)lr * 2048 + s_ + 64 + lc); }
#define ATT_LSTORE(BUF, K0, K1, V0, V1) { bf16_t* k_ = (bf16_t*)(sK + (BUF) * ATT_KBYTES); bf16_t* v_ = (bf16_t*)(sV + (BUF) * ATT_VBYTES); \
        *(u32x4g*)(k_ + lr * ATT_LDK + lc) = K0; *(u32x4g*)(k_ + (64 + lr) * ATT_LDK + lc) = K1; \
        *(u32x4g*)(v_ + lr * ATT_LDV + lc) = V0; *(u32x4g*)(v_ + lr * ATT_LDV + 64 + lc) = V1; }
    u32x4g ka0, ka1, va0, va1, kb0, kb1, vb0, vb1;
    ATT_GLOAD(0, ka0, ka1, va0, va1)
    ATT_GLOAD(1, kb0, kb1, vb0, vb1)
    unsigned long long nm00 = mrow0[0], nm01 = mrow0[1], nm10 = mrow1[0], nm11 = mrow1[1];
    __syncthreads();
    ATT_LSTORE(0, ka0, ka1, va0, va1)
    __syncthreads();
    for (int kt = 0; kt < ntile; ++kt) {
        const int cur = kt & 1;
        ka0 = kb0; ka1 = kb1; va0 = vb0; va1 = vb1;
        { const int t2 = (kt + 2 < ntile) ? kt + 2 : ntile - 1; ATT_GLOAD(t2, kb0, kb1, vb0, vb1) }
        if (128 * kt <= q0 + 31) {
            const bf16_t* tK = (const bf16_t*)(sK + cur * ATT_KBYTES); const bf16_t* tV = (const bf16_t*)(sV + cur * ATT_VBYTES);
            unsigned long long mb[2][2];
            mb[0][0] = (2 * kt <= wmax0) ? nm00 : 0ull; mb[0][1] = (2 * kt + 1 <= wmax0) ? nm01 : 0ull;
            mb[1][0] = (2 * kt <= wmax1) ? nm10 : 0ull; mb[1][1] = (2 * kt + 1 <= wmax1) ? nm11 : 0ull;
            { const int tn = (kt + 1 < ntile) ? kt + 1 : kt; nm00 = mrow0[2 * tn]; nm01 = mrow0[2 * tn + 1]; nm10 = mrow1[2 * tn]; nm11 = mrow1[2 * tn + 1]; }
            f32x4 st[2][8];
#pragma unroll
            for (int j = 0; j < 8; ++j) {
                const bf16_t* kr = tK + (16 * j + cL) * ATT_LDK + gq * 8;
                const bf16x8 k0 = ld8(kr), k1 = ld8(kr + 32);
#pragma unroll
                for (int s2 = 0; s2 < 2; ++s2) { f32x4 a = (f32x4){0.f, 0.f, 0.f, 0.f}; a = mfma16(k0, qf[s2][0], a); a = mfma16(k1, qf[s2][1], a); st[s2][j] = a; }
            }
            float alpha[2];
#pragma unroll
            for (int s2 = 0; s2 < 2; ++s2) {
                float mx = m_run[s2];
                const unsigned mw[4] = {(unsigned)mb[s2][0] >> (4 * gq), (unsigned)(mb[s2][0] >> 32) >> (4 * gq), (unsigned)mb[s2][1] >> (4 * gq), (unsigned)(mb[s2][1] >> 32) >> (4 * gq)};
#pragma unroll
                for (int j = 0; j < 8; ++j)
#pragma unroll
                    for (int r = 0; r < 4; ++r) {
                        const unsigned m = (unsigned)__builtin_amdgcn_sbfe((int)mw[j >> 1], 16 * (j & 1) + r, 1);
                        const float v = __uint_as_float((__float_as_uint(st[s2][j][r]) & m) | (0xFF800000u & ~m));
                        st[s2][j][r] = v; mx = fmaxf(mx, v);
                    }
                mx = max_x32(max_x16(mx));
                alpha[s2] = __builtin_amdgcn_exp2f(m_run[s2] - mx); m_run[s2] = mx;
                const f32x4 mx4 = (f32x4){mx, mx, mx, mx};
                f32x4 ls4 = (f32x4){0.f, 0.f, 0.f, 0.f};
#pragma unroll
                for (int j = 0; j < 8; ++j) {
                    const f32x4 d4 = st[s2][j] - mx4;
                    const f32x4 p4 = (f32x4){__builtin_amdgcn_exp2f(d4[0]), __builtin_amdgcn_exp2f(d4[1]), __builtin_amdgcn_exp2f(d4[2]), __builtin_amdgcn_exp2f(d4[3])};
                    st[s2][j] = p4; ls4 += p4;
                }
                float ls = (ls4[0] + ls4[1]) + (ls4[2] + ls4[3]);
                ls = sum_x32(sum_x16(ls));
                l_run[s2] = l_run[s2] * alpha[s2] + ls;
#pragma unroll
                for (int i = 0; i < 4; ++i) o[s2][i] = o[s2][i] * alpha[s2];
            }
#pragma unroll
            for (int kk = 0; kk < 4; ++kk) {
                bf16x8 pf[2];
#pragma unroll
                for (int s2 = 0; s2 < 2; ++s2) {
                    const u32x4g pw = (u32x4g){pack2(st[s2][2 * kk][0], st[s2][2 * kk][1]), pack2(st[s2][2 * kk][2], st[s2][2 * kk][3]), pack2(st[s2][2 * kk + 1][0], st[s2][2 * kk + 1][1]), pack2(st[s2][2 * kk + 1][2], st[s2][2 * kk + 1][3])};
                    pf[s2] = __builtin_bit_cast(bf16x8, pw);
                }
#pragma unroll
                for (int dt = 0; dt < 4; ++dt) {
                    const bf16_t* vr = tV + (16 * dt + cL) * ATT_LDV + 32 * kk + 4 * gq;
                    const bf16x8 vf = cat4(*(const bf16x4*)vr, *(const bf16x4*)(vr + 16));
                    o[0][dt] = mfma16(vf, pf[0], o[0][dt]); o[1][dt] = mfma16(vf, pf[1], o[1][dt]);
                }
            }
        }
        if (kt + 1 < ntile) ATT_LSTORE(cur ^ 1, ka0, ka1, va0, va1)
        __syncthreads();
    }
#undef ATT_GLOAD
#undef ATT_LSTORE
#pragma unroll
    for (int s2 = 0; s2 < 2; ++s2) {
        const float inv = 1.f / l_run[s2];
        bf16_t* mix = (bf16_t*)(ws + O_MIX) + (size_t)(b * 2048 + q0 + 16 * s2 + cL) * 1024 + h * 64;
#pragma unroll
        for (int dt = 0; dt < 4; ++dt)
            *(uint2*)(mix + 16 * dt + 4 * gq) = make_uint2(pack2(o[s2][dt][0] * inv, o[s2][dt][1] * inv), pack2(o[s2][dt][2] * inv, o[s2][dt][3] * inv));
    }
}

#define SSM_TILE (128 * 136 * 2)
struct SsdPair { u32x4g x[4], car[4], z[4]; };
__device__ __forceinline__ void ssd_pair_load(SsdPair& P, const char* ws, int b, int c, int g, int pr, int tid) {
    const int row0 = tid >> 4, c16 = tid & 15;
    const int tok0 = b * 2048 + c * 128;
#pragma unroll
    for (int k = 0; k < 4; ++k) {
        const int row = row0 + 32 * k;
        const int h = 4 * g + 2 * pr + (row >> 6), pp = row & 63;
        P.x[k] = *(const u32x4g*)((const bf16_t*)(ws + O_XT) + ((size_t)b * 512 + h * 64 + pp) * 2048 + c * 128 + c16 * 8);
        P.car[k] = *(const u32x4g*)((const bf16_t*)(ws + O_CAR) + ((size_t)((b * 16 + c) * 8 + h)) * 8192 + pp * 128 + c16 * 8);
        P.z[k] = *(const u32x4g*)((const bf16_t*)(ws + O_ZB) + (size_t)(tok0 + row) * 512 + (4 * g + 2 * pr) * 64 + c16 * 8);
    }
}
__device__ __forceinline__ void ssd_pair_store(const SsdPair& P, char* tiles, int tid) {
    const int row0 = tid >> 4, c16 = tid & 15;
#pragma unroll
    for (int k = 0; k < 4; ++k) {
        const int off = ((row0 + 32 * k) * 136 + c16 * 8) * 2;
        *(u32x4g*)(tiles + off) = P.x[k]; *(u32x4g*)(tiles + SSM_TILE + off) = P.car[k]; *(u32x4g*)(tiles + 2 * SSM_TILE + off) = P.z[k];
    }
}
__device__ __forceinline__ void ssd_main_unit(const Params& p, int unit, char* smem) {
    const int tid = tid_op(), lane = tid & 63, w = tid >> 6, cL = lane & 15, gq = lane >> 4;
    const int g = unit & 1, c = (unit >> 1) & 15, b = unit >> 5;
    char* ws = p.ws;
    float* sAc = (float*)smem;
    float* sDt = sAc + 512;
    char* tiles = smem + 4096;
    const int tok0 = b * 2048 + c * 128;
    const int lt = (w < 4) ? w : 11 - w;
    const int ltok = tok0 + 16 * lt + cL;
    __syncthreads();
    SsdPair P;
    {
        const int row0 = tid >> 4, c16 = tid & 15;
        u32x4g bv[4], cv[4];
#pragma unroll
        for (int k = 0; k < 4; ++k) {
            const size_t go = (size_t)(tok0 + row0 + 32 * k) * 256 + g * 128 + c16 * 8;
            bv[k] = *(const u32x4g*)((const bf16_t*)(ws + O_BRM) + go); cv[k] = *(const u32x4g*)((const bf16_t*)(ws + O_CRM) + go);
        }
        const int hh = tid >> 7, l = tid & 127;
        const float av = ((const float*)(ws + O_ACUM))[(size_t)(b * 8 + 4 * g + hh) * 2048 + c * 128 + l];
        const float dv = ((const float*)(ws + O_DTF))[(size_t)(tok0 + l) * 8 + 4 * g + hh];
        ssd_pair_load(P, ws, b, c, g, 0, tid);
#pragma unroll
        for (int k = 0; k < 4; ++k) {
            const int off = ((row0 + 32 * k) * 136 + c16 * 8) * 2;
            *(u32x4g*)(tiles + off) = bv[k]; *(u32x4g*)(tiles + SSM_TILE + off) = cv[k];
        }
        sAc[tid] = av; sDt[tid] = dv;
    }
    __syncthreads();
    bf16x8 Cq[4];
    f32x4 cbT[8];
    {
        const bf16_t* sB = (const bf16_t*)tiles; const bf16_t* sC = (const bf16_t*)(tiles + SSM_TILE);
#pragma unroll
        for (int ks = 0; ks < 4; ++ks) Cq[ks] = ld8(sC + (16 * lt + cL) * 136 + ks * 32 + gq * 8);
#pragma unroll
        for (int st = 0; st < 8; ++st) {
            cbT[st] = (f32x4){0.f, 0.f, 0.f, 0.f};
            if (st <= lt) {
#pragma unroll
                for (int ks = 0; ks < 4; ++ks) cbT[st] = mfma16(ld8(sB + (16 * st + cL) * 136 + ks * 32 + gq * 8), Cq[ks], cbT[st]);
            }
        }
    }
    __syncthreads();
    float ssq = 0.f;
    u32x4g y0raw[4] = {};
    float* s_rstd = (float*)(tiles + 3 * SSM_TILE);
    bf16_t* mix = (bf16_t*)(ws + O_MIX);
#pragma unroll
    for (int pr = 0; pr < 2; ++pr) {
        if (pr) {
            __syncthreads();
#pragma unroll
            for (int k = 0; k < 4; ++k) y0raw[k] = *(const u32x4g*)(tiles + 2 * SSM_TILE + (((tid >> 4) + 32 * k) * 136 + (tid & 15) * 8) * 2);
            __syncthreads();
        }
        ssd_pair_store(P, tiles, tid);
        if (pr == 0) ssd_pair_load(P, ws, b, c, g, 1, tid);
        __syncthreads();
        const bf16_t* sX = (const bf16_t*)tiles; const bf16_t* sCar = (const bf16_t*)(tiles + SSM_TILE); const bf16_t* sZ = (const bf16_t*)(tiles + 2 * SSM_TILE);
#pragma unroll 1
        for (int h2 = 0; h2 < 2; ++h2) {
            const int hh = 2 * pr + h2, h = 4 * g + hh;
            const float* ac = sAc + hh * 128; const float* dtl = sDt + hh * 128;
            const float al = ac[16 * lt + cL];
            const bf16_t* xh = sX + h2 * 64 * 136; const bf16_t* carh = sCar + h2 * 64 * 136;
            f32x4 acc1[4], acc2[4];
#pragma unroll
            for (int i = 0; i < 4; ++i) { acc1[i] = (f32x4){0.f, 0.f, 0.f, 0.f}; acc2[i] = (f32x4){0.f, 0.f, 0.f, 0.f}; }
#pragma unroll
            for (int kk = 0; kk < 4; ++kk) {
                if (2 * kk <= lt) {
                    float mv[8];
#pragma unroll
                    for (int half = 0; half < 2; ++half) {
                        const int st = 2 * kk + half;
#pragma unroll
                        for (int r = 0; r < 4; ++r) {
                            const int sl = 16 * st + 4 * gq + r;
                            float v = 0.f;
                            if (st <= lt && sl <= 16 * lt + cL) v = cbT[st][r] * __expf(al - ac[sl]) * dtl[sl];
                            mv[half * 4 + r] = v;
                        }
                    }
                    const bf16x8 mf = __builtin_bit_cast(bf16x8, (u32x4g){pack2(mv[0], mv[1]), pack2(mv[2], mv[3]), pack2(mv[4], mv[5]), pack2(mv[6], mv[7])});
#pragma unroll
                    for (int pt = 0; pt < 4; ++pt) {
                        const bf16_t* xr = xh + (16 * pt + cL) * 136 + 32 * kk + 4 * gq;
                        acc1[pt] = mfma16(cat4(*(const bf16x4*)xr, *(const bf16x4*)(xr + 16)), mf, acc1[pt]);
                    }
                }
            }
#pragma unroll
            for (int ks = 0; ks < 4; ++ks)
#pragma unroll
                for (int pt = 0; pt < 4; ++pt) acc2[pt] = mfma16(ld8(carh + (16 * pt + cL) * 136 + ks * 32 + gq * 8), Cq[ks], acc2[pt]);
            const float el = __expf(al), dsk = p.d_skip[h];
#pragma unroll
            for (int pt = 0; pt < 4; ++pt) {
                const uint2 zz = *(const uint2*)(sZ + (16 * lt + cL) * 136 + h2 * 64 + 16 * pt + 4 * gq);
                const float zf[4] = {bf2f((bf16_t)(zz.x & 0xFFFF)), bf2f((bf16_t)(zz.x >> 16)), bf2f((bf16_t)(zz.y & 0xFFFF)), bf2f((bf16_t)(zz.y >> 16))};
                float yv[4];
#pragma unroll
                for (int r = 0; r < 4; ++r) {
                    const float xs = bf2f(xh[(16 * pt + 4 * gq + r) * 136 + 16 * lt + cL]);
                    float t = acc1[pt][r] + el * acc2[pt][r] + xs * dsk;
                    t *= silu_f(zf[r]);
                    yv[r] = bf2f(f2bf(t)); ssq += t * t;
                }
                *(uint2*)((bf16_t*)(tiles + 2 * SSM_TILE) + (16 * lt + cL) * 136 + h2 * 64 + 16 * pt + 4 * gq) = make_uint2(pack2(yv[0], yv[1]), pack2(yv[2], yv[3]));
            }
        }
    }
    ssq = sum_x32(sum_x16(ssq));
    if (gq == 0) s_rstd[16 * lt + cL] = rsqrtf(ssq * (1.f / 256.f) + LN_EPS);
    __syncthreads();
    {
        const int row0 = tid >> 4, c16 = tid & 15;
#pragma unroll
        for (int pr = 0; pr < 2; ++pr) {
            const int ch = (4 * g + 2 * pr) * 64 + c16 * 8;
            const float4 n0 = *(const float4*)(p.norm_w + ch), n1 = *(const float4*)(p.norm_w + ch + 4);
#pragma unroll
            for (int k = 0; k < 4; ++k) {
                const int row = row0 + 32 * k;
                const u32x4g y = pr ? *(const u32x4g*)(tiles + 2 * SSM_TILE + (row * 136 + c16 * 8) * 2) : y0raw[k];
                const float rs = s_rstd[row];
                u32x4g o;
                o.x = pack2(__uint_as_float(y.x << 16) * rs * n0.x, __uint_as_float(y.x & 0xFFFF0000u) * rs * n0.y);
                o.y = pack2(__uint_as_float(y.y << 16) * rs * n0.z, __uint_as_float(y.y & 0xFFFF0000u) * rs * n0.w);
                o.z = pack2(__uint_as_float(y.z << 16) * rs * n1.x, __uint_as_float(y.z & 0xFFFF0000u) * rs * n1.y);
                o.w = pack2(__uint_as_float(y.w << 16) * rs * n1.z, __uint_as_float(y.w & 0xFFFF0000u) * rs * n1.w);
                *(u32x4g*)(mix + (size_t)(tok0 + row) * 1024 + 512 + ch) = o;
            }
        }
    }
}

__device__ __forceinline__ void phase2(const Params& p, char* smem, int which = 3) {
    const int G = gridDim.x;
    if (which & 2) for (int u = blockIdx.x; u < 256; u += G) ssd_prep_unit(p, u, smem);
    if (which & 1) for (int k = 0; k * G < 1024; ++k) {
        const int u = k * G + ((k & 1) ? (G - 1 - (int)blockIdx.x) : (int)blockIdx.x);
        if (u < 1024) indexer_unit(p, u, smem);
    }
}
__device__ __forceinline__ void phase3(const Params& p, char* smem, int which = 3) {
    const int G = gridDim.x;
    for (int k = 0; k * G < 512 + 256; ++k) {
        const int u = k * G + ((k & 1) ? (G - 1 - (int)blockIdx.x) : (int)blockIdx.x);
        if (u >= 512 + 256) continue;
        if (u < 256) { if (which & 1) ssd_main_unit(p, u, smem); } else { if (which & 2) attn_unit2(p, u - 256, smem); }
    }
}

struct OutEpi {
    const float* x; float* y;
    __device__ __forceinline__ void operator()(const f32x4 (&acc)[4][4], int mb, int nb, int lane, char* lds) const {
        const int c = lane & 15, g = lane >> 4;
        float* L = (float*)lds;
#pragma unroll
        for (int half = 0; half < 2; ++half) {
#pragma unroll
            for (int mi2 = 0; mi2 < 2; ++mi2)
#pragma unroll
                for (int r = 0; r < 4; ++r)
#pragma unroll
                    for (int ni = 0; ni < 4; ++ni) L[(16 * mi2 + 4 * g + r) * 68 + 16 * ni + c] = acc[2 * half + mi2][ni][r];
#pragma unroll
            for (int i = 0; i < 8; ++i) {
                const int row = 4 * i + g;
                const float4 a = *(const float4*)(L + row * 68 + 4 * c);
                const size_t o = (size_t)(mb + 32 * half + row) * 1024 + nb + 4 * c;
                const float4 xv = *(const float4*)(x + o);
                *(float4*)(y + o) = make_float4(ALPHA * xv.x + a.x, ALPHA * xv.y + a.y, ALPHA * xv.z + a.z, ALPHA * xv.w + a.w);
            }
        }
    }
};
__device__ __forceinline__ void phase4(const Params& p, char* smem, const XcdMap xm) {
    pg8::Gemm g{(const bf16_t*)(p.ws + O_MIX), (const bf16_t*)(p.ws + O_WOUT_T), NTOK, 1024, 1024};
    pg8::StaticOrder S; S.init(NTOK, 1024, (int)gridDim.x, (int)blockIdx.x);
    pg8::EpiResInPlace E{(bf16_t*)(p.ws + O_HB), 1024, ALPHA};
    pg8::gemm_phase<pg8::EpiResInPlace, pg8::StaticOrder, false>((PG8_LAS unsigned char*)smem, g, S, E, nullptr);
}

__device__ __forceinline__ void phase5(const Params& p, int chain_row0) {
    const int lane = tid_op() & 63, w = tid_op() >> 6;
    bf16_t* hb = (bf16_t*)(p.ws + O_HB);
    const int rbeg = chain_row0 >= 0 ? chain_row0 + w : (int)blockIdx.x * 8 + w, rend = chain_row0 >= 0 ? chain_row0 + 64 : NTOK, rstep = chain_row0 >= 0 ? 8 : (int)gridDim.x * 8;
    for (int row = rbeg; row < rend; row += rstep) {
        bf16_t* yr = hb + (size_t)row * 1024 + 8 * lane;
        float v[16]; float s = 0.f;
#pragma unroll
        for (int j = 0; j < 2; ++j) {
            const uint4 r = *(const uint4*)(yr + 512 * j);
            const unsigned rw[4] = {r.x, r.y, r.z, r.w};
#pragma unroll
            for (int k = 0; k < 4; ++k) { v[8 * j + 2 * k] = __uint_as_float(rw[k] << 16); v[8 * j + 2 * k + 1] = __uint_as_float(rw[k] & 0xFFFF0000u); }
        }
#pragma unroll
        for (int k = 0; k < 16; ++k) s += v[k];
        const float mean = wave_sum(s) * (1.f / 1024.f);
        float q = 0.f;
#pragma unroll
        for (int k = 0; k < 16; ++k) { const float a = v[k] - mean; q += a * a; }
        const float rstd = rsqrtf(wave_sum(q) * (1.f / 1024.f) + LN_EPS);
        float o[16]; float am = 0.f;
#pragma unroll
        for (int j = 0; j < 2; ++j) {
            const int col = 8 * lane + 512 * j;
            const float4 g0 = *(const float4*)(p.ln1_g + col), g1 = *(const float4*)(p.ln1_g + col + 4), b0 = *(const float4*)(p.ln1_b + col), b1 = *(const float4*)(p.ln1_b + col + 4);
            const float gg[8] = {g0.x, g0.y, g0.z, g0.w, g1.x, g1.y, g1.z, g1.w}, bb[8] = {b0.x, b0.y, b0.z, b0.w, b1.x, b1.y, b1.z, b1.w};
#pragma unroll
            for (int k = 0; k < 8; ++k) { o[8 * j + k] = (v[8 * j + k] - mean) * rstd * gg[k] + bb[k]; am = fmaxf(am, fabsf(o[8 * j + k])); }
            *(uint4*)(yr + 512 * j) = make_uint4(pack2(o[8 * j], o[8 * j + 1]), pack2(o[8 * j + 2], o[8 * j + 3]), pack2(o[8 * j + 4], o[8 * j + 5]), pack2(o[8 * j + 6], o[8 * j + 7]));
        }
        am = wave_max(am);
        const float step = quant_step(am), inv = step > 0.f ? 1.f / step : 0.f;
        unsigned* h8 = (unsigned*)(p.ws + O_H8) + (size_t)row * 256;
#pragma unroll
        for (int j = 0; j < 2; ++j)
#pragma unroll
            for (int mh = 0; mh < 2; ++mh)
                h8[4 * ((2 * lane + mh) & 63) + 2 * j + (lane >> 5)] = quant4_i8(o[8 * j + 4 * mh], o[8 * j + 4 * mh + 1], o[8 * j + 4 * mh + 2], o[8 * j + 4 * mh + 3], inv);
        if (lane == 0) ((float*)(p.ws + O_HS))[row] = step;
    }
    convert_rows<false>(p, (size_t)V_EARLY * 256, (size_t)16384 * 256, (int)blockIdx.x, (int)gridDim.x);
}

struct QpEpi {
    bf16_t* qp;
    __device__ __forceinline__ void operator()(const f32x4 (&acc)[4][4], int mb, int nb, int lane, char* lds) const {
        const int c = lane & 15, g = lane >> 4;
        bf16_t* L = (bf16_t*)lds;
#pragma unroll
        for (int mi = 0; mi < 4; ++mi)
#pragma unroll
            for (int r = 0; r < 4; ++r)
#pragma unroll
                for (int ni = 0; ni < 4; ++ni) L[(16 * mi + 4 * g + r) * 72 + 16 * ni + c] = f2bf(acc[mi][ni][r]);
#pragma unroll
        for (int i = 0; i < 8; ++i) {
            const int row = 8 * i + (lane >> 3), cc = (lane & 7) * 8;
            *(uint4*)(qp + (size_t)(mb + row) * 2048 + nb + cc) = *(const uint4*)(L + row * 72 + cc);
        }
    }
};
__device__ __forceinline__ void phase6(const Params& p, char* smem, const XcdMap xm) {
    pg8::Gemm g{(const bf16_t*)(p.ws + O_HB), (const bf16_t*)(p.ws + O_WQ_T), NTOK, 2048, 1024};
    pg8::StaticOrder S; S.init(NTOK, 2048, (int)gridDim.x, (int)blockIdx.x);
    pg8::EpiBf16Plain E{(bf16_t*)(p.ws + O_QP), 2048};
    pg8::gemm_phase<pg8::EpiBf16Plain, pg8::StaticOrder, false>((PG8_LAS unsigned char*)smem, g, S, E, nullptr);
}

__device__ __forceinline__ float gelu_erf(float d) {
    const float x = d * 0.70710678118654752f, ax = fabsf(x);
    const float t = __builtin_amdgcn_rcpf(1.f + 0.3275911f * ax);
    const float poly = t * (0.254829592f + t * (-0.284496736f + t * (1.421413741f + t * (-1.453152027f + t * 1.061405429f))));
    const float r = 1.f - poly * __builtin_amdgcn_exp2f(-ax * ax * 1.4426950408889634f);
    return 0.5f * d * (1.f + copysignf(r, x));
}
typedef unsigned u32x4n __attribute__((ext_vector_type(4)));
__device__ __forceinline__ long lo64n(const u32x4n v) { return (long)(((unsigned long long)v.y << 32) | v.x); }
__device__ __forceinline__ long hi64n(const u32x4n v) { return (long)(((unsigned long long)v.w << 32) | v.z); }
struct P8aRows { u32x4n a[16]; };
__device__ __forceinline__ void p8a_load(P8aRows& R, const unsigned char* U8, int eid, int gq) {
    const unsigned char* urow = U8 + (size_t)eid * 1024 + 16 * gq;
#pragma unroll
    for (int j = 0; j < 16; ++j) R.a[j] = *(const u32x4n*)(urow + 64 * j);
}
__device__ __forceinline__ float p8_dot16(const u32x4n r, const f32x2 (&hp)[8]) {
    f32x2 acc = __builtin_amdgcn_cvt_pk_f32_fp8((int)r.x, false) * hp[0];
    acc += __builtin_amdgcn_cvt_pk_f32_fp8((int)r.x, true) * hp[1];
    acc += __builtin_amdgcn_cvt_pk_f32_fp8((int)r.y, false) * hp[2]; acc += __builtin_amdgcn_cvt_pk_f32_fp8((int)r.y, true) * hp[3];
    acc += __builtin_amdgcn_cvt_pk_f32_fp8((int)r.z, false) * hp[4]; acc += __builtin_amdgcn_cvt_pk_f32_fp8((int)r.z, true) * hp[5];
    acc += __builtin_amdgcn_cvt_pk_f32_fp8((int)r.w, false) * hp[6]; acc += __builtin_amdgcn_cvt_pk_f32_fp8((int)r.w, true) * hp[7];
    return acc.x + acc.y;
}
__device__ __forceinline__ float p8_reduce16(const float (&p)[16], int lane) {
    float q[8], r4[4], t2[2];
#pragma unroll
    for (int k = 0; k < 8; ++k) { const u32x2_t sw = __builtin_amdgcn_permlane32_swap(__float_as_uint(p[k]), __float_as_uint(p[k + 8]), false, false); q[k] = __uint_as_float(sw.x) + __uint_as_float(sw.y); }
#pragma unroll
    for (int k = 0; k < 4; ++k) { const u32x2_t sw = __builtin_amdgcn_permlane16_swap(__float_as_uint(q[k]), __float_as_uint(q[k + 4]), false, false); r4[k] = __uint_as_float(sw.x) + __uint_as_float(sw.y); }
    const bool b3 = (lane & 8) != 0, b2 = (lane & 4) != 0;
#pragma unroll
    for (int k = 0; k < 2; ++k) { const float snd = b3 ? r4[k] : r4[k + 2], keep = b3 ? r4[k + 2] : r4[k]; t2[k] = keep + dpp_f<0x128, 0xF, true>(snd); }
    const float snd = b2 ? t2[0] : t2[1], keep = b2 ? t2[1] : t2[0];
    float z = keep + dpp_f<0x141, 0xF, true>(snd);
    z += dpp_f<0xB1, 0xF, true>(z); z += dpp_f<0x4E, 0xF, true>(z);
    return z;
}
__device__ __forceinline__ int p8_reduce16_i(const int (&p)[16], int lane) {
    int q[8], r4[4], t2[2];
#pragma unroll
    for (int k = 0; k < 8; ++k) { const u32x2_t sw = __builtin_amdgcn_permlane32_swap((unsigned)p[k], (unsigned)p[k + 8], false, false); q[k] = (int)(sw.x + sw.y); }
#pragma unroll
    for (int k = 0; k < 4; ++k) { const u32x2_t sw = __builtin_amdgcn_permlane16_swap((unsigned)q[k], (unsigned)q[k + 4], false, false); r4[k] = (int)(sw.x + sw.y); }
    const bool b3 = (lane & 8) != 0, b2 = (lane & 4) != 0;
#pragma unroll
    for (int k = 0; k < 2; ++k) { const int snd = b3 ? r4[k] : r4[k + 2], keep = b3 ? r4[k + 2] : r4[k]; t2[k] = keep + dpp_i<0x128, 0xF, true>(snd); }
    const int snd = b2 ? t2[0] : t2[1], keep = b2 ? t2[1] : t2[0];
    int z = keep + dpp_i<0x141, 0xF, true>(snd);
    z += dpp_i<0xB1, 0xF, true>(z); z += dpp_i<0x4E, 0xF, true>(z);
    return z;
}
__constant__ unsigned char CAND_I[64] = {0,0,0,0,0,0,0,0,0,0,0,0,0,0,0,0, 1,1,1,1,1,1,1,1, 2,2,2,2,2, 3,3,3,3, 4,4,4, 5,5, 6,6, 7,7, 8,9,10,11,12,13,14,15, 0,0,0,0,0,0,0,0,0,0,0,0,0,0};
__constant__ unsigned char CAND_J[64] = {0,1,2,3,4,5,6,7,8,9,10,11,12,13,14,15, 0,1,2,3,4,5,6,7, 0,1,2,3,4, 0,1,2,3, 0,1,2, 0,1, 0,1, 0,1, 0,0,0,0,0,0,0,0, 0,0,0,0,0,0,0,0,0,0,0,0,0,0};
__device__ __forceinline__ unsigned rowmax_u(unsigned v) { return row_max_u(v); }
struct PeerSel { int ev[4]; float gv[4]; };
struct P7Q { bf16x8 a[2][4]; };
__device__ __forceinline__ void p7_load_q(const Params& p, int wunit, P7Q& q) {
    const int lane = tid_op() & 63, cL = lane & 15, gq = lane >> 4;
    const int tok0 = (wunit >> 3) * 16, h = wunit & 7;
    const bf16_t* QP = (const bf16_t*)(p.ws + O_QP);
#pragma unroll
    for (int half = 0; half < 2; ++half)
#pragma unroll
        for (int ks = 0; ks < 4; ++ks) q.a[half][ks] = ld8(QP + (size_t)(tok0 + cL) * 2048 + h * 256 + half * 128 + ks * 32 + gq * 8);
}
__device__ __forceinline__ PeerSel peer_select_q(const P7Q& qf, const char* ktab) {
    const int lane = tid_op() & 63, cL = lane & 15, rowbase = lane & 48;
    unsigned top[2][4];
#pragma unroll
    for (int half = 0; half < 2; ++half) {
        const bf16_t* KB = (const bf16_t*)(ktab + half * (128 * 144 * 2));
        const int gq = lane >> 4;
        bf16x8 a[4];
#pragma unroll
        for (int ks = 0; ks < 4; ++ks) a[ks] = qf.a[half][ks];
        unsigned pk[8][4];
#pragma unroll
        for (int nt = 0; nt < 8; ++nt) {
            f32x4 acc = (f32x4){0.f, 0.f, 0.f, 0.f};
#pragma unroll
            for (int ks = 0; ks < 4; ++ks) acc = mfma16(a[ks], ld8(KB + (16 * nt + cL) * 144 + ks * 32 + gq * 8), acc);
#pragma unroll
            for (int r = 0; r < 4; ++r) pk[nt][r] = (f2sort(acc[r]) & ~0x7Fu) | (unsigned)(127 - (16 * nt + cL));
        }
#pragma unroll
        for (int r = 0; r < 4; ++r) top[half][r] = 0u;
#define PS_CAS(A, B) { const unsigned hi_ = max(pk[A][r], pk[B][r]), lo_ = min(pk[A][r], pk[B][r]); pk[A][r] = hi_; pk[B][r] = lo_; }
#pragma unroll
        for (int r = 0; r < 4; ++r) {
            PS_CAS(0, 1) PS_CAS(2, 3) PS_CAS(4, 5) PS_CAS(6, 7)
            PS_CAS(0, 2) PS_CAS(1, 3) PS_CAS(4, 6) PS_CAS(5, 7)
            PS_CAS(1, 2) PS_CAS(5, 6)
            PS_CAS(0, 4) PS_CAS(1, 5) PS_CAS(2, 6) PS_CAS(3, 7)
            PS_CAS(2, 4) PS_CAS(3, 5)
            PS_CAS(1, 2) PS_CAS(3, 4) PS_CAS(5, 6)
        }
#undef PS_CAS
        for (int it = 0; it < 8; ++it) {
#pragma unroll
            for (int r = 0; r < 4; ++r) {
                const unsigned gm = rowmax_u(pk[0][r]);
                if (cL == it) top[half][r] = gm;
                const bool pop = (pk[0][r] == gm);
#pragma unroll
                for (int nt = 0; nt < 7; ++nt) pk[nt][r] = pop ? pk[nt + 1][r] : pk[nt][r];
                pk[7][r] = pop ? 0u : pk[7][r];
            }
        }
#pragma unroll
        for (int it = 8; it < 16; ++it) {
#pragma unroll
            for (int r = 0; r < 4; ++r) {
                const unsigned gm = rowmax_u(pk[0][r]);
                if (cL == it) top[half][r] = gm;
                const bool pop = (pk[0][r] == gm);
#pragma unroll
                for (int nt = 0; nt < 15 - it; ++nt) pk[nt][r] = pop ? pk[nt + 1][r] : pk[nt][r];
            }
        }
    }
    unsigned ck[4][4];
#pragma unroll
    for (int s = 0; s < 4; ++s) {
        const int q = s * 16 + cL; const int ci = CAND_I[q], cj = CAND_J[q];
#pragma unroll
        for (int r = 0; r < 4; ++r) {
            const unsigned t1 = (unsigned)__shfl((int)top[0][r], rowbase + ci), t2 = (unsigned)__shfl((int)top[1][r], rowbase + cj);
            const float f = sort2f(t1 & ~0x7Fu) + sort2f(t2 & ~0x7Fu);
            ck[s][r] = (q < 50) ? ((f2sort(f) & ~0x3Fu) | (unsigned)(63 - q)) : 0u;
        }
    }
    unsigned best[4] = {0u, 0u, 0u, 0u};
#define PS_CAS(A, B) { const unsigned hi_ = max(ck[A][r], ck[B][r]), lo_ = min(ck[A][r], ck[B][r]); ck[A][r] = hi_; ck[B][r] = lo_; }
#pragma unroll
    for (int r = 0; r < 4; ++r) { PS_CAS(0, 1) PS_CAS(2, 3) PS_CAS(0, 2) PS_CAS(1, 3) PS_CAS(1, 2) }
#undef PS_CAS
    for (int it = 0; it < 12; ++it) {
#pragma unroll
        for (int r = 0; r < 4; ++r) {
            const unsigned gm = rowmax_u(ck[0][r]);
            if (cL == it) best[r] = gm;
            const bool pop = (ck[0][r] == gm);
            ck[0][r] = pop ? ck[1][r] : ck[0][r]; ck[1][r] = pop ? ck[2][r] : ck[1][r]; ck[2][r] = pop ? ck[3][r] : ck[2][r]; ck[3][r] = pop ? 0u : ck[3][r];
        }
    }
#pragma unroll
    for (int it = 12; it < 16; ++it) {
#pragma unroll
        for (int r = 0; r < 4; ++r) {
            const unsigned gm = rowmax_u(ck[0][r]);
            if (cL == it) best[r] = gm;
            const bool pop = (ck[0][r] == gm);
#pragma unroll
            for (int d = 0; d < 15 - it; ++d) ck[d][r] = pop ? ck[d + 1][r] : ck[d][r];
        }
    }
    PeerSel S_;
#pragma unroll
    for (int r = 0; r < 4; ++r) {
        const float fv = sort2f(best[r] & ~0x3Fu);
        const int q = 63 - (int)(best[r] & 63u);
        const int ci = CAND_I[q], cj = CAND_J[q];
        const unsigned t1 = (unsigned)__shfl((int)top[0][r], rowbase + ci), t2 = (unsigned)__shfl((int)top[1][r], rowbase + cj);
        S_.ev[r] = (127 - (int)(t1 & 127u)) * 128 + (127 - (int)(t2 & 127u));
        const float mx = __shfl(fv, rowbase);
        const float ex = __expf(fv - mx);
        const float sm = row_sum(ex);
        S_.gv[r] = ex / sm;
    }
    return S_;
}
#define PU_ROWEID(SEL, TT, I) __builtin_amdgcn_readlane(SEL.ev[(TT) & 3], 16 * ((TT) >> 2) + (I))
__device__ __forceinline__ void peer_blocks(const Params& p, int wunit, const PeerSel& S_, const PeerSel& N_, bool has_next, P8aRows& R0, P8aRows& R1, const bf16_t* us) {
    const int lane = tid_op() & 63;
    const int tok0 = (wunit >> 3) * 16, h = wunit & 7;
    char* ws = p.ws;
    const unsigned char* U8 = (const unsigned char*)(ws + O_U8) + 16 * lane;
    const unsigned char* H8 = (const unsigned char*)(ws + O_H8) + (size_t)tok0 * 1024 + 16 * lane;
    const float* HS = (const float*)(ws + O_HS) + tok0;
    unsigned* ACT = (unsigned*)(ws + O_ACT) + (size_t)tok0 * 128 + h * 16;
#define PU_STEP(RC, TT) { \
        const u32x4n hq = *(const u32x4n*)(H8 + (TT) * 1024); const float hs_ = HS[TT]; \
        int pp[16]; \
        _Pragma("unroll") for (int i = 0; i < 16; ++i) { \
            int d_ = __builtin_amdgcn_sdot4((int)RC.a[i].x, (int)hq.x, 0, false); d_ = __builtin_amdgcn_sdot4((int)RC.a[i].y, (int)hq.y, d_, false); \
            d_ = __builtin_amdgcn_sdot4((int)RC.a[i].z, (int)hq.z, d_, false); d_ = __builtin_amdgcn_sdot4((int)RC.a[i].w, (int)hq.w, d_, false); pp[i] = d_; \
            if ((TT) < 14) RC.a[i] = *(const u32x4n*)(U8 + (size_t)PU_ROWEID(S_, ((TT) + 2) & 15, i) * 1024); \
            else if (has_next) RC.a[i] = *(const u32x4n*)(U8 + (size_t)PU_ROWEID(N_, ((TT) + 2) & 15, i) * 1024); } \
        const int src_ = 16 * ((TT) >> 2) + (lane >> 2); \
        const float gt_ = __shfl(S_.gv[(TT) & 3], src_); const int ei_ = __shfl(S_.ev[(TT) & 3], src_); \
        const float dot = (float)p8_reduce16_i(pp, lane) * (hs_ * bf2f(us[ei_])); \
        const float act_ = gelu_erf(dot) * gt_; \
        if ((lane & 3) == 0) ACT[(TT) * 128 + (lane >> 2)] = (unsigned)ei_ | ((unsigned)f2bf(act_) << 16); }
    PU_STEP(R0, 0) PU_STEP(R1, 1) PU_STEP(R0, 2) PU_STEP(R1, 3) PU_STEP(R0, 4) PU_STEP(R1, 5) PU_STEP(R0, 6) PU_STEP(R1, 7)
    PU_STEP(R0, 8) PU_STEP(R1, 9) PU_STEP(R0, 10) PU_STEP(R1, 11) PU_STEP(R0, 12) PU_STEP(R1, 13) PU_STEP(R0, 14) PU_STEP(R1, 15)
#undef PU_STEP
}
__device__ __forceinline__ void p7_stage(const Params& p, char* smem) {
    const int tid = tid_op();
    __syncthreads();
#pragma unroll
    for (int k = 0; k < 8; ++k) {
        const int c = tid + 512 * k, half = c >> 11, row = (c >> 4) & 127, ch = c & 15;
        *(uint4*)(smem + half * (128 * 144 * 2) + row * 288 + ch * 16) = *(const uint4*)(p.ws + (half ? O_K2B : O_K1B) + (size_t)row * 256 + ch * 16);
    }
#pragma unroll
    for (int k = 0; k < 4; ++k) *(uint4*)(smem + 2 * 128 * 144 * 2 + (tid + 512 * k) * 16) = *(const uint4*)(p.ws + O_US + (size_t)(tid + 512 * k) * 16);
    __syncthreads();
}
__device__ __forceinline__ PeerSel peer_select(const Params& p, int wunit, const char* ktab) { P7Q q; p7_load_q(p, wunit, q); return peer_select_q(q, ktab); }
__device__ __forceinline__ void p7_select_store(const Params& p, char* smem, int u, const P7Q& qf) {
    const int lane = tid_op() & 63, cL = lane & 15, gq = lane >> 4;
    const PeerSel s0 = peer_select_q(qf, smem);
    const int tok0 = (u >> 3) * 16, h = u & 7;
    unsigned* EG = (unsigned*)(p.ws + O_EV);
#pragma unroll
    for (int r = 0; r < 4; ++r) EG[(size_t)(tok0 + 4 * gq + r) * 128 + h * 16 + cL] = (unsigned)s0.ev[r] | ((unsigned)f2bf(s0.gv[r]) << 16);
}
__device__ __forceinline__ int p7b_filter(unsigned w0, unsigned w1, int sl, uint2* lstp, int lane) {
    const int e0 = (int)(w0 & 0x3FFFu), e1 = (int)(w1 & 0x3FFFu);
    const float g0 = __uint_as_float(w0 & 0xFFFF0000u), g1 = __uint_as_float(w1 & 0xFFFF0000u);
    const bool m0b = (e0 >> 11) == sl, m1b = (e1 >> 11) == sl;
    const unsigned long long m0 = __ballot(m0b), m1 = __ballot(m1b);
    const int n0 = (int)__builtin_popcountll(m0), n = n0 + (int)__builtin_popcountll(m1);
    const int r0 = (int)__builtin_amdgcn_mbcnt_hi((unsigned)(m0 >> 32), __builtin_amdgcn_mbcnt_lo((unsigned)m0, 0u));
    const int r1 = n0 + (int)__builtin_amdgcn_mbcnt_hi((unsigned)(m1 >> 32), __builtin_amdgcn_mbcnt_lo((unsigned)m1, 0u));
    const int below = (int)__builtin_popcountll(__ballot((e0 >> 11) < sl)) + (int)__builtin_popcountll(__ballot((e1 >> 11) < sl));
    asm volatile("" ::: "memory");
    if (m0b) lstp[r0] = make_uint2((unsigned)e0 | ((unsigned)(below + r0) << 16), __float_as_uint(g0));
    if (m1b) lstp[r1] = make_uint2((unsigned)e1 | ((unsigned)(below + r1) << 16), __float_as_uint(g1));
    const int np = (n + 3) & ~3;
    if (lane < np - n) lstp[n + lane] = make_uint2((unsigned)(sl * 2048) | 0x80000000u, 0u);
    asm volatile("s_waitcnt lgkmcnt(0)" ::: "memory");
    return np;
}
struct TokRaw { unsigned w0, w1; u32x4n hq; float hs; };
__device__ __forceinline__ void p7b_load_raw(TokRaw& T, int t, int lane, unsigned loff, const unsigned* EG, const unsigned char* H8, const float* HS) {
    T.w0 = EG[(size_t)t * 128 + lane]; T.w1 = EG[(size_t)t * 128 + 64 + lane];
    T.hq = *(const u32x4n*)(H8 + (size_t)t * 1024 + loff); T.hs = HS[t];
}
__device__ __forceinline__ void phase7b_sliced(const Params& p, const XcdMap xm, char* smem) {
    const int lane = tid_op() & 63, w = __builtin_amdgcn_readfirstlane(tid_op() >> 6);
    char* ws = p.ws;
    const unsigned char* U8 = (const unsigned char*)(ws + O_U8);
    const unsigned loff = 16u * (unsigned)lane;
    const bf16_t* us = (const bf16_t*)(smem + 2 * 128 * 144 * 2);
    uint2* lst = (uint2*)(smem + 2 * 128 * 144 * 2 + 32768) + w * 256;
    const unsigned* EG = (const unsigned*)(ws + O_EV);
    const unsigned char* H8 = (const unsigned char*)(ws + O_H8); const float* HS = (const float*)(ws + O_HS);
    unsigned* ACT = (unsigned*)(ws + O_ACT);
    const int sl = xm.slice, stride = xm.nloc * 8;
    const int t0 = xm.rank * 8 + w;
    if (t0 >= NTOK) return;
    const int ntok = (NTOK - t0 + stride - 1) / stride;
#define P7B_TOK(J) (t0 + stride * (((J) < ntok) ? (J) : ntok - 1))
    uint2* lA = lst; uint2* lB = lst + 128;
    int tA = t0, tB = P7B_TOK(1);
    TokRaw ra, rb;
    p7b_load_raw(ra, tA, lane, loff, EG, H8, HS); p7b_load_raw(rb, tB, lane, loff, EG, H8, HS);
    TokRaw cur[4], nxt[4];
#pragma unroll
    for (int k = 0; k < 4; ++k) p7b_load_raw(cur[k], P7B_TOK(2 + k), lane, loff, EG, H8, HS);
    int nA = p7b_filter(ra.w0, ra.w1, sl, lA, lane);
    int nB = (ntok > 1) ? p7b_filter(rb.w0, rb.w1, sl, lB, lane) : 0;
    u32x4n hqA = ra.hq, hqB = rb.hq; float hsA = ra.hs, hsB = rb.hs;
    int jA = 0, offA = 0;
    for (int g = 0; jA < ntok; ++g) {
#pragma unroll
        for (int k = 0; k < 4; ++k) {
            if (jA >= ntok) { p7b_load_raw(nxt[k], P7B_TOK(4 * g + 6 + k), lane, loff, EG, H8, HS); }
            else {
                int cntB = 0;
                bool need = true;
                for (;;) {
                    const int remA = nA - offA, cntA = remA < 16 ? remA : 16;
                    cntB = (cntA < 16) ? ((16 - cntA < nB) ? 16 - cntA : nB) : 0;
                    const int cnt = cntA + cntB;
                    if (cnt > 0) {
                        const int li = lane & 15;
                        const uint2 eA = lA[(li < cntA) ? offA + li : 0], eB = lB[(li >= cntA && li < cnt) ? li - cntA : 0];
                        const unsigned ent_l = (li < cntA) ? eA.x : ((li < cnt) ? eB.x : (unsigned)(sl * 2048));
                        const unsigned gat_l = (li < cntA) ? eA.y : eB.y;
                        P8aRows R;
#pragma unroll
                        for (int i = 0; i < 16; ++i) R.a[i] = *(const u32x4n*)(U8 + (size_t)(__builtin_amdgcn_readlane((int)ent_l, i) & 0xFFFF) * 1024 + loff);
                        if (need) { p7b_load_raw(nxt[k], P7B_TOK(4 * g + 6 + k), lane, loff, EG, H8, HS); need = false; }
                        const int ri = lane >> 2;
                        const unsigned ent = (unsigned)__shfl((int)ent_l, ri);
                        const float gate = __uint_as_float((unsigned)__shfl((int)gat_l, ri));
                        const int eid = (int)(ent & 0xFFFFu), slot = (int)((ent >> 16) & 0x7FFFu);
                        const int tr = (ri < cntA) ? tA : tB;
                        int pp[16];
#pragma unroll
                        for (int q4 = 0; q4 < 4; ++q4) {
                            if (4 * q4 < cntA) {
#pragma unroll
                                for (int i = 4 * q4; i < 4 * q4 + 4; ++i) {
                                    int d_ = __builtin_amdgcn_sdot4((int)R.a[i].x, (int)hqA.x, 0, false); d_ = __builtin_amdgcn_sdot4((int)R.a[i].y, (int)hqA.y, d_, false);
                                    d_ = __builtin_amdgcn_sdot4((int)R.a[i].z, (int)hqA.z, d_, false); d_ = __builtin_amdgcn_sdot4((int)R.a[i].w, (int)hqA.w, d_, false); pp[i] = d_;
                                }
                            } else {
#pragma unroll
                                for (int i = 4 * q4; i < 4 * q4 + 4; ++i) {
                                    int d_ = __builtin_amdgcn_sdot4((int)R.a[i].x, (int)hqB.x, 0, false); d_ = __builtin_amdgcn_sdot4((int)R.a[i].y, (int)hqB.y, d_, false);
                                    d_ = __builtin_amdgcn_sdot4((int)R.a[i].z, (int)hqB.z, d_, false); d_ = __builtin_amdgcn_sdot4((int)R.a[i].w, (int)hqB.w, d_, false); pp[i] = d_;
                                }
                            }
#pragma unroll
                            for (int i = 4 * q4; i < 4 * q4 + 4; ++i) asm volatile("" : "+v"(pp[i]));
                        }
                        const float hsr = (ri < cntA) ? hsA : hsB;
                        const float dot = (float)p8_reduce16_i(pp, lane) * (hsr * bf2f(us[eid]));
                        const float act_ = gelu_erf(dot) * gate;
                        if ((lane & 3) == 0 && ri < cnt && (int)ent >= 0) ACT[(size_t)tr * 128 + slot] = (unsigned)eid | ((unsigned)f2bf(act_) << 16);
                    }
                    if (cntA < 16) break;
                    offA += 16;
                }
                if (need) p7b_load_raw(nxt[k], P7B_TOK(4 * g + 6 + k), lane, loff, EG, H8, HS);
                uint2* lt = lA; lA = lB; lB = lt;
                tA = tB; nA = nB; offA = cntB; hqA = hqB; hsA = hsB;
                ++jA;
                const int jn = 4 * g + k + 2;
                tB = P7B_TOK(jn);
                asm volatile("" ::: "memory");
                nB = p7b_filter(cur[k].w0, cur[k].w1, sl, lB, lane);
                if (jn >= ntok) nB = 0;
                hqB = cur[k].hq; hsB = cur[k].hs;
            }
        }
#pragma unroll
        for (int k = 0; k < 4; ++k) cur[k] = nxt[k];
    }
#undef P7B_TOK
}
__device__ __forceinline__ void phase7(const Params& p, char* smem, int chain_tg0) {
    const int lane = tid_op() & 63;
    const int w = __builtin_amdgcn_readfirstlane(tid_op() >> 6);
    const int stride = gridDim.x * 8;
    const unsigned char* U8 = (const unsigned char*)(p.ws + O_U8) + 16 * lane;
    {
        const int tid = tid_op();
        __syncthreads();
#pragma unroll
        for (int k = 0; k < 8; ++k) {
            const int c = tid + 512 * k, half = c >> 11, row = (c >> 4) & 127, ch = c & 15;
            *(uint4*)(smem + half * (128 * 144 * 2) + row * 288 + ch * 16) = *(const uint4*)(p.ws + (half ? O_K2B : O_K1B) + (size_t)row * 256 + ch * 16);
        }
#pragma unroll
        for (int k = 0; k < 4; ++k) *(uint4*)(smem + 2 * 128 * 144 * 2 + (tid + 512 * k) * 16) = *(const uint4*)(p.ws + O_US + (size_t)(tid + 512 * k) * 16);
        __syncthreads();
    }
    const int ubeg = chain_tg0 >= 0 ? chain_tg0 * 8 + w : (int)blockIdx.x * 8 + w, uend = chain_tg0 >= 0 ? (chain_tg0 + 4) * 8 : 8192, ustep = chain_tg0 >= 0 ? 8 : stride;
    for (int u = ubeg; u < uend; u += ustep) {
        const PeerSel s0 = peer_select(p, u, smem);
        P8aRows R0, R1;
#pragma unroll
        for (int i = 0; i < 16; ++i) { R0.a[i] = *(const u32x4n*)(U8 + (size_t)PU_ROWEID(s0, 0, i) * 1024); R1.a[i] = *(const u32x4n*)(U8 + (size_t)PU_ROWEID(s0, 1, i) * 1024); }
        peer_blocks(p, u, s0, s0, false, R0, R1, (const bf16_t*)(smem + 2 * 128 * 144 * 2));
    }
}
#undef PU_ROWEID

__device__ __forceinline__ float dot16_fp8(const uint4& r, const float (&hv)[16]) {
    const f32x2 a0 = __builtin_amdgcn_cvt_pk_f32_fp8((int)r.x, false), a1 = __builtin_amdgcn_cvt_pk_f32_fp8((int)r.x, true);
    const f32x2 b0 = __builtin_amdgcn_cvt_pk_f32_fp8((int)r.y, false), b1 = __builtin_amdgcn_cvt_pk_f32_fp8((int)r.y, true);
    const f32x2 c0 = __builtin_amdgcn_cvt_pk_f32_fp8((int)r.z, false), c1 = __builtin_amdgcn_cvt_pk_f32_fp8((int)r.z, true);
    const f32x2 d0 = __builtin_amdgcn_cvt_pk_f32_fp8((int)r.w, false), d1 = __builtin_amdgcn_cvt_pk_f32_fp8((int)r.w, true);
    return (hv[0] * a0.x + hv[1] * a0.y + hv[2] * a1.x + hv[3] * a1.y) + (hv[4] * b0.x + hv[5] * b0.y + hv[6] * b1.x + hv[7] * b1.y)
         + (hv[8] * c0.x + hv[9] * c0.y + hv[10] * c1.x + hv[11] * c1.y) + (hv[12] * d0.x + hv[13] * d0.y + hv[14] * d1.x + hv[15] * d1.y);
}
struct P8bRows { u32x4n v[8]; };
struct P8bMeta { u32x4n m[4]; };
__device__ __forceinline__ void p8b_meta(P8bMeta& M, const unsigned* ACT, int row, int e8) {
#pragma unroll
    for (int k = 0; k < 4; ++k) M.m[k] = *(const u32x4n*)(ACT + (size_t)row * 128 + e8 * 16 + 4 * k);
}
template <int HALF> __device__ __forceinline__ void p8b_load(P8bRows& R, const P8bMeta& M, const unsigned char* V8, unsigned c8off) {
#pragma unroll
    for (int k = 0; k < 2; ++k) {
        const u32x4n mm = M.m[2 * HALF + k];
        R.v[4 * k + 0] = *(const u32x4n*)(V8 + (((mm.x & 0xFFFFu) << 7) | c8off)); R.v[4 * k + 1] = *(const u32x4n*)(V8 + (((mm.y & 0xFFFFu) << 7) | c8off));
        R.v[4 * k + 2] = *(const u32x4n*)(V8 + (((mm.z & 0xFFFFu) << 7) | c8off)); R.v[4 * k + 3] = *(const u32x4n*)(V8 + (((mm.w & 0xFFFFu) << 7) | c8off));
    }
}
template <int HALF> __device__ __forceinline__ void p8b_accum(f32x2 (&acc)[8], const P8bRows& R, const P8bMeta& M) {
#pragma unroll
    for (int k = 0; k < 2; ++k) {
        const u32x4n mm = M.m[2 * HALF + k];
        const unsigned mw[4] = {mm.x, mm.y, mm.z, mm.w};
#pragma unroll
        for (int q = 0; q < 4; ++q) {
            const float a1 = __uint_as_float(mw[q] & 0xFFFF0000u);
            const f32x2 av = (f32x2){a1, a1};
            const u32x4n x = R.v[4 * k + q];
            acc[0] += av * __builtin_amdgcn_cvt_pk_f32_fp8((int)x.x, false); acc[1] += av * __builtin_amdgcn_cvt_pk_f32_fp8((int)x.x, true);
            acc[2] += av * __builtin_amdgcn_cvt_pk_f32_fp8((int)x.y, false); acc[3] += av * __builtin_amdgcn_cvt_pk_f32_fp8((int)x.y, true);
            acc[4] += av * __builtin_amdgcn_cvt_pk_f32_fp8((int)x.z, false); acc[5] += av * __builtin_amdgcn_cvt_pk_f32_fp8((int)x.z, true);
            acc[6] += av * __builtin_amdgcn_cvt_pk_f32_fp8((int)x.w, false); acc[7] += av * __builtin_amdgcn_cvt_pk_f32_fp8((int)x.w, true);
        }
    }
}
__device__ __forceinline__ void p8b_store(const f32x2 (&acc)[8], bf16_t* hr2, unsigned hw, int lane) {
    float r[16];
#pragma unroll
    for (int j = 0; j < 8; ++j) { r[2 * j] = acc[j].x; r[2 * j + 1] = acc[j].y; }
    float q[8], r4[4], t2[2];
#pragma unroll
    for (int k = 0; k < 8; ++k) { const u32x2_t sw = __builtin_amdgcn_permlane32_swap(__float_as_uint(r[k]), __float_as_uint(r[k + 8]), false, false); q[k] = __uint_as_float(sw.x) + __uint_as_float(sw.y); }
#pragma unroll
    for (int k = 0; k < 4; ++k) { const u32x2_t sw = __builtin_amdgcn_permlane16_swap(__float_as_uint(q[k]), __float_as_uint(q[k + 4]), false, false); r4[k] = __uint_as_float(sw.x) + __uint_as_float(sw.y); }
    const bool b3 = (lane & 8) != 0;
#pragma unroll
    for (int k = 0; k < 2; ++k) { const float snd = b3 ? r4[k] : r4[k + 2], keep = b3 ? r4[k + 2] : r4[k]; t2[k] = keep + dpp_f<0x128, 0xF, true>(snd); }
    *(unsigned*)hr2 = pack2(ALPHA * __uint_as_float(hw << 16) + t2[0], ALPHA * __uint_as_float(hw & 0xFFFF0000u) + t2[1]);
}
__device__ __forceinline__ void phase8b(const Params& p, const XcdMap xm, bf16_t* outp) {
    const int lane = tid_op() & 63, w = tid_op() >> 6, e8 = lane >> 3, c8 = lane & 7;
    char* ws = p.ws;
    const unsigned char* V8 = (const unsigned char*)(ws + O_V8) + (size_t)xm.slice * 16384 * 128;
    const unsigned c8off = 16u * (unsigned)c8;
    const unsigned* ACT = (const unsigned*)(ws + O_ACT);
    const int stride = xm.nloc * 8;
    int row = xm.rank * 8 + w;
    if (row >= NTOK) return;
    bf16_t* const hbase = outp + xm.slice * 128 + 16 * c8 + 2 * e8;
    const bf16_t* const hbb = (const bf16_t*)(ws + O_HB) + xm.slice * 128 + 16 * c8 + 2 * e8;
    P8bMeta Mc, Mn; P8bRows Ra, Rb;
    p8b_meta(Mc, ACT, row, e8);
    p8b_meta(Mn, ACT, (row + stride < NTOK) ? row + stride : row, e8);
    p8b_load<0>(Ra, Mc, V8, c8off);
    for (; row < NTOK; row += stride) {
        f32x2 acc[8];
#pragma unroll
        for (int j = 0; j < 8; ++j) acc[j] = (f32x2){0.f, 0.f};
        const unsigned hw = *(const unsigned*)(hbb + (size_t)row * 1024);
        p8b_load<1>(Rb, Mc, V8, c8off);
        p8b_accum<0>(acc, Ra, Mc);
        p8b_load<0>(Ra, Mn, V8, c8off);
        p8b_accum<1>(acc, Rb, Mc);
        p8b_store(acc, hbase + (size_t)row * 1024, hw, lane);
        Mc = Mn;
        const int r2 = row + 2 * stride;
        p8b_meta(Mn, ACT, r2 < NTOK ? r2 : row, e8);
    }
}
__device__ __forceinline__ void phase8c(const Params& p) {
    const int lane = tid_op() & 63, w = tid_op() >> 6;
    for (int row = blockIdx.x * 8 + w; row < NTOK; row += gridDim.x * 8) {
        float* yr = p.out + (size_t)row * 1024;
        const bf16_t* yb = (const bf16_t*)(p.ws + O_QP) + (size_t)row * 1024;
        float4 v[4]; float s = 0.f;
#pragma unroll
        for (int j = 0; j < 4; ++j) {
            const uint2 u = *(const uint2*)(yb + 4 * lane + 256 * j);
            v[j] = make_float4(__uint_as_float(u.x << 16), __uint_as_float(u.x & 0xFFFF0000u), __uint_as_float(u.y << 16), __uint_as_float(u.y & 0xFFFF0000u));
            s += v[j].x + v[j].y + v[j].z + v[j].w;
        }
        const float mean = wave_sum(s) * (1.f / 1024.f);
        float q = 0.f;
#pragma unroll
        for (int j = 0; j < 4; ++j) { const float a = v[j].x - mean, b2 = v[j].y - mean, c2 = v[j].z - mean, d = v[j].w - mean; q += a * a + b2 * b2 + c2 * c2 + d * d; }
        const float rstd = rsqrtf(wave_sum(q) * (1.f / 1024.f) + LN_EPS);
#pragma unroll
        for (int j = 0; j < 4; ++j) {
            const int col = 4 * lane + 256 * j;
            const float4 gg = *(const float4*)(p.ln2_g + col), bb = *(const float4*)(p.ln2_b + col);
            float4 o;
            o.x = (v[j].x - mean) * rstd * gg.x + bb.x; o.y = (v[j].y - mean) * rstd * gg.y + bb.y; o.z = (v[j].z - mean) * rstd * gg.z + bb.z; o.w = (v[j].w - mean) * rstd * gg.w + bb.w;
            *(float4*)(yr + col) = o;
        }
    }
}

#if ONE_LAUNCH
__global__ void __launch_bounds__(512, 2) fwd_megakernel(Params p) {
    __shared__ __attribute__((aligned(16))) char smem[SMEM_BYTES];
    cg::grid_group grid = cg::this_grid();
    volatile LAS unsigned* st = (volatile LAS unsigned*)(smem + SMEM_BYTES - 16);
    if (threadIdx.x == 0) { st[0] = 0u; st[1] = 0u; st[2] = 0u; st[3] = 0u; }
    __syncthreads();
    const XcdBarrier xb = xcd_barrier_post((unsigned*)(p.ws + O_BAR), st);
    if (p.use_cg) grid.sync();
#define GRID_BAR() xcd_barrier(xb)
#ifndef DUP
#define DUP -1
#endif
#define PP (params_reload())
#define RUNPH(k, call) { int n_ = (DUP == k) ? 2 : 1; asm volatile("" : "+s"(n_)); _Pragma("unroll 1") for (int i_ = 0; i_ < n_; ++i_) { call; GRID_BAR(); } }
    RUNPH(0, phase0(PP))
    XcdMap xm;
    if (st[2]) { xm.slice = (int)xb.x; xm.rank = (int)st[3]; xm.nloc = (int)st[0]; }
    else { xm.slice = blockIdx.x & 7; xm.rank = blockIdx.x >> 3; xm.nloc = gridDim.x >> 3; }
    xm.slice = __builtin_amdgcn_readfirstlane(xm.slice); xm.rank = __builtin_amdgcn_readfirstlane(xm.rank); xm.nloc = __builtin_amdgcn_readfirstlane(xm.nloc);
    asm volatile("" : "+s"(xm.slice), "+s"(xm.rank), "+s"(xm.nloc));
    RUNPH(1, phase1(PP, smem, xm))
    RUNPH(2, phase2(PP, smem))
    if (DUP == 20) { int wh_ = 1; asm volatile("" : "+s"(wh_)); phase2(PP, smem, wh_); GRID_BAR(); }
    if (DUP == 21) { int wh_ = 2; asm volatile("" : "+s"(wh_)); phase2(PP, smem, wh_); GRID_BAR(); }
    phase2c(PP); GRID_BAR();
    RUNPH(3, phase3(PP, smem))
    if (DUP == 30) { int wh_ = 1; asm volatile("" : "+s"(wh_)); phase3(PP, smem, wh_); GRID_BAR(); }
    if (DUP == 31) { int wh_ = 2; asm volatile("" : "+s"(wh_)); phase3(PP, smem, wh_); GRID_BAR(); }
    if (DUP == -1 && gridDim.x == 256) {
        const int c_ = (int)blockIdx.x, pm_ = 8 * (c_ & 7) + ((c_ >> 3) & 7), q_ = c_ >> 6;
        unsigned* bar_ = (unsigned*)(PP.ws + O_BAR);
        phase4(PP, smem, xm); panel_sync(bar_, pm_, 4u);
        phase5(PP, 256 * pm_ + 64 * q_); panel_sync(bar_, pm_, 8u);
        phase6(PP, smem, xm); panel_sync(bar_, pm_, 12u);
        {
            const int tg0_ = 16 * pm_ + 4 * q_, w_ = __builtin_amdgcn_readfirstlane(tid_op() >> 6);
            const Params P7 = PP;
            P7Q qc_, qn_;
            p7_load_q(P7, tg0_ * 8 + w_, qc_);
            p7_stage(P7, smem);
#pragma unroll
            for (int k = 0; k < 4; ++k) {
                if (k < 3) p7_load_q(P7, (tg0_ + k + 1) * 8 + w_, qn_);
                p7_select_store(P7, smem, (tg0_ + k) * 8 + w_, qc_);
                if (k < 3) qc_ = qn_;
            }
            GRID_BAR();
            phase7b_sliced(PP, xm, smem); GRID_BAR();
        }
    } else {
        RUNPH(4, phase4(PP, smem, xm))
        phase5(PP, -1); GRID_BAR();
        RUNPH(6, phase6(PP, smem, xm))
        RUNPH(7, phase7(PP, smem, -1))
    }
#ifdef SCRAMBLE
    { const int x_ = xm.slice, r_ = xm.rank; xm.slice = (x_ + r_) & 7; xm.rank = (r_ >> 3) * 8 + x_; xm.nloc = 32; }
#endif
    if (DUP == 9) { phase8b(PP, xm, (bf16_t*)(PP.ws + O_QP + 32 * MB)); GRID_BAR(); }
    phase8b(PP, xm, (bf16_t*)(PP.ws + O_QP)); GRID_BAR();
    phase8c(PP);
}
#else
__global__ void __launch_bounds__(512, 2) k_phase0(Params p) { phase0(p); }
__global__ void __launch_bounds__(512, 2) k_phase1(Params p) { __shared__ __attribute__((aligned(16))) char smem[SMEM_BYTES]; XcdMap xm; xm.slice = blockIdx.x & 7; xm.rank = blockIdx.x >> 3; xm.nloc = gridDim.x >> 3; phase1(p, smem, xm); }
__global__ void __launch_bounds__(512, 2) k_phase2(Params p) { __shared__ __attribute__((aligned(16))) char smem[SMEM_BYTES]; phase2(p, smem); }
__global__ void __launch_bounds__(512, 2) k_phase2c(Params p) { phase2c(p); }
__global__ void __launch_bounds__(512, 2) k_phase3(Params p) { __shared__ __attribute__((aligned(16))) char smem[SMEM_BYTES]; phase3(p, smem); }
__global__ void __launch_bounds__(512, 2) k_phase4(Params p) { __shared__ __attribute__((aligned(16))) char smem[SMEM_BYTES]; XcdMap xm; xm.slice = blockIdx.x & 7; xm.rank = blockIdx.x >> 3; xm.nloc = gridDim.x >> 3; phase4(p, smem, xm); }
__global__ void __launch_bounds__(512, 2) k_phase5(Params p) { phase5(p, -1); }
__global__ void __launch_bounds__(512, 2) k_phase6(Params p) { __shared__ __attribute__((aligned(16))) char smem[SMEM_BYTES]; XcdMap xm; xm.slice = blockIdx.x & 7; xm.rank = blockIdx.x >> 3; xm.nloc = gridDim.x >> 3; phase6(p, smem, xm); }
__global__ void __launch_bounds__(512, 2) k_phase7(Params p) { __shared__ __attribute__((aligned(16))) char smem_[SMEM_BYTES]; phase7(p, smem_, -1); }
__global__ void __launch_bounds__(512, 2) k_phase8b(Params p) { XcdMap xm; xm.slice = blockIdx.x & 7; xm.rank = blockIdx.x >> 3; xm.nloc = gridDim.x >> 3; phase8b(p, xm, p.out); }
__global__ void __launch_bounds__(512, 2) k_phase8c(Params p) { phase8c(p); }
#endif

extern "C" void kernel_launch(void* const* d_in, const int* in_sizes, int n_in, void* d_out, int out_size, void* d_ws, size_t ws_size, hipStream_t stream) {
    Params p{};
    p.x = (const float*)d_in[0]; p.pos = (const int*)d_in[1]; p.w_in = (const float*)d_in[2]; p.conv_w = (const float*)d_in[3]; p.conv_b = (const float*)d_in[4];
    p.dt_bias = (const float*)d_in[5]; p.a_log = (const float*)d_in[6]; p.d_skip = (const float*)d_in[7]; p.norm_w = (const float*)d_in[8]; p.w_out = (const float*)d_in[9];
    p.ln1_g = (const float*)d_in[10]; p.ln1_b = (const float*)d_in[11]; p.wq = (const float*)d_in[12]; p.k1 = (const float*)d_in[13]; p.k2 = (const float*)d_in[14];
    p.u = (const float*)d_in[15]; p.v = (const float*)d_in[16]; p.ln2_g = (const float*)d_in[17]; p.ln2_b = (const float*)d_in[18];
    p.out = (float*)d_out; p.ws = (char*)d_ws;
    if (ws_size < WS_NEEDED) { fprintf(stderr, "kernel_launch: workspace too small (%zu < %zu)\n", ws_size, (size_t)WS_NEEDED); return; }
#if ONE_LAUNCH
    static int grid_blocks = 0;
    if (!grid_blocks) {
        int dev = 0, cus = 0, per_cu = 0;
        hipGetDevice(&dev);
        hipDeviceGetAttribute(&cus, hipDeviceAttributeMultiprocessorCount, dev);
        hipOccupancyMaxActiveBlocksPerMultiprocessor(&per_cu, fwd_megakernel, 512, 0);
        if (per_cu > 1) per_cu = 1;
        if (per_cu < 1) per_cu = 1;
        grid_blocks = cus * per_cu;
    }
    (void)hipMemsetAsync((char*)d_ws + O_BAR, 0, (PCNT_WORD0 + PCNT_WORDS) * 4, stream);
    void* args[] = {&p};
    hipError_t e = hipLaunchCooperativeKernel((void*)fwd_megakernel, dim3(grid_blocks), dim3(512), args, 0, stream);
    if (e != hipSuccess) fprintf(stderr, "cooperative launch failed: %s (grid %d)\n", hipGetErrorString(e), grid_blocks);
#else
    const int G = 512;
    k_phase0<<<G, 512, 0, stream>>>(p);
    k_phase1<<<G, 512, 0, stream>>>(p);
    k_phase2<<<G, 512, 0, stream>>>(p);
    k_phase2c<<<G, 512, 0, stream>>>(p);
    k_phase3<<<G, 512, 0, stream>>>(p);
    k_phase4<<<G, 512, 0, stream>>>(p);
    k_phase5<<<G, 512, 0, stream>>>(p);
    k_phase6<<<G, 512, 0, stream>>>(p);
    k_phase7<<<G, 512, 0, stream>>>(p);
    k_phase8b<<<G, 512, 0, stream>>>(p);
    k_phase8c<<<G, 512, 0, stream>>>(p);
#endif
}
```
